# Optimizing an MI355X kernel written in HIP

```python
import math
import jax, jax.numpy as jnp
from jax import lax
import numpy as np

D_MODEL = 1024
BATCH = 4
SEQ = 8192
DEPTH = 1

CHUNK = 64
N_MEM = 256
D_MIX = D_MODEL
GLA_HEADS = 4
GLA_DV = (D_MIX // 2) // GLA_HEADS
GLA_DK = GLA_DV // 2
GLA_GATE_RANK = 16
GLA_GATE_TAU = 16.0
RET_HEADS = 4
RET_DV = (D_MIX // 2) // RET_HEADS
RET_DK = RET_DV // 2
RET_DECAY_EXP_LO = 5.0
RET_DECAY_EXP_HI = 12.0
ROPE_BASE = 10000.0
XATTN_HEADS = 4
XATTN_DH = D_MODEL // XATTN_HEADS
D_FF = 4 * D_MODEL
EPS = 1e-6
IN_SPLITS = (GLA_HEADS * GLA_DK, GLA_HEADS * GLA_DK, GLA_HEADS * GLA_DV, GLA_GATE_RANK, GLA_HEADS * GLA_DV,
             RET_HEADS * RET_DK, RET_HEADS * RET_DK, RET_HEADS * RET_DV, RET_HEADS * RET_DV)
D_IN_PROJ = sum(IN_SPLITS)

kernel_name = "hybrid_gla_retnet_parallel_heads"


def rmsnorm(x, g):
    xf = x.astype(jnp.float32)
    y = xf * lax.rsqrt(jnp.mean(xf * xf, axis=-1, keepdims=True) + EPS)
    return (y * g.astype(jnp.float32)).astype(x.dtype)


def group_norm(x, g):
    xf = x.astype(jnp.float32)
    mu = jnp.mean(xf, axis=-1, keepdims=True)
    var = jnp.mean(jnp.square(xf - mu), axis=-1, keepdims=True)
    return ((xf - mu) * lax.rsqrt(var + EPS) * g.astype(jnp.float32)).astype(x.dtype)


def to_chunks(t, heads, d):
    B, S = t.shape[0], t.shape[1]
    t = t.reshape(B, S // CHUNK, CHUNK, heads, d)
    return jnp.transpose(t, (0, 3, 1, 2, 4))


def from_chunks(t):
    B, H, N, C, d = t.shape
    return jnp.transpose(t, (0, 2, 3, 1, 4)).reshape(B, N * C, H, d)


def carry_states(decay, contrib):
    decay = jnp.broadcast_to(decay, contrib.shape[:-1] + (1,)).astype(contrib.dtype)
    def step(state, inp):
        dec, u = inp
        return dec * state + u, state
    s0 = jnp.zeros(contrib.shape[1:], contrib.dtype)
    _, s_prev = lax.scan(step, s0, (decay, contrib))
    return jnp.moveaxis(s_prev, 0, 2)


def gla_group(q, k, v, g_lr, w_gate, b_gate):
    log_a = jax.nn.log_sigmoid((g_lr @ w_gate + b_gate).astype(jnp.float32)) / GLA_GATE_TAU
    qc = to_chunks(q, GLA_HEADS, GLA_DK).astype(jnp.float32) * (GLA_DK ** -0.5)
    kc = to_chunks(k, GLA_HEADS, GLA_DK).astype(jnp.float32)
    vc = to_chunks(v, GLA_HEADS, GLA_DV).astype(jnp.float32)
    bcum = jnp.cumsum(to_chunks(log_a, GLA_HEADS, GLA_DK), axis=3)
    b_last = bcum[:, :, :, -1:, :]
    eb, ebi = jnp.exp(bcum), jnp.exp(-bcum)
    lower = jnp.tril(jnp.ones((CHUNK, CHUNK), dtype=bool))
    a_lo = jnp.einsum('bhnik,bhnjk->bhnij', qc * eb, kc * ebi)
    a_up = jnp.einsum('bhnik,bhnjk->bhnij', qc * ebi, kc * eb)
    attn = jnp.where(lower, a_lo, a_up)
    intra = jnp.einsum('bhnij,bhnjv->bhniv', attn, vc)
    contrib = jnp.einsum('bhnjk,bhnjv->bhnkv', kc * jnp.exp(b_last - bcum), vc)
    decay = jnp.moveaxis(jnp.exp(b_last[:, :, :, 0, :]), 2, 0)[..., None]
    s_prev = carry_states(decay, jnp.moveaxis(contrib, 2, 0))
    inter = jnp.einsum('bhnik,bhnkv->bhniv', qc * eb, s_prev)
    return from_chunks(intra + inter).astype(v.dtype)


def rope(t, cos, sin):
    half = t.shape[-1] // 2
    t1, t2 = t[..., :half], t[..., half:]
    c, s = cos[None, :, None, :], sin[None, :, None, :]
    return jnp.concatenate([t1 * c - t2 * s, t1 * s + t2 * c], axis=-1).astype(t.dtype)


def retention_group(q, k, v, cos, sin):
    B, S, _ = q.shape
    qh = rope(q.reshape(B, S, RET_HEADS, RET_DK).astype(jnp.float32), cos, sin)
    kh = rope(k.reshape(B, S, RET_HEADS, RET_DK).astype(jnp.float32), cos, sin) * (RET_DK ** -0.5)
    qc, kc = to_chunks(qh, RET_HEADS, RET_DK), to_chunks(kh, RET_HEADS, RET_DK)
    vc = to_chunks(v, RET_HEADS, RET_DV).astype(jnp.float32)
    gamma = 1.0 - jnp.exp2(-jnp.linspace(RET_DECAY_EXP_LO, RET_DECAY_EXP_HI, RET_HEADS, dtype=jnp.float32))
    log_g = jnp.log(gamma)
    pos = jnp.arange(CHUNK, dtype=jnp.float32)
    dmat = jnp.exp(jnp.abs(pos[:, None] - pos[None, :])[None] * log_g[:, None, None])
    scores = jnp.einsum('bhnik,bhnjk->bhnij', qc, kc) * dmat[None, :, None]
    intra = jnp.einsum('bhnij,bhnjv->bhniv', scores, vc)
    k_dec = jnp.exp((CHUNK - 1.0 - pos)[None, :] * log_g[:, None])
    contrib = jnp.einsum('bhnjk,bhnjv->bhnkv', kc * k_dec[None, :, None, :, None], vc)
    decay = jnp.exp(CHUNK * log_g)[None, None, :, None, None]
    s_prev = carry_states(decay, jnp.moveaxis(contrib, 2, 0))
    q_dec = jnp.exp((pos + 1.0)[None, :] * log_g[:, None])
    inter = jnp.einsum('bhnik,bhnkv->bhniv', qc, s_prev) * q_dec[None, :, None, :, None]
    return from_chunks(intra + inter).astype(v.dtype)


def parallel_mixer(xn, w_in, gla_w_gate, gla_b_gate, gla_norm_g, ret_norm_g, w_out, cos, sin):
    B, S, _ = xn.shape
    proj = xn @ w_in
    idx, acc = [], 0
    for sz in IN_SPLITS[:-1]:
        acc += sz
        idx.append(acc)
    gq, gk, gv, glr, gg, rq, rk, rv, rg = jnp.split(proj, idx, axis=-1)
    o_gla = gla_group(gq, gk, gv, glr, gla_w_gate, gla_b_gate)
    o_gla = rmsnorm(o_gla, gla_norm_g) * jax.nn.silu(gg.reshape(B, S, GLA_HEADS, GLA_DV))
    o_ret = retention_group(rq, rk, rv, cos, sin)
    o_ret = group_norm(o_ret, ret_norm_g) * jax.nn.silu(rg.reshape(B, S, RET_HEADS, RET_DV))
    y = jnp.concatenate([o_gla.reshape(B, S, -1), o_ret.reshape(B, S, -1)], axis=-1)
    return y @ w_out


def cross_attention(hn, mem_n, w_q, w_kv, w_o):
    B, S, _ = hn.shape
    M = mem_n.shape[1]
    q = (hn @ w_q).reshape(B, S, XATTN_HEADS, XATTN_DH)
    k, v = jnp.split(mem_n @ w_kv, 2, axis=-1)
    k = k.reshape(B, M, XATTN_HEADS, XATTN_DH)
    v = v.reshape(B, M, XATTN_HEADS, XATTN_DH)
    s = jnp.einsum('bshd,bmhd->bhsm', q, k).astype(jnp.float32) * (XATTN_DH ** -0.5)
    p = jax.nn.softmax(s, axis=-1).astype(v.dtype)
    o = jnp.einsum('bhsm,bmhd->bshd', p, v).reshape(B, S, D_MODEL)
    return o @ w_o


def squared_relu_mlp(hn, w1, w2):
    return jnp.square(jax.nn.relu(hn @ w1)) @ w2


def setup_inputs(seed: int = 0) -> dict:
    key = jax.random.key(seed)
    ks = jax.random.split(key, 20)

    def w(k, shape, fan_in):
        return jax.random.normal(k, shape, jnp.float32) * (fan_in ** -0.5)

    def gain(k, shape):
        return 1.0 + 0.02 * jax.random.normal(k, shape, jnp.float32)

    L = DEPTH
    return {
        "x": jax.random.normal(ks[0], (BATCH, SEQ, D_MODEL), jnp.float32),
        "mem": jax.random.normal(ks[1], (BATCH, N_MEM, D_MODEL), jnp.float32),
        "norm_mix_g": gain(ks[2], (L, D_MODEL)),
        "w_in": w(ks[3], (L, D_MODEL, D_IN_PROJ), D_MODEL),
        "gla_w_gate": w(ks[4], (L, GLA_GATE_RANK, GLA_HEADS * GLA_DK), GLA_GATE_RANK),
        "gla_b_gate": 0.01 * jax.random.normal(ks[5], (L, GLA_HEADS * GLA_DK), jnp.float32),
        "gla_norm_g": gain(ks[6], (L, GLA_HEADS, GLA_DV)),
        "ret_norm_g": gain(ks[7], (L, RET_HEADS, RET_DV)),
        "w_out": w(ks[8], (L, D_MIX, D_MODEL), D_MIX),
        "norm_x_g": gain(ks[9], (L, D_MODEL)),
        "norm_mem_g": gain(ks[10], (L, D_MODEL)),
        "xa_w_q": w(ks[11], (L, D_MODEL, D_MODEL), D_MODEL),
        "xa_w_kv": w(ks[12], (L, D_MODEL, 2 * D_MODEL), D_MODEL),
        "xa_w_o": w(ks[13], (L, D_MODEL, D_MODEL), D_MODEL),
        "norm_ffn_g": gain(ks[14], (L, D_MODEL)),
        "ffn_w1": w(ks[15], (L, D_MODEL, D_FF), D_MODEL),
        "ffn_w2": w(ks[16], (L, D_FF, D_MODEL), D_FF),
        "final_norm_g": gain(ks[17], (D_MODEL,)),
    }


def reference(x, mem, norm_mix_g, w_in, gla_w_gate, gla_b_gate, gla_norm_g, ret_norm_g, w_out,
              norm_x_g, norm_mem_g, xa_w_q, xa_w_kv, xa_w_o, norm_ffn_g, ffn_w1, ffn_w2, final_norm_g):
    S = x.shape[1]
    inv_freq = ROPE_BASE ** (-jnp.arange(0, RET_DK, 2, dtype=jnp.float32) / RET_DK)
    ang = jnp.arange(S, dtype=jnp.float32)[:, None] * inv_freq[None, :]
    cos, sin = jnp.cos(ang), jnp.sin(ang)
    h = x
    for l in range(DEPTH):
        h = h + parallel_mixer(rmsnorm(h, norm_mix_g[l]), w_in[l], gla_w_gate[l], gla_b_gate[l],
                               gla_norm_g[l], ret_norm_g[l], w_out[l], cos, sin)
        h = h + cross_attention(rmsnorm(h, norm_x_g[l]), rmsnorm(mem, norm_mem_g[l]),
                                xa_w_q[l], xa_w_kv[l], xa_w_o[l])
        h = h + squared_relu_mlp(rmsnorm(h, norm_ffn_g[l]), ffn_w1[l], ffn_w2[l])
    return rmsnorm(h, final_norm_g)
```

```cpp
#include <hip/hip_runtime.h>
#include <hip/hip_cooperative_groups.h>
#include <cstdio>
#include <cstdint>
namespace cg = cooperative_groups;
namespace pg8 {
#define PG8_LAS __attribute__((address_space(3)))
typedef unsigned short bf16_t;
typedef short bf16x8 __attribute__((ext_vector_type(8)));
typedef float f32x4 __attribute__((ext_vector_type(4)));
typedef unsigned u32x4 __attribute__((ext_vector_type(4)));
constexpr int BM = 256, BK = 64, HALF = 128, HTB = HALF * BK * 2  , STAGE_BYTES = 8 * HTB, NXCD = 8, WGM = 8;

__host__ __device__ __forceinline__ int lds_byte(int r, int c) { const int st = (r >> 4) * 2 + (c >> 5), rr = r & 15, cc = c & 31, ob = rr * 64 + cc * 2; return st * 1024 + (ob ^ (((ob >> 9) & 1) << 5)); }
__host__ __device__ __forceinline__ void stage_rc(int b, int& R, int& C) { const int st = b / 1024, sb = b % 1024, swz = sb ^ (((sb >> 9) & 1) << 5); R = (st >> 1) * 16 + swz / 64; C = (st & 1) * 32 + (swz % 64) / 2; }
__host__ __device__ __forceinline__ int perm32(int rho) { const int n = rho >> 4, i = rho & 15; return 8 * (i >> 2) + 4 * n + (i & 3); }

struct Unit { int pm, pn; };
struct Gemm { const bf16_t* A; const bf16_t* Bt; int M, N, K; };

struct StaticOrder {
    int nM, nN, nwg, G, c;
    __host__ __device__ void init(int M, int N, int G_, int c_) { nM = M / BM; nN = N / BM; nwg = nM * nN; G = G_; c = c_; }
    __host__ __device__ bool next(int i, Unit& u) const {
        const long L = (long)i * G + c; if (L >= nwg) return false;
        int wgid = (int)L; { const int q = nwg / NXCD, r = nwg % NXCD, xcd = wgid % NXCD, off = wgid / NXCD; wgid = (xcd < r ? xcd * (q + 1) : r * (q + 1) + (xcd - r) * q) + off; }
        const int nig = WGM * nN, gid = wgid / nig, fm = gid * WGM, gsz = (nM - fm) < WGM ? (nM - fm) : WGM;
        u.pm = fm + ((wgid % nig) % gsz); u.pn = (wgid % nig) / gsz; return true;
    }
    __device__ __forceinline__ void a_ready(const Unit&) const {}
    __device__ __forceinline__ void done(const Unit&) const {}
};

__device__ __forceinline__ unsigned cvt_pk_bf16(float lo, float hi) { unsigned r; asm volatile("v_cvt_pk_bf16_f32 %0, %1, %2" : "=v"(r) : "v"(lo), "v"(hi)); return r; }
typedef float f32x2 __attribute__((ext_vector_type(2)));
__device__ __forceinline__ f32x2 gelu_pk(f32x2 v) {
    const f32x2 av = __builtin_elementwise_abs(v), d = av * 0.2316418882f + 1.0f;
    f32x2 t; t.x = __builtin_amdgcn_rcpf(d.x); t.y = __builtin_amdgcn_rcpf(d.y);
    f32x2 q = t * 0.5307027145f + (-0.7265760135f); q = q * t + 0.7107068705f; q = q * t + (-0.142248368f); q = q * t + 0.127414796f; q = q * t;
    const f32x2 s = (v * v) * (-0.72134752044f);
    f32x2 e; e.x = __builtin_amdgcn_exp2f(s.x); e.y = __builtin_amdgcn_exp2f(s.y);
    const f32x2 m = v * (q * e), r = v - m;
    f32x2 o; o.x = v.x < 0.f ? m.x : r.x; o.y = v.y < 0.f ? m.y : r.y; return o;
}

template <int ACT  > struct EpiBf16 {
    static constexpr bool PERM = true, AFTER_DRAIN = false; static_assert(ACT == 0 || ACT == 1, "EpiBf16: ACT is 0 (none) or 1 (gelu_pk)");
    bf16_t* O; int ldc; const float* bias; int split_cols; size_t split_stride; float scale0;
    __device__ __forceinline__ void operator()(const f32x4 (&acc)[2][2][4][2], const Unit& u, int wr, int wc, int fr, int fq) const {
        const int row0 = u.pm * BM + wr * 64 + fr; int colt = u.pn * BM; bf16_t* base = O;
        float sc = 1.f; if (split_cols) { const int t = colt / split_cols; base += (size_t)t * split_stride; colt -= t * split_cols; if (t == 0) sc = scale0; }
        const int col0 = colt + wc * 32 + 8 * fq, bcol0 = u.pn * BM + wc * 32 + 8 * fq;
        f32x4 bv[2][2];
#pragma unroll
        for (int bj = 0; bj < 2; ++bj)
#pragma unroll
            for (int n = 0; n < 2; ++n) bv[bj][n] = bias ? *(const f32x4*)(bias + bcol0 + bj * HALF + 4 * n) : (f32x4){0.f, 0.f, 0.f, 0.f};
#pragma unroll
        for (int ai = 0; ai < 2; ++ai)
#pragma unroll
            for (int m = 0; m < 4; ++m) { bf16_t* rowp = base + (size_t)(row0 + ai * HALF + m * 16) * ldc + col0;
#pragma unroll
                for (int bj = 0; bj < 2; ++bj) { f32x4 v0 = acc[ai][bj][m][0] + bv[bj][0], v1 = acc[ai][bj][m][1] + bv[bj][1];
                    if (ACT == 1) { f32x2 a = gelu_pk((f32x2){v0[0], v0[1]}), b = gelu_pk((f32x2){v0[2], v0[3]}), c = gelu_pk((f32x2){v1[0], v1[1]}), d = gelu_pk((f32x2){v1[2], v1[3]});
                        v0 = (f32x4){a.x, a.y, b.x, b.y}; v1 = (f32x4){c.x, c.y, d.x, d.y}; }
                    v0 = v0 * sc; v1 = v1 * sc; u32x4 w; w.x = cvt_pk_bf16(v0[0], v0[1]); w.y = cvt_pk_bf16(v0[2], v0[3]); w.z = cvt_pk_bf16(v1[0], v1[1]); w.w = cvt_pk_bf16(v1[2], v1[3]);
                    *(u32x4*)(rowp + bj * HALF) = w; } }
    }
};

struct PanelStats {
    unsigned* xbuf;
    unsigned* cnt;
    unsigned* tmo;
    int ntn; float eps;
    unsigned code;
    __device__ __forceinline__ bool run(const f32x4 (&v)[2][2][4][2], const Unit& u, int wr, int wc, int fr, int fq, PG8_LAS unsigned char* lds, int wid, int lane) const {
        typedef float f32x2v __attribute__((ext_vector_type(2)));
        PG8_LAS f32x2v* P = (PG8_LAS f32x2v*)lds;
        PG8_LAS f32x2v* S = (PG8_LAS f32x2v*)(lds + 8192);
        PG8_LAS unsigned* flag = (PG8_LAS unsigned*)(lds + 8192 + 2048);
#pragma unroll
        for (int ai = 0; ai < 2; ++ai)
#pragma unroll
            for (int m = 0; m < 4; ++m) {
                float s = 0.f;
#pragma unroll
                for (int bj = 0; bj < 2; ++bj)
#pragma unroll
                    for (int n = 0; n < 2; ++n) { const f32x4 x = v[ai][bj][m][n]; s += (x[0] + x[1]) + (x[2] + x[3]); }
                s += __shfl_xor(s, 16); s += __shfl_xor(s, 32);
                const float mw = s * (1.0f / 64.0f); float q = 0.f;
#pragma unroll
                for (int bj = 0; bj < 2; ++bj)
#pragma unroll
                    for (int n = 0; n < 2; ++n) { const f32x4 d = v[ai][bj][m][n] - mw; q += (d[0] * d[0] + d[1] * d[1]) + (d[2] * d[2] + d[3] * d[3]); }
                q += __shfl_xor(q, 16); q += __shfl_xor(q, 32);
                if (fq == 0) P[(ai * HALF + wr * 64 + m * 16 + fr) * 4 + wc] = (f32x2v){mw, q};
            }
        asm volatile("s_waitcnt lgkmcnt(0)" ::: "memory"); __builtin_amdgcn_s_barrier(); asm volatile("" ::: "memory");
#if defined(BROKEN_EXCHANGE_NO_WAIT)
#warning BROKEN CONTROL BUILD: the row-statistics exchange does not wait; results are wrong by design
        if (blockIdx.x >= 64) { const long long t0_ = clock64(); while (clock64() - t0_ < 60000) __builtin_amdgcn_s_sleep(8); }
#endif
        const int row = wid * 32 + (lane & 31);
        if (lane < 32) {
            const f32x2v a = P[row * 4 + 0], b = P[row * 4 + 1], c = P[row * 4 + 2], d = P[row * 4 + 3];
            const float mt = (a.x + b.x + c.x + d.x) * 0.25f;
            const float da = a.x - mt, db = b.x - mt, dc = c.x - mt, dd = d.x - mt;
            const float m2 = (a.y + b.y) + (c.y + d.y) + 64.0f * ((da * da + db * db) + (dc * dc + dd * dd));
            unsigned long long* slot = (unsigned long long*)xbuf + ((size_t)(u.pm * BM + row) * 4 + u.pn);
            __hip_atomic_store(slot, ((unsigned long long)__float_as_uint(m2) << 32) | __float_as_uint(mt), __ATOMIC_RELAXED, __HIP_MEMORY_SCOPE_AGENT);
        }
        asm volatile("s_waitcnt vmcnt(0)" ::: "memory");
        if (lane == 0) __hip_atomic_fetch_add(cnt + 64 * u.pm, 1u, __ATOMIC_RELAXED, __HIP_MEMORY_SCOPE_AGENT);
        if (wid == 0) {
            bool dead = false; const unsigned long long t0 = __builtin_amdgcn_s_memrealtime(); const unsigned want = 8u * (unsigned)ntn;
            for (;;) {
#if defined(BROKEN_EXCHANGE_NO_WAIT)
                break;
#endif
                if ((unsigned)__builtin_amdgcn_readfirstlane(__hip_atomic_load(cnt + 64 * u.pm, __ATOMIC_RELAXED, __HIP_MEMORY_SCOPE_AGENT)) >= want) break;
                if (__builtin_amdgcn_s_memrealtime() - t0 > 2000000ull) {
                    if (lane == 0) { unsigned expect = 0u; __hip_atomic_compare_exchange_strong(tmo + 1, &expect, code | (unsigned)(u.pm & 0xff), __ATOMIC_RELAXED, __ATOMIC_RELAXED, __HIP_MEMORY_SCOPE_AGENT);
                                     __hip_atomic_store(tmo, 1u, __ATOMIC_RELAXED, __HIP_MEMORY_SCOPE_AGENT); }
                    dead = true; break; }
                __builtin_amdgcn_s_sleep(2);
            }
            __builtin_amdgcn_fence(__ATOMIC_ACQUIRE, "agent");
            if (lane == 0) flag[0] = dead ? 1u : 0u;
        }
        asm volatile("s_waitcnt vmcnt(0) lgkmcnt(0)" ::: "memory"); __builtin_amdgcn_s_barrier(); asm volatile("" ::: "memory");
        const bool bad = flag[0] != 0u;
        if (lane < 32) {
            const unsigned long long* slot = (const unsigned long long*)xbuf + (size_t)(u.pm * BM + row) * 4; float mt[4], m2[4]; float ms = 0.f;
#pragma unroll
            for (int t = 0; t < 4; ++t) { if (t < ntn) { const unsigned long long w = __hip_atomic_load(slot + t, __ATOMIC_RELAXED, __HIP_MEMORY_SCOPE_AGENT); mt[t] = __uint_as_float((unsigned)w); m2[t] = __uint_as_float((unsigned)(w >> 32)); } else { mt[t] = 0.f; m2[t] = 0.f; } ms += mt[t]; }
            const float mean = ms / (float)ntn; float q = 0.f;
#pragma unroll
            for (int t = 0; t < 4; ++t) if (t < ntn) { const float dm = mt[t] - mean; q += m2[t] + 256.0f * dm * dm; }
            S[row] = (f32x2v){mean, 1.0f / sqrtf(q / (256.0f * (float)ntn) + eps)};
        }
        asm volatile("s_waitcnt lgkmcnt(0)" ::: "memory"); __builtin_amdgcn_s_barrier(); asm volatile("" ::: "memory");
        return bad;
    }
};
struct EpiLnRes {
    static constexpr bool PERM = false, AFTER_DRAIN = true;
    const float* base; float* out; int ldc; const float* bias; PanelStats st; unsigned poison;
    __device__ __forceinline__ void fused(f32x4 (&acc)[2][2][4][2], const Unit& u, int wr, int wc, int fr, int fq, PG8_LAS unsigned char* lds, int wid, int lane) const {
        typedef float f32x2v __attribute__((ext_vector_type(2)));
        const PG8_LAS f32x2v* S = (const PG8_LAS f32x2v*)(lds + 8192);
        const int col0 = u.pn * BM + wc * 32 + 4 * fq;
#pragma unroll
        for (int bj = 0; bj < 2; ++bj)
#pragma unroll
            for (int n = 0; n < 2; ++n) { const f32x4 bv = bias ? *(const f32x4*)(bias + col0 + bj * HALF + n * 16) : (f32x4){0.f, 0.f, 0.f, 0.f};
#pragma unroll
                for (int ai = 0; ai < 2; ++ai)
#pragma unroll
                    for (int m = 0; m < 4; ++m) acc[ai][bj][m][n] += bv; }
        f32x4 pre[4][2][2];
#pragma unroll
        for (int m = 0; m < 4; ++m) { const size_t off = (size_t)(u.pm * BM + wr * 64 + m * 16 + fr) * ldc + col0;
#pragma unroll
            for (int bj = 0; bj < 2; ++bj)
#pragma unroll
                for (int n = 0; n < 2; ++n) pre[m][bj][n] = *(const f32x4*)(base + off + bj * HALF + n * 16); }
        const bool bad = st.run(acc, u, wr, wc, fr, fq, lds, wid, lane) || poison != 0u;
        const float qnan = __builtin_nanf("");
#pragma unroll
        for (int ai = 0; ai < 2; ++ai)
#pragma unroll
            for (int m = 0; m < 4; ++m) { const int r = ai * HALF + wr * 64 + m * 16 + fr; const f32x2v sr = S[r]; const size_t off = (size_t)(u.pm * BM + r) * ldc + col0;
#pragma unroll
                for (int bj = 0; bj < 2; ++bj)
#pragma unroll
                    for (int n = 0; n < 2; ++n) { const f32x4 bs = ai == 0 ? pre[m][bj][n] : *(const f32x4*)(base + off + bj * HALF + n * 16); f32x4 o = bs + (acc[ai][bj][m][n] - sr.x) * sr.y;
                        if (bad) o = (f32x4){qnan, qnan, qnan, qnan}; *(f32x4*)(out + off + bj * HALF + n * 16) = o; }
                if (m & 1) asm volatile("" ::: "memory"); }
    }
};
struct EpiLnResLn {
    static constexpr bool PERM = false, AFTER_DRAIN = true;
    const float* base; float* out; bf16_t* xn; int ldc; const float* bias; PanelStats st1, st2; unsigned poison;
    __device__ __forceinline__ void fused(f32x4 (&acc)[2][2][4][2], const Unit& u, int wr, int wc, int fr, int fq, PG8_LAS unsigned char* lds, int wid, int lane) const {
        typedef float f32x2v __attribute__((ext_vector_type(2))); typedef unsigned u32x2v __attribute__((ext_vector_type(2)));
        const PG8_LAS f32x2v* S = (const PG8_LAS f32x2v*)(lds + 8192);
        const int col0 = u.pn * BM + wc * 32 + 4 * fq;
#pragma unroll
        for (int bj = 0; bj < 2; ++bj)
#pragma unroll
            for (int n = 0; n < 2; ++n) { const f32x4 bv = bias ? *(const f32x4*)(bias + col0 + bj * HALF + n * 16) : (f32x4){0.f, 0.f, 0.f, 0.f};
#pragma unroll
                for (int ai = 0; ai < 2; ++ai)
#pragma unroll
                    for (int m = 0; m < 4; ++m) acc[ai][bj][m][n] += bv; }
        bool bad = st1.run(acc, u, wr, wc, fr, fq, lds, wid, lane) || poison != 0u;
        const float qnan = __builtin_nanf("");
#pragma unroll
        for (int ai = 0; ai < 2; ++ai)
#pragma unroll
            for (int m = 0; m < 4; ++m) { const int r = ai * HALF + wr * 64 + m * 16 + fr; const f32x2v sr = S[r]; const size_t off = (size_t)(u.pm * BM + r) * ldc + col0;
#pragma unroll
                for (int bj = 0; bj < 2; ++bj)
#pragma unroll
                    for (int n = 0; n < 2; ++n) { const f32x4 bs = *(const f32x4*)(base + off + bj * HALF + n * 16); acc[ai][bj][m][n] = bs + (acc[ai][bj][m][n] - sr.x) * sr.y; }
                asm volatile("" : "+v"(acc[ai][0][m][0]), "+v"(acc[ai][0][m][1]), "+v"(acc[ai][1][m][0]), "+v"(acc[ai][1][m][1]));
                if (m & 1) asm volatile("" ::: "memory"); }
        const bool bad1 = bad;
        bad = st2.run(acc, u, wr, wc, fr, fq, lds, wid, lane) || bad;
#pragma unroll
        for (int ai = 0; ai < 2; ++ai)
#pragma unroll
            for (int m = 0; m < 4; ++m) { const int r = ai * HALF + wr * 64 + m * 16 + fr; const f32x2v sr = S[r]; const size_t off = (size_t)(u.pm * BM + r) * ldc + col0;
#pragma unroll
                for (int bj = 0; bj < 2; ++bj)
#pragma unroll
                    for (int n = 0; n < 2; ++n) { const f32x4 x1 = acc[ai][bj][m][n]; *(f32x4*)(out + off + bj * HALF + n * 16) = bad1 ? (f32x4){qnan, qnan, qnan, qnan} : x1;
                        const f32x4 o = (x1 - sr.x) * sr.y; u32x2v w; w.x = cvt_pk_bf16(o[0], o[1]); w.y = cvt_pk_bf16(o[2], o[3]);
                        if (bad) { w.x = 0x7fc07fc0u; w.y = 0x7fc07fc0u; } *(u32x2v*)(xn + off + bj * HALF + n * 16) = w; }
                asm volatile("" ::: "memory"); }
    }
};

template <class Epi, class Sched, bool ALIGN_EPI = false, bool SP2 = false>
__device__ __forceinline__ void gemm_phase(PG8_LAS unsigned char* lds, const Gemm g, const Sched& S, const Epi& E) {
    const int tid = threadIdx.x, wid = __builtin_amdgcn_readfirstlane(tid >> 6), lane = tid & 63, wr = wid >> 2, wc = wid & 3, fr = lane & 15, fq = lane >> 4;
    const int K = g.K, nt = K / BK;
    unsigned voffA[2], voffB[2];
#pragma unroll
    for (int i = 0; i < 2; ++i) { int R, C; stage_rc(tid * 16 + i * 8192, R, C); const int Rb = Epi::PERM ? ((R & ~31) + perm32(R & 31)) : R;
        voffA[i] = (unsigned)(R * K + C) * 2u; voffB[i] = (unsigned)(Rb * K + C) * 2u; }
    const size_t kstep = (size_t)(BK * 2);
    const size_t hstep = (size_t)HALF * K * 2;
    const size_t tstep = 2 * hstep;
    const unsigned ldsw = (unsigned)wid * 1024u;
    const int aoff = lds_byte(wr * 64 + fr, fq * 8), boff = lds_byte(wc * 32 + fr, fq * 8);
#define PG8_SA(b, h) (((b) * 2 + (h)) * HTB)
#define PG8_SB(b, h) ((4 + (b) * 2 + (h)) * HTB)
#define PG8_STAGE(bufoff, gbase, voff) do { _Pragma("unroll") for (int _i = 0; _i < 2; ++_i) \
        __builtin_amdgcn_global_load_lds((const unsigned*)((const char*)(gbase) + (voff)[_i]), (PG8_LAS unsigned*)(lds + (bufoff) + ldsw + _i * 8192), 16, 0, 0); } while (0)
#define PG8_LDA(dst, b, h) do { _Pragma("unroll") for (int m = 0; m < 4; ++m) _Pragma("unroll") for (int k = 0; k < 2; ++k) dst[m][k] = *(const PG8_LAS bf16x8*)(lds + PG8_SA(b, h) + aoff + m * 2048 + k * 1024); } while (0)
#define PG8_LDB(dst, b, h) do { _Pragma("unroll") for (int n = 0; n < 2; ++n) _Pragma("unroll") for (int k = 0; k < 2; ++k) dst[n][k] = *(const PG8_LAS bf16x8*)(lds + PG8_SB(b, h) + boff + n * 2048 + k * 1024); } while (0)
#define PG8_MMA(ai, bj, At, Bt) do { __builtin_amdgcn_s_setprio(1); _Pragma("unroll") for (int m = 0; m < 4; ++m) _Pragma("unroll") for (int n = 0; n < 2; ++n) _Pragma("unroll") for (int k = 0; k < 2; ++k) \
        acc[ai][bj][m][n] = __builtin_amdgcn_mfma_f32_16x16x32_bf16(Bt[n][k], At[m][k], acc[ai][bj][m][n], 0, 0, 0); __builtin_amdgcn_s_setprio(0); } while (0)
#define PG8_WAIT_V(n) asm volatile("s_waitcnt vmcnt(" #n ")" ::: "memory")
#define PG8_WAIT_L(n) asm volatile("s_waitcnt lgkmcnt(" #n ")" ::: "memory")
#define PG8_BAR __builtin_amdgcn_s_barrier()
#define PG8_SCHED __builtin_amdgcn_sched_barrier(0)
    Unit cur, nxt; int ui = 0;
    if (!S.next(0, cur)) return;
    f32x4 acc[2][2][4][2];
#pragma unroll
    for (int a = 0; a < 2; ++a)
#pragma unroll
        for (int b = 0; b < 2; ++b)
#pragma unroll
            for (int m = 0; m < 4; ++m)
#pragma unroll
                for (int n = 0; n < 2; ++n) acc[a][b][m][n] = (f32x4){0.f, 0.f, 0.f, 0.f};
    bf16x8 At[4][2], B0[2][2], B1[2][2];
    const char* cA = (const char*)g.A + (size_t)cur.pm * tstep; const char* cB = (const char*)g.Bt + (size_t)cur.pn * tstep;
    S.a_ready(cur);
    if constexpr (SP2) {
        PG8_STAGE(PG8_SB(0, 0), cB, voffB); PG8_STAGE(PG8_SB(0, 1), cB + hstep, voffB); PG8_STAGE(PG8_SA(0, 0), cA, voffA); PG8_STAGE(PG8_SA(0, 1), cA + hstep, voffA);
        if (wr == 1) PG8_BAR;
        PG8_WAIT_V(2); PG8_BAR;
        PG8_STAGE(PG8_SB(1, 0), cB + kstep, voffB); PG8_STAGE(PG8_SA(1, 0), cA + kstep, voffA); PG8_STAGE(PG8_SB(1, 1), cB + hstep + kstep, voffB);
        PG8_WAIT_V(6); PG8_BAR;
    } else {
        PG8_STAGE(PG8_SB(0, 0), cB, voffB); PG8_STAGE(PG8_SA(0, 0), cA, voffA); PG8_STAGE(PG8_SB(0, 1), cB + hstep, voffB); PG8_STAGE(PG8_SA(0, 1), cA + hstep, voffA);
        if (wr == 1) PG8_BAR;
        PG8_WAIT_V(4); PG8_BAR;
        PG8_STAGE(PG8_SB(1, 0), cB + kstep, voffB); PG8_STAGE(PG8_SA(1, 0), cA + kstep, voffA); PG8_STAGE(PG8_SB(1, 1), cB + hstep + kstep, voffB);
        PG8_WAIT_V(6); PG8_BAR;
    }
    for (;;) {
        const bool has_next = S.next(ui + 1, nxt);
        const char* nA = has_next ? (const char*)g.A + (size_t)nxt.pm * tstep : cA; const char* nB = has_next ? (const char*)g.Bt + (size_t)nxt.pn * tstep : cB;
        for (int t = 0; t < nt; t += 2) {
            const bool last = (t == nt - 2);
            const char* a1 = cA + (size_t)(t + 1) * kstep;
            const char* a2 = last ? nA : cA + (size_t)(t + 2) * kstep; const char* b2 = last ? nB : cB + (size_t)(t + 2) * kstep;
            const char* a3 = a2 + kstep; const char* b3 = b2 + kstep;
            if (last && has_next) S.a_ready(nxt);
            if constexpr (SP2) {
            PG8_LDB(B0, 0, 0); PG8_LDB(B1, 0, 1); PG8_SCHED; PG8_LDA(At, 0, 0); PG8_STAGE(PG8_SA(1, 1), a1 + hstep, voffA);
            PG8_WAIT_V(8); PG8_WAIT_L(0); PG8_BAR; PG8_MMA(0, 0, At, B0); PG8_MMA(0, 1, At, B1); PG8_BAR; PG8_SCHED;
            PG8_LDA(At, 0, 1); PG8_STAGE(PG8_SB(0, 0), b2, voffB); PG8_STAGE(PG8_SB(0, 1), b2 + hstep, voffB); PG8_STAGE(PG8_SA(0, 0), a2, voffA);
            PG8_WAIT_V(8); PG8_WAIT_L(0); PG8_BAR; PG8_MMA(1, 0, At, B0); PG8_MMA(1, 1, At, B1); PG8_BAR; PG8_SCHED;
            PG8_LDB(B0, 1, 0); PG8_LDB(B1, 1, 1); PG8_SCHED; PG8_LDA(At, 1, 0); PG8_STAGE(PG8_SA(0, 1), a2 + hstep, voffA);
            PG8_WAIT_V(8); PG8_WAIT_L(0); PG8_BAR; PG8_MMA(0, 0, At, B0); PG8_MMA(0, 1, At, B1); PG8_BAR; PG8_SCHED;
            PG8_LDA(At, 1, 1); PG8_STAGE(PG8_SB(1, 0), b3, voffB); PG8_STAGE(PG8_SB(1, 1), b3 + hstep, voffB); PG8_STAGE(PG8_SA(1, 0), a3, voffA);
            PG8_WAIT_V(8); PG8_WAIT_L(0); PG8_BAR; PG8_MMA(1, 0, At, B0); PG8_MMA(1, 1, At, B1); PG8_BAR; PG8_SCHED;
            } else {
            PG8_LDB(B0, 0, 0); PG8_SCHED; PG8_LDA(At, 0, 0); PG8_STAGE(PG8_SA(1, 1), a1 + hstep, voffA);
            PG8_WAIT_L(8); PG8_BAR; PG8_WAIT_L(0); PG8_MMA(0, 0, At, B0); PG8_BAR; PG8_SCHED;
            PG8_LDB(B1, 0, 1); PG8_STAGE(PG8_SB(0, 0), b2, voffB);
            PG8_BAR; PG8_WAIT_L(0); PG8_MMA(0, 1, At, B1); PG8_BAR;
            PG8_LDA(At, 0, 1); PG8_STAGE(PG8_SA(0, 0), a2, voffA);
            PG8_BAR; PG8_WAIT_L(0); PG8_MMA(1, 0, At, B0); PG8_BAR; PG8_SCHED;
            PG8_STAGE(PG8_SB(0, 1), b2 + hstep, voffB);
            PG8_WAIT_V(6); PG8_BAR; PG8_MMA(1, 1, At, B1); PG8_BAR;
            PG8_LDB(B0, 1, 0); PG8_SCHED; PG8_LDA(At, 1, 0); PG8_STAGE(PG8_SA(0, 1), a2 + hstep, voffA);
            PG8_WAIT_L(8); PG8_BAR; PG8_WAIT_L(0); PG8_MMA(0, 0, At, B0); PG8_BAR; PG8_SCHED;
            PG8_LDB(B1, 1, 1); PG8_STAGE(PG8_SB(1, 0), b3, voffB);
            PG8_BAR; PG8_WAIT_L(0); PG8_MMA(0, 1, At, B1); PG8_BAR;
            PG8_LDA(At, 1, 1); PG8_STAGE(PG8_SA(1, 0), a3, voffA);
            PG8_BAR; PG8_WAIT_L(0); PG8_MMA(1, 0, At, B0); PG8_BAR; PG8_SCHED;
            PG8_STAGE(PG8_SB(1, 1), b3 + hstep, voffB);
            PG8_WAIT_V(6); PG8_BAR; PG8_MMA(1, 1, At, B1); PG8_BAR;
            }
        }
        if constexpr (ALIGN_EPI) { if (wr == 0) PG8_BAR; }
        if constexpr (!Epi::AFTER_DRAIN) { E(acc, cur, wr, wc, fr, fq); S.done(cur); }
        if (!has_next) break;
#pragma unroll
        for (int a = 0; a < 2; ++a)
#pragma unroll
            for (int b = 0; b < 2; ++b)
#pragma unroll
                for (int m = 0; m < 4; ++m)
#pragma unroll
                    for (int n = 0; n < 2; ++n) acc[a][b][m][n] = (f32x4){0.f, 0.f, 0.f, 0.f};
        cur = nxt; cA = nA; cB = nB; ++ui;
        if constexpr (ALIGN_EPI) { if (wr == 1) PG8_BAR; }
    }
    PG8_WAIT_V(0);
    if constexpr (!ALIGN_EPI) { if (wr == 0) PG8_BAR; }
    PG8_BAR;
    if constexpr (Epi::AFTER_DRAIN) { E.fused(acc, cur, wr, wc, fr, fq, lds, wid, lane); S.done(cur); }
#undef PG8_SA
#undef PG8_SB
#undef PG8_STAGE
#undef PG8_LDA
#undef PG8_LDB
#undef PG8_MMA
#undef PG8_WAIT_V
#undef PG8_WAIT_L
#undef PG8_BAR
#undef PG8_SCHED
}
}

typedef float f32x2_t __attribute__((ext_vector_type(2))); typedef __bf16 bf16x2_t __attribute__((ext_vector_type(2)));
__device__ __forceinline__ unsigned cvtpk(float lo, float hi) { f32x2_t v = {lo, hi}; bf16x2_t b = __builtin_convertvector(v, bf16x2_t); return __builtin_bit_cast(unsigned, b); }

namespace pg8 {
struct EpiRes {
    static constexpr bool PERM = true, AFTER_DRAIN = false;
    const float* base; float* out; bf16_t* hb; float* ssq;
    __device__ __forceinline__ void operator()(const f32x4 (&acc)[2][2][4][2], const Unit& u, int wr, int wc, int fr, int fq) const {
        const int row0 = u.pm * BM + wr * 64 + fr, col0 = u.pn * BM + wc * 32 + 8 * fq;
#pragma unroll
        for (int ai = 0; ai < 2; ++ai)
#pragma unroll
            for (int m = 0; m < 4; ++m) {
                const size_t row = (size_t)(row0 + ai * HALF + m * 16); float s = 0.f;
#pragma unroll
                for (int bj = 0; bj < 2; ++bj) {
                    const size_t off = row * 1024 + col0 + bj * HALF;
                    const f32x4 b0 = *(const f32x4*)(base + off), b1 = *(const f32x4*)(base + off + 4);
                    const f32x4 v0 = acc[ai][bj][m][0] + b0, v1 = acc[ai][bj][m][1] + b1;
                    *(f32x4*)(out + off) = v0; *(f32x4*)(out + off + 4) = v1;
                    s += (v0[0] * v0[0] + v0[1] * v0[1]) + (v0[2] * v0[2] + v0[3] * v0[3]) + (v1[0] * v1[0] + v1[1] * v1[1]) + (v1[2] * v1[2] + v1[3] * v1[3]);
                    if (hb) { u32x4 w; w.x = cvtpk(v0[0], v0[1]); w.y = cvtpk(v0[2], v0[3]); w.z = cvtpk(v1[0], v1[1]); w.w = cvtpk(v1[2], v1[3]); *(u32x4*)(hb + off) = w; }
                }
                if (ssq) { s += __shfl_xor(s, 16); s += __shfl_xor(s, 32); if (fq == 0) ssq[row * 16 + u.pn * 4 + wc] = s; }
            }
    }
};
template <int MODE> struct EpiScale {
    static constexpr bool PERM = true, AFTER_DRAIN = false;
    bf16_t* O; int ldc; const float* ssq; float scale;
    __device__ __forceinline__ void operator()(const f32x4 (&acc)[2][2][4][2], const Unit& u, int wr, int wc, int fr, int fq) const {
        const int row0 = u.pm * BM + wr * 64 + fr, col0 = u.pn * BM + wc * 32 + 8 * fq;
#pragma unroll
        for (int ai = 0; ai < 2; ++ai)
#pragma unroll
            for (int m = 0; m < 4; ++m) {
                const size_t row = (size_t)(row0 + ai * HALF + m * 16);
                const f32x4 s0 = *(const f32x4*)(ssq + row * 16), s1 = *(const f32x4*)(ssq + row * 16 + 4), s2 = *(const f32x4*)(ssq + row * 16 + 8), s3 = *(const f32x4*)(ssq + row * 16 + 12);
                const f32x4 st = (s0 + s1) + (s2 + s3);
                const float rs = __builtin_amdgcn_rsqf(((st[0] + st[1]) + (st[2] + st[3])) * (1.0f / 1024.0f) + 1e-6f) * scale;
#pragma unroll
                for (int bj = 0; bj < 2; ++bj) {
                    f32x4 v0 = acc[ai][bj][m][0] * rs, v1 = acc[ai][bj][m][1] * rs;
                    if (MODE == 1) {
#pragma unroll
                        for (int e = 0; e < 4; ++e) { const float a = fmaxf(v0[e], 0.f), b = fmaxf(v1[e], 0.f); v0[e] = a * a; v1[e] = b * b; }
                    }
                    u32x4 w; w.x = cvtpk(v0[0], v0[1]); w.y = cvtpk(v0[2], v0[3]); w.z = cvtpk(v1[0], v1[1]); w.w = cvtpk(v1[2], v1[3]);
                    *(u32x4*)(O + row * ldc + col0 + bj * HALF) = w;
                }
            }
    }
};
struct EpiKV {
    static constexpr bool PERM = true, AFTER_DRAIN = false;
    bf16_t* Kb; bf16_t* Vt;
    __device__ __forceinline__ void operator()(const f32x4 (&acc)[2][2][4][2], const Unit& u, int wr, int wc, int fr, int fq) const {
        const int row0 = u.pm * BM + wr * 64 + fr, col0 = u.pn * BM + wc * 32 + 8 * fq;
#pragma unroll
        for (int ai = 0; ai < 2; ++ai)
#pragma unroll
            for (int m = 0; m < 4; ++m) {
                const int row = row0 + ai * HALF + m * 16;
#pragma unroll
                for (int bj = 0; bj < 2; ++bj) {
                    const int col = col0 + bj * HALF; const f32x4 v0 = acc[ai][bj][m][0], v1 = acc[ai][bj][m][1];
                    u32x4 w; w.x = cvtpk(v0[0], v0[1]); w.y = cvtpk(v0[2], v0[3]); w.z = cvtpk(v1[0], v1[1]); w.w = cvtpk(v1[2], v1[3]);
                    if (col < 1024) { *(u32x4*)(Kb + (size_t)row * 1024 + col) = w; }
                    else {
                        const int b = row >> 8, mm = row & 255; bf16_t* p = Vt + ((size_t)(b * 1024 + (col - 1024))) * 256 + mm;
                        p[0 * 256] = (bf16_t)(w.x & 0xffffu); p[1 * 256] = (bf16_t)(w.x >> 16); p[2 * 256] = (bf16_t)(w.y & 0xffffu); p[3 * 256] = (bf16_t)(w.y >> 16);
                        p[4 * 256] = (bf16_t)(w.z & 0xffffu); p[5 * 256] = (bf16_t)(w.z >> 16); p[6 * 256] = (bf16_t)(w.w & 0xffffu); p[7 * 256] = (bf16_t)(w.w >> 16);
                    }
                }
            }
    }
};
}

#define LAS __attribute__((address_space(3)))
typedef pg8::bf16_t bf16_t;
typedef pg8::bf16x8 bf16x8;
typedef pg8::f32x4 f32x4;
typedef pg8::u32x4 u32x4;
typedef unsigned u32x2 __attribute__((ext_vector_type(2)));

constexpr int NTOK = 32768, DM = 1024, SEQ = 8192, NBATCH = 4, NCHUNK = 128, NPROJ = 3328, DFF = 4096, NMEMROWS = 1024;
constexpr int C_GQ = 0, C_GK = 256, C_GV = 512, C_GG = 1024, C_RQ = 1536, C_RK = 1792, C_RV = 2048, C_RG = 2560, C_Z = 3072;
constexpr int NWAVES = 8, NTHREADS = 512;
constexpr int WAVE_LDS = 18432, LDS_BYTES = NWAVES * WAVE_LDS;
constexpr int VPITCH = 72;
constexpr int APITCH = 528;
constexpr size_t MiB = 1u << 20;
constexpr size_t WS_WIN = 1 * MiB, WS_WOUT = 8 * MiB, WS_WQ = 10 * MiB, WS_WKV = 12 * MiB, WS_WO = 16 * MiB, WS_W1 = 18 * MiB, WS_W2 = 26 * MiB;
constexpr size_t WS_COS = 34 * MiB, WS_SIN = 35 * MiB, WS_MEMN = 36 * MiB, WS_KB = 38 * MiB, WS_VT = 40 * MiB, WS_DEC = 42 * MiB, WS_SSQ1 = 44 * MiB, WS_SSQ2 = 46 * MiB;
constexpr size_t WS_A1 = 64 * MiB;
constexpr size_t WS_A2 = 128 * MiB;
constexpr size_t WS_BIG = 192 * MiB;
constexpr size_t WS_NEED = 448 * MiB;

struct Params {
    const float *x, *mem, *norm_mix_g, *w_in, *gla_w_gate, *gla_b_gate, *gla_norm_g, *ret_norm_g, *w_out, *norm_x_g, *norm_mem_g, *xa_w_q, *xa_w_kv, *xa_w_o, *norm_ffn_g, *ffn_w1, *ffn_w2, *final_norm_g;
    float* out; unsigned char* ws; int ph_lo, ph_hi;
};

__device__ __forceinline__ float bf2f(unsigned short b) { return __uint_as_float(((unsigned)b) << 16); }
__device__ __forceinline__ unsigned short f2bf(float f) { const unsigned u = __float_as_uint(f); return (unsigned short)((u + 0x7fffu + ((u >> 16) & 1u)) >> 16); }
__device__ __forceinline__ bf16x8 pack8(f32x4 a, f32x4 b) {
    u32x4 w; w.x = cvtpk(a[0], a[1]); w.y = cvtpk(a[2], a[3]); w.z = cvtpk(b[0], b[1]); w.w = cvtpk(b[2], b[3]);
    return __builtin_bit_cast(bf16x8, w);
}
__device__ __forceinline__ void unpack8(bf16x8 v, f32x4& a, f32x4& b) {
    const u32x4 w = __builtin_bit_cast(u32x4, v);
    a[0] = __uint_as_float(w.x << 16); a[1] = __uint_as_float(w.x & 0xffff0000u); a[2] = __uint_as_float(w.y << 16); a[3] = __uint_as_float(w.y & 0xffff0000u);
    b[0] = __uint_as_float(w.z << 16); b[1] = __uint_as_float(w.z & 0xffff0000u); b[2] = __uint_as_float(w.w << 16); b[3] = __uint_as_float(w.w & 0xffff0000u);
}
__device__ __forceinline__ float wave_sum(float v) {
#pragma unroll
    for (int o = 1; o < 64; o <<= 1) v += __shfl_xor(v, o);
    return v;
}
#define MFMA16(a, b, c) __builtin_amdgcn_mfma_f32_16x16x32_bf16((a), (b), (c), 0, 0, 0)
#define LDS_FENCE() asm volatile("s_waitcnt lgkmcnt(0)" ::: "memory")
#define CFENCE() do { asm volatile("" ::: "memory"); __builtin_amdgcn_sched_barrier(0); } while (0)
__device__ __forceinline__ float scan16(float v, int r) {
#pragma unroll
    for (int off = 1; off < 16; off <<= 1) { const float t = __shfl_up(v, off, 16); if (r >= off) v += t; }
    return v;
}

__device__ __forceinline__ void transpose_item(const float* W, int ldw, int col0, int K, int Nn, const float* g, bf16_t* WT, int row_off, LAS float* scr, int item, int lane) {
    const int nblk = Nn / 32, kb = item / nblk, nb = item % nblk, k0 = 64 * kb, n0 = 32 * nb;
#pragma unroll 8
    for (int i = 0; i < 32; ++i) { const int kk = 2 * i + (lane >> 5); float w = W[(size_t)(k0 + kk) * ldw + col0 + n0 + (lane & 31)]; if (g) w *= g[k0 + kk]; scr[kk * 33 + (lane & 31)] = w; }
    LDS_FENCE();
    const int c = lane & 7;
#pragma unroll
    for (int j = 0; j < 4; ++j) { const int n = (lane >> 3) + 8 * j; const LAS float* s = scr + (8 * c) * 33 + n;
        u32x4 o; o.x = cvtpk(s[0 * 33], s[1 * 33]); o.y = cvtpk(s[2 * 33], s[3 * 33]); o.z = cvtpk(s[4 * 33], s[5 * 33]); o.w = cvtpk(s[6 * 33], s[7 * 33]);
        *(u32x4*)(WT + (size_t)(row_off + n0 + n) * K + k0 + 8 * c) = o; }
    LDS_FENCE();
}
__device__ __forceinline__ void rms_row_to_bf16(const float* xrow, const float* g, bf16_t* orow, int lane) {
    const f32x4* xr = (const f32x4*)xrow + lane; const f32x4* gr = (const f32x4*)g + lane;
    f32x4 v[4]; float s = 0.f;
#pragma unroll
    for (int j = 0; j < 4; ++j) { v[j] = xr[64 * j]; s += (v[j][0] * v[j][0] + v[j][1] * v[j][1]) + (v[j][2] * v[j][2] + v[j][3] * v[j][3]); }
    const float rstd = 1.0f / sqrtf(wave_sum(s) * (1.0f / 1024.0f) + 1e-6f);
    u32x2* o8 = (u32x2*)orow + lane;
#pragma unroll
    for (int j = 0; j < 4; ++j) { const f32x4 gg = gr[64 * j]; u32x2 w; w.x = cvtpk(v[j][0] * rstd * gg[0], v[j][1] * rstd * gg[1]); w.y = cvtpk(v[j][2] * rstd * gg[2], v[j][3] * rstd * gg[3]); o8[64 * j] = w; }
}
__device__ __forceinline__ void p0_prologue(const Params& p, LAS unsigned char* lds, int G) {
    const int tid = threadIdx.x, lane = tid & 63, wave = __builtin_amdgcn_readfirstlane(tid >> 6);
    unsigned char* ws = p.ws;
    LAS float* scr = (LAS float*)(lds + wave * WAVE_LDS);
    const int gw = blockIdx.x * NWAVES + wave, NGW = G * NWAVES;
    bf16_t* Win_t = (bf16_t*)(ws + WS_WIN);
    constexpr int I_INA = 16 * 32, I_INB = 16 * 64, I_OUT = 16 * 32, I_Q = 16 * 32, I_KV = 16 * 64, I_O = 16 * 32, I_1 = 16 * 128, I_2 = 64 * 32;
    constexpr int NITEMS = I_INA + I_INB + I_OUT + I_Q + I_KV + I_O + I_1 + I_2;
    for (int it = gw; it < NITEMS; it += NGW) {
        int r = it;
        if (r < I_INA) { transpose_item(p.w_in, 3088, 0, 1024, 1024, nullptr, Win_t, 0, scr, r, lane); continue; } r -= I_INA;
        if (r < I_INB) { transpose_item(p.w_in, 3088, 1040, 1024, 2048, nullptr, Win_t, 1024, scr, r, lane); continue; } r -= I_INB;
        if (r < I_OUT) { transpose_item(p.w_out, 1024, 0, 1024, 1024, nullptr, (bf16_t*)(ws + WS_WOUT), 0, scr, r, lane); continue; } r -= I_OUT;
        if (r < I_Q) { transpose_item(p.xa_w_q, 1024, 0, 1024, 1024, p.norm_x_g, (bf16_t*)(ws + WS_WQ), 0, scr, r, lane); continue; } r -= I_Q;
        if (r < I_KV) { transpose_item(p.xa_w_kv, 2048, 0, 1024, 2048, nullptr, (bf16_t*)(ws + WS_WKV), 0, scr, r, lane); continue; } r -= I_KV;
        if (r < I_O) { transpose_item(p.xa_w_o, 1024, 0, 1024, 1024, nullptr, (bf16_t*)(ws + WS_WO), 0, scr, r, lane); continue; } r -= I_O;
        if (r < I_1) { transpose_item(p.ffn_w1, 4096, 0, 1024, 4096, p.norm_ffn_g, (bf16_t*)(ws + WS_W1), 0, scr, r, lane); continue; } r -= I_1;
        transpose_item(p.ffn_w2, 1024, 0, 4096, 1024, nullptr, (bf16_t*)(ws + WS_W2), 0, scr, r, lane);
    }
    const int gt = blockIdx.x * NTHREADS + tid, NGT = G * NTHREADS;
    for (int o = gt; o < 256 * 1024; o += NGT) {
        const int n = o >> 10, k = o & 1023; const float* wr = p.w_in + (size_t)k * 3088 + 1024; float s = 0.f;
#pragma unroll
        for (int r = 0; r < 16; ++r) s += wr[r] * p.gla_w_gate[r * 256 + n];
        Win_t[(size_t)(3072 + n) * 1024 + k] = f2bf(s);
    }
    float* cosT = (float*)(ws + WS_COS); float* sinT = (float*)(ws + WS_SIN);
    for (int o = gt; o < SEQ * 32; o += NGT) {
        const int pos = o >> 5, i = o & 31; double f = 1.0;
        for (int k = 0; k < i; ++k) f *= 0.7498942093324559;
        const double t = (double)pos * f * 0.15915494309189535;
        const float fr = (float)(t - floor(t));
        cosT[o] = __builtin_amdgcn_cosf(fr); sinT[o] = __builtin_amdgcn_sinf(fr);
    }
    bf16_t* XN = (bf16_t*)(ws + WS_A1); bf16_t* MEMN = (bf16_t*)(ws + WS_MEMN);
    for (int m = gw; m < NTOK + NMEMROWS; m += NGW) {
        if (m < NTOK) rms_row_to_bf16(p.x + (size_t)m * DM, p.norm_mix_g, XN + (size_t)m * DM, lane);
        else rms_row_to_bf16(p.mem + (size_t)(m - NTOK) * DM, p.norm_mem_g, MEMN + (size_t)(m - NTOK) * DM, lane);
    }
}

__device__ __forceinline__ void gla_gates(const bf16_t* P, int zcol, const float* bg, int r, int q, float (&bc)[4][2][8], float (&bl)[2][8]) {
#pragma unroll
    for (int ks = 0; ks < 2; ++ks) {
        const f32x4 b0 = *(const f32x4*)(bg + 32 * ks + 8 * q), b1 = *(const f32x4*)(bg + 32 * ks + 8 * q + 4);
#pragma unroll
        for (int mt = 0; mt < 4; ++mt) {
            CFENCE();
            const bf16x8 z = *(const bf16x8*)(P + (size_t)(16 * mt + r) * NPROJ + zcol + 32 * ks + 8 * q);
            f32x4 z0, z1; unpack8(z, z0, z1); z0 += b0; z1 += b1;
#pragma unroll
            for (int e = 0; e < 4; ++e) {
                bc[mt][ks][e] = (fminf(z0[e], 0.f) - __logf(1.0f + __expf(-fabsf(z0[e])))) * (1.0f / 16.0f);
                bc[mt][ks][4 + e] = (fminf(z1[e], 0.f) - __logf(1.0f + __expf(-fabsf(z1[e])))) * (1.0f / 16.0f);
            }
        }
#pragma unroll
        for (int e = 0; e < 8; ++e) {
            float carry = 0.f;
#pragma unroll
            for (int mt = 0; mt < 4; ++mt) { const float v = scan16(bc[mt][ks][e], r); const float tot = __shfl(v, 15, 16); bc[mt][ks][e] = v + carry; carry += tot; }
            bl[ks][e] = carry;
        }
    }
}
__device__ __forceinline__ float ret_log2g(int hr) { return hr == 0 ? -0.04580368961312479f : hr == 1 ? -0.008973692110584325f : hr == 2 ? -0.0017761724589428754f : -0.0003522634716290214f; }
__device__ __forceinline__ void rope_tile(bf16x8 f0, bf16x8 f1, const float* cosT, const float* sinT, int pos, int q, f32x4 (&o)[4]) {
    f32x4 a0, a1, b0, b1; unpack8(f0, a0, a1); unpack8(f1, b0, b1);
    const f32x4 c0 = *(const f32x4*)(cosT + pos * 32 + 8 * q), c1 = *(const f32x4*)(cosT + pos * 32 + 8 * q + 4), s0 = *(const f32x4*)(sinT + pos * 32 + 8 * q), s1 = *(const f32x4*)(sinT + pos * 32 + 8 * q + 4);
    o[0] = a0 * c0 - b0 * s0; o[1] = a1 * c1 - b1 * s1; o[2] = a0 * s0 + b0 * c0; o[3] = a1 * s1 + b1 * c1;
}

__device__ __forceinline__ void chunk_contrib(const Params& p, LAS unsigned char* lds, int G) {
    const int tid = threadIdx.x, lane = tid & 63, wave = __builtin_amdgcn_readfirstlane(tid >> 6);
    unsigned char* ws = p.ws;
    const bf16_t* PROJ = (const bf16_t*)(ws + WS_BIG); bf16_t* CT = (bf16_t*)(ws + WS_A2); float* DEC = (float*)(ws + WS_DEC);
    const float* cosT = (const float*)(ws + WS_COS); const float* sinT = (const float*)(ws + WS_SIN);
    LAS bf16_t* Kdt = (LAS bf16_t*)(lds + wave * WAVE_LDS); LAS bf16_t* Vt = Kdt + 64 * VPITCH;
    for (int u = blockIdx.x * NWAVES + wave; u < NBATCH * NCHUNK * 8; u += G * NWAVES) {
        const int h8 = u & 7, bn = u >> 3, b = bn >> 7, n = bn & 127;
        const size_t tok0 = (size_t)b * SEQ + (size_t)n * 64;
        const bf16_t* P = PROJ + tok0 * NPROJ;
        const int unit = (b * 8 + h8) * NCHUNK + n;
        int r = lane & 15, q = lane >> 4; asm volatile("" : "+v"(r), "+v"(q));
        int vcol;
        LDS_FENCE();
        if (h8 < 4) {
            const int h = h8; vcol = C_GV + h * 128;
            float bc[4][2][8], bl[2][8];
            gla_gates(P, C_Z + h * 64, p.gla_b_gate + h * 64, r, q, bc, bl);
            if (r == 0) {
#pragma unroll
                for (int ks = 0; ks < 2; ++ks) {
                    f32x4 d0, d1;
#pragma unroll
                    for (int e = 0; e < 4; ++e) { d0[e] = __expf(bl[ks][e]); d1[e] = __expf(bl[ks][4 + e]); }
                    *(f32x4*)(DEC + (size_t)unit * 64 + 32 * ks + 8 * q) = d0; *(f32x4*)(DEC + (size_t)unit * 64 + 32 * ks + 8 * q + 4) = d1;
                }
            }
#pragma unroll
            for (int mt = 0; mt < 4; ++mt)
#pragma unroll
                for (int ks = 0; ks < 2; ++ks) {
                    CFENCE();
                    const bf16x8 kf = *(const bf16x8*)(P + (size_t)(16 * mt + r) * NPROJ + C_GK + h * 64 + 32 * ks + 8 * q);
                    f32x4 k0, k1; unpack8(kf, k0, k1);
#pragma unroll
                    for (int e = 0; e < 4; ++e) {
                        Kdt[(32 * ks + 8 * q + e) * VPITCH + 16 * mt + r] = f2bf(k0[e] * __expf(bl[ks][e] - bc[mt][ks][e]));
                        Kdt[(32 * ks + 8 * q + 4 + e) * VPITCH + 16 * mt + r] = f2bf(k1[e] * __expf(bl[ks][4 + e] - bc[mt][ks][4 + e]));
                    }
                }
        } else {
            const int hr = h8 - 4; vcol = C_RV + hr * 128; const float l2g = ret_log2g(hr);
            if (r == 0) {
                const float d = exp2f(64.0f * l2g); const f32x4 dv = {d, d, d, d};
#pragma unroll
                for (int ks = 0; ks < 2; ++ks) { *(f32x4*)(DEC + (size_t)unit * 64 + 32 * ks + 8 * q) = dv; *(f32x4*)(DEC + (size_t)unit * 64 + 32 * ks + 8 * q + 4) = dv; }
            }
#pragma unroll
            for (int mt = 0; mt < 4; ++mt) {
                CFENCE();
                const bf16x8 f0 = *(const bf16x8*)(P + (size_t)(16 * mt + r) * NPROJ + C_RK + hr * 64 + 8 * q);
                const bf16x8 f1 = *(const bf16x8*)(P + (size_t)(16 * mt + r) * NPROJ + C_RK + hr * 64 + 32 + 8 * q);
                f32x4 o[4]; rope_tile(f0, f1, cosT, sinT, n * 64 + 16 * mt + r, q, o);
                const float sc = 0.125f * exp2f((float)(63 - (16 * mt + r)) * l2g);
#pragma unroll
                for (int e = 0; e < 4; ++e) {
                    Kdt[(8 * q + e) * VPITCH + 16 * mt + r] = f2bf(o[0][e] * sc); Kdt[(8 * q + 4 + e) * VPITCH + 16 * mt + r] = f2bf(o[1][e] * sc);
                    Kdt[(32 + 8 * q + e) * VPITCH + 16 * mt + r] = f2bf(o[2][e] * sc); Kdt[(32 + 8 * q + 4 + e) * VPITCH + 16 * mt + r] = f2bf(o[3][e] * sc);
                }
            }
        }
        bf16_t* outp = CT + (size_t)unit * 8192;
#pragma unroll 1
        for (int vh = 0; vh < 2; ++vh) {
            LDS_FENCE();
#pragma unroll
            for (int i = 0; i < 8; ++i) {
                const int token = i * 8 + (lane >> 3), vv = (lane & 7) * 8;
                const bf16x8 x = *(const bf16x8*)(P + (size_t)token * NPROJ + vcol + vh * 64 + vv);
#pragma unroll
                for (int e = 0; e < 8; ++e) Vt[(vv + e) * VPITCH + token] = (bf16_t)x[e];
            }
            LDS_FENCE();
#pragma unroll
            for (int vt = 0; vt < 4; ++vt) {
                CFENCE();
                bf16x8 a[2];
#pragma unroll
                for (int s = 0; s < 2; ++s) a[s] = *(const LAS bf16x8*)(Vt + (16 * vt + r) * VPITCH + 32 * s + 8 * q);
#pragma unroll
                for (int dt = 0; dt < 4; ++dt) {
                    f32x4 acc = {0.f, 0.f, 0.f, 0.f};
#pragma unroll
                    for (int s = 0; s < 2; ++s) { const bf16x8 bb = *(const LAS bf16x8*)(Kdt + (16 * dt + r) * VPITCH + 32 * s + 8 * q); acc = MFMA16(a[s], bb, acc); }
#pragma unroll
                    for (int e = 0; e < 4; ++e) outp[(vh * 64 + 16 * vt + 4 * q + e) * 64 + 16 * dt + r] = f2bf(acc[e]);
                }
            }
        }
    }
}

__device__ __forceinline__ void chunk_scan(const Params& p, int G) {
    unsigned char* ws = p.ws; bf16_t* CT = (bf16_t*)(ws + WS_A2); const float* DEC = (const float*)(ws + WS_DEC);
    const int NGT = G * NTHREADS;
    for (int o = blockIdx.x * NTHREADS + threadIdx.x; o < 32 * 128 * 16; o += NGT) {
        const int d4 = o & 15, v = (o >> 4) & 127, bh = o >> 11;
        bf16_t* base = CT + (size_t)bh * NCHUNK * 8192 + v * 64 + d4 * 4; const float* dbase = DEC + (size_t)bh * NCHUNK * 64 + d4 * 4;
        f32x4 s = {0.f, 0.f, 0.f, 0.f};
#pragma unroll 1
        for (int n0 = 0; n0 < NCHUNK; n0 += 8) {
            u32x2 uu[8]; f32x4 dd[8];
#pragma unroll
            for (int j = 0; j < 8; ++j) { uu[j] = *(const u32x2*)(base + (size_t)(n0 + j) * 8192); dd[j] = *(const f32x4*)(dbase + (size_t)(n0 + j) * 64); }
#pragma unroll
            for (int j = 0; j < 8; ++j) {
                u32x2 w; w.x = cvtpk(s[0], s[1]); w.y = cvtpk(s[2], s[3]);
                *(u32x2*)(base + (size_t)(n0 + j) * 8192) = w;
                f32x4 c; c[0] = __uint_as_float(uu[j].x << 16); c[1] = __uint_as_float(uu[j].x & 0xffff0000u); c[2] = __uint_as_float(uu[j].y << 16); c[3] = __uint_as_float(uu[j].y & 0xffff0000u);
                s = dd[j] * s + c;
            }
        }
    }
}

template <bool GN> __device__ __forceinline__ void norm_gate_store(const f32x4 (&O)[8], int it, int r, int q, const float* gain, const bf16_t* gate, bf16_t* y) {
    f32x4 mean = {0.f, 0.f, 0.f, 0.f};
    if (GN) {
        f32x4 s = {0.f, 0.f, 0.f, 0.f};
#pragma unroll
        for (int vt = 0; vt < 8; ++vt) s += O[vt];
#pragma unroll
        for (int e = 0; e < 4; ++e) { float t = s[e]; t += __shfl_xor(t, 1); t += __shfl_xor(t, 2); t += __shfl_xor(t, 4); t += __shfl_xor(t, 8); mean[e] = t * (1.0f / 128.0f); }
    }
    f32x4 ss = {0.f, 0.f, 0.f, 0.f};
#pragma unroll
    for (int vt = 0; vt < 8; ++vt) { const f32x4 d = O[vt] - mean; ss += d * d; }
    f32x4 rstd;
#pragma unroll
    for (int e = 0; e < 4; ++e) { float t = ss[e]; t += __shfl_xor(t, 1); t += __shfl_xor(t, 2); t += __shfl_xor(t, 4); t += __shfl_xor(t, 8); rstd[e] = __builtin_amdgcn_rsqf(t * (1.0f / 128.0f) + 1e-6f); }
#pragma unroll
    for (int vt = 0; vt < 8; ++vt) {
        const int v = 16 * vt + r; const float g = gain[v];
        CFENCE();
#pragma unroll
        for (int e = 0; e < 4; ++e) {
            const int i = 16 * it + 4 * q + e;
            const float gt = bf2f(gate[(size_t)i * NPROJ + v]);
            const float sil = gt / (1.0f + __expf(-gt));
            y[(size_t)i * DM + v] = f2bf((O[vt][e] - mean[e]) * rstd[e] * g * sil);
        }
    }
}
__device__ __forceinline__ void out_tile(f32x4 (&O)[8], const bf16x8 (&pf)[2], const bf16x8 (&qi)[2], const LAS bf16_t* Vt, const bf16_t* SP, int r, int q) {
#pragma unroll
    for (int vt = 0; vt < 8; ++vt) {
        f32x4 acc = {0.f, 0.f, 0.f, 0.f};
        CFENCE();
#pragma unroll
        for (int s = 0; s < 2; ++s) {
            const u32x2 lo = *(const LAS u32x2*)(Vt + (16 * vt + r) * VPITCH + 32 * s + 4 * q), hi = *(const LAS u32x2*)(Vt + (16 * vt + r) * VPITCH + 32 * s + 16 + 4 * q);
            const u32x4 w = {lo.x, lo.y, hi.x, hi.y};
            acc = MFMA16(pf[s], __builtin_bit_cast(bf16x8, w), acc);
        }
#pragma unroll
        for (int ks = 0; ks < 2; ++ks) { const bf16x8 sb = *(const bf16x8*)(SP + (16 * vt + r) * 64 + 32 * ks + 8 * q); acc = MFMA16(qi[ks], sb, acc); }
        O[vt] = acc;
    }
}

__device__ __forceinline__ void chunk_output(const Params& p, LAS unsigned char* lds, int G) {
    const int tid = threadIdx.x, lane = tid & 63, wave = __builtin_amdgcn_readfirstlane(tid >> 6);
    unsigned char* ws = p.ws;
    const bf16_t* PROJ = (const bf16_t*)(ws + WS_BIG); const bf16_t* SPB = (const bf16_t*)(ws + WS_A2); bf16_t* Y = (bf16_t*)(ws + WS_A1);
    const float* cosT = (const float*)(ws + WS_COS); const float* sinT = (const float*)(ws + WS_SIN);
    LAS bf16_t* Vt = (LAS bf16_t*)(lds + wave * WAVE_LDS);
    for (int u = blockIdx.x * NWAVES + wave; u < NBATCH * NCHUNK * 8; u += G * NWAVES) {
        const int h8 = u & 7, bn = u >> 3, b = bn >> 7, n = bn & 127;
        const size_t tok0 = (size_t)b * SEQ + (size_t)n * 64;
        const bf16_t* P = PROJ + tok0 * NPROJ;
        const int unit = (b * 8 + h8) * NCHUNK + n;
        const bf16_t* SP = SPB + (size_t)unit * 8192;
        int r = lane & 15, q = lane >> 4; asm volatile("" : "+v"(r), "+v"(q));
        const int vcol = (h8 < 4) ? C_GV + h8 * 128 : C_RV + (h8 - 4) * 128;
        LDS_FENCE();
#pragma unroll
        for (int i = 0; i < 16; ++i) {
            CFENCE();
            const int token = i * 4 + (lane >> 4), vv = (lane & 15) * 8;
            const bf16x8 x = *(const bf16x8*)(P + (size_t)token * NPROJ + vcol + vv);
#pragma unroll
            for (int e = 0; e < 8; ++e) Vt[(vv + e) * VPITCH + token] = (bf16_t)x[e];
        }
        LDS_FENCE();
#ifdef NO_GLA4
        if (false) {
#else
        if (h8 < 4) {
#endif
            const int h = h8;
            bf16x8 Qe[4][2], Qi[4][2], Ki[4][2], Ke[4][2], pfa[4][2];
            {
                float bc[4][2][8], bl[2][8];
                gla_gates(P, C_Z + h * 64, p.gla_b_gate + h * 64, r, q, bc, bl);
#pragma unroll
                for (int mt = 0; mt < 4; ++mt)
#pragma unroll
                    for (int ks = 0; ks < 2; ++ks) {
                        CFENCE();
                        const bf16x8 qf = *(const bf16x8*)(P + (size_t)(16 * mt + r) * NPROJ + C_GQ + h * 64 + 32 * ks + 8 * q);
                        const bf16x8 kf = *(const bf16x8*)(P + (size_t)(16 * mt + r) * NPROJ + C_GK + h * 64 + 32 * ks + 8 * q);
                        f32x4 q0, q1, k0, k1; unpack8(qf, q0, q1); unpack8(kf, k0, k1);
                        f32x4 e0, e1, i0, i1;
#pragma unroll
                        for (int e = 0; e < 4; ++e) { e0[e] = __expf(bc[mt][ks][e]); e1[e] = __expf(bc[mt][ks][4 + e]); i0[e] = __expf(-bc[mt][ks][e]); i1[e] = __expf(-bc[mt][ks][4 + e]); }
                        Qe[mt][ks] = pack8(q0 * e0 * 0.125f, q1 * e1 * 0.125f); Qi[mt][ks] = pack8(q0 * i0 * 0.125f, q1 * i1 * 0.125f);
                        Ki[mt][ks] = pack8(k0 * i0, k1 * i1); Ke[mt][ks] = pack8(k0 * e0, k1 * e1);
                    }
            }
#pragma unroll
            for (int it = 0; it < 4; ++it) {
                f32x4 Pt[4];
#pragma unroll
                for (int jt = 0; jt < 4; ++jt) {
                    f32x4 lo = {0.f, 0.f, 0.f, 0.f}, up = {0.f, 0.f, 0.f, 0.f};
                    if (jt <= it) { lo = MFMA16(Ki[jt][0], Qe[it][0], lo); lo = MFMA16(Ki[jt][1], Qe[it][1], lo); }
                    if (jt >= it) { up = MFMA16(Ke[jt][0], Qi[it][0], up); up = MFMA16(Ke[jt][1], Qi[it][1], up); }
                    if (jt < it) Pt[jt] = lo; else if (jt > it) Pt[jt] = up;
                    else {
#pragma unroll
                        for (int e = 0; e < 4; ++e) Pt[jt][e] = (4 * q + e <= r) ? lo[e] : up[e];
                    }
                }
                pfa[it][0] = pack8(Pt[0], Pt[1]); pfa[it][1] = pack8(Pt[2], Pt[3]);
                CFENCE();
            }
#pragma unroll
            for (int it = 0; it < 4; ++it) {
                f32x4 O[8];
                out_tile(O, pfa[it], Qe[it], Vt, SP, r, q);
                CFENCE();
                norm_gate_store<false>(O, it, r, q, p.gla_norm_g + h * 128, P + C_GG + h * 128, Y + tok0 * DM + h * 128);
                CFENCE();
            }
        }
#ifdef NO_RET4
        else if (false) {
#else
        else {
#endif
            const int hr = h8 - 4; const float l2g = ret_log2g(hr);
            bf16x8 Qr[4][2], Qd[4][2], Kr[4][2], pfa[4][2];
#pragma unroll
            for (int mt = 0; mt < 4; ++mt) {
                const int pos = n * 64 + 16 * mt + r;
                CFENCE();
                {
                    const bf16x8 f0 = *(const bf16x8*)(P + (size_t)(16 * mt + r) * NPROJ + C_RQ + hr * 64 + 8 * q);
                    const bf16x8 f1 = *(const bf16x8*)(P + (size_t)(16 * mt + r) * NPROJ + C_RQ + hr * 64 + 32 + 8 * q);
                    f32x4 o[4]; rope_tile(f0, f1, cosT, sinT, pos, q, o);
                    Qr[mt][0] = pack8(o[0], o[1]); Qr[mt][1] = pack8(o[2], o[3]);
                    const float qd = exp2f((float)(16 * mt + r + 1) * l2g);
                    Qd[mt][0] = pack8(o[0] * qd, o[1] * qd); Qd[mt][1] = pack8(o[2] * qd, o[3] * qd);
                }
                {
                    const bf16x8 f0 = *(const bf16x8*)(P + (size_t)(16 * mt + r) * NPROJ + C_RK + hr * 64 + 8 * q);
                    const bf16x8 f1 = *(const bf16x8*)(P + (size_t)(16 * mt + r) * NPROJ + C_RK + hr * 64 + 32 + 8 * q);
                    f32x4 o[4]; rope_tile(f0, f1, cosT, sinT, pos, q, o);
                    Kr[mt][0] = pack8(o[0] * 0.125f, o[1] * 0.125f); Kr[mt][1] = pack8(o[2] * 0.125f, o[3] * 0.125f);
                }
            }
#pragma unroll
            for (int it = 0; it < 4; ++it) {
                f32x4 Pt[4];
#pragma unroll
                for (int jt = 0; jt < 4; ++jt) {
                    f32x4 st = {0.f, 0.f, 0.f, 0.f};
                    st = MFMA16(Kr[jt][0], Qr[it][0], st); st = MFMA16(Kr[jt][1], Qr[it][1], st);
#pragma unroll
                    for (int e = 0; e < 4; ++e) { const int dj = (16 * it + r) - (16 * jt + 4 * q + e); Pt[jt][e] = st[e] * exp2f((float)(dj < 0 ? -dj : dj) * l2g); }
                }
                pfa[it][0] = pack8(Pt[0], Pt[1]); pfa[it][1] = pack8(Pt[2], Pt[3]);
                CFENCE();
            }
#pragma unroll
            for (int it = 0; it < 4; ++it) {
                f32x4 O[8];
                out_tile(O, pfa[it], Qd[it], Vt, SP, r, q);
                CFENCE();
                norm_gate_store<true>(O, it, r, q, p.ret_norm_g + hr * 128, P + C_RG + hr * 128, Y + tok0 * DM + 512 + hr * 128);
                CFENCE();
            }
        }
    }
}

__device__ __forceinline__ void stage_image(LAS unsigned char* lds, const bf16_t* src, int tid) {
#pragma unroll
    for (int i = 0; i < 16; ++i) { const int row = (tid >> 5) + 16 * i, c = tid & 31; const u32x4 x = *(const u32x4*)(src + (size_t)row * 256 + c * 8); *(LAS u32x4*)(lds + row * APITCH + c * 16) = x; }
}
__device__ __forceinline__ void cross_attention(const Params& p, LAS unsigned char* lds, int G) {
    const int tid = threadIdx.x, lane = tid & 63, wave = __builtin_amdgcn_readfirstlane(tid >> 6);
    unsigned char* ws = p.ws;
    const bf16_t* Q = (const bf16_t*)(ws + WS_A1); const bf16_t* Kb = (const bf16_t*)(ws + WS_KB); const bf16_t* Vtg = (const bf16_t*)(ws + WS_VT); bf16_t* OA = (bf16_t*)(ws + WS_A2);
    for (int u = blockIdx.x; u < 512; u += G) {
        const int bh = u >> 5, b = bh >> 2, h = bh & 3, qb = u & 31;
        int r = lane & 15, q = lane >> 4; asm volatile("" : "+v"(r), "+v"(q));
        __syncthreads();
        {
#pragma unroll
            for (int i = 0; i < 16; ++i) { const int row = (tid >> 5) + 16 * i, c = tid & 31; const u32x4 x = *(const u32x4*)(Kb + (size_t)(b * 256 + row) * 1024 + h * 256 + c * 8); *(LAS u32x4*)(lds + row * APITCH + c * 16) = x; }
        }
        __syncthreads();
        bf16x8 pf[2][8];
#pragma unroll
        for (int it = 0; it < 2; ++it) {
            const size_t i0 = (size_t)b * SEQ + qb * 256 + wave * 32 + 16 * it;
            bf16x8 Qf[8];
#pragma unroll
            for (int ks = 0; ks < 8; ++ks) Qf[ks] = *(const bf16x8*)(Q + (i0 + r) * DM + h * 256 + 32 * ks + 8 * q);
            f32x4 S[16];
#pragma unroll
            for (int mt = 0; mt < 16; ++mt) {
                f32x4 acc = {0.f, 0.f, 0.f, 0.f};
                CFENCE();
#pragma unroll
                for (int ks = 0; ks < 8; ++ks) { const bf16x8 a = *(const LAS bf16x8*)(lds + (16 * mt + r) * APITCH + (32 * ks + 8 * q) * 2); acc = MFMA16(a, Qf[ks], acc); }
                S[mt] = acc;
            }
            CFENCE();
            float mx = -3.0e38f;
#pragma unroll
            for (int mt = 0; mt < 16; ++mt) mx = fmaxf(fmaxf(fmaxf(S[mt][0], S[mt][1]), fmaxf(S[mt][2], S[mt][3])), mx);
            mx = fmaxf(mx, __shfl_xor(mx, 16)); mx = fmaxf(mx, __shfl_xor(mx, 32));
            CFENCE();
            float sum = 0.f;
#pragma unroll
            for (int mt = 0; mt < 16; ++mt) {
#pragma unroll
                for (int e = 0; e < 4; ++e) { S[mt][e] = __builtin_amdgcn_exp2f(S[mt][e] - mx); sum += S[mt][e]; }
                CFENCE();
            }
            sum += __shfl_xor(sum, 16); sum += __shfl_xor(sum, 32);
            const float inv = 1.0f / sum;
            CFENCE();
#pragma unroll
            for (int s = 0; s < 8; ++s) { pf[it][s] = pack8(S[2 * s] * inv, S[2 * s + 1] * inv); CFENCE(); }
        }
        __syncthreads();
        stage_image(lds, Vtg + (size_t)(b * 1024 + h * 256) * 256, tid);
        __syncthreads();
#pragma unroll
        for (int it = 0; it < 2; ++it) {
            const size_t i0 = (size_t)b * SEQ + qb * 256 + wave * 32 + 16 * it;
#pragma unroll
            for (int nt = 0; nt < 16; ++nt) {
                f32x4 acc = {0.f, 0.f, 0.f, 0.f};
                CFENCE();
#pragma unroll
                for (int s = 0; s < 8; ++s) {
                    const u32x2 lo = *(const LAS u32x2*)(lds + (16 * nt + r) * APITCH + (32 * s + 4 * q) * 2), hi = *(const LAS u32x2*)(lds + (16 * nt + r) * APITCH + (32 * s + 16 + 4 * q) * 2);
                    const u32x4 w = {lo.x, lo.y, hi.x, hi.y};
                    acc = MFMA16(pf[it][s], __builtin_bit_cast(bf16x8, w), acc);
                }
#pragma unroll
                for (int e = 0; e < 4; ++e) OA[(i0 + 4 * q + e) * DM + h * 256 + 16 * nt + r] = f2bf(acc[e]);
            }
        }
    }
}

__device__ __forceinline__ void final_norm(const Params& p, int G) {
    const int lane = threadIdx.x & 63, wave = __builtin_amdgcn_readfirstlane(threadIdx.x >> 6);
    for (int m = blockIdx.x * NWAVES + wave; m < NTOK; m += G * NWAVES) {
        f32x4* xr = (f32x4*)(p.out + (size_t)m * DM) + lane; const f32x4* gr = (const f32x4*)p.final_norm_g + lane;
        f32x4 v[4]; float s = 0.f;
#pragma unroll
        for (int j = 0; j < 4; ++j) { v[j] = xr[64 * j]; s += (v[j][0] * v[j][0] + v[j][1] * v[j][1]) + (v[j][2] * v[j][2] + v[j][3] * v[j][3]); }
        const float rstd = 1.0f / sqrtf(wave_sum(s) * (1.0f / 1024.0f) + 1e-6f);
#pragma unroll
        for (int j = 0; j < 4; ++j) xr[64 * j] = v[j] * rstd * gr[64 * j];
    }
}

constexpr int NPHASE = 12;
__global__ void __launch_bounds__(NTHREADS, 2) fwd_megakernel(Params p) {
    extern __shared__ __attribute__((aligned(16))) unsigned char lds_raw[];
    LAS unsigned char* lds = (LAS unsigned char*)lds_raw;
    cg::grid_group grid = cg::this_grid();
    const int G = gridDim.x, lo = p.ph_lo, hi = p.ph_hi;
    unsigned char* ws = p.ws;
#define IN(k) (lo <= (k) && (k) < hi)
#define SEAM(k) do { if (IN(k) && IN((k) + 1)) { asm volatile("s_waitcnt vmcnt(0) lgkmcnt(0)" ::: "memory"); grid.sync(); __builtin_amdgcn_fence(__ATOMIC_ACQUIRE, "agent"); asm volatile("s_waitcnt vmcnt(0)" ::: "memory"); } } while (0)
    #ifndef NO_P0
    if (IN(0)) { p0_prologue(p, lds, G); }
#endif
    SEAM(0);
    if (IN(1)) {
        {
            pg8::Gemm g{(const bf16_t*)(ws + WS_A1), (const bf16_t*)(ws + WS_WIN), NTOK, NPROJ, DM}; pg8::StaticOrder S; S.init(NTOK, NPROJ, G, (int)blockIdx.x);
            pg8::EpiBf16<0> E{(bf16_t*)(ws + WS_BIG), NPROJ, nullptr, 0, 0, 1.f};
            pg8::gemm_phase<pg8::EpiBf16<0>, pg8::StaticOrder, true, true>(lds, g, S, E);
        }
        __syncthreads();
        {
            pg8::Gemm g{(const bf16_t*)(ws + WS_MEMN), (const bf16_t*)(ws + WS_WKV), NMEMROWS, 2048, DM}; pg8::StaticOrder S; S.init(NMEMROWS, 2048, G, (int)((blockIdx.x + G / 2) % G));
            pg8::EpiKV E{(bf16_t*)(ws + WS_KB), (bf16_t*)(ws + WS_VT)};
            pg8::gemm_phase<pg8::EpiKV, pg8::StaticOrder, true, true>(lds, g, S, E);
        }
        __syncthreads();
    } SEAM(1);
    #ifndef NO_P2
    if (IN(2)) { chunk_contrib(p, lds, G); }
#endif
    SEAM(2);
    if (IN(3)) { chunk_scan(p, G); } SEAM(3);
    #ifndef NO_P4
    if (IN(4)) { chunk_output(p, lds, G); }
#endif
    SEAM(4);
    if (IN(5)) {
        pg8::Gemm g{(const bf16_t*)(ws + WS_A1), (const bf16_t*)(ws + WS_WOUT), NTOK, DM, DM}; pg8::StaticOrder S; S.init(NTOK, DM, G, (int)blockIdx.x);
        pg8::EpiRes E{p.x, p.out, (bf16_t*)(ws + WS_A2), (float*)(ws + WS_SSQ1)};
        pg8::gemm_phase<pg8::EpiRes, pg8::StaticOrder, true, true>(lds, g, S, E);
        __syncthreads();
    } SEAM(5);
    if (IN(6)) {
        pg8::Gemm g{(const bf16_t*)(ws + WS_A2), (const bf16_t*)(ws + WS_WQ), NTOK, DM, DM}; pg8::StaticOrder S; S.init(NTOK, DM, G, (int)blockIdx.x);
        pg8::EpiScale<0> E{(bf16_t*)(ws + WS_A1), DM, (const float*)(ws + WS_SSQ1), 0.0625f * 1.4426950408889634f};
        pg8::gemm_phase<pg8::EpiScale<0>, pg8::StaticOrder, true, true>(lds, g, S, E);
        __syncthreads();
    } SEAM(6);
    #ifndef NO_P7
    if (IN(7)) { cross_attention(p, lds, G); __syncthreads(); }
#endif
    SEAM(7);
    if (IN(8)) {
        pg8::Gemm g{(const bf16_t*)(ws + WS_A2), (const bf16_t*)(ws + WS_WO), NTOK, DM, DM}; pg8::StaticOrder S; S.init(NTOK, DM, G, (int)blockIdx.x);
        pg8::EpiRes E{p.out, p.out, (bf16_t*)(ws + WS_A1), (float*)(ws + WS_SSQ2)};
        pg8::gemm_phase<pg8::EpiRes, pg8::StaticOrder, true, true>(lds, g, S, E);
        __syncthreads();
    } SEAM(8);
    if (IN(9)) {
        pg8::Gemm g{(const bf16_t*)(ws + WS_A1), (const bf16_t*)(ws + WS_W1), NTOK, DFF, DM}; pg8::StaticOrder S; S.init(NTOK, DFF, G, (int)blockIdx.x);
        pg8::EpiScale<1> E{(bf16_t*)(ws + WS_BIG), DFF, (const float*)(ws + WS_SSQ2), 1.0f};
        pg8::gemm_phase<pg8::EpiScale<1>, pg8::StaticOrder, true, true>(lds, g, S, E);
        __syncthreads();
    } SEAM(9);
    if (IN(10)) {
        pg8::Gemm g{(const bf16_t*)(ws + WS_BIG), (const bf16_t*)(ws + WS_W2), NTOK, DM, DFF}; pg8::StaticOrder S; S.init(NTOK, DM, G, (int)blockIdx.x);
        pg8::EpiRes E{p.out, p.out, nullptr, nullptr};
        pg8::gemm_phase<pg8::EpiRes, pg8::StaticOrder, true, true>(lds, g, S, E);
        __syncthreads();
    } SEAM(10);
    if (IN(11)) { final_norm(p, G); }
#undef IN
#undef SEAM
}

#ifndef MK_PER_PHASE
#define MK_PER_PHASE 0
#endif
#ifdef DBG_DUMP_OFF
__global__ void dump_kernel(const bf16_t* src, size_t n, float* out) {
    for (size_t i = (size_t)blockIdx.x * blockDim.x + threadIdx.x; i < (size_t)NTOK * DM; i += (size_t)gridDim.x * blockDim.x) {
        float s = 0.f; for (size_t j = i; j < n; j += (size_t)NTOK * DM) s += bf2f(src[j]); out[i] = s; }
}
#endif
extern "C" void kernel_launch(void* const* d_in, const int* in_sizes, int n_in, void* d_out, int out_size, void* d_ws, size_t ws_size, hipStream_t stream) {
    static int grid = 0;
    if (grid == 0) {
        if (n_in != 18 || ws_size < WS_NEED) { fprintf(stderr, "kernel_launch: expected 18 inputs and >= %zu bytes of workspace (got %d, %zu)\n", (size_t)WS_NEED, n_in, ws_size); grid = -1; return; }
        int dev = 0, cus = 0, per_cu = 0;
        (void)hipGetDevice(&dev); (void)hipDeviceGetAttribute(&cus, hipDeviceAttributeMultiprocessorCount, dev);
        if (hipFuncSetAttribute((const void*)fwd_megakernel, hipFuncAttributeMaxDynamicSharedMemorySize, LDS_BYTES) != hipSuccess) { fprintf(stderr, "kernel_launch: hipFuncSetAttribute failed\n"); grid = -1; return; }
        if (hipOccupancyMaxActiveBlocksPerMultiprocessor(&per_cu, (const void*)fwd_megakernel, NTHREADS, LDS_BYTES) != hipSuccess || per_cu < 1) { fprintf(stderr, "kernel_launch: occupancy query failed (%d)\n", per_cu); (void)hipGetLastError(); grid = -1; return; }
        grid = cus * per_cu;
    }
    if (grid < 0) return;
    Params p{};
    const float** pp = (const float**)&p;
    for (int i = 0; i < 18; ++i) pp[i] = (const float*)d_in[i];
    p.out = (float*)d_out; p.ws = (unsigned char*)d_ws;
#if MK_PER_PHASE
#ifndef DBG_HI
#define DBG_HI NPHASE
#endif
    for (int k = 0; k < DBG_HI; ++k) { p.ph_lo = k; p.ph_hi = k + 1; hipLaunchKernelGGL(fwd_megakernel, dim3(grid), dim3(NTHREADS), LDS_BYTES, stream, p); }
#ifdef DBG_DUMP_OFF
    hipLaunchKernelGGL(dump_kernel, dim3(2048), dim3(256), 0, stream, (const bf16_t*)((unsigned char*)d_ws + (size_t)(DBG_DUMP_OFF) * MiB), (size_t)(DBG_DUMP_N), (float*)d_out);
#endif
#else
    p.ph_lo = 0; p.ph_hi = NPHASE;
    void* args[] = {&p};
    const hipError_t e = hipLaunchCooperativeKernel((const void*)fwd_megakernel, dim3(grid), dim3(NTHREADS), args, LDS_BYTES, stream);
    if (e != hipSuccess) fprintf(stderr, "kernel_launch: cooperative launch failed: %s (grid %d)\n", hipGetErrorString(e), grid);
#endif
}
```

```cpp
#include <hip/hip_runtime.h>
#include <hip/hip_cooperative_groups.h>
#include <cstdio>
#include <cstdint>
namespace cg = cooperative_groups;
namespace pg8 {
#define PG8_LAS __attribute__((address_space(3)))
typedef unsigned short bf16_t;
typedef short bf16x8 __attribute__((ext_vector_type(8)));
typedef float f32x4 __attribute__((ext_vector_type(4)));
typedef unsigned u32x4 __attribute__((ext_vector_type(4)));
constexpr int BM = 256, BK = 64, HALF = 128, HTB = HALF * BK * 2  , STAGE_BYTES = 8 * HTB, NXCD = 8, WGM = 8;

__host__ __device__ __forceinline__ int lds_byte(int r, int c) { const int st = (r >> 4) * 2 + (c >> 5), rr = r & 15, cc = c & 31, ob = rr * 64 + cc * 2; return st * 1024 + (ob ^ (((ob >> 9) & 1) << 5)); }
__host__ __device__ __forceinline__ void stage_rc(int b, int& R, int& C) { const int st = b / 1024, sb = b % 1024, swz = sb ^ (((sb >> 9) & 1) << 5); R = (st >> 1) * 16 + swz / 64; C = (st & 1) * 32 + (swz % 64) / 2; }
__host__ __device__ __forceinline__ int perm32(int rho) { const int n = rho >> 4, i = rho & 15; return 8 * (i >> 2) + 4 * n + (i & 3); }

struct Unit { int pm, pn; };
struct Gemm { const bf16_t* A; const bf16_t* Bt; int M, N, K; };

struct StaticOrder {
    int nM, nN, nwg, G, c;
    __host__ __device__ void init(int M, int N, int G_, int c_) { nM = M / BM; nN = N / BM; nwg = nM * nN; G = G_; c = c_; }
    __host__ __device__ bool next(int i, Unit& u) const {
        const long L = (long)i * G + c; if (L >= nwg) return false;
        int wgid = (int)L; { const int q = nwg / NXCD, r = nwg % NXCD, xcd = wgid % NXCD, off = wgid / NXCD; wgid = (xcd < r ? xcd * (q + 1) : r * (q + 1) + (xcd - r) * q) + off; }
        const int nig = WGM * nN, gid = wgid / nig, fm = gid * WGM, gsz = (nM - fm) < WGM ? (nM - fm) : WGM;
        u.pm = fm + ((wgid % nig) % gsz); u.pn = (wgid % nig) / gsz; return true;
    }
    __device__ __forceinline__ void a_ready(const Unit&) const {}
    __device__ __forceinline__ void done(const Unit&) const {}
};

__device__ __forceinline__ unsigned cvt_pk_bf16(float lo, float hi) { unsigned r; asm volatile("v_cvt_pk_bf16_f32 %0, %1, %2" : "=v"(r) : "v"(lo), "v"(hi)); return r; }
typedef float f32x2 __attribute__((ext_vector_type(2)));
__device__ __forceinline__ f32x2 gelu_pk(f32x2 v) {
    const f32x2 av = __builtin_elementwise_abs(v), d = av * 0.2316418882f + 1.0f;
    f32x2 t; t.x = __builtin_amdgcn_rcpf(d.x); t.y = __builtin_amdgcn_rcpf(d.y);
    f32x2 q = t * 0.5307027145f + (-0.7265760135f); q = q * t + 0.7107068705f; q = q * t + (-0.142248368f); q = q * t + 0.127414796f; q = q * t;
    const f32x2 s = (v * v) * (-0.72134752044f);
    f32x2 e; e.x = __builtin_amdgcn_exp2f(s.x); e.y = __builtin_amdgcn_exp2f(s.y);
    const f32x2 m = v * (q * e), r = v - m;
    f32x2 o; o.x = v.x < 0.f ? m.x : r.x; o.y = v.y < 0.f ? m.y : r.y; return o;
}

template <int ACT  > struct EpiBf16 {
    static constexpr bool PERM = true, AFTER_DRAIN = false; static_assert(ACT == 0 || ACT == 1, "EpiBf16: ACT is 0 (none) or 1 (gelu_pk)");
    bf16_t* O; int ldc; const float* bias; int split_cols; size_t split_stride; float scale0;
    __device__ __forceinline__ void operator()(const f32x4 (&acc)[2][2][4][2], const Unit& u, int wr, int wc, int fr, int fq) const {
        const int row0 = u.pm * BM + wr * 64 + fr; int colt = u.pn * BM; bf16_t* base = O;
        float sc = 1.f; if (split_cols) { const int t = colt / split_cols; base += (size_t)t * split_stride; colt -= t * split_cols; if (t == 0) sc = scale0; }
        const int col0 = colt + wc * 32 + 8 * fq, bcol0 = u.pn * BM + wc * 32 + 8 * fq;
        f32x4 bv[2][2];
#pragma unroll
        for (int bj = 0; bj < 2; ++bj)
#pragma unroll
            for (int n = 0; n < 2; ++n) bv[bj][n] = bias ? *(const f32x4*)(bias + bcol0 + bj * HALF + 4 * n) : (f32x4){0.f, 0.f, 0.f, 0.f};
#pragma unroll
        for (int ai = 0; ai < 2; ++ai)
#pragma unroll
            for (int m = 0; m < 4; ++m) { bf16_t* rowp = base + (size_t)(row0 + ai * HALF + m * 16) * ldc + col0;
#pragma unroll
                for (int bj = 0; bj < 2; ++bj) { f32x4 v0 = acc[ai][bj][m][0] + bv[bj][0], v1 = acc[ai][bj][m][1] + bv[bj][1];
                    if (ACT == 1) { f32x2 a = gelu_pk((f32x2){v0[0], v0[1]}), b = gelu_pk((f32x2){v0[2], v0[3]}), c = gelu_pk((f32x2){v1[0], v1[1]}), d = gelu_pk((f32x2){v1[2], v1[3]});
                        v0 = (f32x4){a.x, a.y, b.x, b.y}; v1 = (f32x4){c.x, c.y, d.x, d.y}; }
                    v0 = v0 * sc; v1 = v1 * sc; u32x4 w; w.x = cvt_pk_bf16(v0[0], v0[1]); w.y = cvt_pk_bf16(v0[2], v0[3]); w.z = cvt_pk_bf16(v1[0], v1[1]); w.w = cvt_pk_bf16(v1[2], v1[3]);
                    *(u32x4*)(rowp + bj * HALF) = w; } }
    }
};

struct PanelStats {
    unsigned* xbuf;
    unsigned* cnt;
    unsigned* tmo;
    int ntn; float eps;
    unsigned code;
    __device__ __forceinline__ bool run(const f32x4 (&v)[2][2][4][2], const Unit& u, int wr, int wc, int fr, int fq, PG8_LAS unsigned char* lds, int wid, int lane) const {
        typedef float f32x2v __attribute__((ext_vector_type(2)));
        PG8_LAS f32x2v* P = (PG8_LAS f32x2v*)lds;
        PG8_LAS f32x2v* S = (PG8_LAS f32x2v*)(lds + 8192);
        PG8_LAS unsigned* flag = (PG8_LAS unsigned*)(lds + 8192 + 2048);
#pragma unroll
        for (int ai = 0; ai < 2; ++ai)
#pragma unroll
            for (int m = 0; m < 4; ++m) {
                float s = 0.f;
#pragma unroll
                for (int bj = 0; bj < 2; ++bj)
#pragma unroll
                    for (int n = 0; n < 2; ++n) { const f32x4 x = v[ai][bj][m][n]; s += (x[0] + x[1]) + (x[2] + x[3]); }
                s += __shfl_xor(s, 16); s += __shfl_xor(s, 32);
                const float mw = s * (1.0f / 64.0f); float q = 0.f;
#pragma unroll
                for (int bj = 0; bj < 2; ++bj)
#pragma unroll
                    for (int n = 0; n < 2; ++n) { const f32x4 d = v[ai][bj][m][n] - mw; q += (d[0] * d[0] + d[1] * d[1]) + (d[2] * d[2] + d[3] * d[3]); }
                q += __shfl_xor(q, 16); q += __shfl_xor(q, 32);
                if (fq == 0) P[(ai * HALF + wr * 64 + m * 16 + fr) * 4 + wc] = (f32x2v){mw, q};
            }
        asm volatile("s_waitcnt lgkmcnt(0)" ::: "memory"); __builtin_amdgcn_s_barrier(); asm volatile("" ::: "memory");
#if defined(BROKEN_EXCHANGE_NO_WAIT)
#warning BROKEN CONTROL BUILD: the row-statistics exchange does not wait; results are wrong by design
        if (blockIdx.x >= 64) { const long long t0_ = clock64(); while (clock64() - t0_ < 60000) __builtin_amdgcn_s_sleep(8); }
#endif
        const int row = wid * 32 + (lane & 31);
        if (lane < 32) {
            const f32x2v a = P[row * 4 + 0], b = P[row * 4 + 1], c = P[row * 4 + 2], d = P[row * 4 + 3];
            const float mt = (a.x + b.x + c.x + d.x) * 0.25f;
            const float da = a.x - mt, db = b.x - mt, dc = c.x - mt, dd = d.x - mt;
            const float m2 = (a.y + b.y) + (c.y + d.y) + 64.0f * ((da * da + db * db) + (dc * dc + dd * dd));
            unsigned long long* slot = (unsigned long long*)xbuf + ((size_t)(u.pm * BM + row) * 4 + u.pn);
            __hip_atomic_store(slot, ((unsigned long long)__float_as_uint(m2) << 32) | __float_as_uint(mt), __ATOMIC_RELAXED, __HIP_MEMORY_SCOPE_AGENT);
        }
        asm volatile("s_waitcnt vmcnt(0)" ::: "memory");
        if (lane == 0) __hip_atomic_fetch_add(cnt + 64 * u.pm, 1u, __ATOMIC_RELAXED, __HIP_MEMORY_SCOPE_AGENT);
        if (wid == 0) {
            bool dead = false; const unsigned long long t0 = __builtin_amdgcn_s_memrealtime(); const unsigned want = 8u * (unsigned)ntn;
            for (;;) {
#if defined(BROKEN_EXCHANGE_NO_WAIT)
                break;
#endif
                if ((unsigned)__builtin_amdgcn_readfirstlane(__hip_atomic_load(cnt + 64 * u.pm, __ATOMIC_RELAXED, __HIP_MEMORY_SCOPE_AGENT)) >= want) break;
                if (__builtin_amdgcn_s_memrealtime() - t0 > 2000000ull) {
                    if (lane == 0) { unsigned expect = 0u; __hip_atomic_compare_exchange_strong(tmo + 1, &expect, code | (unsigned)(u.pm & 0xff), __ATOMIC_RELAXED, __ATOMIC_RELAXED, __HIP_MEMORY_SCOPE_AGENT);
                                     __hip_atomic_store(tmo, 1u, __ATOMIC_RELAXED, __HIP_MEMORY_SCOPE_AGENT); }
                    dead = true; break; }
                __builtin_amdgcn_s_sleep(2);
            }
            __builtin_amdgcn_fence(__ATOMIC_ACQUIRE, "agent");
            if (lane == 0) flag[0] = dead ? 1u : 0u;
        }
        asm volatile("s_waitcnt vmcnt(0) lgkmcnt(0)" ::: "memory"); __builtin_amdgcn_s_barrier(); asm volatile("" ::: "memory");
        const bool bad = flag[0] != 0u;
        if (lane < 32) {
            const unsigned long long* slot = (const unsigned long long*)xbuf + (size_t)(u.pm * BM + row) * 4; float mt[4], m2[4]; float ms = 0.f;
#pragma unroll
            for (int t = 0; t < 4; ++t) { if (t < ntn) { const unsigned long long w = __hip_atomic_load(slot + t, __ATOMIC_RELAXED, __HIP_MEMORY_SCOPE_AGENT); mt[t] = __uint_as_float((unsigned)w); m2[t] = __uint_as_float((unsigned)(w >> 32)); } else { mt[t] = 0.f; m2[t] = 0.f; } ms += mt[t]; }
            const float mean = ms / (float)ntn; float q = 0.f;
#pragma unroll
            for (int t = 0; t < 4; ++t) if (t < ntn) { const float dm = mt[t] - mean; q += m2[t] + 256.0f * dm * dm; }
            S[row] = (f32x2v){mean, 1.0f / sqrtf(q / (256.0f * (float)ntn) + eps)};
        }
        asm volatile("s_waitcnt lgkmcnt(0)" ::: "memory"); __builtin_amdgcn_s_barrier(); asm volatile("" ::: "memory");
        return bad;
    }
};
struct EpiLnRes {
    static constexpr bool PERM = false, AFTER_DRAIN = true;
    const float* base; float* out; int ldc; const float* bias; PanelStats st; unsigned poison;
    __device__ __forceinline__ void fused(f32x4 (&acc)[2][2][4][2], const Unit& u, int wr, int wc, int fr, int fq, PG8_LAS unsigned char* lds, int wid, int lane) const {
        typedef float f32x2v __attribute__((ext_vector_type(2)));
        const PG8_LAS f32x2v* S = (const PG8_LAS f32x2v*)(lds + 8192);
        const int col0 = u.pn * BM + wc * 32 + 4 * fq;
#pragma unroll
        for (int bj = 0; bj < 2; ++bj)
#pragma unroll
            for (int n = 0; n < 2; ++n) { const f32x4 bv = bias ? *(const f32x4*)(bias + col0 + bj * HALF + n * 16) : (f32x4){0.f, 0.f, 0.f, 0.f};
#pragma unroll
                for (int ai = 0; ai < 2; ++ai)
#pragma unroll
                    for (int m = 0; m < 4; ++m) acc[ai][bj][m][n] += bv; }
        f32x4 pre[4][2][2];
#pragma unroll
        for (int m = 0; m < 4; ++m) { const size_t off = (size_t)(u.pm * BM + wr * 64 + m * 16 + fr) * ldc + col0;
#pragma unroll
            for (int bj = 0; bj < 2; ++bj)
#pragma unroll
                for (int n = 0; n < 2; ++n) pre[m][bj][n] = *(const f32x4*)(base + off + bj * HALF + n * 16); }
        const bool bad = st.run(acc, u, wr, wc, fr, fq, lds, wid, lane) || poison != 0u;
        const float qnan = __builtin_nanf("");
#pragma unroll
        for (int ai = 0; ai < 2; ++ai)
#pragma unroll
            for (int m = 0; m < 4; ++m) { const int r = ai * HALF + wr * 64 + m * 16 + fr; const f32x2v sr = S[r]; const size_t off = (size_t)(u.pm * BM + r) * ldc + col0;
#pragma unroll
                for (int bj = 0; bj < 2; ++bj)
#pragma unroll
                    for (int n = 0; n < 2; ++n) { const f32x4 bs = ai == 0 ? pre[m][bj][n] : *(const f32x4*)(base + off + bj * HALF + n * 16); f32x4 o = bs + (acc[ai][bj][m][n] - sr.x) * sr.y;
                        if (bad) o = (f32x4){qnan, qnan, qnan, qnan}; *(f32x4*)(out + off + bj * HALF + n * 16) = o; }
                if (m & 1) asm volatile("" ::: "memory"); }
    }
};
struct EpiLnResLn {
    static constexpr bool PERM = false, AFTER_DRAIN = true;
    const float* base; float* out; bf16_t* xn; int ldc; const float* bias; PanelStats st1, st2; unsigned poison;
    __device__ __forceinline__ void fused(f32x4 (&acc)[2][2][4][2], const Unit& u, int wr, int wc, int fr, int fq, PG8_LAS unsigned char* lds, int wid, int lane) const {
        typedef float f32x2v __attribute__((ext_vector_type(2))); typedef unsigned u32x2v __attribute__((ext_vector_type(2)));
        const PG8_LAS f32x2v* S = (const PG8_LAS f32x2v*)(lds + 8192);
        const int col0 = u.pn * BM + wc * 32 + 4 * fq;
#pragma unroll
        for (int bj = 0; bj < 2; ++bj)
#pragma unroll
            for (int n = 0; n < 2; ++n) { const f32x4 bv = bias ? *(const f32x4*)(bias + col0 + bj * HALF + n * 16) : (f32x4){0.f, 0.f, 0.f, 0.f};
#pragma unroll
                for (int ai = 0; ai < 2; ++ai)
#pragma unroll
                    for (int m = 0; m < 4; ++m) acc[ai][bj][m][n] += bv; }
        bool bad = st1.run(acc, u, wr, wc, fr, fq, lds, wid, lane) || poison != 0u;
        const float qnan = __builtin_nanf("");
#pragma unroll
        for (int ai = 0; ai < 2; ++ai)
#pragma unroll
            for (int m = 0; m < 4; ++m) { const int r = ai * HALF + wr * 64 + m * 16 + fr; const f32x2v sr = S[r]; const size_t off = (size_t)(u.pm * BM + r) * ldc + col0;
#pragma unroll
                for (int bj = 0; bj < 2; ++bj)
#pragma unroll
                    for (int n = 0; n < 2; ++n) { const f32x4 bs = *(const f32x4*)(base + off + bj * HALF + n * 16); acc[ai][bj][m][n] = bs + (acc[ai][bj][m][n] - sr.x) * sr.y; }
                asm volatile("" : "+v"(acc[ai][0][m][0]), "+v"(acc[ai][0][m][1]), "+v"(acc[ai][1][m][0]), "+v"(acc[ai][1][m][1]));
                if (m & 1) asm volatile("" ::: "memory"); }
        const bool bad1 = bad;
        bad = st2.run(acc, u, wr, wc, fr, fq, lds, wid, lane) || bad;
#pragma unroll
        for (int ai = 0; ai < 2; ++ai)
#pragma unroll
            for (int m = 0; m < 4; ++m) { const int r = ai * HALF + wr * 64 + m * 16 + fr; const f32x2v sr = S[r]; const size_t off = (size_t)(u.pm * BM + r) * ldc + col0;
#pragma unroll
                for (int bj = 0; bj < 2; ++bj)
#pragma unroll
                    for (int n = 0; n < 2; ++n) { const f32x4 x1 = acc[ai][bj][m][n]; *(f32x4*)(out + off + bj * HALF + n * 16) = bad1 ? (f32x4){qnan, qnan, qnan, qnan} : x1;
                        const f32x4 o = (x1 - sr.x) * sr.y; u32x2v w; w.x = cvt_pk_bf16(o[0], o[1]); w.y = cvt_pk_bf16(o[2], o[3]);
                        if (bad) { w.x = 0x7fc07fc0u; w.y = 0x7fc07fc0u; } *(u32x2v*)(xn + off + bj * HALF + n * 16) = w; }
                asm volatile("" ::: "memory"); }
    }
};

template <class Epi, class Sched, bool ALIGN_EPI = false, bool SP2 = false>
__device__ __forceinline__ void gemm_phase(PG8_LAS unsigned char* lds, const Gemm g, const Sched& S, const Epi& E) {
    const int tid = threadIdx.x, wid = __builtin_amdgcn_readfirstlane(tid >> 6), lane = tid & 63, wr = wid >> 2, wc = wid & 3, fr = lane & 15, fq = lane >> 4;
    const int K = g.K, nt = K / BK;
    unsigned voffA[2], voffB[2];
#pragma unroll
    for (int i = 0; i < 2; ++i) { int R, C; stage_rc(tid * 16 + i * 8192, R, C); const int Rb = Epi::PERM ? ((R & ~31) + perm32(R & 31)) : R;
        voffA[i] = (unsigned)(R * K + C) * 2u; voffB[i] = (unsigned)(Rb * K + C) * 2u; }
    const size_t kstep = (size_t)(BK * 2);
    const size_t hstep = (size_t)HALF * K * 2;
    const size_t tstep = 2 * hstep;
    const unsigned ldsw = (unsigned)wid * 1024u;
    const int aoff = lds_byte(wr * 64 + fr, fq * 8), boff = lds_byte(wc * 32 + fr, fq * 8);
#define PG8_SA(b, h) (((b) * 2 + (h)) * HTB)
#define PG8_SB(b, h) ((4 + (b) * 2 + (h)) * HTB)
#define PG8_STAGE(bufoff, gbase, voff) do { _Pragma("unroll") for (int _i = 0; _i < 2; ++_i) \
        __builtin_amdgcn_global_load_lds((const unsigned*)((const char*)(gbase) + (voff)[_i]), (PG8_LAS unsigned*)(lds + (bufoff) + ldsw + _i * 8192), 16, 0, 0); } while (0)
#define PG8_LDA(dst, b, h) do { _Pragma("unroll") for (int m = 0; m < 4; ++m) _Pragma("unroll") for (int k = 0; k < 2; ++k) dst[m][k] = *(const PG8_LAS bf16x8*)(lds + PG8_SA(b, h) + aoff + m * 2048 + k * 1024); } while (0)
#define PG8_LDB(dst, b, h) do { _Pragma("unroll") for (int n = 0; n < 2; ++n) _Pragma("unroll") for (int k = 0; k < 2; ++k) dst[n][k] = *(const PG8_LAS bf16x8*)(lds + PG8_SB(b, h) + boff + n * 2048 + k * 1024); } while (0)
#define PG8_MMA(ai, bj, At, Bt) do { __builtin_amdgcn_s_setprio(1); _Pragma("unroll") for (int m = 0; m < 4; ++m) _Pragma("unroll") for (int n = 0; n < 2; ++n) _Pragma("unroll") for (int k = 0; k < 2; ++k) \
        acc[ai][bj][m][n] = __builtin_amdgcn_mfma_f32_16x16x32_bf16(Bt[n][k], At[m][k], acc[ai][bj][m][n], 0, 0, 0); __builtin_amdgcn_s_setprio(0); } while (0)
#define PG8_WAIT_V(n) asm volatile("s_waitcnt vmcnt(" #n ")" ::: "memory")
#define PG8_WAIT_L(n) asm volatile("s_waitcnt lgkmcnt(" #n ")" ::: "memory")
#define PG8_BAR __builtin_amdgcn_s_barrier()
#define PG8_SCHED __builtin_amdgcn_sched_barrier(0)
    Unit cur, nxt; int ui = 0;
    if (!S.next(0, cur)) return;
    f32x4 acc[2][2][4][2];
#pragma unroll
    for (int a = 0; a < 2; ++a)
#pragma unroll
        for (int b = 0; b < 2; ++b)
#pragma unroll
            for (int m = 0; m < 4; ++m)
#pragma unroll
                for (int n = 0; n < 2; ++n) acc[a][b][m][n] = (f32x4){0.f, 0.f, 0.f, 0.f};
    bf16x8 At[4][2], B0[2][2], B1[2][2];
    const char* cA = (const char*)g.A + (size_t)cur.pm * tstep; const char* cB = (const char*)g.Bt + (size_t)cur.pn * tstep;
    S.a_ready(cur);
    if constexpr (SP2) {
        PG8_STAGE(PG8_SB(0, 0), cB, voffB); PG8_STAGE(PG8_SB(0, 1), cB + hstep, voffB); PG8_STAGE(PG8_SA(0, 0), cA, voffA); PG8_STAGE(PG8_SA(0, 1), cA + hstep, voffA);
        if (wr == 1) PG8_BAR;
        PG8_WAIT_V(2); PG8_BAR;
        PG8_STAGE(PG8_SB(1, 0), cB + kstep, voffB); PG8_STAGE(PG8_SA(1, 0), cA + kstep, voffA); PG8_STAGE(PG8_SB(1, 1), cB + hstep + kstep, voffB);
        PG8_WAIT_V(6); PG8_BAR;
    } else {
        PG8_STAGE(PG8_SB(0, 0), cB, voffB); PG8_STAGE(PG8_SA(0, 0), cA, voffA); PG8_STAGE(PG8_SB(0, 1), cB + hstep, voffB); PG8_STAGE(PG8_SA(0, 1), cA + hstep, voffA);
        if (wr == 1) PG8_BAR;
        PG8_WAIT_V(4); PG8_BAR;
        PG8_STAGE(PG8_SB(1, 0), cB + kstep, voffB); PG8_STAGE(PG8_SA(1, 0), cA + kstep, voffA); PG8_STAGE(PG8_SB(1, 1), cB + hstep + kstep, voffB);
        PG8_WAIT_V(6); PG8_BAR;
    }
    for (;;) {
        const bool has_next = S.next(ui + 1, nxt);
        const char* nA = has_next ? (const char*)g.A + (size_t)nxt.pm * tstep : cA; const char* nB = has_next ? (const char*)g.Bt + (size_t)nxt.pn * tstep : cB;
        for (int t = 0; t < nt; t += 2) {
            const bool last = (t == nt - 2);
            const char* a1 = cA + (size_t)(t + 1) * kstep;
            const char* a2 = last ? nA : cA + (size_t)(t + 2) * kstep; const char* b2 = last ? nB : cB + (size_t)(t + 2) * kstep;
            const char* a3 = a2 + kstep; const char* b3 = b2 + kstep;
            if (last && has_next) S.a_ready(nxt);
            if constexpr (SP2) {
            PG8_LDB(B0, 0, 0); PG8_LDB(B1, 0, 1); PG8_SCHED; PG8_LDA(At, 0, 0); PG8_STAGE(PG8_SA(1, 1), a1 + hstep, voffA);
            PG8_WAIT_V(8); PG8_WAIT_L(0); PG8_BAR; PG8_MMA(0, 0, At, B0); PG8_MMA(0, 1, At, B1); PG8_BAR; PG8_SCHED;
            PG8_LDA(At, 0, 1); PG8_STAGE(PG8_SB(0, 0), b2, voffB); PG8_STAGE(PG8_SB(0, 1), b2 + hstep, voffB); PG8_STAGE(PG8_SA(0, 0), a2, voffA);
            PG8_WAIT_V(8); PG8_WAIT_L(0); PG8_BAR; PG8_MMA(1, 0, At, B0); PG8_MMA(1, 1, At, B1); PG8_BAR; PG8_SCHED;
            PG8_LDB(B0, 1, 0); PG8_LDB(B1, 1, 1); PG8_SCHED; PG8_LDA(At, 1, 0); PG8_STAGE(PG8_SA(0, 1), a2 + hstep, voffA);
            PG8_WAIT_V(8); PG8_WAIT_L(0); PG8_BAR; PG8_MMA(0, 0, At, B0); PG8_MMA(0, 1, At, B1); PG8_BAR; PG8_SCHED;
            PG8_LDA(At, 1, 1); PG8_STAGE(PG8_SB(1, 0), b3, voffB); PG8_STAGE(PG8_SB(1, 1), b3 + hstep, voffB); PG8_STAGE(PG8_SA(1, 0), a3, voffA);
            PG8_WAIT_V(8); PG8_WAIT_L(0); PG8_BAR; PG8_MMA(1, 0, At, B0); PG8_MMA(1, 1, At, B1); PG8_BAR; PG8_SCHED;
            } else {
            PG8_LDB(B0, 0, 0); PG8_SCHED; PG8_LDA(At, 0, 0); PG8_STAGE(PG8_SA(1, 1), a1 + hstep, voffA);
            PG8_WAIT_L(8); PG8_BAR; PG8_WAIT_L(0); PG8_MMA(0, 0, At, B0); PG8_BAR; PG8_SCHED;
            PG8_LDB(B1, 0, 1); PG8_STAGE(PG8_SB(0, 0), b2, voffB);
            PG8_BAR; PG8_WAIT_L(0); PG8_MMA(0, 1, At, B1); PG8_BAR;
            PG8_LDA(At, 0, 1); PG8_STAGE(PG8_SA(0, 0), a2, voffA);
            PG8_BAR; PG8_WAIT_L(0); PG8_MMA(1, 0, At, B0); PG8_BAR; PG8_SCHED;
            PG8_STAGE(PG8_SB(0, 1), b2 + hstep, voffB);
            PG8_WAIT_V(6); PG8_BAR; PG8_MMA(1, 1, At, B1); PG8_BAR;
            PG8_LDB(B0, 1, 0); PG8_SCHED; PG8_LDA(At, 1, 0); PG8_STAGE(PG8_SA(0, 1), a2 + hstep, voffA);
            PG8_WAIT_L(8); PG8_BAR; PG8_WAIT_L(0); PG8_MMA(0, 0, At, B0); PG8_BAR; PG8_SCHED;
            PG8_LDB(B1, 1, 1); PG8_STAGE(PG8_SB(1, 0), b3, voffB);
            PG8_BAR; PG8_WAIT_L(0); PG8_MMA(0, 1, At, B1); PG8_BAR;
            PG8_LDA(At, 1, 1); PG8_STAGE(PG8_SA(1, 0), a3, voffA);
            PG8_BAR; PG8_WAIT_L(0); PG8_MMA(1, 0, At, B0); PG8_BAR; PG8_SCHED;
            PG8_STAGE(PG8_SB(1, 1), b3 + hstep, voffB);
            PG8_WAIT_V(6); PG8_BAR; PG8_MMA(1, 1, At, B1); PG8_BAR;
            }
        }
        if constexpr (ALIGN_EPI) { if (wr == 0) PG8_BAR; }
        if constexpr (!Epi::AFTER_DRAIN) { E(acc, cur, wr, wc, fr, fq); S.done(cur); }
        if (!has_next) break;
#pragma unroll
        for (int a = 0; a < 2; ++a)
#pragma unroll
            for (int b = 0; b < 2; ++b)
#pragma unroll
                for (int m = 0; m < 4; ++m)
#pragma unroll
                    for (int n = 0; n < 2; ++n) acc[a][b][m][n] = (f32x4){0.f, 0.f, 0.f, 0.f};
        cur = nxt; cA = nA; cB = nB; ++ui;
        if constexpr (ALIGN_EPI) { if (wr == 1) PG8_BAR; }
    }
    PG8_WAIT_V(0);
    if constexpr (!ALIGN_EPI) { if (wr == 0) PG8_BAR; }
    PG8_BAR;
    if constexpr (Epi::AFTER_DRAIN) { E.fused(acc, cur, wr, wc, fr, fq, lds, wid, lane); S.done(cur); }
#undef PG8_SA
#undef PG8_SB
#undef PG8_STAGE
#undef PG8_LDA
#undef PG8_LDB
#undef PG8_MMA
#undef PG8_WAIT_V
#undef PG8_WAIT_L
#undef PG8_BAR
#undef PG8_SCHED
}
}

typedef float f32x2_t __attribute__((ext_vector_type(2))); typedef __bf16 bf16x2_t __attribute__((ext_vector_type(2)));
__device__ __forceinline__ unsigned cvtpk(float lo, float hi) { f32x2_t v = {lo, hi}; bf16x2_t b = __builtin_convertvector(v, bf16x2_t); return __builtin_bit_cast(unsigned, b); }

namespace pg8 {
template <bool BASE_BF16> struct EpiRes {
    static constexpr bool PERM = true, AFTER_DRAIN = false;
    const void* base; bf16_t* hb; float* ssq;
    __device__ __forceinline__ void operator()(const f32x4 (&acc)[2][2][4][2], const Unit& u, int wr, int wc, int fr, int fq) const {
        const int row0 = u.pm * BM + wr * 64 + fr, col0 = u.pn * BM + wc * 32 + 8 * fq;
#pragma unroll
        for (int ai = 0; ai < 2; ++ai) {
            f32x4 b0[4][2], b1[4][2];
#pragma unroll
            for (int m = 0; m < 4; ++m)
#pragma unroll
                for (int bj = 0; bj < 2; ++bj) {
                    const size_t off = (size_t)(row0 + ai * HALF + m * 16) * 1024 + col0 + bj * HALF;
                    if (BASE_BF16) {
                        const u32x4 w = *(const u32x4*)((const bf16_t*)base + off);
                        b0[m][bj][0] = __uint_as_float(w.x << 16); b0[m][bj][1] = __uint_as_float(w.x & 0xffff0000u); b0[m][bj][2] = __uint_as_float(w.y << 16); b0[m][bj][3] = __uint_as_float(w.y & 0xffff0000u);
                        b1[m][bj][0] = __uint_as_float(w.z << 16); b1[m][bj][1] = __uint_as_float(w.z & 0xffff0000u); b1[m][bj][2] = __uint_as_float(w.w << 16); b1[m][bj][3] = __uint_as_float(w.w & 0xffff0000u);
                    } else { b0[m][bj] = *(const f32x4*)((const float*)base + off); b1[m][bj] = *(const f32x4*)((const float*)base + off + 4); }
                }
#pragma unroll
            for (int m = 0; m < 4; ++m) {
                const size_t row = (size_t)(row0 + ai * HALF + m * 16); float s = 0.f;
#pragma unroll
                for (int bj = 0; bj < 2; ++bj) {
                    const size_t off = row * 1024 + col0 + bj * HALF;
                    const f32x4 v0 = acc[ai][bj][m][0] + b0[m][bj], v1 = acc[ai][bj][m][1] + b1[m][bj];
                    s += (v0[0] * v0[0] + v0[1] * v0[1]) + (v0[2] * v0[2] + v0[3] * v0[3]) + (v1[0] * v1[0] + v1[1] * v1[1]) + (v1[2] * v1[2] + v1[3] * v1[3]);
                    u32x4 w; w.x = cvtpk(v0[0], v0[1]); w.y = cvtpk(v0[2], v0[3]); w.z = cvtpk(v1[0], v1[1]); w.w = cvtpk(v1[2], v1[3]); *(u32x4*)(hb + off) = w;
                }
                s += __shfl_xor(s, 16); s += __shfl_xor(s, 32); if (fq == 0) ssq[row * 16 + u.pn * 4 + wc] = s;
            }
        }
    }
};
template <int MODE> struct EpiScale {
    static constexpr bool PERM = true, AFTER_DRAIN = false;
    bf16_t* O; int ldc; const float* ssq; float scale;
    __device__ __forceinline__ void operator()(const f32x4 (&acc)[2][2][4][2], const Unit& u, int wr, int wc, int fr, int fq) const {
        const int row0 = u.pm * BM + wr * 64 + fr, col0 = u.pn * BM + wc * 32 + 8 * fq;
#pragma unroll
        for (int ai = 0; ai < 2; ++ai)
#pragma unroll
            for (int m = 0; m < 4; ++m) {
                const size_t row = (size_t)(row0 + ai * HALF + m * 16);
                const f32x4 s0 = *(const f32x4*)(ssq + row * 16), s1 = *(const f32x4*)(ssq + row * 16 + 4), s2 = *(const f32x4*)(ssq + row * 16 + 8), s3 = *(const f32x4*)(ssq + row * 16 + 12);
                const f32x4 st = (s0 + s1) + (s2 + s3);
                const float rs = __builtin_amdgcn_rsqf(((st[0] + st[1]) + (st[2] + st[3])) * (1.0f / 1024.0f) + 1e-6f) * scale;
#pragma unroll
                for (int bj = 0; bj < 2; ++bj) {
                    f32x4 v0 = acc[ai][bj][m][0] * rs, v1 = acc[ai][bj][m][1] * rs;
                    if (MODE == 1) {
#pragma unroll
                        for (int e = 0; e < 4; ++e) { const float a = fmaxf(v0[e], 0.f), b = fmaxf(v1[e], 0.f); v0[e] = a * a; v1[e] = b * b; }
                    }
                    u32x4 w; w.x = cvtpk(v0[0], v0[1]); w.y = cvtpk(v0[2], v0[3]); w.z = cvtpk(v1[0], v1[1]); w.w = cvtpk(v1[2], v1[3]);
                    *(u32x4*)(O + row * ldc + col0 + bj * HALF) = w;
                }
            }
    }
};
struct EpiKV {
    static constexpr bool PERM = true, AFTER_DRAIN = false;
    bf16_t* Kb; bf16_t* Vt;
    __device__ __forceinline__ void operator()(const f32x4 (&acc)[2][2][4][2], const Unit& u, int wr, int wc, int fr, int fq) const {
        const int row0 = u.pm * BM + wr * 64 + fr, col0 = u.pn * BM + wc * 32 + 8 * fq;
#pragma unroll
        for (int ai = 0; ai < 2; ++ai)
#pragma unroll
            for (int m = 0; m < 4; ++m) {
                const int row = row0 + ai * HALF + m * 16;
#pragma unroll
                for (int bj = 0; bj < 2; ++bj) {
                    const int col = col0 + bj * HALF; const f32x4 v0 = acc[ai][bj][m][0], v1 = acc[ai][bj][m][1];
                    u32x4 w; w.x = cvtpk(v0[0], v0[1]); w.y = cvtpk(v0[2], v0[3]); w.z = cvtpk(v1[0], v1[1]); w.w = cvtpk(v1[2], v1[3]);
                    if (col < 1024) { *(u32x4*)(Kb + (size_t)row * 1024 + col) = w; }
                    else {
                        const int b = row >> 8, mm = row & 255; bf16_t* p = Vt + ((size_t)(b * 1024 + (col - 1024))) * 256 + mm;
                        p[0 * 256] = (bf16_t)(w.x & 0xffffu); p[1 * 256] = (bf16_t)(w.x >> 16); p[2 * 256] = (bf16_t)(w.y & 0xffffu); p[3 * 256] = (bf16_t)(w.y >> 16);
                        p[4 * 256] = (bf16_t)(w.z & 0xffffu); p[5 * 256] = (bf16_t)(w.z >> 16); p[6 * 256] = (bf16_t)(w.w & 0xffffu); p[7 * 256] = (bf16_t)(w.w >> 16);
                    }
                }
            }
    }
};
}

#define LAS __attribute__((address_space(3)))
typedef pg8::bf16_t bf16_t;
typedef pg8::bf16x8 bf16x8;
typedef pg8::f32x4 f32x4;
typedef pg8::u32x4 u32x4;
typedef unsigned u32x2 __attribute__((ext_vector_type(2)));

constexpr int NTOK = 32768, DM = 1024, SEQ = 8192, NBATCH = 4, NCHUNK = 128, NPROJ = 3328, DFF = 4096, NMEMROWS = 1024;
constexpr int C_GQ = 0, C_GK = 256, C_GV = 512, C_GG = 1024, C_RQ = 1536, C_RK = 1792, C_RV = 2048, C_RG = 2560, C_Z = 3072;
constexpr int NWAVES = 8, NTHREADS = 512;
constexpr int WAVE_LDS = 18432, MISC_OFF = NWAVES * WAVE_LDS, LDS_BYTES = MISC_OFF + 64;
constexpr int VPITCH = 72;
constexpr int APITCH = 528;
constexpr size_t MiB = 1u << 20;
constexpr size_t WS_WIN = 1 * MiB, WS_WOUT = 8 * MiB, WS_WQ = 10 * MiB, WS_WKV = 12 * MiB, WS_WO = 16 * MiB, WS_W1 = 18 * MiB, WS_W2 = 26 * MiB;
constexpr size_t WS_COS = 34 * MiB, WS_SIN = 35 * MiB, WS_MEMN = 36 * MiB, WS_KB = 38 * MiB, WS_VT = 40 * MiB, WS_DEC = 42 * MiB, WS_SSQ1 = 44 * MiB, WS_SSQ2 = 46 * MiB, WS_SSQ3 = 48 * MiB, WS_CTL = 0;
constexpr size_t WS_A1 = 64 * MiB;
constexpr size_t WS_A2 = 128 * MiB;
constexpr size_t WS_BIG = 192 * MiB;
constexpr size_t WS_NEED = 448 * MiB;

struct Params {
    const float *x, *mem, *norm_mix_g, *w_in, *gla_w_gate, *gla_b_gate, *gla_norm_g, *ret_norm_g, *w_out, *norm_x_g, *norm_mem_g, *xa_w_q, *xa_w_kv, *xa_w_o, *norm_ffn_g, *ffn_w1, *ffn_w2, *final_norm_g;
    float* out; unsigned char* ws; int ph_lo, ph_hi;
};

__device__ __forceinline__ float bf2f(unsigned short b) { return __uint_as_float(((unsigned)b) << 16); }
__device__ __forceinline__ unsigned short f2bf(float f) { const unsigned u = __float_as_uint(f); return (unsigned short)((u + 0x7fffu + ((u >> 16) & 1u)) >> 16); }
__device__ __forceinline__ bf16x8 pack8(f32x4 a, f32x4 b) {
    u32x4 w; w.x = cvtpk(a[0], a[1]); w.y = cvtpk(a[2], a[3]); w.z = cvtpk(b[0], b[1]); w.w = cvtpk(b[2], b[3]);
    return __builtin_bit_cast(bf16x8, w);
}
__device__ __forceinline__ void unpack8(bf16x8 v, f32x4& a, f32x4& b) {
    const u32x4 w = __builtin_bit_cast(u32x4, v);
    a[0] = __uint_as_float(w.x << 16); a[1] = __uint_as_float(w.x & 0xffff0000u); a[2] = __uint_as_float(w.y << 16); a[3] = __uint_as_float(w.y & 0xffff0000u);
    b[0] = __uint_as_float(w.z << 16); b[1] = __uint_as_float(w.z & 0xffff0000u); b[2] = __uint_as_float(w.w << 16); b[3] = __uint_as_float(w.w & 0xffff0000u);
}
__device__ __forceinline__ float wave_sum(float v) {
#pragma unroll
    for (int o = 1; o < 64; o <<= 1) v += __shfl_xor(v, o);
    return v;
}
#define MFMA16(a, b, c) __builtin_amdgcn_mfma_f32_16x16x32_bf16((a), (b), (c), 0, 0, 0)
#define LDS_FENCE() asm volatile("s_waitcnt lgkmcnt(0)" ::: "memory")
#define CFENCE() do { asm volatile("" ::: "memory"); __builtin_amdgcn_sched_barrier(0); } while (0)
__device__ __forceinline__ float scan16(float v, int r) {
#pragma unroll
    for (int off = 1; off < 16; off <<= 1) { const float t = __shfl_up(v, off, 16); if (r >= off) v += t; }
    return v;
}

#define XB_TMO      128
#define XB_XCNT(j)  (256  + 64 * (j))
#define XB_XSUB(j)  (1280 + 64 * (j))
#define XB_XGEN(j)  (2304 + 64 * (j))
#define XB_TOP      3328
#define XB_TOPGEN   3392
#define XCD_BAR_WORDS 3456
#define XB_SPIN_CAP (1u << 18)

__device__ __forceinline__ unsigned xb_ld(unsigned* p)              { return __hip_atomic_load(p, __ATOMIC_RELAXED, __HIP_MEMORY_SCOPE_AGENT); }
__device__ __forceinline__ unsigned xb_add(unsigned* p, unsigned v) { return __hip_atomic_fetch_add(p, v, __ATOMIC_RELAXED, __HIP_MEMORY_SCOPE_AGENT); }
__device__ __forceinline__ unsigned xb_xcc_id() { return (unsigned)__builtin_amdgcn_s_getreg((3 << 11) | 20) & 0xFu; }
#define XB_SPIN(cond, bar) do { unsigned _sp = 0; while (cond) { __builtin_amdgcn_s_sleep(1); \
    if ((++_sp & 255u) == 0u) { if (xb_ld(&(bar)[XB_TMO])) break; if (_sp > XB_SPIN_CAP) { atomicAdd(&(bar)[XB_TMO], 1u); break; } } } } while (0)

struct XcdBarrier {
    unsigned* bar; unsigned x;
    volatile LAS unsigned* st;
};

__device__ __forceinline__ XcdBarrier xcd_barrier_post(unsigned* bar, volatile LAS unsigned* st) {
    XcdBarrier b; b.bar = bar; b.x = xb_xcc_id(); b.st = st;
    if (threadIdx.x == 0) (void)xb_add(&bar[XB_XCNT(b.x)], 1u);
    return b;
}
__device__ __forceinline__ void xcd_barrier_complete(unsigned* bar, unsigned x, unsigned& nloc, unsigned& nx) {
    const unsigned G = gridDim.x * gridDim.y * gridDim.z;
    unsigned sum, cnt, mine, sp = 0u;
    for (;;) {
        sum = 0u; cnt = 0u; mine = 0u;
#pragma unroll
        for (unsigned j = 0; j < 16; ++j) { const unsigned c = xb_ld(&bar[XB_XCNT(j)]); sum += c; cnt += (c > 0u) ? 1u : 0u; mine = (j == x) ? c : mine; }
        if (sum == G) break;
        __builtin_amdgcn_s_sleep(1);
        if ((++sp & 255u) == 0u) { if (xb_ld(&bar[XB_TMO])) break; if (sp > XB_SPIN_CAP) { atomicAdd(&bar[XB_TMO], 1u); break; } }
    }
    nloc = mine > 0u ? mine : 1u; nx = cnt > 0u ? cnt : 1u;
}

__device__ __forceinline__ void xcd_barrier(const XcdBarrier& b) {
    asm volatile("s_waitcnt vmcnt(0)" ::: "memory");
    __syncthreads();
    if (threadIdx.x == 0) {
        unsigned* bar = b.bar;
        __builtin_amdgcn_s_waitcnt(0);
        unsigned nloc = b.st[0], nx = b.st[1];
        if (nloc == 0u) { xcd_barrier_complete(bar, b.x, nloc, nx); b.st[0] = nloc; b.st[1] = nx; }
        const unsigned old = xb_add(&bar[XB_XSUB(b.x)], 1u);
        const unsigned gen = old / nloc;
        if (old + 1u == (gen + 1u) * nloc) {
            __builtin_amdgcn_fence(__ATOMIC_RELEASE, "agent");
            asm volatile("s_waitcnt vmcnt(0)" ::: "memory");
            const unsigned og = xb_add(&bar[XB_TOP], 1u);
            const unsigned tg = og / nx;
            if (og + 1u == (tg + 1u) * nx) xb_add(&bar[XB_TOPGEN], 1u);
            else XB_SPIN(xb_ld(&bar[XB_TOPGEN]) == tg, bar);
            __builtin_amdgcn_fence(__ATOMIC_ACQUIRE, "agent");
            xb_add(&bar[XB_XGEN(b.x)], 1u);
            asm volatile("s_waitcnt vmcnt(0)" ::: "memory");
        } else {
            XB_SPIN(xb_ld(&bar[XB_XGEN(b.x)]) == gen, bar);
            __builtin_amdgcn_fence(__ATOMIC_ACQUIRE, "agent");
            asm volatile("s_waitcnt vmcnt(0)" ::: "memory");
        }
    }
    __syncthreads();
}

__device__ __forceinline__ void transpose_item(const float* W, int ldw, int col0, int K, int Nn, const float* g, bf16_t* WT, int row_off, LAS float* scr, int item, int lane) {
    const int nblk = Nn / 32, kb = item / nblk, nb = item % nblk, k0 = 64 * kb, n0 = 32 * nb;
#pragma unroll 8
    for (int i = 0; i < 32; ++i) { const int kk = 2 * i + (lane >> 5); float w = W[(size_t)(k0 + kk) * ldw + col0 + n0 + (lane & 31)]; if (g) w *= g[k0 + kk]; scr[kk * 33 + (lane & 31)] = w; }
    LDS_FENCE();
    const int c = lane & 7;
#pragma unroll
    for (int j = 0; j < 4; ++j) { const int n = (lane >> 3) + 8 * j; const LAS float* s = scr + (8 * c) * 33 + n;
        u32x4 o; o.x = cvtpk(s[0 * 33], s[1 * 33]); o.y = cvtpk(s[2 * 33], s[3 * 33]); o.z = cvtpk(s[4 * 33], s[5 * 33]); o.w = cvtpk(s[6 * 33], s[7 * 33]);
        *(u32x4*)(WT + (size_t)(row_off + n0 + n) * K + k0 + 8 * c) = o; }
    LDS_FENCE();
}
__device__ __forceinline__ void rms_row_to_bf16(const float* xrow, const float* g, bf16_t* orow, int lane) {
    const f32x4* xr = (const f32x4*)xrow + lane; const f32x4* gr = (const f32x4*)g + lane;
    f32x4 v[4]; float s = 0.f;
#pragma unroll
    for (int j = 0; j < 4; ++j) { v[j] = xr[64 * j]; s += (v[j][0] * v[j][0] + v[j][1] * v[j][1]) + (v[j][2] * v[j][2] + v[j][3] * v[j][3]); }
    const float rstd = 1.0f / sqrtf(wave_sum(s) * (1.0f / 1024.0f) + 1e-6f);
    u32x2* o8 = (u32x2*)orow + lane;
#pragma unroll
    for (int j = 0; j < 4; ++j) { const f32x4 gg = gr[64 * j]; u32x2 w; w.x = cvtpk(v[j][0] * rstd * gg[0], v[j][1] * rstd * gg[1]); w.y = cvtpk(v[j][2] * rstd * gg[2], v[j][3] * rstd * gg[3]); o8[64 * j] = w; }
}
__device__ __forceinline__ void p0_prologue(const Params& p, LAS unsigned char* lds, int G) {
    const int tid = threadIdx.x, lane = tid & 63, wave = __builtin_amdgcn_readfirstlane(tid >> 6);
    unsigned char* ws = p.ws;
    LAS float* scr = (LAS float*)(lds + wave * WAVE_LDS);
    const int gw = blockIdx.x * NWAVES + wave, NGW = G * NWAVES;
    bf16_t* Win_t = (bf16_t*)(ws + WS_WIN);
    constexpr int I_INA = 16 * 32, I_INB = 16 * 64, I_OUT = 16 * 32, I_Q = 16 * 32, I_KV = 16 * 64, I_O = 16 * 32, I_1 = 16 * 128, I_2 = 64 * 32;
    constexpr int NITEMS = I_INA + I_INB + I_OUT + I_Q + I_KV + I_O + I_1 + I_2;
    for (int it = gw; it < NITEMS; it += NGW) {
        int r = it;
        if (r < I_INA) { transpose_item(p.w_in, 3088, 0, 1024, 1024, nullptr, Win_t, 0, scr, r, lane); continue; } r -= I_INA;
        if (r < I_INB) { transpose_item(p.w_in, 3088, 1040, 1024, 2048, nullptr, Win_t, 1024, scr, r, lane); continue; } r -= I_INB;
        if (r < I_OUT) { transpose_item(p.w_out, 1024, 0, 1024, 1024, nullptr, (bf16_t*)(ws + WS_WOUT), 0, scr, r, lane); continue; } r -= I_OUT;
        if (r < I_Q) { transpose_item(p.xa_w_q, 1024, 0, 1024, 1024, p.norm_x_g, (bf16_t*)(ws + WS_WQ), 0, scr, r, lane); continue; } r -= I_Q;
        if (r < I_KV) { transpose_item(p.xa_w_kv, 2048, 0, 1024, 2048, nullptr, (bf16_t*)(ws + WS_WKV), 0, scr, r, lane); continue; } r -= I_KV;
        if (r < I_O) { transpose_item(p.xa_w_o, 1024, 0, 1024, 1024, nullptr, (bf16_t*)(ws + WS_WO), 0, scr, r, lane); continue; } r -= I_O;
        if (r < I_1) { transpose_item(p.ffn_w1, 4096, 0, 1024, 4096, p.norm_ffn_g, (bf16_t*)(ws + WS_W1), 0, scr, r, lane); continue; } r -= I_1;
        transpose_item(p.ffn_w2, 1024, 0, 4096, 1024, nullptr, (bf16_t*)(ws + WS_W2), 0, scr, r, lane);
    }
    const int gt = blockIdx.x * NTHREADS + tid, NGT = G * NTHREADS;
    for (int o = gt; o < 256 * 1024; o += NGT) {
        const int n = o >> 10, k = o & 1023; const float* wr = p.w_in + (size_t)k * 3088 + 1024; float s = 0.f;
#pragma unroll
        for (int r = 0; r < 16; ++r) s += wr[r] * p.gla_w_gate[r * 256 + n];
        Win_t[(size_t)(3072 + n) * 1024 + k] = f2bf(s);
    }
    float* cosT = (float*)(ws + WS_COS); float* sinT = (float*)(ws + WS_SIN);
    for (int o = gt; o < SEQ * 32; o += NGT) {
        const int pos = o >> 5, i = o & 31; double f = 1.0;
        for (int k = 0; k < i; ++k) f *= 0.7498942093324559;
        const double t = (double)pos * f * 0.15915494309189535;
        const float fr = (float)(t - floor(t));
        cosT[o] = __builtin_amdgcn_cosf(fr); sinT[o] = __builtin_amdgcn_sinf(fr);
    }
    bf16_t* XN = (bf16_t*)(ws + WS_A1); bf16_t* MEMN = (bf16_t*)(ws + WS_MEMN);
    for (int m = gw; m < NTOK + NMEMROWS; m += NGW) {
        if (m < NTOK) rms_row_to_bf16(p.x + (size_t)m * DM, p.norm_mix_g, XN + (size_t)m * DM, lane);
        else rms_row_to_bf16(p.mem + (size_t)(m - NTOK) * DM, p.norm_mem_g, MEMN + (size_t)(m - NTOK) * DM, lane);
    }
}

__device__ __forceinline__ void gla_gates(const bf16_t* P, int zcol, const float* bg, int r, int q, float (&bc)[4][2][8], float (&bl)[2][8]) {
#pragma unroll
    for (int ks = 0; ks < 2; ++ks) {
        const f32x4 b0 = *(const f32x4*)(bg + 32 * ks + 8 * q), b1 = *(const f32x4*)(bg + 32 * ks + 8 * q + 4);
#pragma unroll
        for (int mt = 0; mt < 4; ++mt) {
            CFENCE();
            const bf16x8 z = *(const bf16x8*)(P + (size_t)(16 * mt + r) * NPROJ + zcol + 32 * ks + 8 * q);
            f32x4 z0, z1; unpack8(z, z0, z1); z0 += b0; z1 += b1;
#pragma unroll
            for (int e = 0; e < 4; ++e) {
                bc[mt][ks][e] = (fminf(z0[e], 0.f) - __logf(1.0f + __expf(-fabsf(z0[e])))) * (1.0f / 16.0f);
                bc[mt][ks][4 + e] = (fminf(z1[e], 0.f) - __logf(1.0f + __expf(-fabsf(z1[e])))) * (1.0f / 16.0f);
            }
        }
#pragma unroll
        for (int e = 0; e < 8; ++e) {
            float carry = 0.f;
#pragma unroll
            for (int mt = 0; mt < 4; ++mt) { const float v = scan16(bc[mt][ks][e], r); const float tot = __shfl(v, 15, 16); bc[mt][ks][e] = v + carry; carry += tot; }
            bl[ks][e] = carry;
        }
    }
}
__device__ __forceinline__ float ret_log2g(int hr) { return hr == 0 ? -0.04580368961312479f : hr == 1 ? -0.008973692110584325f : hr == 2 ? -0.0017761724589428754f : -0.0003522634716290214f; }
__device__ __forceinline__ void rope_tile(bf16x8 f0, bf16x8 f1, const float* cosT, const float* sinT, int pos, int q, f32x4 (&o)[4]) {
    f32x4 a0, a1, b0, b1; unpack8(f0, a0, a1); unpack8(f1, b0, b1);
    const f32x4 c0 = *(const f32x4*)(cosT + pos * 32 + 8 * q), c1 = *(const f32x4*)(cosT + pos * 32 + 8 * q + 4), s0 = *(const f32x4*)(sinT + pos * 32 + 8 * q), s1 = *(const f32x4*)(sinT + pos * 32 + 8 * q + 4);
    o[0] = a0 * c0 - b0 * s0; o[1] = a1 * c1 - b1 * s1; o[2] = a0 * s0 + b0 * c0; o[3] = a1 * s1 + b1 * c1;
}

__device__ __forceinline__ void chunk_contrib(const Params& p, LAS unsigned char* lds, int G) {
    const int tid = threadIdx.x, lane = tid & 63, wave = __builtin_amdgcn_readfirstlane(tid >> 6);
    unsigned char* ws = p.ws;
    const bf16_t* PROJ = (const bf16_t*)(ws + WS_BIG); bf16_t* CT = (bf16_t*)(ws + WS_A2); float* DEC = (float*)(ws + WS_DEC);
    const float* cosT = (const float*)(ws + WS_COS); const float* sinT = (const float*)(ws + WS_SIN);
    LAS bf16_t* Kdt = (LAS bf16_t*)(lds + wave * WAVE_LDS); LAS bf16_t* Vt = Kdt + 64 * VPITCH;
    for (int u = blockIdx.x * NWAVES + wave; u < NBATCH * NCHUNK * 8; u += G * NWAVES) {
        const int h8 = u & 7, bn = u >> 3, b = bn >> 7, n = bn & 127;
        const size_t tok0 = (size_t)b * SEQ + (size_t)n * 64;
        const bf16_t* P = PROJ + tok0 * NPROJ;
        const int unit = (b * 8 + h8) * NCHUNK + n;
        int r = lane & 15, q = lane >> 4; asm volatile("" : "+v"(r), "+v"(q));
        int vcol;
        LDS_FENCE();
        if (h8 < 4) {
            const int h = h8; vcol = C_GV + h * 128;
            float bc[4][2][8], bl[2][8];
            gla_gates(P, C_Z + h * 64, p.gla_b_gate + h * 64, r, q, bc, bl);
            if (r == 0) {
#pragma unroll
                for (int ks = 0; ks < 2; ++ks) {
                    f32x4 d0, d1;
#pragma unroll
                    for (int e = 0; e < 4; ++e) { d0[e] = __expf(bl[ks][e]); d1[e] = __expf(bl[ks][4 + e]); }
                    *(f32x4*)(DEC + (size_t)unit * 64 + 32 * ks + 8 * q) = d0; *(f32x4*)(DEC + (size_t)unit * 64 + 32 * ks + 8 * q + 4) = d1;
                }
            }
#pragma unroll
            for (int mt = 0; mt < 4; ++mt)
#pragma unroll
                for (int ks = 0; ks < 2; ++ks) {
                    CFENCE();
                    const bf16x8 kf = *(const bf16x8*)(P + (size_t)(16 * mt + r) * NPROJ + C_GK + h * 64 + 32 * ks + 8 * q);
                    f32x4 k0, k1; unpack8(kf, k0, k1);
#pragma unroll
                    for (int e = 0; e < 4; ++e) {
                        Kdt[(32 * ks + 8 * q + e) * VPITCH + 16 * mt + r] = f2bf(k0[e] * __expf(bl[ks][e] - bc[mt][ks][e]));
                        Kdt[(32 * ks + 8 * q + 4 + e) * VPITCH + 16 * mt + r] = f2bf(k1[e] * __expf(bl[ks][4 + e] - bc[mt][ks][4 + e]));
                    }
                }
        } else {
            const int hr = h8 - 4; vcol = C_RV + hr * 128; const float l2g = ret_log2g(hr);
            if (r == 0) {
                const float d = exp2f(64.0f * l2g); const f32x4 dv = {d, d, d, d};
#pragma unroll
                for (int ks = 0; ks < 2; ++ks) { *(f32x4*)(DEC + (size_t)unit * 64 + 32 * ks + 8 * q) = dv; *(f32x4*)(DEC + (size_t)unit * 64 + 32 * ks + 8 * q + 4) = dv; }
            }
#pragma unroll
            for (int mt = 0; mt < 4; ++mt) {
                CFENCE();
                const bf16x8 f0 = *(const bf16x8*)(P + (size_t)(16 * mt + r) * NPROJ + C_RK + hr * 64 + 8 * q);
                const bf16x8 f1 = *(const bf16x8*)(P + (size_t)(16 * mt + r) * NPROJ + C_RK + hr * 64 + 32 + 8 * q);
                f32x4 o[4]; rope_tile(f0, f1, cosT, sinT, n * 64 + 16 * mt + r, q, o);
                const float sc = 0.125f * exp2f((float)(63 - (16 * mt + r)) * l2g);
#pragma unroll
                for (int e = 0; e < 4; ++e) {
                    Kdt[(8 * q + e) * VPITCH + 16 * mt + r] = f2bf(o[0][e] * sc); Kdt[(8 * q + 4 + e) * VPITCH + 16 * mt + r] = f2bf(o[1][e] * sc);
                    Kdt[(32 + 8 * q + e) * VPITCH + 16 * mt + r] = f2bf(o[2][e] * sc); Kdt[(32 + 8 * q + 4 + e) * VPITCH + 16 * mt + r] = f2bf(o[3][e] * sc);
                }
            }
        }
        bf16_t* outp = CT + (size_t)unit * 8192;
#pragma unroll 1
        for (int vh = 0; vh < 2; ++vh) {
            LDS_FENCE();
#pragma unroll
            for (int i = 0; i < 8; ++i) {
                const int token = i * 8 + (lane >> 3), vv = (lane & 7) * 8;
                const bf16x8 x = *(const bf16x8*)(P + (size_t)token * NPROJ + vcol + vh * 64 + vv);
#pragma unroll
                for (int e = 0; e < 8; ++e) Vt[(vv + e) * VPITCH + token] = (bf16_t)x[e];
            }
            LDS_FENCE();
#pragma unroll
            for (int vt = 0; vt < 4; ++vt) {
                CFENCE();
                bf16x8 a[2];
#pragma unroll
                for (int s = 0; s < 2; ++s) a[s] = *(const LAS bf16x8*)(Vt + (16 * vt + r) * VPITCH + 32 * s + 8 * q);
#pragma unroll
                for (int dt = 0; dt < 4; ++dt) {
                    f32x4 acc = {0.f, 0.f, 0.f, 0.f};
#pragma unroll
                    for (int s = 0; s < 2; ++s) { const bf16x8 bb = *(const LAS bf16x8*)(Kdt + (16 * dt + r) * VPITCH + 32 * s + 8 * q); acc = MFMA16(a[s], bb, acc); }
#pragma unroll
                    for (int e = 0; e < 4; ++e) outp[(vh * 64 + 16 * vt + 4 * q + e) * 64 + 16 * dt + r] = f2bf(acc[e]);
                }
            }
        }
    }
}

__device__ __forceinline__ void chunk_scan(const Params& p, int G) {
    unsigned char* ws = p.ws; bf16_t* CT = (bf16_t*)(ws + WS_A2); const float* DEC = (const float*)(ws + WS_DEC);
    const int NGT = G * NTHREADS;
    for (int o = blockIdx.x * NTHREADS + threadIdx.x; o < 32 * 128 * 16; o += NGT) {
        const int d4 = o & 15, v = (o >> 4) & 127, bh = o >> 11;
        bf16_t* base = CT + (size_t)bh * NCHUNK * 8192 + v * 64 + d4 * 4; const float* dbase = DEC + (size_t)bh * NCHUNK * 64 + d4 * 4;
        f32x4 s = {0.f, 0.f, 0.f, 0.f};
#pragma unroll 1
        for (int n0 = 0; n0 < NCHUNK; n0 += 8) {
            u32x2 uu[8]; f32x4 dd[8];
#pragma unroll
            for (int j = 0; j < 8; ++j) { uu[j] = *(const u32x2*)(base + (size_t)(n0 + j) * 8192); dd[j] = *(const f32x4*)(dbase + (size_t)(n0 + j) * 64); }
#pragma unroll
            for (int j = 0; j < 8; ++j) {
                u32x2 w; w.x = cvtpk(s[0], s[1]); w.y = cvtpk(s[2], s[3]);
                *(u32x2*)(base + (size_t)(n0 + j) * 8192) = w;
                f32x4 c; c[0] = __uint_as_float(uu[j].x << 16); c[1] = __uint_as_float(uu[j].x & 0xffff0000u); c[2] = __uint_as_float(uu[j].y << 16); c[3] = __uint_as_float(uu[j].y & 0xffff0000u);
                s = dd[j] * s + c;
            }
        }
    }
}

template <bool GN> __device__ __forceinline__ void norm_gate_store(const f32x4 (&O)[8], int it, int r, int q, const float* gain, const bf16_t* gate, bf16_t* y) {
    f32x4 mean = {0.f, 0.f, 0.f, 0.f};
    if (GN) {
        f32x4 s = {0.f, 0.f, 0.f, 0.f};
#pragma unroll
        for (int vt = 0; vt < 8; ++vt) s += O[vt];
#pragma unroll
        for (int e = 0; e < 4; ++e) { float t = s[e]; t += __shfl_xor(t, 1); t += __shfl_xor(t, 2); t += __shfl_xor(t, 4); t += __shfl_xor(t, 8); mean[e] = t * (1.0f / 128.0f); }
    }
    f32x4 ss = {0.f, 0.f, 0.f, 0.f};
#pragma unroll
    for (int vt = 0; vt < 8; ++vt) { const f32x4 d = O[vt] - mean; ss += d * d; }
    f32x4 rstd;
#pragma unroll
    for (int e = 0; e < 4; ++e) { float t = ss[e]; t += __shfl_xor(t, 1); t += __shfl_xor(t, 2); t += __shfl_xor(t, 4); t += __shfl_xor(t, 8); rstd[e] = __builtin_amdgcn_rsqf(t * (1.0f / 128.0f) + 1e-6f); }
#pragma unroll
    for (int vt = 0; vt < 8; ++vt) {
        const int v = 16 * vt + r; const float g = gain[v];
        CFENCE();
#pragma unroll
        for (int e = 0; e < 4; ++e) {
            const int i = 16 * it + 4 * q + e;
            const float gt = bf2f(gate[(size_t)i * NPROJ + v]);
            const float sil = gt / (1.0f + __expf(-gt));
            y[(size_t)i * DM + v] = f2bf((O[vt][e] - mean[e]) * rstd[e] * g * sil);
        }
    }
}
__device__ __forceinline__ void out_tile(f32x4 (&O)[8], const bf16x8 (&pf)[2], const bf16x8 (&qi)[2], const LAS bf16_t* Vt, const bf16_t* SP, int r, int q) {
#pragma unroll
    for (int vt = 0; vt < 8; ++vt) {
        f32x4 acc = {0.f, 0.f, 0.f, 0.f};
        CFENCE();
#pragma unroll
        for (int s = 0; s < 2; ++s) {
            const u32x2 lo = *(const LAS u32x2*)(Vt + (16 * vt + r) * VPITCH + 32 * s + 4 * q), hi = *(const LAS u32x2*)(Vt + (16 * vt + r) * VPITCH + 32 * s + 16 + 4 * q);
            const u32x4 w = {lo.x, lo.y, hi.x, hi.y};
            acc = MFMA16(pf[s], __builtin_bit_cast(bf16x8, w), acc);
        }
#pragma unroll
        for (int ks = 0; ks < 2; ++ks) { const bf16x8 sb = *(const bf16x8*)(SP + (16 * vt + r) * 64 + 32 * ks + 8 * q); acc = MFMA16(qi[ks], sb, acc); }
        O[vt] = acc;
    }
}

__device__ __forceinline__ void chunk_output(const Params& p, LAS unsigned char* lds, int G) {
    const int tid = threadIdx.x, lane = tid & 63, wave = __builtin_amdgcn_readfirstlane(tid >> 6);
    unsigned char* ws = p.ws;
    const bf16_t* PROJ = (const bf16_t*)(ws + WS_BIG); const bf16_t* SPB = (const bf16_t*)(ws + WS_A2); bf16_t* Y = (bf16_t*)(ws + WS_A1);
    const float* cosT = (const float*)(ws + WS_COS); const float* sinT = (const float*)(ws + WS_SIN);
    LAS bf16_t* Vt = (LAS bf16_t*)(lds + wave * WAVE_LDS);
    for (int u = blockIdx.x * NWAVES + wave; u < NBATCH * NCHUNK * 8; u += G * NWAVES) {
        const int h8 = u & 7, bn = u >> 3, b = bn >> 7, n = bn & 127;
        const size_t tok0 = (size_t)b * SEQ + (size_t)n * 64;
        const bf16_t* P = PROJ + tok0 * NPROJ;
        const int unit = (b * 8 + h8) * NCHUNK + n;
        const bf16_t* SP = SPB + (size_t)unit * 8192;
        int r = lane & 15, q = lane >> 4; asm volatile("" : "+v"(r), "+v"(q));
        const int vcol = (h8 < 4) ? C_GV + h8 * 128 : C_RV + (h8 - 4) * 128;
        LDS_FENCE();
#pragma unroll
        for (int i = 0; i < 16; ++i) {
            CFENCE();
            const int token = i * 4 + (lane >> 4), vv = (lane & 15) * 8;
            const bf16x8 x = *(const bf16x8*)(P + (size_t)token * NPROJ + vcol + vv);
#pragma unroll
            for (int e = 0; e < 8; ++e) Vt[(vv + e) * VPITCH + token] = (bf16_t)x[e];
        }
        LDS_FENCE();
#ifdef NO_GLA4
        if (false) {
#else
        if (h8 < 4) {
#endif
            const int h = h8;
            bf16x8 Qe[4][2], Qi[4][2], Ki[4][2], Ke[4][2], pfa[4][2];
            {
                float bc[4][2][8], bl[2][8];
                gla_gates(P, C_Z + h * 64, p.gla_b_gate + h * 64, r, q, bc, bl);
#pragma unroll
                for (int mt = 0; mt < 4; ++mt)
#pragma unroll
                    for (int ks = 0; ks < 2; ++ks) {
                        CFENCE();
                        const bf16x8 qf = *(const bf16x8*)(P + (size_t)(16 * mt + r) * NPROJ + C_GQ + h * 64 + 32 * ks + 8 * q);
                        const bf16x8 kf = *(const bf16x8*)(P + (size_t)(16 * mt + r) * NPROJ + C_GK + h * 64 + 32 * ks + 8 * q);
                        f32x4 q0, q1, k0, k1; unpack8(qf, q0, q1); unpack8(kf, k0, k1);
                        f32x4 e0, e1, i0, i1;
#pragma unroll
                        for (int e = 0; e < 4; ++e) { e0[e] = __expf(bc[mt][ks][e]); e1[e] = __expf(bc[mt][ks][4 + e]); i0[e] = __expf(-bc[mt][ks][e]); i1[e] = __expf(-bc[mt][ks][4 + e]); }
                        Qe[mt][ks] = pack8(q0 * e0 * 0.125f, q1 * e1 * 0.125f); Qi[mt][ks] = pack8(q0 * i0 * 0.125f, q1 * i1 * 0.125f);
                        Ki[mt][ks] = pack8(k0 * i0, k1 * i1); Ke[mt][ks] = pack8(k0 * e0, k1 * e1);
                    }
            }
#pragma unroll
            for (int it = 0; it < 4; ++it) {
                f32x4 Pt[4];
#pragma unroll
                for (int jt = 0; jt < 4; ++jt) {
                    f32x4 lo = {0.f, 0.f, 0.f, 0.f}, up = {0.f, 0.f, 0.f, 0.f};
                    if (jt <= it) { lo = MFMA16(Ki[jt][0], Qe[it][0], lo); lo = MFMA16(Ki[jt][1], Qe[it][1], lo); }
                    if (jt >= it) { up = MFMA16(Ke[jt][0], Qi[it][0], up); up = MFMA16(Ke[jt][1], Qi[it][1], up); }
                    if (jt < it) Pt[jt] = lo; else if (jt > it) Pt[jt] = up;
                    else {
#pragma unroll
                        for (int e = 0; e < 4; ++e) Pt[jt][e] = (4 * q + e <= r) ? lo[e] : up[e];
                    }
                }
                pfa[it][0] = pack8(Pt[0], Pt[1]); pfa[it][1] = pack8(Pt[2], Pt[3]);
                CFENCE();
            }
#pragma unroll
            for (int it = 0; it < 4; ++it) {
                f32x4 O[8];
                out_tile(O, pfa[it], Qe[it], Vt, SP, r, q);
                CFENCE();
                norm_gate_store<false>(O, it, r, q, p.gla_norm_g + h * 128, P + C_GG + h * 128, Y + tok0 * DM + h * 128);
                CFENCE();
            }
        }
#ifdef NO_RET4
        else if (false) {
#else
        else {
#endif
            const int hr = h8 - 4; const float l2g = ret_log2g(hr);
            bf16x8 Qr[4][2], Qd[4][2], Kr[4][2], pfa[4][2];
#pragma unroll
            for (int mt = 0; mt < 4; ++mt) {
                const int pos = n * 64 + 16 * mt + r;
                CFENCE();
                {
                    const bf16x8 f0 = *(const bf16x8*)(P + (size_t)(16 * mt + r) * NPROJ + C_RQ + hr * 64 + 8 * q);
                    const bf16x8 f1 = *(const bf16x8*)(P + (size_t)(16 * mt + r) * NPROJ + C_RQ + hr * 64 + 32 + 8 * q);
                    f32x4 o[4]; rope_tile(f0, f1, cosT, sinT, pos, q, o);
                    Qr[mt][0] = pack8(o[0], o[1]); Qr[mt][1] = pack8(o[2], o[3]);
                    const float qd = exp2f((float)(16 * mt + r + 1) * l2g);
                    Qd[mt][0] = pack8(o[0] * qd, o[1] * qd); Qd[mt][1] = pack8(o[2] * qd, o[3] * qd);
                }
                {
                    const bf16x8 f0 = *(const bf16x8*)(P + (size_t)(16 * mt + r) * NPROJ + C_RK + hr * 64 + 8 * q);
                    const bf16x8 f1 = *(const bf16x8*)(P + (size_t)(16 * mt + r) * NPROJ + C_RK + hr * 64 + 32 + 8 * q);
                    f32x4 o[4]; rope_tile(f0, f1, cosT, sinT, pos, q, o);
                    Kr[mt][0] = pack8(o[0] * 0.125f, o[1] * 0.125f); Kr[mt][1] = pack8(o[2] * 0.125f, o[3] * 0.125f);
                }
            }
#pragma unroll
            for (int it = 0; it < 4; ++it) {
                f32x4 Pt[4];
#pragma unroll
                for (int jt = 0; jt < 4; ++jt) {
                    f32x4 st = {0.f, 0.f, 0.f, 0.f};
                    st = MFMA16(Kr[jt][0], Qr[it][0], st); st = MFMA16(Kr[jt][1], Qr[it][1], st);
#pragma unroll
                    for (int e = 0; e < 4; ++e) { const int dj = (16 * it + r) - (16 * jt + 4 * q + e); Pt[jt][e] = st[e] * exp2f((float)(dj < 0 ? -dj : dj) * l2g); }
                }
                pfa[it][0] = pack8(Pt[0], Pt[1]); pfa[it][1] = pack8(Pt[2], Pt[3]);
                CFENCE();
            }
#pragma unroll
            for (int it = 0; it < 4; ++it) {
                f32x4 O[8];
                out_tile(O, pfa[it], Qd[it], Vt, SP, r, q);
                CFENCE();
                norm_gate_store<true>(O, it, r, q, p.ret_norm_g + hr * 128, P + C_RG + hr * 128, Y + tok0 * DM + 512 + hr * 128);
                CFENCE();
            }
        }
    }
}

__device__ __forceinline__ void stage_image(LAS unsigned char* lds, const bf16_t* src, int tid) {
#pragma unroll
    for (int i = 0; i < 16; ++i) { const int row = (tid >> 5) + 16 * i, c = tid & 31; const u32x4 x = *(const u32x4*)(src + (size_t)row * 256 + c * 8); *(LAS u32x4*)(lds + row * APITCH + c * 16) = x; }
}
__device__ __forceinline__ void cross_attention(const Params& p, LAS unsigned char* lds, int G) {
    const int tid = threadIdx.x, lane = tid & 63, wave = __builtin_amdgcn_readfirstlane(tid >> 6);
    unsigned char* ws = p.ws;
    const bf16_t* Q = (const bf16_t*)(ws + WS_A1); const bf16_t* Kb = (const bf16_t*)(ws + WS_KB); const bf16_t* Vtg = (const bf16_t*)(ws + WS_VT); bf16_t* OA = (bf16_t*)(ws + WS_BIG);
    for (int u = blockIdx.x; u < 512; u += G) {
        const int bh = u >> 5, b = bh >> 2, h = bh & 3, qb = u & 31;
        int r = lane & 15, q = lane >> 4; asm volatile("" : "+v"(r), "+v"(q));
        __syncthreads();
        {
#pragma unroll
            for (int i = 0; i < 16; ++i) { const int row = (tid >> 5) + 16 * i, c = tid & 31; const u32x4 x = *(const u32x4*)(Kb + (size_t)(b * 256 + row) * 1024 + h * 256 + c * 8); *(LAS u32x4*)(lds + row * APITCH + c * 16) = x; }
        }
        __syncthreads();
        bf16x8 pf[2][8];
#pragma unroll
        for (int it = 0; it < 2; ++it) {
            const size_t i0 = (size_t)b * SEQ + qb * 256 + wave * 32 + 16 * it;
            bf16x8 Qf[8];
#pragma unroll
            for (int ks = 0; ks < 8; ++ks) Qf[ks] = *(const bf16x8*)(Q + (i0 + r) * DM + h * 256 + 32 * ks + 8 * q);
            f32x4 S[16];
#pragma unroll
            for (int mt = 0; mt < 16; ++mt) {
                f32x4 acc = {0.f, 0.f, 0.f, 0.f};
                CFENCE();
#pragma unroll
                for (int ks = 0; ks < 8; ++ks) { const bf16x8 a = *(const LAS bf16x8*)(lds + (16 * mt + r) * APITCH + (32 * ks + 8 * q) * 2); acc = MFMA16(a, Qf[ks], acc); }
                S[mt] = acc;
            }
            CFENCE();
            float mx = -3.0e38f;
#pragma unroll
            for (int mt = 0; mt < 16; ++mt) mx = fmaxf(fmaxf(fmaxf(S[mt][0], S[mt][1]), fmaxf(S[mt][2], S[mt][3])), mx);
            mx = fmaxf(mx, __shfl_xor(mx, 16)); mx = fmaxf(mx, __shfl_xor(mx, 32));
            CFENCE();
            float sum = 0.f;
#pragma unroll
            for (int mt = 0; mt < 16; ++mt) {
#pragma unroll
                for (int e = 0; e < 4; ++e) { S[mt][e] = __builtin_amdgcn_exp2f(S[mt][e] - mx); sum += S[mt][e]; }
                CFENCE();
            }
            sum += __shfl_xor(sum, 16); sum += __shfl_xor(sum, 32);
            const float inv = 1.0f / sum;
            CFENCE();
#pragma unroll
            for (int s = 0; s < 8; ++s) { pf[it][s] = pack8(S[2 * s] * inv, S[2 * s + 1] * inv); CFENCE(); }
        }
        __syncthreads();
        stage_image(lds, Vtg + (size_t)(b * 1024 + h * 256) * 256, tid);
        __syncthreads();
#pragma unroll
        for (int it = 0; it < 2; ++it) {
            const size_t i0 = (size_t)b * SEQ + qb * 256 + wave * 32 + 16 * it;
#pragma unroll
            for (int nt = 0; nt < 16; ++nt) {
                f32x4 acc = {0.f, 0.f, 0.f, 0.f};
                CFENCE();
#pragma unroll
                for (int s = 0; s < 8; ++s) {
                    const u32x2 lo = *(const LAS u32x2*)(lds + (16 * nt + r) * APITCH + (32 * s + 4 * q) * 2), hi = *(const LAS u32x2*)(lds + (16 * nt + r) * APITCH + (32 * s + 16 + 4 * q) * 2);
                    const u32x4 w = {lo.x, lo.y, hi.x, hi.y};
                    acc = MFMA16(pf[it][s], __builtin_bit_cast(bf16x8, w), acc);
                }
#pragma unroll
                for (int e = 0; e < 4; ++e) OA[(i0 + 4 * q + e) * DM + h * 256 + 16 * nt + r] = f2bf(acc[e]);
            }
        }
    }
}

__device__ __forceinline__ void final_norm(const Params& p, int G) {
    const int lane = threadIdx.x & 63, wave = __builtin_amdgcn_readfirstlane(threadIdx.x >> 6);
    const bf16_t* H = (const bf16_t*)(p.ws + WS_A2); const float* SSQ = (const float*)(p.ws + WS_SSQ3);
    const f32x4 g0 = *(const f32x4*)(p.final_norm_g + lane * 8), g1 = *(const f32x4*)(p.final_norm_g + lane * 8 + 4), g2 = *(const f32x4*)(p.final_norm_g + 512 + lane * 8), g3 = *(const f32x4*)(p.final_norm_g + 512 + lane * 8 + 4);
    for (int m = blockIdx.x * NWAVES + wave; m < NTOK; m += G * NWAVES) {
        const bf16x8 h0 = *(const bf16x8*)(H + (size_t)m * DM + lane * 8), h1 = *(const bf16x8*)(H + (size_t)m * DM + 512 + lane * 8);
        const f32x4 s0 = *(const f32x4*)(SSQ + (size_t)m * 16), s1 = *(const f32x4*)(SSQ + (size_t)m * 16 + 4), s2 = *(const f32x4*)(SSQ + (size_t)m * 16 + 8), s3 = *(const f32x4*)(SSQ + (size_t)m * 16 + 12);
        const f32x4 st = (s0 + s1) + (s2 + s3);
        const float rstd = 1.0f / sqrtf(((st[0] + st[1]) + (st[2] + st[3])) * (1.0f / 1024.0f) + 1e-6f);
        f32x4 a0, a1, b0, b1; unpack8(h0, a0, a1); unpack8(h1, b0, b1);
        float* o = p.out + (size_t)m * DM + lane * 8;
        *(f32x4*)(o) = a0 * rstd * g0; *(f32x4*)(o + 4) = a1 * rstd * g1; *(f32x4*)(o + 512) = b0 * rstd * g2; *(f32x4*)(o + 516) = b1 * rstd * g3;
    }
}

constexpr int NPHASE = 12;
__global__ void __launch_bounds__(NTHREADS, 2) fwd_megakernel(Params p) {
    extern __shared__ __attribute__((aligned(16))) unsigned char lds_raw[];
    LAS unsigned char* lds = (LAS unsigned char*)lds_raw;
    cg::grid_group grid = cg::this_grid();
    const int G = gridDim.x, lo = p.ph_lo, hi = p.ph_hi;
    unsigned char* ws = p.ws;
#define IN(k) (lo <= (k) && (k) < hi)
#define SEAM(k) do { if (IN(k) && IN((k) + 1)) { if ((k) == 0) { asm volatile("s_waitcnt vmcnt(0) lgkmcnt(0)" ::: "memory"); grid.sync(); __builtin_amdgcn_fence(__ATOMIC_ACQUIRE, "agent"); asm volatile("s_waitcnt vmcnt(0)" ::: "memory"); } \
    else xcd_barrier(bar); } } while (0)
    LAS unsigned* misc = (LAS unsigned*)(lds + MISC_OFF);
    if (threadIdx.x < 16) misc[threadIdx.x] = 0u;
    __syncthreads();
    XcdBarrier bar; bar.bar = (unsigned*)(ws + WS_CTL); bar.x = 0; bar.st = nullptr;
    if (hi - lo > 1) bar = xcd_barrier_post((unsigned*)(ws + WS_CTL), (volatile LAS unsigned*)misc);
#ifndef NO_P0
    if (IN(0)) { p0_prologue(p, lds, G); }
#endif
#if defined(DBG_REP) && DBG_REP == 0
    __syncthreads(); if (IN(0)) { p0_prologue(p, lds, G); }
#endif
    SEAM(0);
    if (IN(1)) {
        {
            pg8::Gemm g{(const bf16_t*)(ws + WS_A1), (const bf16_t*)(ws + WS_WIN), NTOK, NPROJ, DM}; pg8::StaticOrder S; S.init(NTOK, NPROJ, G, (int)blockIdx.x);
            pg8::EpiBf16<0> E{(bf16_t*)(ws + WS_BIG), NPROJ, nullptr, 0, 0, 1.f};
            pg8::gemm_phase<pg8::EpiBf16<0>, pg8::StaticOrder, true, true>(lds, g, S, E);
        }
        __syncthreads();
        {
            pg8::Gemm g{(const bf16_t*)(ws + WS_MEMN), (const bf16_t*)(ws + WS_WKV), NMEMROWS, 2048, DM}; pg8::StaticOrder S; S.init(NMEMROWS, 2048, G, (int)((blockIdx.x + G / 2) % G));
            pg8::EpiKV E{(bf16_t*)(ws + WS_KB), (bf16_t*)(ws + WS_VT)};
            pg8::gemm_phase<pg8::EpiKV, pg8::StaticOrder, true, true>(lds, g, S, E);
        }
        __syncthreads();
    } SEAM(1);
    #ifndef NO_P2
    if (IN(2)) { chunk_contrib(p, lds, G); }
#endif
#if defined(DBG_REP) && DBG_REP == 2
    __syncthreads(); if (IN(2)) { chunk_contrib(p, lds, G); }
#endif
    SEAM(2);
    if (IN(3)) { chunk_scan(p, G); } SEAM(3);
    #ifndef NO_P4
    if (IN(4)) { chunk_output(p, lds, G); }
#endif
#if defined(DBG_REP) && DBG_REP == 4
    __syncthreads(); if (IN(4)) { chunk_output(p, lds, G); }
#endif
    SEAM(4);
    if (IN(5)) {
        pg8::Gemm g{(const bf16_t*)(ws + WS_A1), (const bf16_t*)(ws + WS_WOUT), NTOK, DM, DM}; pg8::StaticOrder S; S.init(NTOK, DM, G, (int)blockIdx.x);
        pg8::EpiRes<false> E{p.x, (bf16_t*)(ws + WS_A2), (float*)(ws + WS_SSQ1)};
        pg8::gemm_phase<pg8::EpiRes<false>, pg8::StaticOrder, true, true>(lds, g, S, E);
        __syncthreads();
    } SEAM(5);
    if (IN(6)) {
        pg8::Gemm g{(const bf16_t*)(ws + WS_A2), (const bf16_t*)(ws + WS_WQ), NTOK, DM, DM}; pg8::StaticOrder S; S.init(NTOK, DM, G, (int)blockIdx.x);
        pg8::EpiScale<0> E{(bf16_t*)(ws + WS_A1), DM, (const float*)(ws + WS_SSQ1), 0.0625f * 1.4426950408889634f};
        pg8::gemm_phase<pg8::EpiScale<0>, pg8::StaticOrder, true, true>(lds, g, S, E);
        __syncthreads();
    } SEAM(6);
#ifndef NO_P7
    if (IN(7)) { cross_attention(p, lds, G); __syncthreads(); }
#endif
#if defined(DBG_REP) && DBG_REP == 7
    if (IN(7)) { cross_attention(p, lds, G); __syncthreads(); }
#endif
    SEAM(7);
    if (IN(8)) {
        pg8::Gemm g{(const bf16_t*)(ws + WS_BIG), (const bf16_t*)(ws + WS_WO), NTOK, DM, DM}; pg8::StaticOrder S; S.init(NTOK, DM, G, (int)blockIdx.x);
        pg8::EpiRes<true> E{(const void*)(ws + WS_A2), (bf16_t*)(ws + WS_A1), (float*)(ws + WS_SSQ2)};
        pg8::gemm_phase<pg8::EpiRes<true>, pg8::StaticOrder, true, true>(lds, g, S, E);
        __syncthreads();
    } SEAM(8);
    if (IN(9)) {
        pg8::Gemm g{(const bf16_t*)(ws + WS_A1), (const bf16_t*)(ws + WS_W1), NTOK, DFF, DM}; pg8::StaticOrder S; S.init(NTOK, DFF, G, (int)blockIdx.x);
        pg8::EpiScale<1> E{(bf16_t*)(ws + WS_BIG), DFF, (const float*)(ws + WS_SSQ2), 1.0f};
        pg8::gemm_phase<pg8::EpiScale<1>, pg8::StaticOrder, true, true>(lds, g, S, E);
        __syncthreads();
    } SEAM(9);
    if (IN(10)) {
        pg8::Gemm g{(const bf16_t*)(ws + WS_BIG), (const bf16_t*)(ws + WS_W2), NTOK, DM, DFF}; pg8::StaticOrder S; S.init(NTOK, DM, G, (int)blockIdx.x);
        pg8::EpiRes<true> E{(const void*)(ws + WS_A1), (bf16_t*)(ws + WS_A2), (float*)(ws + WS_SSQ3)};
        pg8::gemm_phase<pg8::EpiRes<true>, pg8::StaticOrder, true, true>(lds, g, S, E);
        __syncthreads();
    } SEAM(10);
    if (IN(11)) { final_norm(p, G); }
#undef IN
#undef SEAM
}

#ifndef MK_PER_PHASE
#define MK_PER_PHASE 0
#endif
#ifdef DBG_DUMP_OFF
__global__ void dump_kernel(const bf16_t* src, size_t n, float* out) {
    for (size_t i = (size_t)blockIdx.x * blockDim.x + threadIdx.x; i < (size_t)NTOK * DM; i += (size_t)gridDim.x * blockDim.x) {
        float s = 0.f; for (size_t j = i; j < n; j += (size_t)NTOK * DM) s += bf2f(src[j]); out[i] = s; }
}
#endif
extern "C" void kernel_launch(void* const* d_in, const int* in_sizes, int n_in, void* d_out, int out_size, void* d_ws, size_t ws_size, hipStream_t stream) {
    static int grid = 0;
    if (grid == 0) {
        if (n_in != 18 || ws_size < WS_NEED) { fprintf(stderr, "kernel_launch: expected 18 inputs and >= %zu bytes of workspace (got %d, %zu)\n", (size_t)WS_NEED, n_in, ws_size); grid = -1; return; }
        int dev = 0, cus = 0, per_cu = 0;
        (void)hipGetDevice(&dev); (void)hipDeviceGetAttribute(&cus, hipDeviceAttributeMultiprocessorCount, dev);
        if (hipFuncSetAttribute((const void*)fwd_megakernel, hipFuncAttributeMaxDynamicSharedMemorySize, LDS_BYTES) != hipSuccess) { fprintf(stderr, "kernel_launch: hipFuncSetAttribute failed\n"); grid = -1; return; }
        if (hipOccupancyMaxActiveBlocksPerMultiprocessor(&per_cu, (const void*)fwd_megakernel, NTHREADS, LDS_BYTES) != hipSuccess || per_cu < 1) { fprintf(stderr, "kernel_launch: occupancy query failed (%d)\n", per_cu); (void)hipGetLastError(); grid = -1; return; }
        grid = cus * per_cu;
    }
    if (grid < 0) return;
    Params p{};
    const float** pp = (const float**)&p;
    for (int i = 0; i < 18; ++i) pp[i] = (const float*)d_in[i];
    p.out = (float*)d_out; p.ws = (unsigned char*)d_ws;
#if MK_PER_PHASE
#ifndef DBG_HI
#define DBG_HI NPHASE
#endif
    for (int k = 0; k < DBG_HI; ++k) { p.ph_lo = k; p.ph_hi = k + 1; hipLaunchKernelGGL(fwd_megakernel, dim3(grid), dim3(NTHREADS), LDS_BYTES, stream, p); }
#ifdef DBG_DUMP_OFF
    hipLaunchKernelGGL(dump_kernel, dim3(2048), dim3(256), 0, stream, (const bf16_t*)((unsigned char*)d_ws + (size_t)(DBG_DUMP_OFF) * MiB), (size_t)(DBG_DUMP_N), (float*)d_out);
#endif
#else
    p.ph_lo = 0; p.ph_hi = NPHASE;
    if (hipMemsetAsync((char*)d_ws + WS_CTL, 0, 16384, stream) != hipSuccess) { fprintf(stderr, "kernel_launch: hipMemsetAsync failed\n"); return; }
    void* args[] = {&p};
    const hipError_t e = hipLaunchCooperativeKernel((const void*)fwd_megakernel, dim3(grid), dim3(NTHREADS), args, LDS_BYTES, stream);
    if (e != hipSuccess) fprintf(stderr, "kernel_launch: cooperative launch failed: %s (grid %d)\n", hipGetErrorString(e), grid);
#endif
}
```

```cpp
#include <hip/hip_runtime.h>
#include <hip/hip_cooperative_groups.h>
#include <cstdio>
#include <cstdint>
namespace cg = cooperative_groups;
namespace pg8 {
#define PG8_LAS __attribute__((address_space(3)))
typedef unsigned short bf16_t;
typedef short bf16x8 __attribute__((ext_vector_type(8)));
typedef float f32x4 __attribute__((ext_vector_type(4)));
typedef unsigned u32x4 __attribute__((ext_vector_type(4)));
constexpr int BM = 256, BK = 64, HALF = 128, HTB = HALF * BK * 2  , STAGE_BYTES = 8 * HTB, NXCD = 8, WGM = 8;

__host__ __device__ __forceinline__ int lds_byte(int r, int c) { const int st = (r >> 4) * 2 + (c >> 5), rr = r & 15, cc = c & 31, ob = rr * 64 + cc * 2; return st * 1024 + (ob ^ (((ob >> 9) & 1) << 5)); }
__host__ __device__ __forceinline__ void stage_rc(int b, int& R, int& C) { const int st = b / 1024, sb = b % 1024, swz = sb ^ (((sb >> 9) & 1) << 5); R = (st >> 1) * 16 + swz / 64; C = (st & 1) * 32 + (swz % 64) / 2; }
__host__ __device__ __forceinline__ int perm32(int rho) { const int n = rho >> 4, i = rho & 15; return 8 * (i >> 2) + 4 * n + (i & 3); }

struct Unit { int pm, pn; };
struct Gemm { const bf16_t* A; const bf16_t* Bt; int M, N, K; };

struct StaticOrder {
    int nM, nN, nwg, G, c;
    __host__ __device__ void init(int M, int N, int G_, int c_) { nM = M / BM; nN = N / BM; nwg = nM * nN; G = G_; c = c_; }
    __host__ __device__ bool next(int i, Unit& u) const {
        const long L = (long)i * G + c; if (L >= nwg) return false;
        int wgid = (int)L; { const int q = nwg / NXCD, r = nwg % NXCD, xcd = wgid % NXCD, off = wgid / NXCD; wgid = (xcd < r ? xcd * (q + 1) : r * (q + 1) + (xcd - r) * q) + off; }
        const int nig = WGM * nN, gid = wgid / nig, fm = gid * WGM, gsz = (nM - fm) < WGM ? (nM - fm) : WGM;
        u.pm = fm + ((wgid % nig) % gsz); u.pn = (wgid % nig) / gsz; return true;
    }
    __device__ __forceinline__ void a_ready(const Unit&) const {}
    __device__ __forceinline__ void done(const Unit&) const {}
};

__device__ __forceinline__ unsigned cvt_pk_bf16(float lo, float hi) { unsigned r; asm volatile("v_cvt_pk_bf16_f32 %0, %1, %2" : "=v"(r) : "v"(lo), "v"(hi)); return r; }
typedef float f32x2 __attribute__((ext_vector_type(2)));
__device__ __forceinline__ f32x2 gelu_pk(f32x2 v) {
    const f32x2 av = __builtin_elementwise_abs(v), d = av * 0.2316418882f + 1.0f;
    f32x2 t; t.x = __builtin_amdgcn_rcpf(d.x); t.y = __builtin_amdgcn_rcpf(d.y);
    f32x2 q = t * 0.5307027145f + (-0.7265760135f); q = q * t + 0.7107068705f; q = q * t + (-0.142248368f); q = q * t + 0.127414796f; q = q * t;
    const f32x2 s = (v * v) * (-0.72134752044f);
    f32x2 e; e.x = __builtin_amdgcn_exp2f(s.x); e.y = __builtin_amdgcn_exp2f(s.y);
    const f32x2 m = v * (q * e), r = v - m;
    f32x2 o; o.x = v.x < 0.f ? m.x : r.x; o.y = v.y < 0.f ? m.y : r.y; return o;
}

template <int ACT  > struct EpiBf16 {
    static constexpr bool PERM = true, AFTER_DRAIN = false; static_assert(ACT == 0 || ACT == 1, "EpiBf16: ACT is 0 (none) or 1 (gelu_pk)");
    bf16_t* O; int ldc; const float* bias; int split_cols; size_t split_stride; float scale0;
    __device__ __forceinline__ void operator()(const f32x4 (&acc)[2][2][4][2], const Unit& u, int wr, int wc, int fr, int fq) const {
        const int row0 = u.pm * BM + wr * 64 + fr; int colt = u.pn * BM; bf16_t* base = O;
        float sc = 1.f; if (split_cols) { const int t = colt / split_cols; base += (size_t)t * split_stride; colt -= t * split_cols; if (t == 0) sc = scale0; }
        const int col0 = colt + wc * 32 + 8 * fq, bcol0 = u.pn * BM + wc * 32 + 8 * fq;
        f32x4 bv[2][2];
#pragma unroll
        for (int bj = 0; bj < 2; ++bj)
#pragma unroll
            for (int n = 0; n < 2; ++n) bv[bj][n] = bias ? *(const f32x4*)(bias + bcol0 + bj * HALF + 4 * n) : (f32x4){0.f, 0.f, 0.f, 0.f};
#pragma unroll
        for (int ai = 0; ai < 2; ++ai)
#pragma unroll
            for (int m = 0; m < 4; ++m) { bf16_t* rowp = base + (size_t)(row0 + ai * HALF + m * 16) * ldc + col0;
#pragma unroll
                for (int bj = 0; bj < 2; ++bj) { f32x4 v0 = acc[ai][bj][m][0] + bv[bj][0], v1 = acc[ai][bj][m][1] + bv[bj][1];
                    if (ACT == 1) { f32x2 a = gelu_pk((f32x2){v0[0], v0[1]}), b = gelu_pk((f32x2){v0[2], v0[3]}), c = gelu_pk((f32x2){v1[0], v1[1]}), d = gelu_pk((f32x2){v1[2], v1[3]});
                        v0 = (f32x4){a.x, a.y, b.x, b.y}; v1 = (f32x4){c.x, c.y, d.x, d.y}; }
                    v0 = v0 * sc; v1 = v1 * sc; u32x4 w; w.x = cvt_pk_bf16(v0[0], v0[1]); w.y = cvt_pk_bf16(v0[2], v0[3]); w.z = cvt_pk_bf16(v1[0], v1[1]); w.w = cvt_pk_bf16(v1[2], v1[3]);
                    *(u32x4*)(rowp + bj * HALF) = w; } }
    }
};

struct PanelStats {
    unsigned* xbuf;
    unsigned* cnt;
    unsigned* tmo;
    int ntn; float eps;
    unsigned code;
    __device__ __forceinline__ bool run(const f32x4 (&v)[2][2][4][2], const Unit& u, int wr, int wc, int fr, int fq, PG8_LAS unsigned char* lds, int wid, int lane) const {
        typedef float f32x2v __attribute__((ext_vector_type(2)));
        PG8_LAS f32x2v* P = (PG8_LAS f32x2v*)lds;
        PG8_LAS f32x2v* S = (PG8_LAS f32x2v*)(lds + 8192);
        PG8_LAS unsigned* flag = (PG8_LAS unsigned*)(lds + 8192 + 2048);
#pragma unroll
        for (int ai = 0; ai < 2; ++ai)
#pragma unroll
            for (int m = 0; m < 4; ++m) {
                float s = 0.f;
#pragma unroll
                for (int bj = 0; bj < 2; ++bj)
#pragma unroll
                    for (int n = 0; n < 2; ++n) { const f32x4 x = v[ai][bj][m][n]; s += (x[0] + x[1]) + (x[2] + x[3]); }
                s += __shfl_xor(s, 16); s += __shfl_xor(s, 32);
                const float mw = s * (1.0f / 64.0f); float q = 0.f;
#pragma unroll
                for (int bj = 0; bj < 2; ++bj)
#pragma unroll
                    for (int n = 0; n < 2; ++n) { const f32x4 d = v[ai][bj][m][n] - mw; q += (d[0] * d[0] + d[1] * d[1]) + (d[2] * d[2] + d[3] * d[3]); }
                q += __shfl_xor(q, 16); q += __shfl_xor(q, 32);
                if (fq == 0) P[(ai * HALF + wr * 64 + m * 16 + fr) * 4 + wc] = (f32x2v){mw, q};
            }
        asm volatile("s_waitcnt lgkmcnt(0)" ::: "memory"); __builtin_amdgcn_s_barrier(); asm volatile("" ::: "memory");
#if defined(BROKEN_EXCHANGE_NO_WAIT)
#warning BROKEN CONTROL BUILD: the row-statistics exchange does not wait; results are wrong by design
        if (blockIdx.x >= 64) { const long long t0_ = clock64(); while (clock64() - t0_ < 60000) __builtin_amdgcn_s_sleep(8); }
#endif
        const int row = wid * 32 + (lane & 31);
        if (lane < 32) {
            const f32x2v a = P[row * 4 + 0], b = P[row * 4 + 1], c = P[row * 4 + 2], d = P[row * 4 + 3];
            const float mt = (a.x + b.x + c.x + d.x) * 0.25f;
            const float da = a.x - mt, db = b.x - mt, dc = c.x - mt, dd = d.x - mt;
            const float m2 = (a.y + b.y) + (c.y + d.y) + 64.0f * ((da * da + db * db) + (dc * dc + dd * dd));
            unsigned long long* slot = (unsigned long long*)xbuf + ((size_t)(u.pm * BM + row) * 4 + u.pn);
            __hip_atomic_store(slot, ((unsigned long long)__float_as_uint(m2) << 32) | __float_as_uint(mt), __ATOMIC_RELAXED, __HIP_MEMORY_SCOPE_AGENT);
        }
        asm volatile("s_waitcnt vmcnt(0)" ::: "memory");
        if (lane == 0) __hip_atomic_fetch_add(cnt + 64 * u.pm, 1u, __ATOMIC_RELAXED, __HIP_MEMORY_SCOPE_AGENT);
        if (wid == 0) {
            bool dead = false; const unsigned long long t0 = __builtin_amdgcn_s_memrealtime(); const unsigned want = 8u * (unsigned)ntn;
            for (;;) {
#if defined(BROKEN_EXCHANGE_NO_WAIT)
                break;
#endif
                if ((unsigned)__builtin_amdgcn_readfirstlane(__hip_atomic_load(cnt + 64 * u.pm, __ATOMIC_RELAXED, __HIP_MEMORY_SCOPE_AGENT)) >= want) break;
                if (__builtin_amdgcn_s_memrealtime() - t0 > 2000000ull) {
                    if (lane == 0) { unsigned expect = 0u; __hip_atomic_compare_exchange_strong(tmo + 1, &expect, code | (unsigned)(u.pm & 0xff), __ATOMIC_RELAXED, __ATOMIC_RELAXED, __HIP_MEMORY_SCOPE_AGENT);
                                     __hip_atomic_store(tmo, 1u, __ATOMIC_RELAXED, __HIP_MEMORY_SCOPE_AGENT); }
                    dead = true; break; }
                __builtin_amdgcn_s_sleep(2);
            }
            __builtin_amdgcn_fence(__ATOMIC_ACQUIRE, "agent");
            if (lane == 0) flag[0] = dead ? 1u : 0u;
        }
        asm volatile("s_waitcnt vmcnt(0) lgkmcnt(0)" ::: "memory"); __builtin_amdgcn_s_barrier(); asm volatile("" ::: "memory");
        const bool bad = flag[0] != 0u;
        if (lane < 32) {
            const unsigned long long* slot = (const unsigned long long*)xbuf + (size_t)(u.pm * BM + row) * 4; float mt[4], m2[4]; float ms = 0.f;
#pragma unroll
            for (int t = 0; t < 4; ++t) { if (t < ntn) { const unsigned long long w = __hip_atomic_load(slot + t, __ATOMIC_RELAXED, __HIP_MEMORY_SCOPE_AGENT); mt[t] = __uint_as_float((unsigned)w); m2[t] = __uint_as_float((unsigned)(w >> 32)); } else { mt[t] = 0.f; m2[t] = 0.f; } ms += mt[t]; }
            const float mean = ms / (float)ntn; float q = 0.f;
#pragma unroll
            for (int t = 0; t < 4; ++t) if (t < ntn) { const float dm = mt[t] - mean; q += m2[t] + 256.0f * dm * dm; }
            S[row] = (f32x2v){mean, 1.0f / sqrtf(q / (256.0f * (float)ntn) + eps)};
        }
        asm volatile("s_waitcnt lgkmcnt(0)" ::: "memory"); __builtin_amdgcn_s_barrier(); asm volatile("" ::: "memory");
        return bad;
    }
};
struct EpiLnRes {
    static constexpr bool PERM = false, AFTER_DRAIN = true;
    const float* base; float* out; int ldc; const float* bias; PanelStats st; unsigned poison;
    __device__ __forceinline__ void fused(f32x4 (&acc)[2][2][4][2], const Unit& u, int wr, int wc, int fr, int fq, PG8_LAS unsigned char* lds, int wid, int lane) const {
        typedef float f32x2v __attribute__((ext_vector_type(2)));
        const PG8_LAS f32x2v* S = (const PG8_LAS f32x2v*)(lds + 8192);
        const int col0 = u.pn * BM + wc * 32 + 4 * fq;
#pragma unroll
        for (int bj = 0; bj < 2; ++bj)
#pragma unroll
            for (int n = 0; n < 2; ++n) { const f32x4 bv = bias ? *(const f32x4*)(bias + col0 + bj * HALF + n * 16) : (f32x4){0.f, 0.f, 0.f, 0.f};
#pragma unroll
                for (int ai = 0; ai < 2; ++ai)
#pragma unroll
                    for (int m = 0; m < 4; ++m) acc[ai][bj][m][n] += bv; }
        f32x4 pre[4][2][2];
#pragma unroll
        for (int m = 0; m < 4; ++m) { const size_t off = (size_t)(u.pm * BM + wr * 64 + m * 16 + fr) * ldc + col0;
#pragma unroll
            for (int bj = 0; bj < 2; ++bj)
#pragma unroll
                for (int n = 0; n < 2; ++n) pre[m][bj][n] = *(const f32x4*)(base + off + bj * HALF + n * 16); }
        const bool bad = st.run(acc, u, wr, wc, fr, fq, lds, wid, lane) || poison != 0u;
        const float qnan = __builtin_nanf("");
#pragma unroll
        for (int ai = 0; ai < 2; ++ai)
#pragma unroll
            for (int m = 0; m < 4; ++m) { const int r = ai * HALF + wr * 64 + m * 16 + fr; const f32x2v sr = S[r]; const size_t off = (size_t)(u.pm * BM + r) * ldc + col0;
#pragma unroll
                for (int bj = 0; bj < 2; ++bj)
#pragma unroll
                    for (int n = 0; n < 2; ++n) { const f32x4 bs = ai == 0 ? pre[m][bj][n] : *(const f32x4*)(base + off + bj * HALF + n * 16); f32x4 o = bs + (acc[ai][bj][m][n] - sr.x) * sr.y;
                        if (bad) o = (f32x4){qnan, qnan, qnan, qnan}; *(f32x4*)(out + off + bj * HALF + n * 16) = o; }
                if (m & 1) asm volatile("" ::: "memory"); }
    }
};
struct EpiLnResLn {
    static constexpr bool PERM = false, AFTER_DRAIN = true;
    const float* base; float* out; bf16_t* xn; int ldc; const float* bias; PanelStats st1, st2; unsigned poison;
    __device__ __forceinline__ void fused(f32x4 (&acc)[2][2][4][2], const Unit& u, int wr, int wc, int fr, int fq, PG8_LAS unsigned char* lds, int wid, int lane) const {
        typedef float f32x2v __attribute__((ext_vector_type(2))); typedef unsigned u32x2v __attribute__((ext_vector_type(2)));
        const PG8_LAS f32x2v* S = (const PG8_LAS f32x2v*)(lds + 8192);
        const int col0 = u.pn * BM + wc * 32 + 4 * fq;
#pragma unroll
        for (int bj = 0; bj < 2; ++bj)
#pragma unroll
            for (int n = 0; n < 2; ++n) { const f32x4 bv = bias ? *(const f32x4*)(bias + col0 + bj * HALF + n * 16) : (f32x4){0.f, 0.f, 0.f, 0.f};
#pragma unroll
                for (int ai = 0; ai < 2; ++ai)
#pragma unroll
                    for (int m = 0; m < 4; ++m) acc[ai][bj][m][n] += bv; }
        bool bad = st1.run(acc, u, wr, wc, fr, fq, lds, wid, lane) || poison != 0u;
        const float qnan = __builtin_nanf("");
#pragma unroll
        for (int ai = 0; ai < 2; ++ai)
#pragma unroll
            for (int m = 0; m < 4; ++m) { const int r = ai * HALF + wr * 64 + m * 16 + fr; const f32x2v sr = S[r]; const size_t off = (size_t)(u.pm * BM + r) * ldc + col0;
#pragma unroll
                for (int bj = 0; bj < 2; ++bj)
#pragma unroll
                    for (int n = 0; n < 2; ++n) { const f32x4 bs = *(const f32x4*)(base + off + bj * HALF + n * 16); acc[ai][bj][m][n] = bs + (acc[ai][bj][m][n] - sr.x) * sr.y; }
                asm volatile("" : "+v"(acc[ai][0][m][0]), "+v"(acc[ai][0][m][1]), "+v"(acc[ai][1][m][0]), "+v"(acc[ai][1][m][1]));
                if (m & 1) asm volatile("" ::: "memory"); }
        const bool bad1 = bad;
        bad = st2.run(acc, u, wr, wc, fr, fq, lds, wid, lane) || bad;
#pragma unroll
        for (int ai = 0; ai < 2; ++ai)
#pragma unroll
            for (int m = 0; m < 4; ++m) { const int r = ai * HALF + wr * 64 + m * 16 + fr; const f32x2v sr = S[r]; const size_t off = (size_t)(u.pm * BM + r) * ldc + col0;
#pragma unroll
                for (int bj = 0; bj < 2; ++bj)
#pragma unroll
                    for (int n = 0; n < 2; ++n) { const f32x4 x1 = acc[ai][bj][m][n]; *(f32x4*)(out + off + bj * HALF + n * 16) = bad1 ? (f32x4){qnan, qnan, qnan, qnan} : x1;
                        const f32x4 o = (x1 - sr.x) * sr.y; u32x2v w; w.x = cvt_pk_bf16(o[0], o[1]); w.y = cvt_pk_bf16(o[2], o[3]);
                        if (bad) { w.x = 0x7fc07fc0u; w.y = 0x7fc07fc0u; } *(u32x2v*)(xn + off + bj * HALF + n * 16) = w; }
                asm volatile("" ::: "memory"); }
    }
};

template <class Epi, class Sched, bool ALIGN_EPI = false, bool SP2 = false>
__device__ __forceinline__ void gemm_phase(PG8_LAS unsigned char* lds, const Gemm g, const Sched& S, const Epi& E) {
    const int tid = threadIdx.x, wid = __builtin_amdgcn_readfirstlane(tid >> 6), lane = tid & 63, wr = wid >> 2, wc = wid & 3, fr = lane & 15, fq = lane >> 4;
    const int K = g.K, nt = K / BK;
    unsigned voffA[2], voffB[2];
#pragma unroll
    for (int i = 0; i < 2; ++i) { int R, C; stage_rc(tid * 16 + i * 8192, R, C); const int Rb = Epi::PERM ? ((R & ~31) + perm32(R & 31)) : R;
        voffA[i] = (unsigned)(R * K + C) * 2u; voffB[i] = (unsigned)(Rb * K + C) * 2u; }
    const size_t kstep = (size_t)(BK * 2);
    const size_t hstep = (size_t)HALF * K * 2;
    const size_t tstep = 2 * hstep;
    const unsigned ldsw = (unsigned)wid * 1024u;
    const int aoff = lds_byte(wr * 64 + fr, fq * 8), boff = lds_byte(wc * 32 + fr, fq * 8);
#define PG8_SA(b, h) (((b) * 2 + (h)) * HTB)
#define PG8_SB(b, h) ((4 + (b) * 2 + (h)) * HTB)
#define PG8_STAGE(bufoff, gbase, voff) do { _Pragma("unroll") for (int _i = 0; _i < 2; ++_i) \
        __builtin_amdgcn_global_load_lds((const unsigned*)((const char*)(gbase) + (voff)[_i]), (PG8_LAS unsigned*)(lds + (bufoff) + ldsw + _i * 8192), 16, 0, 0); } while (0)
#define PG8_LDA(dst, b, h) do { _Pragma("unroll") for (int m = 0; m < 4; ++m) _Pragma("unroll") for (int k = 0; k < 2; ++k) dst[m][k] = *(const PG8_LAS bf16x8*)(lds + PG8_SA(b, h) + aoff + m * 2048 + k * 1024); } while (0)
#define PG8_LDB(dst, b, h) do { _Pragma("unroll") for (int n = 0; n < 2; ++n) _Pragma("unroll") for (int k = 0; k < 2; ++k) dst[n][k] = *(const PG8_LAS bf16x8*)(lds + PG8_SB(b, h) + boff + n * 2048 + k * 1024); } while (0)
#define PG8_MMA(ai, bj, At, Bt) do { __builtin_amdgcn_s_setprio(1); _Pragma("unroll") for (int m = 0; m < 4; ++m) _Pragma("unroll") for (int n = 0; n < 2; ++n) _Pragma("unroll") for (int k = 0; k < 2; ++k) \
        acc[ai][bj][m][n] = __builtin_amdgcn_mfma_f32_16x16x32_bf16(Bt[n][k], At[m][k], acc[ai][bj][m][n], 0, 0, 0); __builtin_amdgcn_s_setprio(0); } while (0)
#define PG8_WAIT_V(n) asm volatile("s_waitcnt vmcnt(" #n ")" ::: "memory")
#define PG8_WAIT_L(n) asm volatile("s_waitcnt lgkmcnt(" #n ")" ::: "memory")
#define PG8_BAR __builtin_amdgcn_s_barrier()
#define PG8_SCHED __builtin_amdgcn_sched_barrier(0)
    Unit cur, nxt; int ui = 0;
    if (!S.next(0, cur)) return;
    f32x4 acc[2][2][4][2];
#pragma unroll
    for (int a = 0; a < 2; ++a)
#pragma unroll
        for (int b = 0; b < 2; ++b)
#pragma unroll
            for (int m = 0; m < 4; ++m)
#pragma unroll
                for (int n = 0; n < 2; ++n) acc[a][b][m][n] = (f32x4){0.f, 0.f, 0.f, 0.f};
    bf16x8 At[4][2], B0[2][2], B1[2][2];
    const char* cA = (const char*)g.A + (size_t)cur.pm * tstep; const char* cB = (const char*)g.Bt + (size_t)cur.pn * tstep;
    S.a_ready(cur);
    if constexpr (SP2) {
        PG8_STAGE(PG8_SB(0, 0), cB, voffB); PG8_STAGE(PG8_SB(0, 1), cB + hstep, voffB); PG8_STAGE(PG8_SA(0, 0), cA, voffA); PG8_STAGE(PG8_SA(0, 1), cA + hstep, voffA);
        if (wr == 1) PG8_BAR;
        PG8_WAIT_V(2); PG8_BAR;
        PG8_STAGE(PG8_SB(1, 0), cB + kstep, voffB); PG8_STAGE(PG8_SA(1, 0), cA + kstep, voffA); PG8_STAGE(PG8_SB(1, 1), cB + hstep + kstep, voffB);
        PG8_WAIT_V(6); PG8_BAR;
    } else {
        PG8_STAGE(PG8_SB(0, 0), cB, voffB); PG8_STAGE(PG8_SA(0, 0), cA, voffA); PG8_STAGE(PG8_SB(0, 1), cB + hstep, voffB); PG8_STAGE(PG8_SA(0, 1), cA + hstep, voffA);
        if (wr == 1) PG8_BAR;
        PG8_WAIT_V(4); PG8_BAR;
        PG8_STAGE(PG8_SB(1, 0), cB + kstep, voffB); PG8_STAGE(PG8_SA(1, 0), cA + kstep, voffA); PG8_STAGE(PG8_SB(1, 1), cB + hstep + kstep, voffB);
        PG8_WAIT_V(6); PG8_BAR;
    }
    for (;;) {
        const bool has_next = S.next(ui + 1, nxt);
        const char* nA = has_next ? (const char*)g.A + (size_t)nxt.pm * tstep : cA; const char* nB = has_next ? (const char*)g.Bt + (size_t)nxt.pn * tstep : cB;
        for (int t = 0; t < nt; t += 2) {
            const bool last = (t == nt - 2);
            const char* a1 = cA + (size_t)(t + 1) * kstep;
            const char* a2 = last ? nA : cA + (size_t)(t + 2) * kstep; const char* b2 = last ? nB : cB + (size_t)(t + 2) * kstep;
            const char* a3 = a2 + kstep; const char* b3 = b2 + kstep;
            if (last && has_next) S.a_ready(nxt);
            if constexpr (SP2) {
            PG8_LDB(B0, 0, 0); PG8_LDB(B1, 0, 1); PG8_SCHED; PG8_LDA(At, 0, 0); PG8_STAGE(PG8_SA(1, 1), a1 + hstep, voffA);
            PG8_WAIT_V(8); PG8_WAIT_L(0); PG8_BAR; PG8_MMA(0, 0, At, B0); PG8_MMA(0, 1, At, B1); PG8_BAR; PG8_SCHED;
            PG8_LDA(At, 0, 1); PG8_STAGE(PG8_SB(0, 0), b2, voffB); PG8_STAGE(PG8_SB(0, 1), b2 + hstep, voffB); PG8_STAGE(PG8_SA(0, 0), a2, voffA);
            PG8_WAIT_V(8); PG8_WAIT_L(0); PG8_BAR; PG8_MMA(1, 0, At, B0); PG8_MMA(1, 1, At, B1); PG8_BAR; PG8_SCHED;
            PG8_LDB(B0, 1, 0); PG8_LDB(B1, 1, 1); PG8_SCHED; PG8_LDA(At, 1, 0); PG8_STAGE(PG8_SA(0, 1), a2 + hstep, voffA);
            PG8_WAIT_V(8); PG8_WAIT_L(0); PG8_BAR; PG8_MMA(0, 0, At, B0); PG8_MMA(0, 1, At, B1); PG8_BAR; PG8_SCHED;
            PG8_LDA(At, 1, 1); PG8_STAGE(PG8_SB(1, 0), b3, voffB); PG8_STAGE(PG8_SB(1, 1), b3 + hstep, voffB); PG8_STAGE(PG8_SA(1, 0), a3, voffA);
            PG8_WAIT_V(8); PG8_WAIT_L(0); PG8_BAR; PG8_MMA(1, 0, At, B0); PG8_MMA(1, 1, At, B1); PG8_BAR; PG8_SCHED;
            } else {
            PG8_LDB(B0, 0, 0); PG8_SCHED; PG8_LDA(At, 0, 0); PG8_STAGE(PG8_SA(1, 1), a1 + hstep, voffA);
            PG8_WAIT_L(8); PG8_BAR; PG8_WAIT_L(0); PG8_MMA(0, 0, At, B0); PG8_BAR; PG8_SCHED;
            PG8_LDB(B1, 0, 1); PG8_STAGE(PG8_SB(0, 0), b2, voffB);
            PG8_BAR; PG8_WAIT_L(0); PG8_MMA(0, 1, At, B1); PG8_BAR;
            PG8_LDA(At, 0, 1); PG8_STAGE(PG8_SA(0, 0), a2, voffA);
            PG8_BAR; PG8_WAIT_L(0); PG8_MMA(1, 0, At, B0); PG8_BAR; PG8_SCHED;
            PG8_STAGE(PG8_SB(0, 1), b2 + hstep, voffB);
            PG8_WAIT_V(6); PG8_BAR; PG8_MMA(1, 1, At, B1); PG8_BAR;
            PG8_LDB(B0, 1, 0); PG8_SCHED; PG8_LDA(At, 1, 0); PG8_STAGE(PG8_SA(0, 1), a2 + hstep, voffA);
            PG8_WAIT_L(8); PG8_BAR; PG8_WAIT_L(0); PG8_MMA(0, 0, At, B0); PG8_BAR; PG8_SCHED;
            PG8_LDB(B1, 1, 1); PG8_STAGE(PG8_SB(1, 0), b3, voffB);
            PG8_BAR; PG8_WAIT_L(0); PG8_MMA(0, 1, At, B1); PG8_BAR;
            PG8_LDA(At, 1, 1); PG8_STAGE(PG8_SA(1, 0), a3, voffA);
            PG8_BAR; PG8_WAIT_L(0); PG8_MMA(1, 0, At, B0); PG8_BAR; PG8_SCHED;
            PG8_STAGE(PG8_SB(1, 1), b3 + hstep, voffB);
            PG8_WAIT_V(6); PG8_BAR; PG8_MMA(1, 1, At, B1); PG8_BAR;
            }
        }
        if constexpr (ALIGN_EPI) { if (wr == 0) PG8_BAR; }
        if constexpr (!Epi::AFTER_DRAIN) { E(acc, cur, wr, wc, fr, fq); S.done(cur); }
        if (!has_next) break;
#pragma unroll
        for (int a = 0; a < 2; ++a)
#pragma unroll
            for (int b = 0; b < 2; ++b)
#pragma unroll
                for (int m = 0; m < 4; ++m)
#pragma unroll
                    for (int n = 0; n < 2; ++n) acc[a][b][m][n] = (f32x4){0.f, 0.f, 0.f, 0.f};
        cur = nxt; cA = nA; cB = nB; ++ui;
        if constexpr (ALIGN_EPI) { if (wr == 1) PG8_BAR; }
    }
    PG8_WAIT_V(0);
    if constexpr (!ALIGN_EPI) { if (wr == 0) PG8_BAR; }
    PG8_BAR;
    if constexpr (Epi::AFTER_DRAIN) { E.fused(acc, cur, wr, wc, fr, fq, lds, wid, lane); S.done(cur); }
#undef PG8_SA
#undef PG8_SB
#undef PG8_STAGE
#undef PG8_LDA
#undef PG8_LDB
#undef PG8_MMA
#undef PG8_WAIT_V
#undef PG8_WAIT_L
#undef PG8_BAR
#undef PG8_SCHED
}
}

typedef float f32x2_t __attribute__((ext_vector_type(2))); typedef __bf16 bf16x2_t __attribute__((ext_vector_type(2)));
__device__ __forceinline__ unsigned cvtpk(float lo, float hi) { f32x2_t v = {lo, hi}; bf16x2_t b = __builtin_convertvector(v, bf16x2_t); return __builtin_bit_cast(unsigned, b); }

namespace pg8 {
template <bool BASE_BF16> struct EpiRes {
    static constexpr bool PERM = true, AFTER_DRAIN = false;
    const void* base; bf16_t* hb; float* ssq;
    __device__ __forceinline__ void operator()(const f32x4 (&acc)[2][2][4][2], const Unit& u, int wr, int wc, int fr, int fq) const {
        const int row0 = u.pm * BM + wr * 64 + fr, col0 = u.pn * BM + wc * 32 + 8 * fq;
#pragma unroll
        for (int ai = 0; ai < 2; ++ai) {
            f32x4 b0[4][2], b1[4][2];
#pragma unroll
            for (int m = 0; m < 4; ++m)
#pragma unroll
                for (int bj = 0; bj < 2; ++bj) {
                    const size_t off = (size_t)(row0 + ai * HALF + m * 16) * 1024 + col0 + bj * HALF;
                    if (BASE_BF16) {
                        const u32x4 w = *(const u32x4*)((const bf16_t*)base + off);
                        b0[m][bj][0] = __uint_as_float(w.x << 16); b0[m][bj][1] = __uint_as_float(w.x & 0xffff0000u); b0[m][bj][2] = __uint_as_float(w.y << 16); b0[m][bj][3] = __uint_as_float(w.y & 0xffff0000u);
                        b1[m][bj][0] = __uint_as_float(w.z << 16); b1[m][bj][1] = __uint_as_float(w.z & 0xffff0000u); b1[m][bj][2] = __uint_as_float(w.w << 16); b1[m][bj][3] = __uint_as_float(w.w & 0xffff0000u);
                    } else { b0[m][bj] = *(const f32x4*)((const float*)base + off); b1[m][bj] = *(const f32x4*)((const float*)base + off + 4); }
                }
#pragma unroll
            for (int m = 0; m < 4; ++m) {
                const size_t row = (size_t)(row0 + ai * HALF + m * 16); float s = 0.f;
#pragma unroll
                for (int bj = 0; bj < 2; ++bj) {
                    const size_t off = row * 1024 + col0 + bj * HALF;
                    const f32x4 v0 = acc[ai][bj][m][0] + b0[m][bj], v1 = acc[ai][bj][m][1] + b1[m][bj];
                    s += (v0[0] * v0[0] + v0[1] * v0[1]) + (v0[2] * v0[2] + v0[3] * v0[3]) + (v1[0] * v1[0] + v1[1] * v1[1]) + (v1[2] * v1[2] + v1[3] * v1[3]);
                    u32x4 w; w.x = cvtpk(v0[0], v0[1]); w.y = cvtpk(v0[2], v0[3]); w.z = cvtpk(v1[0], v1[1]); w.w = cvtpk(v1[2], v1[3]); *(u32x4*)(hb + off) = w;
                }
                s += __shfl_xor(s, 16); s += __shfl_xor(s, 32); if (fq == 0) ssq[row * 16 + u.pn * 4 + wc] = s;
            }
        }
    }
};
template <int MODE> struct EpiScale {
    static constexpr bool PERM = true, AFTER_DRAIN = false;
    bf16_t* O; int ldc; const float* ssq; float scale;
    __device__ __forceinline__ void operator()(const f32x4 (&acc)[2][2][4][2], const Unit& u, int wr, int wc, int fr, int fq) const {
        const int row0 = u.pm * BM + wr * 64 + fr, col0 = u.pn * BM + wc * 32 + 8 * fq;
#pragma unroll
        for (int ai = 0; ai < 2; ++ai)
#pragma unroll
            for (int m = 0; m < 4; ++m) {
                const size_t row = (size_t)(row0 + ai * HALF + m * 16);
                const f32x4 s0 = *(const f32x4*)(ssq + row * 16), s1 = *(const f32x4*)(ssq + row * 16 + 4), s2 = *(const f32x4*)(ssq + row * 16 + 8), s3 = *(const f32x4*)(ssq + row * 16 + 12);
                const f32x4 st = (s0 + s1) + (s2 + s3);
                const float rs = __builtin_amdgcn_rsqf(((st[0] + st[1]) + (st[2] + st[3])) * (1.0f / 1024.0f) + 1e-6f) * scale;
#pragma unroll
                for (int bj = 0; bj < 2; ++bj) {
                    f32x4 v0 = acc[ai][bj][m][0] * rs, v1 = acc[ai][bj][m][1] * rs;
                    if (MODE == 1) {
#pragma unroll
                        for (int e = 0; e < 4; ++e) { const float a = fmaxf(v0[e], 0.f), b = fmaxf(v1[e], 0.f); v0[e] = a * a; v1[e] = b * b; }
                    }
                    u32x4 w; w.x = cvtpk(v0[0], v0[1]); w.y = cvtpk(v0[2], v0[3]); w.z = cvtpk(v1[0], v1[1]); w.w = cvtpk(v1[2], v1[3]);
                    *(u32x4*)(O + row * ldc + col0 + bj * HALF) = w;
                }
            }
    }
};
struct EpiKV {
    static constexpr bool PERM = true, AFTER_DRAIN = false;
    bf16_t* Kb; bf16_t* Vt;
    __device__ __forceinline__ void operator()(const f32x4 (&acc)[2][2][4][2], const Unit& u, int wr, int wc, int fr, int fq) const {
        const int row0 = u.pm * BM + wr * 64 + fr, col0 = u.pn * BM + wc * 32 + 8 * fq;
#pragma unroll
        for (int ai = 0; ai < 2; ++ai)
#pragma unroll
            for (int m = 0; m < 4; ++m) {
                const int row = row0 + ai * HALF + m * 16;
#pragma unroll
                for (int bj = 0; bj < 2; ++bj) {
                    const int col = col0 + bj * HALF; const f32x4 v0 = acc[ai][bj][m][0], v1 = acc[ai][bj][m][1];
                    u32x4 w; w.x = cvtpk(v0[0], v0[1]); w.y = cvtpk(v0[2], v0[3]); w.z = cvtpk(v1[0], v1[1]); w.w = cvtpk(v1[2], v1[3]);
                    if (col < 1024) { *(u32x4*)(Kb + (size_t)row * 1024 + col) = w; }
                    else {
                        const int b = row >> 8, mm = row & 255; bf16_t* p = Vt + ((size_t)(b * 1024 + (col - 1024))) * 256 + mm;
                        p[0 * 256] = (bf16_t)(w.x & 0xffffu); p[1 * 256] = (bf16_t)(w.x >> 16); p[2 * 256] = (bf16_t)(w.y & 0xffffu); p[3 * 256] = (bf16_t)(w.y >> 16);
                        p[4 * 256] = (bf16_t)(w.z & 0xffffu); p[5 * 256] = (bf16_t)(w.z >> 16); p[6 * 256] = (bf16_t)(w.w & 0xffffu); p[7 * 256] = (bf16_t)(w.w >> 16);
                    }
                }
            }
    }
};
}

#define LAS __attribute__((address_space(3)))
typedef pg8::bf16_t bf16_t;
typedef pg8::bf16x8 bf16x8;
typedef pg8::f32x4 f32x4;
typedef pg8::u32x4 u32x4;
typedef unsigned u32x2 __attribute__((ext_vector_type(2)));

constexpr int NTOK = 32768, DM = 1024, SEQ = 8192, NBATCH = 4, NCHUNK = 128, NPROJ = 3328, DFF = 4096, NMEMROWS = 1024;
constexpr int C_GQ = 0, C_GK = 256, C_GV = 512, C_GG = 1024, C_RQ = 1536, C_RK = 1792, C_RV = 2048, C_RG = 2560, C_Z = 3072;
constexpr int NWAVES = 8, NTHREADS = 512;
constexpr int WAVE_LDS = 18432, MISC_OFF = NWAVES * WAVE_LDS, LDS_BYTES = MISC_OFF + 64;
constexpr int VPITCH = 72;
constexpr int APITCH = 528;
constexpr size_t MiB = 1u << 20;
constexpr size_t WS_WIN = 1 * MiB, WS_WOUT = 8 * MiB, WS_WQ = 10 * MiB, WS_WKV = 12 * MiB, WS_WO = 16 * MiB, WS_W1 = 18 * MiB, WS_W2 = 26 * MiB;
constexpr size_t WS_COS = 34 * MiB, WS_SIN = 35 * MiB, WS_MEMN = 36 * MiB, WS_KB = 38 * MiB, WS_VT = 40 * MiB, WS_DEC = 42 * MiB, WS_SSQ1 = 44 * MiB, WS_SSQ2 = 46 * MiB, WS_SSQ3 = 48 * MiB, WS_CTL = 0;
constexpr size_t WS_A1 = 64 * MiB;
constexpr size_t WS_A2 = 128 * MiB;
constexpr size_t WS_BIG = 192 * MiB;
constexpr size_t WS_NEED = 448 * MiB;

struct Params {
    const float *x, *mem, *norm_mix_g, *w_in, *gla_w_gate, *gla_b_gate, *gla_norm_g, *ret_norm_g, *w_out, *norm_x_g, *norm_mem_g, *xa_w_q, *xa_w_kv, *xa_w_o, *norm_ffn_g, *ffn_w1, *ffn_w2, *final_norm_g;
    float* out; unsigned char* ws; int ph_lo, ph_hi;
};

__device__ __forceinline__ float bf2f(unsigned short b) { return __uint_as_float(((unsigned)b) << 16); }
__device__ __forceinline__ unsigned short f2bf(float f) { const unsigned u = __float_as_uint(f); return (unsigned short)((u + 0x7fffu + ((u >> 16) & 1u)) >> 16); }
__device__ __forceinline__ bf16x8 pack8(f32x4 a, f32x4 b) {
    u32x4 w; w.x = cvtpk(a[0], a[1]); w.y = cvtpk(a[2], a[3]); w.z = cvtpk(b[0], b[1]); w.w = cvtpk(b[2], b[3]);
    return __builtin_bit_cast(bf16x8, w);
}
__device__ __forceinline__ void unpack8(bf16x8 v, f32x4& a, f32x4& b) {
    const u32x4 w = __builtin_bit_cast(u32x4, v);
    a[0] = __uint_as_float(w.x << 16); a[1] = __uint_as_float(w.x & 0xffff0000u); a[2] = __uint_as_float(w.y << 16); a[3] = __uint_as_float(w.y & 0xffff0000u);
    b[0] = __uint_as_float(w.z << 16); b[1] = __uint_as_float(w.z & 0xffff0000u); b[2] = __uint_as_float(w.w << 16); b[3] = __uint_as_float(w.w & 0xffff0000u);
}
__device__ __forceinline__ float wave_sum(float v) {
#pragma unroll
    for (int o = 1; o < 64; o <<= 1) v += __shfl_xor(v, o);
    return v;
}
#define MFMA16(a, b, c) __builtin_amdgcn_mfma_f32_16x16x32_bf16((a), (b), (c), 0, 0, 0)
#define LDS_FENCE() asm volatile("s_waitcnt lgkmcnt(0)" ::: "memory")
#define CFENCE() do { asm volatile("" ::: "memory"); __builtin_amdgcn_sched_barrier(0); } while (0)
__device__ __forceinline__ float scan16(float v, int r) {
#pragma unroll
    for (int off = 1; off < 16; off <<= 1) { const float t = __shfl_up(v, off, 16); if (r >= off) v += t; }
    return v;
}

#define XB_TMO      128
#define XB_XCNT(j)  (256  + 64 * (j))
#define XB_XSUB(j)  (1280 + 64 * (j))
#define XB_XGEN(j)  (2304 + 64 * (j))
#define XB_TOP      3328
#define XB_TOPGEN   3392
#define XCD_BAR_WORDS 3456
#define XB_SPIN_CAP (1u << 18)

__device__ __forceinline__ unsigned xb_ld(unsigned* p)              { return __hip_atomic_load(p, __ATOMIC_RELAXED, __HIP_MEMORY_SCOPE_AGENT); }
__device__ __forceinline__ unsigned xb_add(unsigned* p, unsigned v) { return __hip_atomic_fetch_add(p, v, __ATOMIC_RELAXED, __HIP_MEMORY_SCOPE_AGENT); }
__device__ __forceinline__ unsigned xb_xcc_id() { return (unsigned)__builtin_amdgcn_s_getreg((3 << 11) | 20) & 0xFu; }
#define XB_SPIN(cond, bar) do { unsigned _sp = 0; while (cond) { __builtin_amdgcn_s_sleep(1); \
    if ((++_sp & 255u) == 0u) { if (xb_ld(&(bar)[XB_TMO])) break; if (_sp > XB_SPIN_CAP) { atomicAdd(&(bar)[XB_TMO], 1u); break; } } } } while (0)

struct XcdBarrier {
    unsigned* bar; unsigned x;
    volatile LAS unsigned* st;
};

__device__ __forceinline__ XcdBarrier xcd_barrier_post(unsigned* bar, volatile LAS unsigned* st) {
    XcdBarrier b; b.bar = bar; b.x = xb_xcc_id(); b.st = st;
    if (threadIdx.x == 0) (void)xb_add(&bar[XB_XCNT(b.x)], 1u);
    return b;
}
__device__ __forceinline__ void xcd_barrier_complete(unsigned* bar, unsigned x, unsigned& nloc, unsigned& nx) {
    const unsigned G = gridDim.x * gridDim.y * gridDim.z;
    unsigned sum, cnt, mine, sp = 0u;
    for (;;) {
        sum = 0u; cnt = 0u; mine = 0u;
#pragma unroll
        for (unsigned j = 0; j < 16; ++j) { const unsigned c = xb_ld(&bar[XB_XCNT(j)]); sum += c; cnt += (c > 0u) ? 1u : 0u; mine = (j == x) ? c : mine; }
        if (sum == G) break;
        __builtin_amdgcn_s_sleep(1);
        if ((++sp & 255u) == 0u) { if (xb_ld(&bar[XB_TMO])) break; if (sp > XB_SPIN_CAP) { atomicAdd(&bar[XB_TMO], 1u); break; } }
    }
    nloc = mine > 0u ? mine : 1u; nx = cnt > 0u ? cnt : 1u;
}

__device__ __forceinline__ void xcd_barrier(const XcdBarrier& b) {
    asm volatile("s_waitcnt vmcnt(0)" ::: "memory");
    __syncthreads();
    if (threadIdx.x == 0) {
        unsigned* bar = b.bar;
        __builtin_amdgcn_s_waitcnt(0);
        unsigned nloc = b.st[0], nx = b.st[1];
        if (nloc == 0u) { xcd_barrier_complete(bar, b.x, nloc, nx); b.st[0] = nloc; b.st[1] = nx; }
        const unsigned old = xb_add(&bar[XB_XSUB(b.x)], 1u);
        const unsigned gen = old / nloc;
        if (old + 1u == (gen + 1u) * nloc) {
            __builtin_amdgcn_fence(__ATOMIC_RELEASE, "agent");
            asm volatile("s_waitcnt vmcnt(0)" ::: "memory");
            const unsigned og = xb_add(&bar[XB_TOP], 1u);
            const unsigned tg = og / nx;
            if (og + 1u == (tg + 1u) * nx) xb_add(&bar[XB_TOPGEN], 1u);
            else XB_SPIN(xb_ld(&bar[XB_TOPGEN]) == tg, bar);
            __builtin_amdgcn_fence(__ATOMIC_ACQUIRE, "agent");
            xb_add(&bar[XB_XGEN(b.x)], 1u);
            asm volatile("s_waitcnt vmcnt(0)" ::: "memory");
        } else {
            XB_SPIN(xb_ld(&bar[XB_XGEN(b.x)]) == gen, bar);
            __builtin_amdgcn_fence(__ATOMIC_ACQUIRE, "agent");
            asm volatile("s_waitcnt vmcnt(0)" ::: "memory");
        }
    }
    __syncthreads();
}

__device__ __forceinline__ void transpose_item(const float* W, int ldw, int col0, int K, int Nn, const float* g, bf16_t* WT, int row_off, LAS float* scr, int item, int lane) {
    const int nblk = Nn / 32, kb = item / nblk, nb = item % nblk, k0 = 64 * kb, n0 = 32 * nb;
#pragma unroll 8
    for (int i = 0; i < 32; ++i) { const int kk = 2 * i + (lane >> 5); float w = W[(size_t)(k0 + kk) * ldw + col0 + n0 + (lane & 31)]; if (g) w *= g[k0 + kk]; scr[kk * 33 + (lane & 31)] = w; }
    LDS_FENCE();
    const int c = lane & 7;
#pragma unroll
    for (int j = 0; j < 4; ++j) { const int n = (lane >> 3) + 8 * j; const LAS float* s = scr + (8 * c) * 33 + n;
        u32x4 o; o.x = cvtpk(s[0 * 33], s[1 * 33]); o.y = cvtpk(s[2 * 33], s[3 * 33]); o.z = cvtpk(s[4 * 33], s[5 * 33]); o.w = cvtpk(s[6 * 33], s[7 * 33]);
        *(u32x4*)(WT + (size_t)(row_off + n0 + n) * K + k0 + 8 * c) = o; }
    LDS_FENCE();
}
__device__ __forceinline__ void rms_row_to_bf16(const float* xrow, const float* g, bf16_t* orow, int lane) {
    const f32x4* xr = (const f32x4*)xrow + lane; const f32x4* gr = (const f32x4*)g + lane;
    f32x4 v[4]; float s = 0.f;
#pragma unroll
    for (int j = 0; j < 4; ++j) { v[j] = xr[64 * j]; s += (v[j][0] * v[j][0] + v[j][1] * v[j][1]) + (v[j][2] * v[j][2] + v[j][3] * v[j][3]); }
    const float rstd = 1.0f / sqrtf(wave_sum(s) * (1.0f / 1024.0f) + 1e-6f);
    u32x2* o8 = (u32x2*)orow + lane;
#pragma unroll
    for (int j = 0; j < 4; ++j) { const f32x4 gg = gr[64 * j]; u32x2 w; w.x = cvtpk(v[j][0] * rstd * gg[0], v[j][1] * rstd * gg[1]); w.y = cvtpk(v[j][2] * rstd * gg[2], v[j][3] * rstd * gg[3]); o8[64 * j] = w; }
}
__device__ __forceinline__ void p0_prologue(const Params& p, LAS unsigned char* lds, int G) {
    const int tid = threadIdx.x, lane = tid & 63, wave = __builtin_amdgcn_readfirstlane(tid >> 6);
    unsigned char* ws = p.ws;
    LAS float* scr = (LAS float*)(lds + wave * WAVE_LDS);
    const int gw = blockIdx.x * NWAVES + wave, NGW = G * NWAVES;
    bf16_t* Win_t = (bf16_t*)(ws + WS_WIN);
    constexpr int I_INA = 16 * 32, I_INB = 16 * 64, I_OUT = 16 * 32, I_Q = 16 * 32, I_KV = 16 * 64, I_O = 16 * 32, I_1 = 16 * 128, I_2 = 64 * 32;
    constexpr int NITEMS = I_INA + I_INB + I_OUT + I_Q + I_KV + I_O + I_1 + I_2;
    for (int it = gw; it < NITEMS; it += NGW) {
        int r = it;
        if (r < I_INA) { transpose_item(p.w_in, 3088, 0, 1024, 1024, nullptr, Win_t, 0, scr, r, lane); continue; } r -= I_INA;
        if (r < I_INB) { transpose_item(p.w_in, 3088, 1040, 1024, 2048, nullptr, Win_t, 1024, scr, r, lane); continue; } r -= I_INB;
        if (r < I_OUT) { transpose_item(p.w_out, 1024, 0, 1024, 1024, nullptr, (bf16_t*)(ws + WS_WOUT), 0, scr, r, lane); continue; } r -= I_OUT;
        if (r < I_Q) { transpose_item(p.xa_w_q, 1024, 0, 1024, 1024, p.norm_x_g, (bf16_t*)(ws + WS_WQ), 0, scr, r, lane); continue; } r -= I_Q;
        if (r < I_KV) { transpose_item(p.xa_w_kv, 2048, 0, 1024, 2048, nullptr, (bf16_t*)(ws + WS_WKV), 0, scr, r, lane); continue; } r -= I_KV;
        if (r < I_O) { transpose_item(p.xa_w_o, 1024, 0, 1024, 1024, nullptr, (bf16_t*)(ws + WS_WO), 0, scr, r, lane); continue; } r -= I_O;
        if (r < I_1) { transpose_item(p.ffn_w1, 4096, 0, 1024, 4096, p.norm_ffn_g, (bf16_t*)(ws + WS_W1), 0, scr, r, lane); continue; } r -= I_1;
        transpose_item(p.ffn_w2, 1024, 0, 4096, 1024, nullptr, (bf16_t*)(ws + WS_W2), 0, scr, r, lane);
    }
    const int gt = blockIdx.x * NTHREADS + tid, NGT = G * NTHREADS;
    for (int o = gt; o < 256 * 1024; o += NGT) {
        const int n = o >> 10, k = o & 1023; const float* wr = p.w_in + (size_t)k * 3088 + 1024; float s = 0.f;
#pragma unroll
        for (int r = 0; r < 16; ++r) s += wr[r] * p.gla_w_gate[r * 256 + n];
        Win_t[(size_t)(3072 + n) * 1024 + k] = f2bf(s);
    }
    float* cosT = (float*)(ws + WS_COS); float* sinT = (float*)(ws + WS_SIN);
    for (int o = gt; o < SEQ * 32; o += NGT) {
        const int pos = o >> 5, i = o & 31; double f = 1.0;
        for (int k = 0; k < i; ++k) f *= 0.7498942093324559;
        const double t = (double)pos * f * 0.15915494309189535;
        const float fr = (float)(t - floor(t));
        cosT[o] = __builtin_amdgcn_cosf(fr); sinT[o] = __builtin_amdgcn_sinf(fr);
    }
    bf16_t* XN = (bf16_t*)(ws + WS_A1); bf16_t* MEMN = (bf16_t*)(ws + WS_MEMN);
    for (int m = gw; m < NTOK + NMEMROWS; m += NGW) {
        if (m < NTOK) rms_row_to_bf16(p.x + (size_t)m * DM, p.norm_mix_g, XN + (size_t)m * DM, lane);
        else rms_row_to_bf16(p.mem + (size_t)(m - NTOK) * DM, p.norm_mem_g, MEMN + (size_t)(m - NTOK) * DM, lane);
    }
}

__device__ __forceinline__ void gla_gates(const bf16_t* P, int zcol, const float* bg, int r, int q, float (&bc)[4][2][8], float (&bl)[2][8]) {
    bf16x8 zf[4][2];
#pragma unroll
    for (int mt = 0; mt < 4; ++mt)
#pragma unroll
        for (int ks = 0; ks < 2; ++ks) zf[mt][ks] = *(const bf16x8*)(P + (size_t)(16 * mt + r) * NPROJ + zcol + 32 * ks + 8 * q);
    CFENCE();
#pragma unroll
    for (int ks = 0; ks < 2; ++ks) {
        const f32x4 b0 = *(const f32x4*)(bg + 32 * ks + 8 * q), b1 = *(const f32x4*)(bg + 32 * ks + 8 * q + 4);
#pragma unroll
        for (int mt = 0; mt < 4; ++mt) {
            f32x4 z0, z1; unpack8(zf[mt][ks], z0, z1); z0 += b0; z1 += b1;
#pragma unroll
            for (int e = 0; e < 4; ++e) {
                bc[mt][ks][e] = (fminf(z0[e], 0.f) - __logf(1.0f + __expf(-fabsf(z0[e])))) * (1.0f / 16.0f);
                bc[mt][ks][4 + e] = (fminf(z1[e], 0.f) - __logf(1.0f + __expf(-fabsf(z1[e])))) * (1.0f / 16.0f);
            }
        }
#pragma unroll
        for (int e = 0; e < 8; ++e) {
            float carry = 0.f;
#pragma unroll
            for (int mt = 0; mt < 4; ++mt) { const float v = scan16(bc[mt][ks][e], r); const float tot = __shfl(v, 15, 16); bc[mt][ks][e] = v + carry; carry += tot; }
            bl[ks][e] = carry;
        }
    }
}
__device__ __forceinline__ float ret_log2g(int hr) { return hr == 0 ? -0.04580368961312479f : hr == 1 ? -0.008973692110584325f : hr == 2 ? -0.0017761724589428754f : -0.0003522634716290214f; }
__device__ __forceinline__ void rope_tile(bf16x8 f0, bf16x8 f1, const float* cosT, const float* sinT, int pos, int q, f32x4 (&o)[4]) {
    f32x4 a0, a1, b0, b1; unpack8(f0, a0, a1); unpack8(f1, b0, b1);
    const f32x4 c0 = *(const f32x4*)(cosT + pos * 32 + 8 * q), c1 = *(const f32x4*)(cosT + pos * 32 + 8 * q + 4), s0 = *(const f32x4*)(sinT + pos * 32 + 8 * q), s1 = *(const f32x4*)(sinT + pos * 32 + 8 * q + 4);
    o[0] = a0 * c0 - b0 * s0; o[1] = a1 * c1 - b1 * s1; o[2] = a0 * s0 + b0 * c0; o[3] = a1 * s1 + b1 * c1;
}

__device__ __forceinline__ void chunk_contrib(const Params& p, LAS unsigned char* lds, int G) {
    const int tid = threadIdx.x, lane = tid & 63, wave = __builtin_amdgcn_readfirstlane(tid >> 6);
    unsigned char* ws = p.ws;
    const bf16_t* PROJ = (const bf16_t*)(ws + WS_BIG); bf16_t* CT = (bf16_t*)(ws + WS_A2); float* DEC = (float*)(ws + WS_DEC);
    const float* cosT = (const float*)(ws + WS_COS); const float* sinT = (const float*)(ws + WS_SIN);
    LAS bf16_t* Kdt = (LAS bf16_t*)(lds + wave * WAVE_LDS); LAS bf16_t* Vt = Kdt + 64 * VPITCH;
    for (int u = blockIdx.x * NWAVES + wave; u < NBATCH * NCHUNK * 8; u += G * NWAVES) {
        const int h8 = u & 7, bn = u >> 3, b = bn >> 7, n = bn & 127;
        const size_t tok0 = (size_t)b * SEQ + (size_t)n * 64;
        const bf16_t* P = PROJ + tok0 * NPROJ;
        const int unit = (b * 8 + h8) * NCHUNK + n;
        int r = lane & 15, q = lane >> 4; asm volatile("" : "+v"(r), "+v"(q));
        int vcol;
        LDS_FENCE();
        if (h8 < 4) {
            const int h = h8; vcol = C_GV + h * 128;
            float bc[4][2][8], bl[2][8];
            gla_gates(P, C_Z + h * 64, p.gla_b_gate + h * 64, r, q, bc, bl);
            if (r == 0) {
#pragma unroll
                for (int ks = 0; ks < 2; ++ks) {
                    f32x4 d0, d1;
#pragma unroll
                    for (int e = 0; e < 4; ++e) { d0[e] = __expf(bl[ks][e]); d1[e] = __expf(bl[ks][4 + e]); }
                    *(f32x4*)(DEC + (size_t)unit * 64 + 32 * ks + 8 * q) = d0; *(f32x4*)(DEC + (size_t)unit * 64 + 32 * ks + 8 * q + 4) = d1;
                }
            }
#pragma unroll
            for (int mt = 0; mt < 4; ++mt)
#pragma unroll
                for (int ks = 0; ks < 2; ++ks) {
                    CFENCE();
                    const bf16x8 kf = *(const bf16x8*)(P + (size_t)(16 * mt + r) * NPROJ + C_GK + h * 64 + 32 * ks + 8 * q);
                    f32x4 k0, k1; unpack8(kf, k0, k1);
#pragma unroll
                    for (int e = 0; e < 4; ++e) {
                        Kdt[(32 * ks + 8 * q + e) * VPITCH + 16 * mt + r] = f2bf(k0[e] * __expf(bl[ks][e] - bc[mt][ks][e]));
                        Kdt[(32 * ks + 8 * q + 4 + e) * VPITCH + 16 * mt + r] = f2bf(k1[e] * __expf(bl[ks][4 + e] - bc[mt][ks][4 + e]));
                    }
                }
        } else {
            const int hr = h8 - 4; vcol = C_RV + hr * 128; const float l2g = ret_log2g(hr);
            if (r == 0) {
                const float d = exp2f(64.0f * l2g); const f32x4 dv = {d, d, d, d};
#pragma unroll
                for (int ks = 0; ks < 2; ++ks) { *(f32x4*)(DEC + (size_t)unit * 64 + 32 * ks + 8 * q) = dv; *(f32x4*)(DEC + (size_t)unit * 64 + 32 * ks + 8 * q + 4) = dv; }
            }
#pragma unroll
            for (int mt = 0; mt < 4; ++mt) {
                CFENCE();
                const bf16x8 f0 = *(const bf16x8*)(P + (size_t)(16 * mt + r) * NPROJ + C_RK + hr * 64 + 8 * q);
                const bf16x8 f1 = *(const bf16x8*)(P + (size_t)(16 * mt + r) * NPROJ + C_RK + hr * 64 + 32 + 8 * q);
                f32x4 o[4]; rope_tile(f0, f1, cosT, sinT, n * 64 + 16 * mt + r, q, o);
                const float sc = 0.125f * exp2f((float)(63 - (16 * mt + r)) * l2g);
#pragma unroll
                for (int e = 0; e < 4; ++e) {
                    Kdt[(8 * q + e) * VPITCH + 16 * mt + r] = f2bf(o[0][e] * sc); Kdt[(8 * q + 4 + e) * VPITCH + 16 * mt + r] = f2bf(o[1][e] * sc);
                    Kdt[(32 + 8 * q + e) * VPITCH + 16 * mt + r] = f2bf(o[2][e] * sc); Kdt[(32 + 8 * q + 4 + e) * VPITCH + 16 * mt + r] = f2bf(o[3][e] * sc);
                }
            }
        }
        bf16_t* outp = CT + (size_t)unit * 8192;
#pragma unroll 1
        for (int vh = 0; vh < 2; ++vh) {
            LDS_FENCE();
#pragma unroll
            for (int i = 0; i < 8; ++i) {
                const int token = i * 8 + (lane >> 3), vv = (lane & 7) * 8;
                const bf16x8 x = *(const bf16x8*)(P + (size_t)token * NPROJ + vcol + vh * 64 + vv);
#pragma unroll
                for (int e = 0; e < 8; ++e) Vt[(vv + e) * VPITCH + token] = (bf16_t)x[e];
            }
            LDS_FENCE();
#pragma unroll
            for (int vt = 0; vt < 4; ++vt) {
                CFENCE();
                bf16x8 a[2];
#pragma unroll
                for (int s = 0; s < 2; ++s) a[s] = *(const LAS bf16x8*)(Vt + (16 * vt + r) * VPITCH + 32 * s + 8 * q);
#pragma unroll
                for (int dt = 0; dt < 4; ++dt) {
                    f32x4 acc = {0.f, 0.f, 0.f, 0.f};
#pragma unroll
                    for (int s = 0; s < 2; ++s) { const bf16x8 bb = *(const LAS bf16x8*)(Kdt + (16 * dt + r) * VPITCH + 32 * s + 8 * q); acc = MFMA16(a[s], bb, acc); }
#pragma unroll
                    for (int e = 0; e < 4; ++e) outp[(vh * 64 + 16 * vt + 4 * q + e) * 64 + 16 * dt + r] = f2bf(acc[e]);
                }
            }
        }
    }
}

__device__ __forceinline__ void chunk_scan(const Params& p, int G) {
    unsigned char* ws = p.ws; bf16_t* CT = (bf16_t*)(ws + WS_A2); const float* DEC = (const float*)(ws + WS_DEC);
    const int NGT = G * NTHREADS;
    for (int o = blockIdx.x * NTHREADS + threadIdx.x; o < 32 * 128 * 16; o += NGT) {
        const int d4 = o & 15, v = (o >> 4) & 127, bh = o >> 11;
        bf16_t* base = CT + (size_t)bh * NCHUNK * 8192 + v * 64 + d4 * 4; const float* dbase = DEC + (size_t)bh * NCHUNK * 64 + d4 * 4;
        f32x4 s = {0.f, 0.f, 0.f, 0.f};
#pragma unroll 1
        for (int n0 = 0; n0 < NCHUNK; n0 += 8) {
            u32x2 uu[8]; f32x4 dd[8];
#pragma unroll
            for (int j = 0; j < 8; ++j) { uu[j] = *(const u32x2*)(base + (size_t)(n0 + j) * 8192); dd[j] = *(const f32x4*)(dbase + (size_t)(n0 + j) * 64); }
#pragma unroll
            for (int j = 0; j < 8; ++j) {
                u32x2 w; w.x = cvtpk(s[0], s[1]); w.y = cvtpk(s[2], s[3]);
                *(u32x2*)(base + (size_t)(n0 + j) * 8192) = w;
                f32x4 c; c[0] = __uint_as_float(uu[j].x << 16); c[1] = __uint_as_float(uu[j].x & 0xffff0000u); c[2] = __uint_as_float(uu[j].y << 16); c[3] = __uint_as_float(uu[j].y & 0xffff0000u);
                s = dd[j] * s + c;
            }
        }
    }
}

template <bool GN> __device__ __forceinline__ void norm_gate_store(const f32x4 (&O)[8], const unsigned short (&gt)[8][4], const float (&gn)[8], int it, int r, int q, bf16_t* y) {
    f32x4 mean = {0.f, 0.f, 0.f, 0.f};
    if (GN) {
        f32x4 s = {0.f, 0.f, 0.f, 0.f};
#pragma unroll
        for (int vt = 0; vt < 8; ++vt) s += O[vt];
#pragma unroll
        for (int e = 0; e < 4; ++e) { float t = s[e]; t += __shfl_xor(t, 1); t += __shfl_xor(t, 2); t += __shfl_xor(t, 4); t += __shfl_xor(t, 8); mean[e] = t * (1.0f / 128.0f); }
    }
    f32x4 ss = {0.f, 0.f, 0.f, 0.f};
#pragma unroll
    for (int vt = 0; vt < 8; ++vt) { const f32x4 d = O[vt] - mean; ss += d * d; }
    f32x4 rstd;
#pragma unroll
    for (int e = 0; e < 4; ++e) { float t = ss[e]; t += __shfl_xor(t, 1); t += __shfl_xor(t, 2); t += __shfl_xor(t, 4); t += __shfl_xor(t, 8); rstd[e] = __builtin_amdgcn_rsqf(t * (1.0f / 128.0f) + 1e-6f); }
#pragma unroll
    for (int vt = 0; vt < 8; ++vt) {
        const int v = 16 * vt + r;
#pragma unroll
        for (int e = 0; e < 4; ++e) {
            const int i = 16 * it + 4 * q + e;
            const float g = bf2f(gt[vt][e]);
            const float sil = g * __builtin_amdgcn_rcpf(1.0f + __expf(-g));
            y[(size_t)i * DM + v] = f2bf((O[vt][e] - mean[e]) * rstd[e] * gn[vt] * sil);
        }
    }
}
__device__ __forceinline__ void out_tile(f32x4 (&O)[8], const bf16x8 (&pf)[2], const bf16x8 (&qi)[2], const LAS bf16_t* Vt, const bf16x8 (&spf)[8][2], int r, int q) {
#pragma unroll
    for (int vt = 0; vt < 8; ++vt) {
        f32x4 acc = {0.f, 0.f, 0.f, 0.f};
#pragma unroll
        for (int s = 0; s < 2; ++s) {
            const u32x2 lo = *(const LAS u32x2*)(Vt + (16 * vt + r) * VPITCH + 32 * s + 4 * q), hi = *(const LAS u32x2*)(Vt + (16 * vt + r) * VPITCH + 32 * s + 16 + 4 * q);
            const u32x4 w = {lo.x, lo.y, hi.x, hi.y};
            acc = MFMA16(pf[s], __builtin_bit_cast(bf16x8, w), acc);
        }
#pragma unroll
        for (int ks = 0; ks < 2; ++ks) acc = MFMA16(qi[ks], spf[vt][ks], acc);
        O[vt] = acc;
    }
}
template <bool GN> __device__ __forceinline__ void out_all(const bf16x8 (&pfa)[4][2], const bf16x8 (&QI)[4][2], const LAS bf16_t* Vt, const bf16_t* SP, const float* gain, const bf16_t* gate, bf16_t* y, int r, int q) {
    bf16x8 spf[8][2]; float gn[8];
#pragma unroll
    for (int vt = 0; vt < 8; ++vt) {
        gn[vt] = gain[16 * vt + r];
#pragma unroll
        for (int ks = 0; ks < 2; ++ks) spf[vt][ks] = *(const bf16x8*)(SP + (16 * vt + r) * 64 + 32 * ks + 8 * q);
    }
#pragma unroll
    for (int it = 0; it < 4; ++it) {
        CFENCE();
        unsigned short gt[8][4];
#pragma unroll
        for (int vt = 0; vt < 8; ++vt)
#pragma unroll
            for (int e = 0; e < 4; ++e) gt[vt][e] = gate[(size_t)(16 * it + 4 * q + e) * NPROJ + 16 * vt + r];
        CFENCE();
        f32x4 O[8];
        out_tile(O, pfa[it], QI[it], Vt, spf, r, q);
        CFENCE();
        norm_gate_store<GN>(O, gt, gn, it, r, q, y);
    }
}

__device__ __forceinline__ void chunk_output(const Params& p, LAS unsigned char* lds, int G) {
    const int tid = threadIdx.x, lane = tid & 63, wave = __builtin_amdgcn_readfirstlane(tid >> 6);
    unsigned char* ws = p.ws;
    const bf16_t* PROJ = (const bf16_t*)(ws + WS_BIG); const bf16_t* SPB = (const bf16_t*)(ws + WS_A2); bf16_t* Y = (bf16_t*)(ws + WS_A1);
    const float* cosT = (const float*)(ws + WS_COS); const float* sinT = (const float*)(ws + WS_SIN);
    LAS bf16_t* Vt = (LAS bf16_t*)(lds + wave * WAVE_LDS);
    for (int u = blockIdx.x * NWAVES + wave; u < NBATCH * NCHUNK * 8; u += G * NWAVES) {
        int h8 = u & 7; asm volatile("" : "+s"(h8));
        const int bn = u >> 3, b = bn >> 7, n = bn & 127;
        const size_t tok0 = (size_t)b * SEQ + (size_t)n * 64;
        const bf16_t* P = PROJ + tok0 * NPROJ;
        const int unit = (b * 8 + h8) * NCHUNK + n;
        const bf16_t* SP = SPB + (size_t)unit * 8192;
        int ln = lane; asm volatile("" : "+v"(ln));
        const int r = ln & 15, q = ln >> 4;
        const int vcol = (h8 < 4) ? C_GV + h8 * 128 : C_RV + (h8 - 4) * 128;
        LDS_FENCE();
        {
            bf16x8 xv[16];
#pragma unroll
            for (int i = 0; i < 16; ++i) xv[i] = *(const bf16x8*)(P + (size_t)(i * 4 + q) * NPROJ + vcol + r * 8);
            CFENCE();
#pragma unroll
            for (int i = 0; i < 16; ++i) {
                const int token = i * 4 + q, vv = r * 8;
#pragma unroll
                for (int e = 0; e < 8; ++e) Vt[(vv + e) * VPITCH + token] = (bf16_t)xv[i][e];
            }
        }
        LDS_FENCE();
        CFENCE();
#ifdef NO_GLA4
        if (false) {
#else
        if (h8 < 4) {
#endif
            const int h = h8;
            bf16x8 Qe[4][2], Qi[4][2], Ki[4][2], Ke[4][2], pfa[4][2];
            {
                bf16x8 qf[4][2], kf[4][2];
#pragma unroll
                for (int mt = 0; mt < 4; ++mt)
#pragma unroll
                    for (int ks = 0; ks < 2; ++ks) {
                        qf[mt][ks] = *(const bf16x8*)(P + (size_t)(16 * mt + r) * NPROJ + C_GQ + h * 64 + 32 * ks + 8 * q);
                        kf[mt][ks] = *(const bf16x8*)(P + (size_t)(16 * mt + r) * NPROJ + C_GK + h * 64 + 32 * ks + 8 * q);
                    }
                float bc[4][2][8], bl[2][8];
                gla_gates(P, C_Z + h * 64, p.gla_b_gate + h * 64, r, q, bc, bl);
#pragma unroll
                for (int mt = 0; mt < 4; ++mt)
#pragma unroll
                    for (int ks = 0; ks < 2; ++ks) {
                        CFENCE();
                        f32x4 q0, q1, k0, k1; unpack8(qf[mt][ks], q0, q1); unpack8(kf[mt][ks], k0, k1);
                        f32x4 e0, e1, i0, i1;
#pragma unroll
                        for (int e = 0; e < 4; ++e) { e0[e] = __expf(bc[mt][ks][e]); e1[e] = __expf(bc[mt][ks][4 + e]); i0[e] = __expf(-bc[mt][ks][e]); i1[e] = __expf(-bc[mt][ks][4 + e]); }
                        Qe[mt][ks] = pack8(q0 * e0 * 0.125f, q1 * e1 * 0.125f); Qi[mt][ks] = pack8(q0 * i0 * 0.125f, q1 * i1 * 0.125f);
                        Ki[mt][ks] = pack8(k0 * i0, k1 * i1); Ke[mt][ks] = pack8(k0 * e0, k1 * e1);
                    }
            }
#pragma unroll
            for (int it = 0; it < 4; ++it) {
                f32x4 Pt[4];
#pragma unroll
                for (int jt = 0; jt < 4; ++jt) {
                    f32x4 lo = {0.f, 0.f, 0.f, 0.f}, up = {0.f, 0.f, 0.f, 0.f};
                    if (jt <= it) { lo = MFMA16(Ki[jt][0], Qe[it][0], lo); lo = MFMA16(Ki[jt][1], Qe[it][1], lo); }
                    if (jt >= it) { up = MFMA16(Ke[jt][0], Qi[it][0], up); up = MFMA16(Ke[jt][1], Qi[it][1], up); }
                    if (jt < it) Pt[jt] = lo; else if (jt > it) Pt[jt] = up;
                    else {
#pragma unroll
                        for (int e = 0; e < 4; ++e) Pt[jt][e] = (4 * q + e <= r) ? lo[e] : up[e];
                    }
                }
                pfa[it][0] = pack8(Pt[0], Pt[1]); pfa[it][1] = pack8(Pt[2], Pt[3]);
                CFENCE();
            }
            out_all<false>(pfa, Qe, Vt, SP, p.gla_norm_g + h * 128, P + C_GG + h * 128, Y + tok0 * DM + h * 128, r, q);
        }
#ifdef NO_RET4
        else if (false) {
#else
        else {
#endif
            const int hr = h8 - 4; const float l2g = ret_log2g(hr);
            bf16x8 Qr[4][2], Qd[4][2], Kr[4][2], pfa[4][2];
            {
                bf16x8 qf[4][2], kf[4][2];
#pragma unroll
                for (int mt = 0; mt < 4; ++mt)
#pragma unroll
                    for (int ks = 0; ks < 2; ++ks) {
                        qf[mt][ks] = *(const bf16x8*)(P + (size_t)(16 * mt + r) * NPROJ + C_RQ + hr * 64 + 32 * ks + 8 * q);
                        kf[mt][ks] = *(const bf16x8*)(P + (size_t)(16 * mt + r) * NPROJ + C_RK + hr * 64 + 32 * ks + 8 * q);
                    }
#pragma unroll
                for (int mt = 0; mt < 4; ++mt) {
                    const int pos = n * 64 + 16 * mt + r;
                    CFENCE();
                    {
                        f32x4 o[4]; rope_tile(qf[mt][0], qf[mt][1], cosT, sinT, pos, q, o);
                        Qr[mt][0] = pack8(o[0], o[1]); Qr[mt][1] = pack8(o[2], o[3]);
                        const float qd = exp2f((float)(16 * mt + r + 1) * l2g);
                        Qd[mt][0] = pack8(o[0] * qd, o[1] * qd); Qd[mt][1] = pack8(o[2] * qd, o[3] * qd);
                    }
                    CFENCE();
                    {
                        f32x4 o[4]; rope_tile(kf[mt][0], kf[mt][1], cosT, sinT, pos, q, o);
                        Kr[mt][0] = pack8(o[0] * 0.125f, o[1] * 0.125f); Kr[mt][1] = pack8(o[2] * 0.125f, o[3] * 0.125f);
                    }
                }
            }
#pragma unroll
            for (int it = 0; it < 4; ++it) {
                f32x4 Pt[4];
#pragma unroll
                for (int jt = 0; jt < 4; ++jt) {
                    f32x4 st = {0.f, 0.f, 0.f, 0.f};
                    st = MFMA16(Kr[jt][0], Qr[it][0], st); st = MFMA16(Kr[jt][1], Qr[it][1], st);
#pragma unroll
                    for (int e = 0; e < 4; ++e) { const int dj = (16 * it + r) - (16 * jt + 4 * q + e); Pt[jt][e] = st[e] * exp2f((float)(dj < 0 ? -dj : dj) * l2g); }
                }
                pfa[it][0] = pack8(Pt[0], Pt[1]); pfa[it][1] = pack8(Pt[2], Pt[3]);
                CFENCE();
            }
            out_all<true>(pfa, Qd, Vt, SP, p.ret_norm_g + hr * 128, P + C_RG + hr * 128, Y + tok0 * DM + 512 + hr * 128, r, q);
        }
    }
}

__device__ __forceinline__ void stage_image(LAS unsigned char* lds, const bf16_t* src, int tid) {
#pragma unroll
    for (int i = 0; i < 16; ++i) { const int row = (tid >> 5) + 16 * i, c = tid & 31; const u32x4 x = *(const u32x4*)(src + (size_t)row * 256 + c * 8); *(LAS u32x4*)(lds + row * APITCH + c * 16) = x; }
}
__device__ __forceinline__ void cross_attention(const Params& p, LAS unsigned char* lds, int G) {
    const int tid = threadIdx.x, lane = tid & 63, wave = __builtin_amdgcn_readfirstlane(tid >> 6);
    unsigned char* ws = p.ws;
    const bf16_t* Q = (const bf16_t*)(ws + WS_A1); const bf16_t* Kb = (const bf16_t*)(ws + WS_KB); const bf16_t* Vtg = (const bf16_t*)(ws + WS_VT); bf16_t* OA = (bf16_t*)(ws + WS_BIG);
    for (int u = blockIdx.x; u < 512; u += G) {
        const int bh = u >> 5, b = bh >> 2, h = bh & 3, qb = u & 31;
        int r = lane & 15, q = lane >> 4; asm volatile("" : "+v"(r), "+v"(q));
        __syncthreads();
        {
#pragma unroll
            for (int i = 0; i < 16; ++i) { const int row = (tid >> 5) + 16 * i, c = tid & 31; const u32x4 x = *(const u32x4*)(Kb + (size_t)(b * 256 + row) * 1024 + h * 256 + c * 8); *(LAS u32x4*)(lds + row * APITCH + c * 16) = x; }
        }
        __syncthreads();
        bf16x8 pf[2][8];
#pragma unroll
        for (int it = 0; it < 2; ++it) {
            const size_t i0 = (size_t)b * SEQ + qb * 256 + wave * 32 + 16 * it;
            bf16x8 Qf[8];
#pragma unroll
            for (int ks = 0; ks < 8; ++ks) Qf[ks] = *(const bf16x8*)(Q + (i0 + r) * DM + h * 256 + 32 * ks + 8 * q);
            f32x4 S[16];
#pragma unroll
            for (int mt = 0; mt < 16; ++mt) {
                f32x4 acc = {0.f, 0.f, 0.f, 0.f};
                CFENCE();
#pragma unroll
                for (int ks = 0; ks < 8; ++ks) { const bf16x8 a = *(const LAS bf16x8*)(lds + (16 * mt + r) * APITCH + (32 * ks + 8 * q) * 2); acc = MFMA16(a, Qf[ks], acc); }
                S[mt] = acc;
            }
            CFENCE();
            float mx = -3.0e38f;
#pragma unroll
            for (int mt = 0; mt < 16; ++mt) mx = fmaxf(fmaxf(fmaxf(S[mt][0], S[mt][1]), fmaxf(S[mt][2], S[mt][3])), mx);
            mx = fmaxf(mx, __shfl_xor(mx, 16)); mx = fmaxf(mx, __shfl_xor(mx, 32));
            CFENCE();
            float sum = 0.f;
#pragma unroll
            for (int mt = 0; mt < 16; ++mt) {
#pragma unroll
                for (int e = 0; e < 4; ++e) { S[mt][e] = __builtin_amdgcn_exp2f(S[mt][e] - mx); sum += S[mt][e]; }
                CFENCE();
            }
            sum += __shfl_xor(sum, 16); sum += __shfl_xor(sum, 32);
            const float inv = 1.0f / sum;
            CFENCE();
#pragma unroll
            for (int s = 0; s < 8; ++s) { pf[it][s] = pack8(S[2 * s] * inv, S[2 * s + 1] * inv); CFENCE(); }
        }
        __syncthreads();
        stage_image(lds, Vtg + (size_t)(b * 1024 + h * 256) * 256, tid);
        __syncthreads();
#pragma unroll
        for (int it = 0; it < 2; ++it) {
            const size_t i0 = (size_t)b * SEQ + qb * 256 + wave * 32 + 16 * it;
#pragma unroll
            for (int nt = 0; nt < 16; ++nt) {
                f32x4 acc = {0.f, 0.f, 0.f, 0.f};
                CFENCE();
#pragma unroll
                for (int s = 0; s < 8; ++s) {
                    const u32x2 lo = *(const LAS u32x2*)(lds + (16 * nt + r) * APITCH + (32 * s + 4 * q) * 2), hi = *(const LAS u32x2*)(lds + (16 * nt + r) * APITCH + (32 * s + 16 + 4 * q) * 2);
                    const u32x4 w = {lo.x, lo.y, hi.x, hi.y};
                    acc = MFMA16(pf[it][s], __builtin_bit_cast(bf16x8, w), acc);
                }
#pragma unroll
                for (int e = 0; e < 4; ++e) OA[(i0 + 4 * q + e) * DM + h * 256 + 16 * nt + r] = f2bf(acc[e]);
            }
        }
    }
}

__device__ __forceinline__ void final_norm(const Params& p, int G) {
    const int lane = threadIdx.x & 63, wave = __builtin_amdgcn_readfirstlane(threadIdx.x >> 6);
    const bf16_t* H = (const bf16_t*)(p.ws + WS_A2); const float* SSQ = (const float*)(p.ws + WS_SSQ3);
    const f32x4 g0 = *(const f32x4*)(p.final_norm_g + lane * 8), g1 = *(const f32x4*)(p.final_norm_g + lane * 8 + 4), g2 = *(const f32x4*)(p.final_norm_g + 512 + lane * 8), g3 = *(const f32x4*)(p.final_norm_g + 512 + lane * 8 + 4);
    for (int m = blockIdx.x * NWAVES + wave; m < NTOK; m += G * NWAVES) {
        const bf16x8 h0 = *(const bf16x8*)(H + (size_t)m * DM + lane * 8), h1 = *(const bf16x8*)(H + (size_t)m * DM + 512 + lane * 8);
        const f32x4 s0 = *(const f32x4*)(SSQ + (size_t)m * 16), s1 = *(const f32x4*)(SSQ + (size_t)m * 16 + 4), s2 = *(const f32x4*)(SSQ + (size_t)m * 16 + 8), s3 = *(const f32x4*)(SSQ + (size_t)m * 16 + 12);
        const f32x4 st = (s0 + s1) + (s2 + s3);
        const float rstd = 1.0f / sqrtf(((st[0] + st[1]) + (st[2] + st[3])) * (1.0f / 1024.0f) + 1e-6f);
        f32x4 a0, a1, b0, b1; unpack8(h0, a0, a1); unpack8(h1, b0, b1);
        float* o = p.out + (size_t)m * DM + lane * 8;
        *(f32x4*)(o) = a0 * rstd * g0; *(f32x4*)(o + 4) = a1 * rstd * g1; *(f32x4*)(o + 512) = b0 * rstd * g2; *(f32x4*)(o + 516) = b1 * rstd * g3;
    }
}

constexpr int NPHASE = 12;
__global__ void __launch_bounds__(NTHREADS, 2) fwd_megakernel(Params p) {
    extern __shared__ __attribute__((aligned(16))) unsigned char lds_raw[];
    LAS unsigned char* lds = (LAS unsigned char*)lds_raw;
    cg::grid_group grid = cg::this_grid();
    const int G = gridDim.x, lo = p.ph_lo, hi = p.ph_hi;
    unsigned char* ws = p.ws;
#define IN(k) (lo <= (k) && (k) < hi)
#define SEAM(k) do { if (IN(k) && IN((k) + 1)) { if ((k) == 0) { asm volatile("s_waitcnt vmcnt(0) lgkmcnt(0)" ::: "memory"); grid.sync(); __builtin_amdgcn_fence(__ATOMIC_ACQUIRE, "agent"); asm volatile("s_waitcnt vmcnt(0)" ::: "memory"); } \
    else xcd_barrier(bar); } } while (0)
    LAS unsigned* misc = (LAS unsigned*)(lds + MISC_OFF);
    if (threadIdx.x < 16) misc[threadIdx.x] = 0u;
    __syncthreads();
    XcdBarrier bar; bar.bar = (unsigned*)(ws + WS_CTL); bar.x = 0; bar.st = nullptr;
    if (hi - lo > 1) bar = xcd_barrier_post((unsigned*)(ws + WS_CTL), (volatile LAS unsigned*)misc);
#ifndef NO_P0
    if (IN(0)) { p0_prologue(p, lds, G); }
#endif
#if defined(DBG_REP) && DBG_REP == 0
    __syncthreads(); if (IN(0)) { p0_prologue(p, lds, G); }
#endif
    SEAM(0);
    if (IN(1)) {
        {
            pg8::Gemm g{(const bf16_t*)(ws + WS_A1), (const bf16_t*)(ws + WS_WIN), NTOK, NPROJ, DM}; pg8::StaticOrder S; S.init(NTOK, NPROJ, G, (int)blockIdx.x);
            pg8::EpiBf16<0> E{(bf16_t*)(ws + WS_BIG), NPROJ, nullptr, 0, 0, 1.f};
            pg8::gemm_phase<pg8::EpiBf16<0>, pg8::StaticOrder, true, true>(lds, g, S, E);
        }
        __syncthreads();
        {
            pg8::Gemm g{(const bf16_t*)(ws + WS_MEMN), (const bf16_t*)(ws + WS_WKV), NMEMROWS, 2048, DM}; pg8::StaticOrder S; S.init(NMEMROWS, 2048, G, (int)((blockIdx.x + G / 2) % G));
            pg8::EpiKV E{(bf16_t*)(ws + WS_KB), (bf16_t*)(ws + WS_VT)};
            pg8::gemm_phase<pg8::EpiKV, pg8::StaticOrder, true, true>(lds, g, S, E);
        }
        __syncthreads();
    } SEAM(1);
    #ifndef NO_P2
    if (IN(2)) { chunk_contrib(p, lds, G); }
#endif
#if defined(DBG_REP) && DBG_REP == 2
    __syncthreads(); if (IN(2)) { chunk_contrib(p, lds, G); }
#endif
    SEAM(2);
    if (IN(3)) { chunk_scan(p, G); } SEAM(3);
    #ifndef NO_P4
    if (IN(4)) { chunk_output(p, lds, G); }
#endif
#if defined(DBG_REP) && DBG_REP == 4
    __syncthreads(); if (IN(4)) { chunk_output(p, lds, G); }
#endif
    SEAM(4);
    if (IN(5)) {
        pg8::Gemm g{(const bf16_t*)(ws + WS_A1), (const bf16_t*)(ws + WS_WOUT), NTOK, DM, DM}; pg8::StaticOrder S; S.init(NTOK, DM, G, (int)blockIdx.x);
        pg8::EpiRes<false> E{p.x, (bf16_t*)(ws + WS_A2), (float*)(ws + WS_SSQ1)};
        pg8::gemm_phase<pg8::EpiRes<false>, pg8::StaticOrder, true, true>(lds, g, S, E);
        __syncthreads();
    } SEAM(5);
    if (IN(6)) {
        pg8::Gemm g{(const bf16_t*)(ws + WS_A2), (const bf16_t*)(ws + WS_WQ), NTOK, DM, DM}; pg8::StaticOrder S; S.init(NTOK, DM, G, (int)blockIdx.x);
        pg8::EpiScale<0> E{(bf16_t*)(ws + WS_A1), DM, (const float*)(ws + WS_SSQ1), 0.0625f * 1.4426950408889634f};
        pg8::gemm_phase<pg8::EpiScale<0>, pg8::StaticOrder, true, true>(lds, g, S, E);
        __syncthreads();
    } SEAM(6);
#ifndef NO_P7
    if (IN(7)) { cross_attention(p, lds, G); __syncthreads(); }
#endif
#if defined(DBG_REP) && DBG_REP == 7
    if (IN(7)) { cross_attention(p, lds, G); __syncthreads(); }
#endif
    SEAM(7);
    if (IN(8)) {
        pg8::Gemm g{(const bf16_t*)(ws + WS_BIG), (const bf16_t*)(ws + WS_WO), NTOK, DM, DM}; pg8::StaticOrder S; S.init(NTOK, DM, G, (int)blockIdx.x);
        pg8::EpiRes<true> E{(const void*)(ws + WS_A2), (bf16_t*)(ws + WS_A1), (float*)(ws + WS_SSQ2)};
        pg8::gemm_phase<pg8::EpiRes<true>, pg8::StaticOrder, true, true>(lds, g, S, E);
        __syncthreads();
    } SEAM(8);
    if (IN(9)) {
        pg8::Gemm g{(const bf16_t*)(ws + WS_A1), (const bf16_t*)(ws + WS_W1), NTOK, DFF, DM}; pg8::StaticOrder S; S.init(NTOK, DFF, G, (int)blockIdx.x);
        pg8::EpiScale<1> E{(bf16_t*)(ws + WS_BIG), DFF, (const float*)(ws + WS_SSQ2), 1.0f};
        pg8::gemm_phase<pg8::EpiScale<1>, pg8::StaticOrder, true, true>(lds, g, S, E);
        __syncthreads();
    } SEAM(9);
    if (IN(10)) {
        pg8::Gemm g{(const bf16_t*)(ws + WS_BIG), (const bf16_t*)(ws + WS_W2), NTOK, DM, DFF}; pg8::StaticOrder S; S.init(NTOK, DM, G, (int)blockIdx.x);
        pg8::EpiRes<true> E{(const void*)(ws + WS_A1), (bf16_t*)(ws + WS_A2), (float*)(ws + WS_SSQ3)};
        pg8::gemm_phase<pg8::EpiRes<true>, pg8::StaticOrder, true, true>(lds, g, S, E);
        __syncthreads();
    } SEAM(10);
    if (IN(11)) { final_norm(p, G); }
#undef IN
#undef SEAM
}

#ifndef MK_PER_PHASE
#define MK_PER_PHASE 0
#endif
#ifdef DBG_DUMP_OFF
__global__ void dump_kernel(const bf16_t* src, size_t n, float* out) {
    for (size_t i = (size_t)blockIdx.x * blockDim.x + threadIdx.x; i < (size_t)NTOK * DM; i += (size_t)gridDim.x * blockDim.x) {
        float s = 0.f; for (size_t j = i; j < n; j += (size_t)NTOK * DM) s += bf2f(src[j]); out[i] = s; }
}
#endif
extern "C" void kernel_launch(void* const* d_in, const int* in_sizes, int n_in, void* d_out, int out_size, void* d_ws, size_t ws_size, hipStream_t stream) {
    static int grid = 0;
    if (grid == 0) {
        if (n_in != 18 || ws_size < WS_NEED) { fprintf(stderr, "kernel_launch: expected 18 inputs and >= %zu bytes of workspace (got %d, %zu)\n", (size_t)WS_NEED, n_in, ws_size); grid = -1; return; }
        int dev = 0, cus = 0, per_cu = 0;
        (void)hipGetDevice(&dev); (void)hipDeviceGetAttribute(&cus, hipDeviceAttributeMultiprocessorCount, dev);
        if (hipFuncSetAttribute((const void*)fwd_megakernel, hipFuncAttributeMaxDynamicSharedMemorySize, LDS_BYTES) != hipSuccess) { fprintf(stderr, "kernel_launch: hipFuncSetAttribute failed\n"); grid = -1; return; }
        if (hipOccupancyMaxActiveBlocksPerMultiprocessor(&per_cu, (const void*)fwd_megakernel, NTHREADS, LDS_BYTES) != hipSuccess || per_cu < 1) { fprintf(stderr, "kernel_launch: occupancy query failed (%d)\n", per_cu); (void)hipGetLastError(); grid = -1; return; }
        grid = cus * per_cu;
    }
    if (grid < 0) return;
    Params p{};
    const float** pp = (const float**)&p;
    for (int i = 0; i < 18; ++i) pp[i] = (const float*)d_in[i];
    p.out = (float*)d_out; p.ws = (unsigned char*)d_ws;
#if MK_PER_PHASE
#ifndef DBG_HI
#define DBG_HI NPHASE
#endif
    for (int k = 0; k < DBG_HI; ++k) { p.ph_lo = k; p.ph_hi = k + 1; hipLaunchKernelGGL(fwd_megakernel, dim3(grid), dim3(NTHREADS), LDS_BYTES, stream, p); }
#ifdef DBG_DUMP_OFF
    hipLaunchKernelGGL(dump_kernel, dim3(2048), dim3(256), 0, stream, (const bf16_t*)((unsigned char*)d_ws + (size_t)(DBG_DUMP_OFF) * MiB), (size_t)(DBG_DUMP_N), (float*)d_out);
#endif
#else
    p.ph_lo = 0; p.ph_hi = NPHASE;
    if (hipMemsetAsync((char*)d_ws + WS_CTL, 0, 16384, stream) != hipSuccess) { fprintf(stderr, "kernel_launch: hipMemsetAsync failed\n"); return; }
    void* args[] = {&p};
    const hipError_t e = hipLaunchCooperativeKernel((const void*)fwd_megakernel, dim3(grid), dim3(NTHREADS), args, LDS_BYTES, stream);
    if (e != hipSuccess) fprintf(stderr, "kernel_launch: cooperative launch failed: %s (grid %d)\n", hipGetErrorString(e), grid);
#endif
}
```

```cpp
#include <hip/hip_runtime.h>
#include <hip/hip_cooperative_groups.h>
#include <cstdio>
#include <cstdint>
namespace cg = cooperative_groups;
namespace pg8 {
#define PG8_LAS __attribute__((address_space(3)))
typedef unsigned short bf16_t;
typedef short bf16x8 __attribute__((ext_vector_type(8)));
typedef float f32x4 __attribute__((ext_vector_type(4)));
typedef unsigned u32x4 __attribute__((ext_vector_type(4)));
constexpr int BM = 256, BK = 64, HALF = 128, HTB = HALF * BK * 2  , STAGE_BYTES = 8 * HTB, NXCD = 8, WGM = 8;

__host__ __device__ __forceinline__ int lds_byte(int r, int c) { const int st = (r >> 4) * 2 + (c >> 5), rr = r & 15, cc = c & 31, ob = rr * 64 + cc * 2; return st * 1024 + (ob ^ (((ob >> 9) & 1) << 5)); }
__host__ __device__ __forceinline__ void stage_rc(int b, int& R, int& C) { const int st = b / 1024, sb = b % 1024, swz = sb ^ (((sb >> 9) & 1) << 5); R = (st >> 1) * 16 + swz / 64; C = (st & 1) * 32 + (swz % 64) / 2; }
__host__ __device__ __forceinline__ int perm32(int rho) { const int n = rho >> 4, i = rho & 15; return 8 * (i >> 2) + 4 * n + (i & 3); }

struct Unit { int pm, pn; };
struct Gemm { const bf16_t* A; const bf16_t* Bt; int M, N, K; };

struct StaticOrder {
    int nM, nN, nwg, G, c;
    __host__ __device__ void init(int M, int N, int G_, int c_) { nM = M / BM; nN = N / BM; nwg = nM * nN; G = G_; c = c_; }
    __host__ __device__ bool next(int i, Unit& u) const {
        const long L = (long)i * G + c; if (L >= nwg) return false;
        int wgid = (int)L; { const int q = nwg / NXCD, r = nwg % NXCD, xcd = wgid % NXCD, off = wgid / NXCD; wgid = (xcd < r ? xcd * (q + 1) : r * (q + 1) + (xcd - r) * q) + off; }
        const int nig = WGM * nN, gid = wgid / nig, fm = gid * WGM, gsz = (nM - fm) < WGM ? (nM - fm) : WGM;
        u.pm = fm + ((wgid % nig) % gsz); u.pn = (wgid % nig) / gsz; return true;
    }
    __device__ __forceinline__ void a_ready(const Unit&) const {}
    __device__ __forceinline__ void done(const Unit&) const {}
};

__device__ __forceinline__ unsigned cvt_pk_bf16(float lo, float hi) { unsigned r; asm volatile("v_cvt_pk_bf16_f32 %0, %1, %2" : "=v"(r) : "v"(lo), "v"(hi)); return r; }
typedef float f32x2 __attribute__((ext_vector_type(2)));
__device__ __forceinline__ f32x2 gelu_pk(f32x2 v) {
    const f32x2 av = __builtin_elementwise_abs(v), d = av * 0.2316418882f + 1.0f;
    f32x2 t; t.x = __builtin_amdgcn_rcpf(d.x); t.y = __builtin_amdgcn_rcpf(d.y);
    f32x2 q = t * 0.5307027145f + (-0.7265760135f); q = q * t + 0.7107068705f; q = q * t + (-0.142248368f); q = q * t + 0.127414796f; q = q * t;
    const f32x2 s = (v * v) * (-0.72134752044f);
    f32x2 e; e.x = __builtin_amdgcn_exp2f(s.x); e.y = __builtin_amdgcn_exp2f(s.y);
    const f32x2 m = v * (q * e), r = v - m;
    f32x2 o; o.x = v.x < 0.f ? m.x : r.x; o.y = v.y < 0.f ? m.y : r.y; return o;
}

template <int ACT  > struct EpiBf16 {
    static constexpr bool PERM = true, AFTER_DRAIN = false; static_assert(ACT == 0 || ACT == 1, "EpiBf16: ACT is 0 (none) or 1 (gelu_pk)");
    bf16_t* O; int ldc; const float* bias; int split_cols; size_t split_stride; float scale0;
    __device__ __forceinline__ void operator()(const f32x4 (&acc)[2][2][4][2], const Unit& u, int wr, int wc, int fr, int fq) const {
        const int row0 = u.pm * BM + wr * 64 + fr; int colt = u.pn * BM; bf16_t* base = O;
        float sc = 1.f; if (split_cols) { const int t = colt / split_cols; base += (size_t)t * split_stride; colt -= t * split_cols; if (t == 0) sc = scale0; }
        const int col0 = colt + wc * 32 + 8 * fq, bcol0 = u.pn * BM + wc * 32 + 8 * fq;
        f32x4 bv[2][2];
#pragma unroll
        for (int bj = 0; bj < 2; ++bj)
#pragma unroll
            for (int n = 0; n < 2; ++n) bv[bj][n] = bias ? *(const f32x4*)(bias + bcol0 + bj * HALF + 4 * n) : (f32x4){0.f, 0.f, 0.f, 0.f};
#pragma unroll
        for (int ai = 0; ai < 2; ++ai)
#pragma unroll
            for (int m = 0; m < 4; ++m) { bf16_t* rowp = base + (size_t)(row0 + ai * HALF + m * 16) * ldc + col0;
#pragma unroll
                for (int bj = 0; bj < 2; ++bj) { f32x4 v0 = acc[ai][bj][m][0] + bv[bj][0], v1 = acc[ai][bj][m][1] + bv[bj][1];
                    if (ACT == 1) { f32x2 a = gelu_pk((f32x2){v0[0], v0[1]}), b = gelu_pk((f32x2){v0[2], v0[3]}), c = gelu_pk((f32x2){v1[0], v1[1]}), d = gelu_pk((f32x2){v1[2], v1[3]});
                        v0 = (f32x4){a.x, a.y, b.x, b.y}; v1 = (f32x4){c.x, c.y, d.x, d.y}; }
                    v0 = v0 * sc; v1 = v1 * sc; u32x4 w; w.x = cvt_pk_bf16(v0[0], v0[1]); w.y = cvt_pk_bf16(v0[2], v0[3]); w.z = cvt_pk_bf16(v1[0], v1[1]); w.w = cvt_pk_bf16(v1[2], v1[3]);
                    *(u32x4*)(rowp + bj * HALF) = w; } }
    }
};

struct PanelStats {
    unsigned* xbuf;
    unsigned* cnt;
    unsigned* tmo;
    int ntn; float eps;
    unsigned code;
    __device__ __forceinline__ bool run(const f32x4 (&v)[2][2][4][2], const Unit& u, int wr, int wc, int fr, int fq, PG8_LAS unsigned char* lds, int wid, int lane) const {
        typedef float f32x2v __attribute__((ext_vector_type(2)));
        PG8_LAS f32x2v* P = (PG8_LAS f32x2v*)lds;
        PG8_LAS f32x2v* S = (PG8_LAS f32x2v*)(lds + 8192);
        PG8_LAS unsigned* flag = (PG8_LAS unsigned*)(lds + 8192 + 2048);
#pragma unroll
        for (int ai = 0; ai < 2; ++ai)
#pragma unroll
            for (int m = 0; m < 4; ++m) {
                float s = 0.f;
#pragma unroll
                for (int bj = 0; bj < 2; ++bj)
#pragma unroll
                    for (int n = 0; n < 2; ++n) { const f32x4 x = v[ai][bj][m][n]; s += (x[0] + x[1]) + (x[2] + x[3]); }
                s += __shfl_xor(s, 16); s += __shfl_xor(s, 32);
                const float mw = s * (1.0f / 64.0f); float q = 0.f;
#pragma unroll
                for (int bj = 0; bj < 2; ++bj)
#pragma unroll
                    for (int n = 0; n < 2; ++n) { const f32x4 d = v[ai][bj][m][n] - mw; q += (d[0] * d[0] + d[1] * d[1]) + (d[2] * d[2] + d[3] * d[3]); }
                q += __shfl_xor(q, 16); q += __shfl_xor(q, 32);
                if (fq == 0) P[(ai * HALF + wr * 64 + m * 16 + fr) * 4 + wc] = (f32x2v){mw, q};
            }
        asm volatile("s_waitcnt lgkmcnt(0)" ::: "memory"); __builtin_amdgcn_s_barrier(); asm volatile("" ::: "memory");
#if defined(BROKEN_EXCHANGE_NO_WAIT)
#warning BROKEN CONTROL BUILD: the row-statistics exchange does not wait; results are wrong by design
        if (blockIdx.x >= 64) { const long long t0_ = clock64(); while (clock64() - t0_ < 60000) __builtin_amdgcn_s_sleep(8); }
#endif
        const int row = wid * 32 + (lane & 31);
        if (lane < 32) {
            const f32x2v a = P[row * 4 + 0], b = P[row * 4 + 1], c = P[row * 4 + 2], d = P[row * 4 + 3];
            const float mt = (a.x + b.x + c.x + d.x) * 0.25f;
            const float da = a.x - mt, db = b.x - mt, dc = c.x - mt, dd = d.x - mt;
            const float m2 = (a.y + b.y) + (c.y + d.y) + 64.0f * ((da * da + db * db) + (dc * dc + dd * dd));
            unsigned long long* slot = (unsigned long long*)xbuf + ((size_t)(u.pm * BM + row) * 4 + u.pn);
            __hip_atomic_store(slot, ((unsigned long long)__float_as_uint(m2) << 32) | __float_as_uint(mt), __ATOMIC_RELAXED, __HIP_MEMORY_SCOPE_AGENT);
        }
        asm volatile("s_waitcnt vmcnt(0)" ::: "memory");
        if (lane == 0) __hip_atomic_fetch_add(cnt + 64 * u.pm, 1u, __ATOMIC_RELAXED, __HIP_MEMORY_SCOPE_AGENT);
        if (wid == 0) {
            bool dead = false; const unsigned long long t0 = __builtin_amdgcn_s_memrealtime(); const unsigned want = 8u * (unsigned)ntn;
            for (;;) {
#if defined(BROKEN_EXCHANGE_NO_WAIT)
                break;
#endif
                if ((unsigned)__builtin_amdgcn_readfirstlane(__hip_atomic_load(cnt + 64 * u.pm, __ATOMIC_RELAXED, __HIP_MEMORY_SCOPE_AGENT)) >= want) break;
                if (__builtin_amdgcn_s_memrealtime() - t0 > 2000000ull) {
                    if (lane == 0) { unsigned expect = 0u; __hip_atomic_compare_exchange_strong(tmo + 1, &expect, code | (unsigned)(u.pm & 0xff), __ATOMIC_RELAXED, __ATOMIC_RELAXED, __HIP_MEMORY_SCOPE_AGENT);
                                     __hip_atomic_store(tmo, 1u, __ATOMIC_RELAXED, __HIP_MEMORY_SCOPE_AGENT); }
                    dead = true; break; }
                __builtin_amdgcn_s_sleep(2);
            }
            __builtin_amdgcn_fence(__ATOMIC_ACQUIRE, "agent");
            if (lane == 0) flag[0] = dead ? 1u : 0u;
        }
        asm volatile("s_waitcnt vmcnt(0) lgkmcnt(0)" ::: "memory"); __builtin_amdgcn_s_barrier(); asm volatile("" ::: "memory");
        const bool bad = flag[0] != 0u;
        if (lane < 32) {
            const unsigned long long* slot = (const unsigned long long*)xbuf + (size_t)(u.pm * BM + row) * 4; float mt[4], m2[4]; float ms = 0.f;
#pragma unroll
            for (int t = 0; t < 4; ++t) { if (t < ntn) { const unsigned long long w = __hip_atomic_load(slot + t, __ATOMIC_RELAXED, __HIP_MEMORY_SCOPE_AGENT); mt[t] = __uint_as_float((unsigned)w); m2[t] = __uint_as_float((unsigned)(w >> 32)); } else { mt[t] = 0.f; m2[t] = 0.f; } ms += mt[t]; }
            const float mean = ms / (float)ntn; float q = 0.f;
#pragma unroll
            for (int t = 0; t < 4; ++t) if (t < ntn) { const float dm = mt[t] - mean; q += m2[t] + 256.0f * dm * dm; }
            S[row] = (f32x2v){mean, 1.0f / sqrtf(q / (256.0f * (float)ntn) + eps)};
        }
        asm volatile("s_waitcnt lgkmcnt(0)" ::: "memory"); __builtin_amdgcn_s_barrier(); asm volatile("" ::: "memory");
        return bad;
    }
};
struct EpiLnRes {
    static constexpr bool PERM = false, AFTER_DRAIN = true;
    const float* base; float* out; int ldc; const float* bias; PanelStats st; unsigned poison;
    __device__ __forceinline__ void fused(f32x4 (&acc)[2][2][4][2], const Unit& u, int wr, int wc, int fr, int fq, PG8_LAS unsigned char* lds, int wid, int lane) const {
        typedef float f32x2v __attribute__((ext_vector_type(2)));
        const PG8_LAS f32x2v* S = (const PG8_LAS f32x2v*)(lds + 8192);
        const int col0 = u.pn * BM + wc * 32 + 4 * fq;
#pragma unroll
        for (int bj = 0; bj < 2; ++bj)
#pragma unroll
            for (int n = 0; n < 2; ++n) { const f32x4 bv = bias ? *(const f32x4*)(bias + col0 + bj * HALF + n * 16) : (f32x4){0.f, 0.f, 0.f, 0.f};
#pragma unroll
                for (int ai = 0; ai < 2; ++ai)
#pragma unroll
                    for (int m = 0; m < 4; ++m) acc[ai][bj][m][n] += bv; }
        f32x4 pre[4][2][2];
#pragma unroll
        for (int m = 0; m < 4; ++m) { const size_t off = (size_t)(u.pm * BM + wr * 64 + m * 16 + fr) * ldc + col0;
#pragma unroll
            for (int bj = 0; bj < 2; ++bj)
#pragma unroll
                for (int n = 0; n < 2; ++n) pre[m][bj][n] = *(const f32x4*)(base + off + bj * HALF + n * 16); }
        const bool bad = st.run(acc, u, wr, wc, fr, fq, lds, wid, lane) || poison != 0u;
        const float qnan = __builtin_nanf("");
#pragma unroll
        for (int ai = 0; ai < 2; ++ai)
#pragma unroll
            for (int m = 0; m < 4; ++m) { const int r = ai * HALF + wr * 64 + m * 16 + fr; const f32x2v sr = S[r]; const size_t off = (size_t)(u.pm * BM + r) * ldc + col0;
#pragma unroll
                for (int bj = 0; bj < 2; ++bj)
#pragma unroll
                    for (int n = 0; n < 2; ++n) { const f32x4 bs = ai == 0 ? pre[m][bj][n] : *(const f32x4*)(base + off + bj * HALF + n * 16); f32x4 o = bs + (acc[ai][bj][m][n] - sr.x) * sr.y;
                        if (bad) o = (f32x4){qnan, qnan, qnan, qnan}; *(f32x4*)(out + off + bj * HALF + n * 16) = o; }
                if (m & 1) asm volatile("" ::: "memory"); }
    }
};
struct EpiLnResLn {
    static constexpr bool PERM = false, AFTER_DRAIN = true;
    const float* base; float* out; bf16_t* xn; int ldc; const float* bias; PanelStats st1, st2; unsigned poison;
    __device__ __forceinline__ void fused(f32x4 (&acc)[2][2][4][2], const Unit& u, int wr, int wc, int fr, int fq, PG8_LAS unsigned char* lds, int wid, int lane) const {
        typedef float f32x2v __attribute__((ext_vector_type(2))); typedef unsigned u32x2v __attribute__((ext_vector_type(2)));
        const PG8_LAS f32x2v* S = (const PG8_LAS f32x2v*)(lds + 8192);
        const int col0 = u.pn * BM + wc * 32 + 4 * fq;
#pragma unroll
        for (int bj = 0; bj < 2; ++bj)
#pragma unroll
            for (int n = 0; n < 2; ++n) { const f32x4 bv = bias ? *(const f32x4*)(bias + col0 + bj * HALF + n * 16) : (f32x4){0.f, 0.f, 0.f, 0.f};
#pragma unroll
                for (int ai = 0; ai < 2; ++ai)
#pragma unroll
                    for (int m = 0; m < 4; ++m) acc[ai][bj][m][n] += bv; }
        bool bad = st1.run(acc, u, wr, wc, fr, fq, lds, wid, lane) || poison != 0u;
        const float qnan = __builtin_nanf("");
#pragma unroll
        for (int ai = 0; ai < 2; ++ai)
#pragma unroll
            for (int m = 0; m < 4; ++m) { const int r = ai * HALF + wr * 64 + m * 16 + fr; const f32x2v sr = S[r]; const size_t off = (size_t)(u.pm * BM + r) * ldc + col0;
#pragma unroll
                for (int bj = 0; bj < 2; ++bj)
#pragma unroll
                    for (int n = 0; n < 2; ++n) { const f32x4 bs = *(const f32x4*)(base + off + bj * HALF + n * 16); acc[ai][bj][m][n] = bs + (acc[ai][bj][m][n] - sr.x) * sr.y; }
                asm volatile("" : "+v"(acc[ai][0][m][0]), "+v"(acc[ai][0][m][1]), "+v"(acc[ai][1][m][0]), "+v"(acc[ai][1][m][1]));
                if (m & 1) asm volatile("" ::: "memory"); }
        const bool bad1 = bad;
        bad = st2.run(acc, u, wr, wc, fr, fq, lds, wid, lane) || bad;
#pragma unroll
        for (int ai = 0; ai < 2; ++ai)
#pragma unroll
            for (int m = 0; m < 4; ++m) { const int r = ai * HALF + wr * 64 + m * 16 + fr; const f32x2v sr = S[r]; const size_t off = (size_t)(u.pm * BM + r) * ldc + col0;
#pragma unroll
                for (int bj = 0; bj < 2; ++bj)
#pragma unroll
                    for (int n = 0; n < 2; ++n) { const f32x4 x1 = acc[ai][bj][m][n]; *(f32x4*)(out + off + bj * HALF + n * 16) = bad1 ? (f32x4){qnan, qnan, qnan, qnan} : x1;
                        const f32x4 o = (x1 - sr.x) * sr.y; u32x2v w; w.x = cvt_pk_bf16(o[0], o[1]); w.y = cvt_pk_bf16(o[2], o[3]);
                        if (bad) { w.x = 0x7fc07fc0u; w.y = 0x7fc07fc0u; } *(u32x2v*)(xn + off + bj * HALF + n * 16) = w; }
                asm volatile("" ::: "memory"); }
    }
};

template <class Epi, class Sched, bool ALIGN_EPI = false, bool SP2 = false>
__device__ __forceinline__ void gemm_phase(PG8_LAS unsigned char* lds, const Gemm g, const Sched& S, const Epi& E) {
    const int tid = threadIdx.x, wid = __builtin_amdgcn_readfirstlane(tid >> 6), lane = tid & 63, wr = wid >> 2, wc = wid & 3, fr = lane & 15, fq = lane >> 4;
    const int K = g.K, nt = K / BK;
    unsigned voffA[2], voffB[2];
#pragma unroll
    for (int i = 0; i < 2; ++i) { int R, C; stage_rc(tid * 16 + i * 8192, R, C); const int Rb = Epi::PERM ? ((R & ~31) + perm32(R & 31)) : R;
        voffA[i] = (unsigned)(R * K + C) * 2u; voffB[i] = (unsigned)(Rb * K + C) * 2u; }
    const size_t kstep = (size_t)(BK * 2);
    const size_t hstep = (size_t)HALF * K * 2;
    const size_t tstep = 2 * hstep;
    const unsigned ldsw = (unsigned)wid * 1024u;
    const int aoff = lds_byte(wr * 64 + fr, fq * 8), boff = lds_byte(wc * 32 + fr, fq * 8);
#define PG8_SA(b, h) (((b) * 2 + (h)) * HTB)
#define PG8_SB(b, h) ((4 + (b) * 2 + (h)) * HTB)
#define PG8_STAGE(bufoff, gbase, voff) do { _Pragma("unroll") for (int _i = 0; _i < 2; ++_i) \
        __builtin_amdgcn_global_load_lds((const unsigned*)((const char*)(gbase) + (voff)[_i]), (PG8_LAS unsigned*)(lds + (bufoff) + ldsw + _i * 8192), 16, 0, 0); } while (0)
#define PG8_LDA(dst, b, h) do { _Pragma("unroll") for (int m = 0; m < 4; ++m) _Pragma("unroll") for (int k = 0; k < 2; ++k) dst[m][k] = *(const PG8_LAS bf16x8*)(lds + PG8_SA(b, h) + aoff + m * 2048 + k * 1024); } while (0)
#define PG8_LDB(dst, b, h) do { _Pragma("unroll") for (int n = 0; n < 2; ++n) _Pragma("unroll") for (int k = 0; k < 2; ++k) dst[n][k] = *(const PG8_LAS bf16x8*)(lds + PG8_SB(b, h) + boff + n * 2048 + k * 1024); } while (0)
#define PG8_MMA(ai, bj, At, Bt) do { __builtin_amdgcn_s_setprio(1); _Pragma("unroll") for (int m = 0; m < 4; ++m) _Pragma("unroll") for (int n = 0; n < 2; ++n) _Pragma("unroll") for (int k = 0; k < 2; ++k) \
        acc[ai][bj][m][n] = __builtin_amdgcn_mfma_f32_16x16x32_bf16(Bt[n][k], At[m][k], acc[ai][bj][m][n], 0, 0, 0); __builtin_amdgcn_s_setprio(0); } while (0)
#define PG8_WAIT_V(n) asm volatile("s_waitcnt vmcnt(" #n ")" ::: "memory")
#define PG8_WAIT_L(n) asm volatile("s_waitcnt lgkmcnt(" #n ")" ::: "memory")
#define PG8_BAR __builtin_amdgcn_s_barrier()
#define PG8_SCHED __builtin_amdgcn_sched_barrier(0)
    Unit cur, nxt; int ui = 0;
    if (!S.next(0, cur)) return;
    f32x4 acc[2][2][4][2];
#pragma unroll
    for (int a = 0; a < 2; ++a)
#pragma unroll
        for (int b = 0; b < 2; ++b)
#pragma unroll
            for (int m = 0; m < 4; ++m)
#pragma unroll
                for (int n = 0; n < 2; ++n) acc[a][b][m][n] = (f32x4){0.f, 0.f, 0.f, 0.f};
    bf16x8 At[4][2], B0[2][2], B1[2][2];
    const char* cA = (const char*)g.A + (size_t)cur.pm * tstep; const char* cB = (const char*)g.Bt + (size_t)cur.pn * tstep;
    S.a_ready(cur);
    if constexpr (SP2) {
        PG8_STAGE(PG8_SB(0, 0), cB, voffB); PG8_STAGE(PG8_SB(0, 1), cB + hstep, voffB); PG8_STAGE(PG8_SA(0, 0), cA, voffA); PG8_STAGE(PG8_SA(0, 1), cA + hstep, voffA);
        if (wr == 1) PG8_BAR;
        PG8_WAIT_V(2); PG8_BAR;
        PG8_STAGE(PG8_SB(1, 0), cB + kstep, voffB); PG8_STAGE(PG8_SA(1, 0), cA + kstep, voffA); PG8_STAGE(PG8_SB(1, 1), cB + hstep + kstep, voffB);
        PG8_WAIT_V(6); PG8_BAR;
    } else {
        PG8_STAGE(PG8_SB(0, 0), cB, voffB); PG8_STAGE(PG8_SA(0, 0), cA, voffA); PG8_STAGE(PG8_SB(0, 1), cB + hstep, voffB); PG8_STAGE(PG8_SA(0, 1), cA + hstep, voffA);
        if (wr == 1) PG8_BAR;
        PG8_WAIT_V(4); PG8_BAR;
        PG8_STAGE(PG8_SB(1, 0), cB + kstep, voffB); PG8_STAGE(PG8_SA(1, 0), cA + kstep, voffA); PG8_STAGE(PG8_SB(1, 1), cB + hstep + kstep, voffB);
        PG8_WAIT_V(6); PG8_BAR;
    }
    for (;;) {
        const bool has_next = S.next(ui + 1, nxt);
        const char* nA = has_next ? (const char*)g.A + (size_t)nxt.pm * tstep : cA; const char* nB = has_next ? (const char*)g.Bt + (size_t)nxt.pn * tstep : cB;
        for (int t = 0; t < nt; t += 2) {
            const bool last = (t == nt - 2);
            const char* a1 = cA + (size_t)(t + 1) * kstep;
            const char* a2 = last ? nA : cA + (size_t)(t + 2) * kstep; const char* b2 = last ? nB : cB + (size_t)(t + 2) * kstep;
            const char* a3 = a2 + kstep; const char* b3 = b2 + kstep;
            if (last && has_next) S.a_ready(nxt);
            if constexpr (SP2) {
            PG8_LDB(B0, 0, 0); PG8_LDB(B1, 0, 1); PG8_SCHED; PG8_LDA(At, 0, 0); PG8_STAGE(PG8_SA(1, 1), a1 + hstep, voffA);
            PG8_WAIT_V(8); PG8_WAIT_L(0); PG8_BAR; PG8_MMA(0, 0, At, B0); PG8_MMA(0, 1, At, B1); PG8_BAR; PG8_SCHED;
            PG8_LDA(At, 0, 1); PG8_STAGE(PG8_SB(0, 0), b2, voffB); PG8_STAGE(PG8_SB(0, 1), b2 + hstep, voffB); PG8_STAGE(PG8_SA(0, 0), a2, voffA);
            PG8_WAIT_V(8); PG8_WAIT_L(0); PG8_BAR; PG8_MMA(1, 0, At, B0); PG8_MMA(1, 1, At, B1); PG8_BAR; PG8_SCHED;
            PG8_LDB(B0, 1, 0); PG8_LDB(B1, 1, 1); PG8_SCHED; PG8_LDA(At, 1, 0); PG8_STAGE(PG8_SA(0, 1), a2 + hstep, voffA);
            PG8_WAIT_V(8); PG8_WAIT_L(0); PG8_BAR; PG8_MMA(0, 0, At, B0); PG8_MMA(0, 1, At, B1); PG8_BAR; PG8_SCHED;
            PG8_LDA(At, 1, 1); PG8_STAGE(PG8_SB(1, 0), b3, voffB); PG8_STAGE(PG8_SB(1, 1), b3 + hstep, voffB); PG8_STAGE(PG8_SA(1, 0), a3, voffA);
            PG8_WAIT_V(8); PG8_WAIT_L(0); PG8_BAR; PG8_MMA(1, 0, At, B0); PG8_MMA(1, 1, At, B1); PG8_BAR; PG8_SCHED;
            } else {
            PG8_LDB(B0, 0, 0); PG8_SCHED; PG8_LDA(At, 0, 0); PG8_STAGE(PG8_SA(1, 1), a1 + hstep, voffA);
            PG8_WAIT_L(8); PG8_BAR; PG8_WAIT_L(0); PG8_MMA(0, 0, At, B0); PG8_BAR; PG8_SCHED;
            PG8_LDB(B1, 0, 1); PG8_STAGE(PG8_SB(0, 0), b2, voffB);
            PG8_BAR; PG8_WAIT_L(0); PG8_MMA(0, 1, At, B1); PG8_BAR;
            PG8_LDA(At, 0, 1); PG8_STAGE(PG8_SA(0, 0), a2, voffA);
            PG8_BAR; PG8_WAIT_L(0); PG8_MMA(1, 0, At, B0); PG8_BAR; PG8_SCHED;
            PG8_STAGE(PG8_SB(0, 1), b2 + hstep, voffB);
            PG8_WAIT_V(6); PG8_BAR; PG8_MMA(1, 1, At, B1); PG8_BAR;
            PG8_LDB(B0, 1, 0); PG8_SCHED; PG8_LDA(At, 1, 0); PG8_STAGE(PG8_SA(0, 1), a2 + hstep, voffA);
            PG8_WAIT_L(8); PG8_BAR; PG8_WAIT_L(0); PG8_MMA(0, 0, At, B0); PG8_BAR; PG8_SCHED;
            PG8_LDB(B1, 1, 1); PG8_STAGE(PG8_SB(1, 0), b3, voffB);
            PG8_BAR; PG8_WAIT_L(0); PG8_MMA(0, 1, At, B1); PG8_BAR;
            PG8_LDA(At, 1, 1); PG8_STAGE(PG8_SA(1, 0), a3, voffA);
            PG8_BAR; PG8_WAIT_L(0); PG8_MMA(1, 0, At, B0); PG8_BAR; PG8_SCHED;
            PG8_STAGE(PG8_SB(1, 1), b3 + hstep, voffB);
            PG8_WAIT_V(6); PG8_BAR; PG8_MMA(1, 1, At, B1); PG8_BAR;
            }
        }
        if constexpr (ALIGN_EPI) { if (wr == 0) PG8_BAR; }
        if constexpr (!Epi::AFTER_DRAIN) { E(acc, cur, wr, wc, fr, fq); S.done(cur); }
        if (!has_next) break;
#pragma unroll
        for (int a = 0; a < 2; ++a)
#pragma unroll
            for (int b = 0; b < 2; ++b)
#pragma unroll
                for (int m = 0; m < 4; ++m)
#pragma unroll
                    for (int n = 0; n < 2; ++n) acc[a][b][m][n] = (f32x4){0.f, 0.f, 0.f, 0.f};
        cur = nxt; cA = nA; cB = nB; ++ui;
        if constexpr (ALIGN_EPI) { if (wr == 1) PG8_BAR; }
    }
    PG8_WAIT_V(0);
    if constexpr (!ALIGN_EPI) { if (wr == 0) PG8_BAR; }
    PG8_BAR;
    if constexpr (Epi::AFTER_DRAIN) { E.fused(acc, cur, wr, wc, fr, fq, lds, wid, lane); S.done(cur); }
#undef PG8_SA
#undef PG8_SB
#undef PG8_STAGE
#undef PG8_LDA
#undef PG8_LDB
#undef PG8_MMA
#undef PG8_WAIT_V
#undef PG8_WAIT_L
#undef PG8_BAR
#undef PG8_SCHED
}
}

typedef float f32x2_t __attribute__((ext_vector_type(2))); typedef __bf16 bf16x2_t __attribute__((ext_vector_type(2)));
__device__ __forceinline__ unsigned cvtpk(float lo, float hi) { f32x2_t v = {lo, hi}; bf16x2_t b = __builtin_convertvector(v, bf16x2_t); return __builtin_bit_cast(unsigned, b); }

namespace pg8 {
template <bool BASE_BF16> struct EpiRes {
    static constexpr bool PERM = true, AFTER_DRAIN = false;
    const void* base; bf16_t* hb; float* ssq;
    __device__ __forceinline__ void operator()(const f32x4 (&acc)[2][2][4][2], const Unit& u, int wr, int wc, int fr, int fq) const {
        const int row0 = u.pm * BM + wr * 64 + fr, col0 = u.pn * BM + wc * 32 + 8 * fq;
#pragma unroll
        for (int ai = 0; ai < 2; ++ai) {
            f32x4 b0[4][2], b1[4][2];
#pragma unroll
            for (int m = 0; m < 4; ++m)
#pragma unroll
                for (int bj = 0; bj < 2; ++bj) {
                    const size_t off = (size_t)(row0 + ai * HALF + m * 16) * 1024 + col0 + bj * HALF;
                    if (BASE_BF16) {
                        const u32x4 w = *(const u32x4*)((const bf16_t*)base + off);
                        b0[m][bj][0] = __uint_as_float(w.x << 16); b0[m][bj][1] = __uint_as_float(w.x & 0xffff0000u); b0[m][bj][2] = __uint_as_float(w.y << 16); b0[m][bj][3] = __uint_as_float(w.y & 0xffff0000u);
                        b1[m][bj][0] = __uint_as_float(w.z << 16); b1[m][bj][1] = __uint_as_float(w.z & 0xffff0000u); b1[m][bj][2] = __uint_as_float(w.w << 16); b1[m][bj][3] = __uint_as_float(w.w & 0xffff0000u);
                    } else { b0[m][bj] = *(const f32x4*)((const float*)base + off); b1[m][bj] = *(const f32x4*)((const float*)base + off + 4); }
                }
#pragma unroll
            for (int m = 0; m < 4; ++m) {
                const size_t row = (size_t)(row0 + ai * HALF + m * 16); float s = 0.f;
#pragma unroll
                for (int bj = 0; bj < 2; ++bj) {
                    const size_t off = row * 1024 + col0 + bj * HALF;
                    const f32x4 v0 = acc[ai][bj][m][0] + b0[m][bj], v1 = acc[ai][bj][m][1] + b1[m][bj];
                    s += (v0[0] * v0[0] + v0[1] * v0[1]) + (v0[2] * v0[2] + v0[3] * v0[3]) + (v1[0] * v1[0] + v1[1] * v1[1]) + (v1[2] * v1[2] + v1[3] * v1[3]);
                    u32x4 w; w.x = cvtpk(v0[0], v0[1]); w.y = cvtpk(v0[2], v0[3]); w.z = cvtpk(v1[0], v1[1]); w.w = cvtpk(v1[2], v1[3]); *(u32x4*)(hb + off) = w;
                }
                s += __shfl_xor(s, 16); s += __shfl_xor(s, 32); if (fq == 0) ssq[row * 16 + u.pn * 4 + wc] = s;
            }
        }
    }
};
template <int MODE> struct EpiScale {
    static constexpr bool PERM = true, AFTER_DRAIN = false;
    bf16_t* O; int ldc; const float* ssq; float scale;
    __device__ __forceinline__ void operator()(const f32x4 (&acc)[2][2][4][2], const Unit& u, int wr, int wc, int fr, int fq) const {
        const int row0 = u.pm * BM + wr * 64 + fr, col0 = u.pn * BM + wc * 32 + 8 * fq;
#pragma unroll
        for (int ai = 0; ai < 2; ++ai)
#pragma unroll
            for (int m = 0; m < 4; ++m) {
                const size_t row = (size_t)(row0 + ai * HALF + m * 16);
                const f32x4 s0 = *(const f32x4*)(ssq + row * 16), s1 = *(const f32x4*)(ssq + row * 16 + 4), s2 = *(const f32x4*)(ssq + row * 16 + 8), s3 = *(const f32x4*)(ssq + row * 16 + 12);
                const f32x4 st = (s0 + s1) + (s2 + s3);
                const float rs = __builtin_amdgcn_rsqf(((st[0] + st[1]) + (st[2] + st[3])) * (1.0f / 1024.0f) + 1e-6f) * scale;
#pragma unroll
                for (int bj = 0; bj < 2; ++bj) {
                    f32x4 v0 = acc[ai][bj][m][0] * rs, v1 = acc[ai][bj][m][1] * rs;
                    if (MODE == 1) {
#pragma unroll
                        for (int e = 0; e < 4; ++e) { const float a = fmaxf(v0[e], 0.f), b = fmaxf(v1[e], 0.f); v0[e] = a * a; v1[e] = b * b; }
                    }
                    u32x4 w; w.x = cvtpk(v0[0], v0[1]); w.y = cvtpk(v0[2], v0[3]); w.z = cvtpk(v1[0], v1[1]); w.w = cvtpk(v1[2], v1[3]);
                    *(u32x4*)(O + row * ldc + col0 + bj * HALF) = w;
                }
            }
    }
};
struct EpiKV {
    static constexpr bool PERM = true, AFTER_DRAIN = false;
    bf16_t* Kb; bf16_t* Vt;
    __device__ __forceinline__ void operator()(const f32x4 (&acc)[2][2][4][2], const Unit& u, int wr, int wc, int fr, int fq) const {
        const int row0 = u.pm * BM + wr * 64 + fr, col0 = u.pn * BM + wc * 32 + 8 * fq;
#pragma unroll
        for (int ai = 0; ai < 2; ++ai)
#pragma unroll
            for (int m = 0; m < 4; ++m) {
                const int row = row0 + ai * HALF + m * 16;
#pragma unroll
                for (int bj = 0; bj < 2; ++bj) {
                    const int col = col0 + bj * HALF; const f32x4 v0 = acc[ai][bj][m][0], v1 = acc[ai][bj][m][1];
                    u32x4 w; w.x = cvtpk(v0[0], v0[1]); w.y = cvtpk(v0[2], v0[3]); w.z = cvtpk(v1[0], v1[1]); w.w = cvtpk(v1[2], v1[3]);
                    if (col < 1024) { *(u32x4*)(Kb + (size_t)row * 1024 + col) = w; }
                    else {
                        const int b = row >> 8, mm = row & 255; bf16_t* p = Vt + ((size_t)(b * 1024 + (col - 1024))) * 256 + mm;
                        p[0 * 256] = (bf16_t)(w.x & 0xffffu); p[1 * 256] = (bf16_t)(w.x >> 16); p[2 * 256] = (bf16_t)(w.y & 0xffffu); p[3 * 256] = (bf16_t)(w.y >> 16);
                        p[4 * 256] = (bf16_t)(w.z & 0xffffu); p[5 * 256] = (bf16_t)(w.z >> 16); p[6 * 256] = (bf16_t)(w.w & 0xffffu); p[7 * 256] = (bf16_t)(w.w >> 16);
                    }
                }
            }
    }
};
}

#define LAS __attribute__((address_space(3)))
typedef pg8::bf16_t bf16_t;
typedef pg8::bf16x8 bf16x8;
typedef pg8::f32x4 f32x4;
typedef pg8::u32x4 u32x4;
typedef unsigned u32x2 __attribute__((ext_vector_type(2)));

constexpr int NTOK = 32768, DM = 1024, SEQ = 8192, NBATCH = 4, NCHUNK = 128, NPROJ = 3328, DFF = 4096, NMEMROWS = 1024;
constexpr int C_GQ = 0, C_GK = 256, C_GV = 512, C_GG = 1024, C_RQ = 1536, C_RK = 1792, C_RV = 2048, C_RG = 2560, C_Z = 3072;
constexpr int NWAVES = 8, NTHREADS = 512;
constexpr int WAVE_LDS = 18432, MISC_OFF = NWAVES * WAVE_LDS, LDS_BYTES = MISC_OFF + 64;
constexpr int VPITCH = 72;
constexpr int APITCH = 528;
constexpr size_t MiB = 1u << 20;
constexpr size_t WS_WIN = 1 * MiB, WS_WOUT = 8 * MiB, WS_WQ = 10 * MiB, WS_WKV = 12 * MiB, WS_WO = 16 * MiB, WS_W1 = 18 * MiB, WS_W2 = 26 * MiB;
constexpr size_t WS_COS = 34 * MiB, WS_SIN = 35 * MiB, WS_MEMN = 36 * MiB, WS_KB = 38 * MiB, WS_VT = 40 * MiB, WS_DEC = 42 * MiB, WS_SSQ1 = 44 * MiB, WS_SSQ2 = 46 * MiB, WS_SSQ3 = 48 * MiB, WS_CTL = 0;
constexpr size_t WS_A1 = 64 * MiB;
constexpr size_t WS_A2 = 128 * MiB;
constexpr size_t WS_BIG = 192 * MiB;
constexpr size_t WS_NEED = 448 * MiB;

struct Params {
    const float *x, *mem, *norm_mix_g, *w_in, *gla_w_gate, *gla_b_gate, *gla_norm_g, *ret_norm_g, *w_out, *norm_x_g, *norm_mem_g, *xa_w_q, *xa_w_kv, *xa_w_o, *norm_ffn_g, *ffn_w1, *ffn_w2, *final_norm_g;
    float* out; unsigned char* ws; int ph_lo, ph_hi;
};

__device__ __forceinline__ float bf2f(unsigned short b) { return __uint_as_float(((unsigned)b) << 16); }
__device__ __forceinline__ unsigned short f2bf(float f) { const unsigned u = __float_as_uint(f); return (unsigned short)((u + 0x7fffu + ((u >> 16) & 1u)) >> 16); }
__device__ __forceinline__ bf16x8 pack8(f32x4 a, f32x4 b) {
    u32x4 w; w.x = cvtpk(a[0], a[1]); w.y = cvtpk(a[2], a[3]); w.z = cvtpk(b[0], b[1]); w.w = cvtpk(b[2], b[3]);
    return __builtin_bit_cast(bf16x8, w);
}
__device__ __forceinline__ void unpack8(bf16x8 v, f32x4& a, f32x4& b) {
    const u32x4 w = __builtin_bit_cast(u32x4, v);
    a[0] = __uint_as_float(w.x << 16); a[1] = __uint_as_float(w.x & 0xffff0000u); a[2] = __uint_as_float(w.y << 16); a[3] = __uint_as_float(w.y & 0xffff0000u);
    b[0] = __uint_as_float(w.z << 16); b[1] = __uint_as_float(w.z & 0xffff0000u); b[2] = __uint_as_float(w.w << 16); b[3] = __uint_as_float(w.w & 0xffff0000u);
}
__device__ __forceinline__ float wave_sum(float v) {
#pragma unroll
    for (int o = 1; o < 64; o <<= 1) v += __shfl_xor(v, o);
    return v;
}
#define MFMA16(a, b, c) __builtin_amdgcn_mfma_f32_16x16x32_bf16((a), (b), (c), 0, 0, 0)
#define LDS_FENCE() asm volatile("s_waitcnt lgkmcnt(0)" ::: "memory")
#define CFENCE() do { asm volatile("" ::: "memory"); __builtin_amdgcn_sched_barrier(0); } while (0)
__device__ __forceinline__ float scan16(float v, int r) {
#pragma unroll
    for (int off = 1; off < 16; off <<= 1) { const float t = __shfl_up(v, off, 16); if (r >= off) v += t; }
    return v;
}

#define XB_TMO      128
#define XB_XCNT(j)  (256  + 64 * (j))
#define XB_XSUB(j)  (1280 + 64 * (j))
#define XB_XGEN(j)  (2304 + 64 * (j))
#define XB_TOP      3328
#define XB_TOPGEN   3392
#define XCD_BAR_WORDS 3456
#define XB_SPIN_CAP (1u << 18)

__device__ __forceinline__ unsigned xb_ld(unsigned* p)              { return __hip_atomic_load(p, __ATOMIC_RELAXED, __HIP_MEMORY_SCOPE_AGENT); }
__device__ __forceinline__ unsigned xb_add(unsigned* p, unsigned v) { return __hip_atomic_fetch_add(p, v, __ATOMIC_RELAXED, __HIP_MEMORY_SCOPE_AGENT); }
__device__ __forceinline__ unsigned xb_xcc_id() { return (unsigned)__builtin_amdgcn_s_getreg((3 << 11) | 20) & 0xFu; }
#define XB_SPIN(cond, bar) do { unsigned _sp = 0; while (cond) { __builtin_amdgcn_s_sleep(1); \
    if ((++_sp & 255u) == 0u) { if (xb_ld(&(bar)[XB_TMO])) break; if (_sp > XB_SPIN_CAP) { atomicAdd(&(bar)[XB_TMO], 1u); break; } } } } while (0)

struct XcdBarrier {
    unsigned* bar; unsigned x;
    volatile LAS unsigned* st;
};

__device__ __forceinline__ XcdBarrier xcd_barrier_post(unsigned* bar, volatile LAS unsigned* st) {
    XcdBarrier b; b.bar = bar; b.x = xb_xcc_id(); b.st = st;
    if (threadIdx.x == 0) (void)xb_add(&bar[XB_XCNT(b.x)], 1u);
    return b;
}
__device__ __forceinline__ void xcd_barrier_complete(unsigned* bar, unsigned x, unsigned& nloc, unsigned& nx) {
    const unsigned G = gridDim.x * gridDim.y * gridDim.z;
    unsigned sum, cnt, mine, sp = 0u;
    for (;;) {
        sum = 0u; cnt = 0u; mine = 0u;
#pragma unroll
        for (unsigned j = 0; j < 16; ++j) { const unsigned c = xb_ld(&bar[XB_XCNT(j)]); sum += c; cnt += (c > 0u) ? 1u : 0u; mine = (j == x) ? c : mine; }
        if (sum == G) break;
        __builtin_amdgcn_s_sleep(1);
        if ((++sp & 255u) == 0u) { if (xb_ld(&bar[XB_TMO])) break; if (sp > XB_SPIN_CAP) { atomicAdd(&bar[XB_TMO], 1u); break; } }
    }
    nloc = mine > 0u ? mine : 1u; nx = cnt > 0u ? cnt : 1u;
}

__device__ __forceinline__ void xcd_barrier(const XcdBarrier& b) {
    asm volatile("s_waitcnt vmcnt(0)" ::: "memory");
    __syncthreads();
    if (threadIdx.x == 0) {
        unsigned* bar = b.bar;
        __builtin_amdgcn_s_waitcnt(0);
        unsigned nloc = b.st[0], nx = b.st[1];
        if (nloc == 0u) { xcd_barrier_complete(bar, b.x, nloc, nx); b.st[0] = nloc; b.st[1] = nx; }
        const unsigned old = xb_add(&bar[XB_XSUB(b.x)], 1u);
        const unsigned gen = old / nloc;
        if (old + 1u == (gen + 1u) * nloc) {
            __builtin_amdgcn_fence(__ATOMIC_RELEASE, "agent");
            asm volatile("s_waitcnt vmcnt(0)" ::: "memory");
            const unsigned og = xb_add(&bar[XB_TOP], 1u);
            const unsigned tg = og / nx;
            if (og + 1u == (tg + 1u) * nx) xb_add(&bar[XB_TOPGEN], 1u);
            else XB_SPIN(xb_ld(&bar[XB_TOPGEN]) == tg, bar);
            __builtin_amdgcn_fence(__ATOMIC_ACQUIRE, "agent");
            xb_add(&bar[XB_XGEN(b.x)], 1u);
            asm volatile("s_waitcnt vmcnt(0)" ::: "memory");
        } else {
            XB_SPIN(xb_ld(&bar[XB_XGEN(b.x)]) == gen, bar);
            __builtin_amdgcn_fence(__ATOMIC_ACQUIRE, "agent");
            asm volatile("s_waitcnt vmcnt(0)" ::: "memory");
        }
    }
    __syncthreads();
}

__device__ __forceinline__ void transpose_item(const float* W, int ldw, int col0, int K, int Nn, const float* g, bf16_t* WT, int row_off, LAS float* scr, int item, int lane) {
    const int nblk = Nn / 32, kb = item / nblk, nb = item % nblk, k0 = 64 * kb, n0 = 32 * nb;
    f32x4 v[8]; const int c4 = (lane & 7) * 4;
#pragma unroll
    for (int i = 0; i < 8; ++i) { const int kk = (lane >> 3) + 8 * i; v[i] = *(const f32x4*)(W + (size_t)(k0 + kk) * ldw + col0 + n0 + c4); }
#pragma unroll
    for (int i = 0; i < 8; ++i) { const int kk = (lane >> 3) + 8 * i; f32x4 w = v[i]; if (g) w *= g[k0 + kk];
        scr[kk * 33 + c4 + 0] = w[0]; scr[kk * 33 + c4 + 1] = w[1]; scr[kk * 33 + c4 + 2] = w[2]; scr[kk * 33 + c4 + 3] = w[3]; }
    LDS_FENCE();
    const int c = lane & 7;
#pragma unroll
    for (int j = 0; j < 4; ++j) { const int n = (lane >> 3) + 8 * j; const LAS float* s = scr + (8 * c) * 33 + n;
        u32x4 o; o.x = cvtpk(s[0 * 33], s[1 * 33]); o.y = cvtpk(s[2 * 33], s[3 * 33]); o.z = cvtpk(s[4 * 33], s[5 * 33]); o.w = cvtpk(s[6 * 33], s[7 * 33]);
        *(u32x4*)(WT + (size_t)(row_off + n0 + n) * K + k0 + 8 * c) = o; }
    LDS_FENCE();
}
__device__ __forceinline__ void rms_rows2_to_bf16(const float* xa, const float* xb, const float* g, bf16_t* oa, bf16_t* ob, int lane) {
    const f32x4* ra = (const f32x4*)xa + lane; const f32x4* rb = (const f32x4*)xb + lane; const f32x4* gr = (const f32x4*)g + lane;
    f32x4 va[4], vb[4]; float sa = 0.f, sb = 0.f;
#pragma unroll
    for (int j = 0; j < 4; ++j) { va[j] = ra[64 * j]; vb[j] = rb[64 * j]; }
#pragma unroll
    for (int j = 0; j < 4; ++j) { sa += (va[j][0] * va[j][0] + va[j][1] * va[j][1]) + (va[j][2] * va[j][2] + va[j][3] * va[j][3]); sb += (vb[j][0] * vb[j][0] + vb[j][1] * vb[j][1]) + (vb[j][2] * vb[j][2] + vb[j][3] * vb[j][3]); }
    const float rsa = 1.0f / sqrtf(wave_sum(sa) * (1.0f / 1024.0f) + 1e-6f), rsb = 1.0f / sqrtf(wave_sum(sb) * (1.0f / 1024.0f) + 1e-6f);
    u32x2* o8a = (u32x2*)oa + lane; u32x2* o8b = (u32x2*)ob + lane;
#pragma unroll
    for (int j = 0; j < 4; ++j) { const f32x4 gg = gr[64 * j];
        u32x2 w; w.x = cvtpk(va[j][0] * rsa * gg[0], va[j][1] * rsa * gg[1]); w.y = cvtpk(va[j][2] * rsa * gg[2], va[j][3] * rsa * gg[3]); o8a[64 * j] = w;
        u32x2 z; z.x = cvtpk(vb[j][0] * rsb * gg[0], vb[j][1] * rsb * gg[1]); z.y = cvtpk(vb[j][2] * rsb * gg[2], vb[j][3] * rsb * gg[3]); o8b[64 * j] = z; }
}
__device__ __forceinline__ void p0_prologue(const Params& p, LAS unsigned char* lds, int G) {
    const int tid = threadIdx.x, lane = tid & 63, wave = __builtin_amdgcn_readfirstlane(tid >> 6);
    unsigned char* ws = p.ws;
    LAS float* scr = (LAS float*)(lds + wave * WAVE_LDS);
    const int gw = blockIdx.x * NWAVES + wave, NGW = G * NWAVES;
    bf16_t* Win_t = (bf16_t*)(ws + WS_WIN);
    constexpr int I_INA = 16 * 32, I_INB = 16 * 64, I_OUT = 16 * 32, I_Q = 16 * 32, I_KV = 16 * 64, I_O = 16 * 32, I_1 = 16 * 128, I_2 = 64 * 32;
    constexpr int NITEMS = I_INA + I_INB + I_OUT + I_Q + I_KV + I_O + I_1 + I_2;
    for (int it = gw; it < NITEMS; it += NGW) {
        int r = it;
        if (r < I_INA) { transpose_item(p.w_in, 3088, 0, 1024, 1024, nullptr, Win_t, 0, scr, r, lane); continue; } r -= I_INA;
        if (r < I_INB) { transpose_item(p.w_in, 3088, 1040, 1024, 2048, nullptr, Win_t, 1024, scr, r, lane); continue; } r -= I_INB;
        if (r < I_OUT) { transpose_item(p.w_out, 1024, 0, 1024, 1024, nullptr, (bf16_t*)(ws + WS_WOUT), 0, scr, r, lane); continue; } r -= I_OUT;
        if (r < I_Q) { transpose_item(p.xa_w_q, 1024, 0, 1024, 1024, p.norm_x_g, (bf16_t*)(ws + WS_WQ), 0, scr, r, lane); continue; } r -= I_Q;
        if (r < I_KV) { transpose_item(p.xa_w_kv, 2048, 0, 1024, 2048, nullptr, (bf16_t*)(ws + WS_WKV), 0, scr, r, lane); continue; } r -= I_KV;
        if (r < I_O) { transpose_item(p.xa_w_o, 1024, 0, 1024, 1024, nullptr, (bf16_t*)(ws + WS_WO), 0, scr, r, lane); continue; } r -= I_O;
        if (r < I_1) { transpose_item(p.ffn_w1, 4096, 0, 1024, 4096, p.norm_ffn_g, (bf16_t*)(ws + WS_W1), 0, scr, r, lane); continue; } r -= I_1;
        transpose_item(p.ffn_w2, 1024, 0, 4096, 1024, nullptr, (bf16_t*)(ws + WS_W2), 0, scr, r, lane);
    }
    const int gt = blockIdx.x * NTHREADS + tid, NGT = G * NTHREADS;
    for (int o = gt; o < 256 * 1024; o += NGT) {
        const int n = o >> 10, k = o & 1023; const float* wr = p.w_in + (size_t)k * 3088 + 1024; float s = 0.f;
#pragma unroll
        for (int r = 0; r < 16; ++r) s += wr[r] * p.gla_w_gate[r * 256 + n];
        Win_t[(size_t)(3072 + n) * 1024 + k] = f2bf(s);
    }
    float* cosT = (float*)(ws + WS_COS); float* sinT = (float*)(ws + WS_SIN);
    for (int o = gt; o < SEQ * 32; o += NGT) {
        const int pos = o >> 5, i = o & 31; double f = 1.0;
        for (int k = 0; k < i; ++k) f *= 0.7498942093324559;
        const double t = (double)pos * f * 0.15915494309189535;
        const float fr = (float)(t - floor(t));
        cosT[o] = __builtin_amdgcn_cosf(fr); sinT[o] = __builtin_amdgcn_sinf(fr);
    }
    bf16_t* XN = (bf16_t*)(ws + WS_A1); bf16_t* MEMN = (bf16_t*)(ws + WS_MEMN);
    for (int m2 = gw; m2 < (NTOK + NMEMROWS) / 2; m2 += NGW) {
        const int m = 2 * m2;
        if (m < NTOK) rms_rows2_to_bf16(p.x + (size_t)m * DM, p.x + (size_t)(m + 1) * DM, p.norm_mix_g, XN + (size_t)m * DM, XN + (size_t)(m + 1) * DM, lane);
        else rms_rows2_to_bf16(p.mem + (size_t)(m - NTOK) * DM, p.mem + (size_t)(m + 1 - NTOK) * DM, p.norm_mem_g, MEMN + (size_t)(m - NTOK) * DM, MEMN + (size_t)(m + 1 - NTOK) * DM, lane);
    }
}

__device__ __forceinline__ void gla_gates(const bf16_t* P, int zcol, const float* bg, int r, int q, float (&bc)[4][2][8], float (&bl)[2][8]) {
    bf16x8 zf[4][2];
#pragma unroll
    for (int mt = 0; mt < 4; ++mt)
#pragma unroll
        for (int ks = 0; ks < 2; ++ks) zf[mt][ks] = *(const bf16x8*)(P + (size_t)(16 * mt + r) * NPROJ + zcol + 32 * ks + 8 * q);
    CFENCE();
#pragma unroll
    for (int ks = 0; ks < 2; ++ks) {
        const f32x4 b0 = *(const f32x4*)(bg + 32 * ks + 8 * q), b1 = *(const f32x4*)(bg + 32 * ks + 8 * q + 4);
#pragma unroll
        for (int mt = 0; mt < 4; ++mt) {
            f32x4 z0, z1; unpack8(zf[mt][ks], z0, z1); z0 += b0; z1 += b1;
#pragma unroll
            for (int e = 0; e < 4; ++e) {
                bc[mt][ks][e] = (fminf(z0[e], 0.f) - __logf(1.0f + __expf(-fabsf(z0[e])))) * (1.0f / 16.0f);
                bc[mt][ks][4 + e] = (fminf(z1[e], 0.f) - __logf(1.0f + __expf(-fabsf(z1[e])))) * (1.0f / 16.0f);
            }
        }
#pragma unroll
        for (int e = 0; e < 8; ++e) {
            float carry = 0.f;
#pragma unroll
            for (int mt = 0; mt < 4; ++mt) { const float v = scan16(bc[mt][ks][e], r); const float tot = __shfl(v, 15, 16); bc[mt][ks][e] = v + carry; carry += tot; }
            bl[ks][e] = carry;
        }
    }
}
__device__ __forceinline__ float ret_log2g(int hr) { return hr == 0 ? -0.04580368961312479f : hr == 1 ? -0.008973692110584325f : hr == 2 ? -0.0017761724589428754f : -0.0003522634716290214f; }
__device__ __forceinline__ void rope_tile(bf16x8 f0, bf16x8 f1, const float* cosT, const float* sinT, int pos, int q, f32x4 (&o)[4]) {
    f32x4 a0, a1, b0, b1; unpack8(f0, a0, a1); unpack8(f1, b0, b1);
    const f32x4 c0 = *(const f32x4*)(cosT + pos * 32 + 8 * q), c1 = *(const f32x4*)(cosT + pos * 32 + 8 * q + 4), s0 = *(const f32x4*)(sinT + pos * 32 + 8 * q), s1 = *(const f32x4*)(sinT + pos * 32 + 8 * q + 4);
    o[0] = a0 * c0 - b0 * s0; o[1] = a1 * c1 - b1 * s1; o[2] = a0 * s0 + b0 * c0; o[3] = a1 * s1 + b1 * c1;
}

__device__ __forceinline__ void chunk_contrib(const Params& p, LAS unsigned char* lds, int G) {
    const int tid = threadIdx.x, lane = tid & 63, wave = __builtin_amdgcn_readfirstlane(tid >> 6);
    unsigned char* ws = p.ws;
    const bf16_t* PROJ = (const bf16_t*)(ws + WS_BIG); bf16_t* CT = (bf16_t*)(ws + WS_A2); float* DEC = (float*)(ws + WS_DEC);
    const float* cosT = (const float*)(ws + WS_COS); const float* sinT = (const float*)(ws + WS_SIN);
    LAS bf16_t* Kdt = (LAS bf16_t*)(lds + wave * WAVE_LDS); LAS bf16_t* Vt = Kdt + 64 * VPITCH;
    for (int u = blockIdx.x * NWAVES + wave; u < NBATCH * NCHUNK * 8; u += G * NWAVES) {
        int h8 = u & 7; asm volatile("" : "+s"(h8));
        const int bn = u >> 3, b = bn >> 7, n = bn & 127;
        const size_t tok0 = (size_t)b * SEQ + (size_t)n * 64;
        const bf16_t* P = PROJ + tok0 * NPROJ;
        const int unit = (b * 8 + h8) * NCHUNK + n;
        int ln = lane; asm volatile("" : "+v"(ln));
        const int r = ln & 15, q = ln >> 4;
        const int vcol = (h8 < 4) ? C_GV + h8 * 128 : C_RV + (h8 - 4) * 128;
        const int kcol = (h8 < 4) ? C_GK + h8 * 64 : C_RK + (h8 - 4) * 64;
        bf16x8 kf[4][2];
#pragma unroll
        for (int mt = 0; mt < 4; ++mt)
#pragma unroll
            for (int ks = 0; ks < 2; ++ks) kf[mt][ks] = *(const bf16x8*)(P + (size_t)(16 * mt + r) * NPROJ + kcol + 32 * ks + 8 * q);
        LDS_FENCE();
        if (h8 < 4) {
            const int h = h8;
            float bc[4][2][8], bl[2][8];
            gla_gates(P, C_Z + h * 64, p.gla_b_gate + h * 64, r, q, bc, bl);
            if (r == 0) {
#pragma unroll
                for (int ks = 0; ks < 2; ++ks) {
                    f32x4 d0, d1;
#pragma unroll
                    for (int e = 0; e < 4; ++e) { d0[e] = __expf(bl[ks][e]); d1[e] = __expf(bl[ks][4 + e]); }
                    *(f32x4*)(DEC + (size_t)unit * 64 + 32 * ks + 8 * q) = d0; *(f32x4*)(DEC + (size_t)unit * 64 + 32 * ks + 8 * q + 4) = d1;
                }
            }
#pragma unroll
            for (int mt = 0; mt < 4; ++mt)
#pragma unroll
                for (int ks = 0; ks < 2; ++ks) {
                    f32x4 k0, k1; unpack8(kf[mt][ks], k0, k1);
#pragma unroll
                    for (int e = 0; e < 4; ++e) {
                        Kdt[(32 * ks + 8 * q + e) * VPITCH + 16 * mt + r] = f2bf(k0[e] * __expf(bl[ks][e] - bc[mt][ks][e]));
                        Kdt[(32 * ks + 8 * q + 4 + e) * VPITCH + 16 * mt + r] = f2bf(k1[e] * __expf(bl[ks][4 + e] - bc[mt][ks][4 + e]));
                    }
                }
        } else {
            const int hr = h8 - 4; const float l2g = ret_log2g(hr);
            if (r == 0) {
                const float d = exp2f(64.0f * l2g); const f32x4 dv = {d, d, d, d};
#pragma unroll
                for (int ks = 0; ks < 2; ++ks) { *(f32x4*)(DEC + (size_t)unit * 64 + 32 * ks + 8 * q) = dv; *(f32x4*)(DEC + (size_t)unit * 64 + 32 * ks + 8 * q + 4) = dv; }
            }
#pragma unroll
            for (int mt = 0; mt < 4; ++mt) {
                CFENCE();
                f32x4 o[4]; rope_tile(kf[mt][0], kf[mt][1], cosT, sinT, n * 64 + 16 * mt + r, q, o);
                const float sc = 0.125f * exp2f((float)(63 - (16 * mt + r)) * l2g);
#pragma unroll
                for (int e = 0; e < 4; ++e) {
                    Kdt[(8 * q + e) * VPITCH + 16 * mt + r] = f2bf(o[0][e] * sc); Kdt[(8 * q + 4 + e) * VPITCH + 16 * mt + r] = f2bf(o[1][e] * sc);
                    Kdt[(32 + 8 * q + e) * VPITCH + 16 * mt + r] = f2bf(o[2][e] * sc); Kdt[(32 + 8 * q + 4 + e) * VPITCH + 16 * mt + r] = f2bf(o[3][e] * sc);
                }
            }
        }
        bf16_t* outp = CT + (size_t)unit * 8192;
#pragma unroll 1
        for (int vh = 0; vh < 2; ++vh) {
            CFENCE();
            bf16x8 xv[8];
#pragma unroll
            for (int i = 0; i < 8; ++i) xv[i] = *(const bf16x8*)(P + (size_t)(i * 8 + (ln >> 3)) * NPROJ + vcol + vh * 64 + (ln & 7) * 8);
            LDS_FENCE();
#pragma unroll
            for (int i = 0; i < 8; ++i) {
                const int token = i * 8 + (ln >> 3), vv = (ln & 7) * 8;
#pragma unroll
                for (int e = 0; e < 8; ++e) Vt[(vv + e) * VPITCH + token] = (bf16_t)xv[i][e];
            }
            LDS_FENCE();
#pragma unroll
            for (int vt = 0; vt < 4; ++vt) {
                CFENCE();
                bf16x8 a[2];
#pragma unroll
                for (int s = 0; s < 2; ++s) a[s] = *(const LAS bf16x8*)(Vt + (16 * vt + r) * VPITCH + 32 * s + 8 * q);
#pragma unroll
                for (int dt = 0; dt < 4; ++dt) {
                    f32x4 acc = {0.f, 0.f, 0.f, 0.f};
#pragma unroll
                    for (int s = 0; s < 2; ++s) { const bf16x8 bb = *(const LAS bf16x8*)(Kdt + (16 * dt + r) * VPITCH + 32 * s + 8 * q); acc = MFMA16(a[s], bb, acc); }
#pragma unroll
                    for (int e = 0; e < 4; ++e) outp[(vh * 64 + 16 * vt + 4 * q + e) * 64 + 16 * dt + r] = f2bf(acc[e]);
                }
            }
        }
    }
}

__device__ __forceinline__ void chunk_scan(const Params& p, int G) {
    unsigned char* ws = p.ws; bf16_t* CT = (bf16_t*)(ws + WS_A2); const float* DEC = (const float*)(ws + WS_DEC);
    const int NGT = G * NTHREADS;
    for (int o = blockIdx.x * NTHREADS + threadIdx.x; o < 32 * 128 * 16; o += NGT) {
        const int d4 = o & 15, v = (o >> 4) & 127, bh = o >> 11;
        bf16_t* base = CT + (size_t)bh * NCHUNK * 8192 + v * 64 + d4 * 4; const float* dbase = DEC + (size_t)bh * NCHUNK * 64 + d4 * 4;
        f32x4 s = {0.f, 0.f, 0.f, 0.f};
#pragma unroll 1
        for (int n0 = 0; n0 < NCHUNK; n0 += 16) {
            u32x2 uu[16]; f32x4 dd[16];
#pragma unroll
            for (int j = 0; j < 16; ++j) { uu[j] = *(const u32x2*)(base + (size_t)(n0 + j) * 8192); dd[j] = *(const f32x4*)(dbase + (size_t)(n0 + j) * 64); }
#pragma unroll
            for (int j = 0; j < 16; ++j) {
                u32x2 w; w.x = cvtpk(s[0], s[1]); w.y = cvtpk(s[2], s[3]);
                *(u32x2*)(base + (size_t)(n0 + j) * 8192) = w;
                f32x4 c; c[0] = __uint_as_float(uu[j].x << 16); c[1] = __uint_as_float(uu[j].x & 0xffff0000u); c[2] = __uint_as_float(uu[j].y << 16); c[3] = __uint_as_float(uu[j].y & 0xffff0000u);
                s = dd[j] * s + c;
            }
        }
    }
}

template <bool GN> __device__ __forceinline__ void norm_gate_store(const f32x4 (&O)[8], const unsigned short (&gt)[8][4], const float (&gn)[8], int it, int r, int q, bf16_t* y) {
    f32x4 mean = {0.f, 0.f, 0.f, 0.f};
    if (GN) {
        f32x4 s = {0.f, 0.f, 0.f, 0.f};
#pragma unroll
        for (int vt = 0; vt < 8; ++vt) s += O[vt];
#pragma unroll
        for (int e = 0; e < 4; ++e) { float t = s[e]; t += __shfl_xor(t, 1); t += __shfl_xor(t, 2); t += __shfl_xor(t, 4); t += __shfl_xor(t, 8); mean[e] = t * (1.0f / 128.0f); }
    }
    f32x4 ss = {0.f, 0.f, 0.f, 0.f};
#pragma unroll
    for (int vt = 0; vt < 8; ++vt) { const f32x4 d = O[vt] - mean; ss += d * d; }
    f32x4 rstd;
#pragma unroll
    for (int e = 0; e < 4; ++e) { float t = ss[e]; t += __shfl_xor(t, 1); t += __shfl_xor(t, 2); t += __shfl_xor(t, 4); t += __shfl_xor(t, 8); rstd[e] = __builtin_amdgcn_rsqf(t * (1.0f / 128.0f) + 1e-6f); }
#pragma unroll
    for (int vt = 0; vt < 8; ++vt) {
        const int v = 16 * vt + r;
#pragma unroll
        for (int e = 0; e < 4; ++e) {
            const int i = 16 * it + 4 * q + e;
            const float g = bf2f(gt[vt][e]);
            const float sil = g * __builtin_amdgcn_rcpf(1.0f + __expf(-g));
            y[(size_t)i * DM + v] = f2bf((O[vt][e] - mean[e]) * rstd[e] * gn[vt] * sil);
        }
    }
}
__device__ __forceinline__ void out_tile(f32x4 (&O)[8], const bf16x8 (&pf)[2], const bf16x8 (&qi)[2], const LAS bf16_t* Vt, const bf16x8 (&spf)[8][2], int r, int q) {
#pragma unroll
    for (int vt = 0; vt < 8; ++vt) {
        f32x4 acc = {0.f, 0.f, 0.f, 0.f};
#pragma unroll
        for (int s = 0; s < 2; ++s) {
            const u32x2 lo = *(const LAS u32x2*)(Vt + (16 * vt + r) * VPITCH + 32 * s + 4 * q), hi = *(const LAS u32x2*)(Vt + (16 * vt + r) * VPITCH + 32 * s + 16 + 4 * q);
            const u32x4 w = {lo.x, lo.y, hi.x, hi.y};
            acc = MFMA16(pf[s], __builtin_bit_cast(bf16x8, w), acc);
        }
#pragma unroll
        for (int ks = 0; ks < 2; ++ks) acc = MFMA16(qi[ks], spf[vt][ks], acc);
        O[vt] = acc;
    }
}
template <bool GN> __device__ __forceinline__ void out_all(const bf16x8 (&pfa)[4][2], const bf16x8 (&QI)[4][2], const LAS bf16_t* Vt, const bf16_t* SP, const float* gain, const bf16_t* gate, bf16_t* y, int r, int q) {
    bf16x8 spf[8][2]; float gn[8];
#pragma unroll
    for (int vt = 0; vt < 8; ++vt) {
        gn[vt] = gain[16 * vt + r];
#pragma unroll
        for (int ks = 0; ks < 2; ++ks) spf[vt][ks] = *(const bf16x8*)(SP + (16 * vt + r) * 64 + 32 * ks + 8 * q);
    }
#pragma unroll
    for (int it = 0; it < 4; ++it) {
        CFENCE();
        unsigned short gt[8][4];
#pragma unroll
        for (int vt = 0; vt < 8; ++vt)
#pragma unroll
            for (int e = 0; e < 4; ++e) gt[vt][e] = gate[(size_t)(16 * it + 4 * q + e) * NPROJ + 16 * vt + r];
        CFENCE();
        f32x4 O[8];
        out_tile(O, pfa[it], QI[it], Vt, spf, r, q);
        CFENCE();
        norm_gate_store<GN>(O, gt, gn, it, r, q, y);
    }
}

__device__ __forceinline__ void chunk_output(const Params& p, LAS unsigned char* lds, int G) {
    const int tid = threadIdx.x, lane = tid & 63, wave = __builtin_amdgcn_readfirstlane(tid >> 6);
    unsigned char* ws = p.ws;
    const bf16_t* PROJ = (const bf16_t*)(ws + WS_BIG); const bf16_t* SPB = (const bf16_t*)(ws + WS_A2); bf16_t* Y = (bf16_t*)(ws + WS_A1);
    const float* cosT = (const float*)(ws + WS_COS); const float* sinT = (const float*)(ws + WS_SIN);
    LAS bf16_t* Vt = (LAS bf16_t*)(lds + wave * WAVE_LDS);
    for (int u = blockIdx.x * NWAVES + wave; u < NBATCH * NCHUNK * 8; u += G * NWAVES) {
        int h8 = u & 7; asm volatile("" : "+s"(h8));
        const int bn = u >> 3, b = bn >> 7, n = bn & 127;
        const size_t tok0 = (size_t)b * SEQ + (size_t)n * 64;
        const bf16_t* P = PROJ + tok0 * NPROJ;
        const int unit = (b * 8 + h8) * NCHUNK + n;
        const bf16_t* SP = SPB + (size_t)unit * 8192;
        int ln = lane; asm volatile("" : "+v"(ln));
        const int r = ln & 15, q = ln >> 4;
        const int vcol = (h8 < 4) ? C_GV + h8 * 128 : C_RV + (h8 - 4) * 128;
        LDS_FENCE();
        {
            bf16x8 xv[16];
#pragma unroll
            for (int i = 0; i < 16; ++i) xv[i] = *(const bf16x8*)(P + (size_t)(i * 4 + q) * NPROJ + vcol + r * 8);
            CFENCE();
#pragma unroll
            for (int i = 0; i < 16; ++i) {
                const int token = i * 4 + q, vv = r * 8;
#pragma unroll
                for (int e = 0; e < 8; ++e) Vt[(vv + e) * VPITCH + token] = (bf16_t)xv[i][e];
            }
        }
        LDS_FENCE();
        CFENCE();
#ifdef NO_GLA4
        if (false) {
#else
        if (h8 < 4) {
#endif
            const int h = h8;
            bf16x8 Qe[4][2], Qi[4][2], Ki[4][2], Ke[4][2], pfa[4][2];
            {
                bf16x8 qf[4][2], kf[4][2];
#pragma unroll
                for (int mt = 0; mt < 4; ++mt)
#pragma unroll
                    for (int ks = 0; ks < 2; ++ks) {
                        qf[mt][ks] = *(const bf16x8*)(P + (size_t)(16 * mt + r) * NPROJ + C_GQ + h * 64 + 32 * ks + 8 * q);
                        kf[mt][ks] = *(const bf16x8*)(P + (size_t)(16 * mt + r) * NPROJ + C_GK + h * 64 + 32 * ks + 8 * q);
                    }
                float bc[4][2][8], bl[2][8];
                gla_gates(P, C_Z + h * 64, p.gla_b_gate + h * 64, r, q, bc, bl);
#pragma unroll
                for (int mt = 0; mt < 4; ++mt)
#pragma unroll
                    for (int ks = 0; ks < 2; ++ks) {
                        CFENCE();
                        f32x4 q0, q1, k0, k1; unpack8(qf[mt][ks], q0, q1); unpack8(kf[mt][ks], k0, k1);
                        f32x4 e0, e1, i0, i1;
#pragma unroll
                        for (int e = 0; e < 4; ++e) { e0[e] = __expf(bc[mt][ks][e]); e1[e] = __expf(bc[mt][ks][4 + e]); i0[e] = __expf(-bc[mt][ks][e]); i1[e] = __expf(-bc[mt][ks][4 + e]); }
                        Qe[mt][ks] = pack8(q0 * e0 * 0.125f, q1 * e1 * 0.125f); Qi[mt][ks] = pack8(q0 * i0 * 0.125f, q1 * i1 * 0.125f);
                        Ki[mt][ks] = pack8(k0 * i0, k1 * i1); Ke[mt][ks] = pack8(k0 * e0, k1 * e1);
                    }
            }
#pragma unroll
            for (int it = 0; it < 4; ++it) {
                f32x4 Pt[4];
#pragma unroll
                for (int jt = 0; jt < 4; ++jt) {
                    f32x4 lo = {0.f, 0.f, 0.f, 0.f}, up = {0.f, 0.f, 0.f, 0.f};
                    if (jt <= it) { lo = MFMA16(Ki[jt][0], Qe[it][0], lo); lo = MFMA16(Ki[jt][1], Qe[it][1], lo); }
                    if (jt >= it) { up = MFMA16(Ke[jt][0], Qi[it][0], up); up = MFMA16(Ke[jt][1], Qi[it][1], up); }
                    if (jt < it) Pt[jt] = lo; else if (jt > it) Pt[jt] = up;
                    else {
#pragma unroll
                        for (int e = 0; e < 4; ++e) Pt[jt][e] = (4 * q + e <= r) ? lo[e] : up[e];
                    }
                }
                pfa[it][0] = pack8(Pt[0], Pt[1]); pfa[it][1] = pack8(Pt[2], Pt[3]);
                CFENCE();
            }
            out_all<false>(pfa, Qe, Vt, SP, p.gla_norm_g + h * 128, P + C_GG + h * 128, Y + tok0 * DM + h * 128, r, q);
        }
#ifdef NO_RET4
        else if (false) {
#else
        else {
#endif
            const int hr = h8 - 4; const float l2g = ret_log2g(hr);
            bf16x8 Qr[4][2], Qd[4][2], Kr[4][2], pfa[4][2];
            {
                bf16x8 qf[4][2], kf[4][2];
#pragma unroll
                for (int mt = 0; mt < 4; ++mt)
#pragma unroll
                    for (int ks = 0; ks < 2; ++ks) {
                        qf[mt][ks] = *(const bf16x8*)(P + (size_t)(16 * mt + r) * NPROJ + C_RQ + hr * 64 + 32 * ks + 8 * q);
                        kf[mt][ks] = *(const bf16x8*)(P + (size_t)(16 * mt + r) * NPROJ + C_RK + hr * 64 + 32 * ks + 8 * q);
                    }
#pragma unroll
                for (int mt = 0; mt < 4; ++mt) {
                    const int pos = n * 64 + 16 * mt + r;
                    CFENCE();
                    {
                        f32x4 o[4]; rope_tile(qf[mt][0], qf[mt][1], cosT, sinT, pos, q, o);
                        Qr[mt][0] = pack8(o[0], o[1]); Qr[mt][1] = pack8(o[2], o[3]);
                        const float qd = exp2f((float)(16 * mt + r + 1) * l2g);
                        Qd[mt][0] = pack8(o[0] * qd, o[1] * qd); Qd[mt][1] = pack8(o[2] * qd, o[3] * qd);
                    }
                    CFENCE();
                    {
                        f32x4 o[4]; rope_tile(kf[mt][0], kf[mt][1], cosT, sinT, pos, q, o);
                        Kr[mt][0] = pack8(o[0] * 0.125f, o[1] * 0.125f); Kr[mt][1] = pack8(o[2] * 0.125f, o[3] * 0.125f);
                    }
                }
            }
#pragma unroll
            for (int it = 0; it < 4; ++it) {
                f32x4 Pt[4];
#pragma unroll
                for (int jt = 0; jt < 4; ++jt) {
                    f32x4 st = {0.f, 0.f, 0.f, 0.f};
                    st = MFMA16(Kr[jt][0], Qr[it][0], st); st = MFMA16(Kr[jt][1], Qr[it][1], st);
#pragma unroll
                    for (int e = 0; e < 4; ++e) { const int dj = (16 * it + r) - (16 * jt + 4 * q + e); Pt[jt][e] = st[e] * exp2f((float)(dj < 0 ? -dj : dj) * l2g); }
                }
                pfa[it][0] = pack8(Pt[0], Pt[1]); pfa[it][1] = pack8(Pt[2], Pt[3]);
                CFENCE();
            }
            out_all<true>(pfa, Qd, Vt, SP, p.ret_norm_g + hr * 128, P + C_RG + hr * 128, Y + tok0 * DM + 512 + hr * 128, r, q);
        }
    }
}

__device__ __forceinline__ void stage_image(LAS unsigned char* lds, const bf16_t* src, int tid) {
#pragma unroll
    for (int i = 0; i < 16; ++i) { const int row = (tid >> 5) + 16 * i, c = tid & 31; const u32x4 x = *(const u32x4*)(src + (size_t)row * 256 + c * 8); *(LAS u32x4*)(lds + row * APITCH + c * 16) = x; }
}
__device__ __forceinline__ void cross_attention(const Params& p, LAS unsigned char* lds, int G) {
    const int tid = threadIdx.x, lane = tid & 63, wave = __builtin_amdgcn_readfirstlane(tid >> 6);
    unsigned char* ws = p.ws;
    const bf16_t* Q = (const bf16_t*)(ws + WS_A1); const bf16_t* Kb = (const bf16_t*)(ws + WS_KB); const bf16_t* Vtg = (const bf16_t*)(ws + WS_VT); bf16_t* OA = (bf16_t*)(ws + WS_BIG);
    for (int u = blockIdx.x; u < 512; u += G) {
        const int bh = u >> 5, b = bh >> 2, h = bh & 3, qb = u & 31;
        int r = lane & 15, q = lane >> 4; asm volatile("" : "+v"(r), "+v"(q));
        __syncthreads();
        {
#pragma unroll
            for (int i = 0; i < 16; ++i) { const int row = (tid >> 5) + 16 * i, c = tid & 31; const u32x4 x = *(const u32x4*)(Kb + (size_t)(b * 256 + row) * 1024 + h * 256 + c * 8); *(LAS u32x4*)(lds + row * APITCH + c * 16) = x; }
        }
        __syncthreads();
        bf16x8 pf[2][8];
#pragma unroll
        for (int it = 0; it < 2; ++it) {
            const size_t i0 = (size_t)b * SEQ + qb * 256 + wave * 32 + 16 * it;
            bf16x8 Qf[8];
#pragma unroll
            for (int ks = 0; ks < 8; ++ks) Qf[ks] = *(const bf16x8*)(Q + (i0 + r) * DM + h * 256 + 32 * ks + 8 * q);
            f32x4 S[16];
#pragma unroll
            for (int mt = 0; mt < 16; ++mt) {
                f32x4 acc = {0.f, 0.f, 0.f, 0.f};
                CFENCE();
#pragma unroll
                for (int ks = 0; ks < 8; ++ks) { const bf16x8 a = *(const LAS bf16x8*)(lds + (16 * mt + r) * APITCH + (32 * ks + 8 * q) * 2); acc = MFMA16(a, Qf[ks], acc); }
                S[mt] = acc;
            }
            CFENCE();
            float mx = -3.0e38f;
#pragma unroll
            for (int mt = 0; mt < 16; ++mt) mx = fmaxf(fmaxf(fmaxf(S[mt][0], S[mt][1]), fmaxf(S[mt][2], S[mt][3])), mx);
            mx = fmaxf(mx, __shfl_xor(mx, 16)); mx = fmaxf(mx, __shfl_xor(mx, 32));
            CFENCE();
            float sum = 0.f;
#pragma unroll
            for (int mt = 0; mt < 16; ++mt) {
#pragma unroll
                for (int e = 0; e < 4; ++e) { S[mt][e] = __builtin_amdgcn_exp2f(S[mt][e] - mx); sum += S[mt][e]; }
                CFENCE();
            }
            sum += __shfl_xor(sum, 16); sum += __shfl_xor(sum, 32);
            const float inv = 1.0f / sum;
            CFENCE();
#pragma unroll
            for (int s = 0; s < 8; ++s) { pf[it][s] = pack8(S[2 * s] * inv, S[2 * s + 1] * inv); CFENCE(); }
        }
        __syncthreads();
        stage_image(lds, Vtg + (size_t)(b * 1024 + h * 256) * 256, tid);
        __syncthreads();
#pragma unroll
        for (int it = 0; it < 2; ++it) {
            const size_t i0 = (size_t)b * SEQ + qb * 256 + wave * 32 + 16 * it;
#pragma unroll
            for (int nt = 0; nt < 16; ++nt) {
                f32x4 acc = {0.f, 0.f, 0.f, 0.f};
                CFENCE();
#pragma unroll
                for (int s = 0; s < 8; ++s) {
                    const u32x2 lo = *(const LAS u32x2*)(lds + (16 * nt + r) * APITCH + (32 * s + 4 * q) * 2), hi = *(const LAS u32x2*)(lds + (16 * nt + r) * APITCH + (32 * s + 16 + 4 * q) * 2);
                    const u32x4 w = {lo.x, lo.y, hi.x, hi.y};
                    acc = MFMA16(pf[it][s], __builtin_bit_cast(bf16x8, w), acc);
                }
#pragma unroll
                for (int e = 0; e < 4; ++e) OA[(i0 + 4 * q + e) * DM + h * 256 + 16 * nt + r] = f2bf(acc[e]);
            }
        }
    }
}

__device__ __forceinline__ void final_norm(const Params& p, int G) {
    const int lane = threadIdx.x & 63, wave = __builtin_amdgcn_readfirstlane(threadIdx.x >> 6);
    const bf16_t* H = (const bf16_t*)(p.ws + WS_A2); const float* SSQ = (const float*)(p.ws + WS_SSQ3);
    const f32x4 g0 = *(const f32x4*)(p.final_norm_g + lane * 8), g1 = *(const f32x4*)(p.final_norm_g + lane * 8 + 4), g2 = *(const f32x4*)(p.final_norm_g + 512 + lane * 8), g3 = *(const f32x4*)(p.final_norm_g + 512 + lane * 8 + 4);
    for (int m = blockIdx.x * NWAVES + wave; m < NTOK; m += G * NWAVES) {
        const bf16x8 h0 = *(const bf16x8*)(H + (size_t)m * DM + lane * 8), h1 = *(const bf16x8*)(H + (size_t)m * DM + 512 + lane * 8);
        const f32x4 s0 = *(const f32x4*)(SSQ + (size_t)m * 16), s1 = *(const f32x4*)(SSQ + (size_t)m * 16 + 4), s2 = *(const f32x4*)(SSQ + (size_t)m * 16 + 8), s3 = *(const f32x4*)(SSQ + (size_t)m * 16 + 12);
        const f32x4 st = (s0 + s1) + (s2 + s3);
        const float rstd = 1.0f / sqrtf(((st[0] + st[1]) + (st[2] + st[3])) * (1.0f / 1024.0f) + 1e-6f);
        f32x4 a0, a1, b0, b1; unpack8(h0, a0, a1); unpack8(h1, b0, b1);
        float* o = p.out + (size_t)m * DM + lane * 8;
        *(f32x4*)(o) = a0 * rstd * g0; *(f32x4*)(o + 4) = a1 * rstd * g1; *(f32x4*)(o + 512) = b0 * rstd * g2; *(f32x4*)(o + 516) = b1 * rstd * g3;
    }
}

constexpr int NPHASE = 12;
__global__ void __launch_bounds__(NTHREADS, 2) fwd_megakernel(Params p) {
    extern __shared__ __attribute__((aligned(16))) unsigned char lds_raw[];
    LAS unsigned char* lds = (LAS unsigned char*)lds_raw;
    cg::grid_group grid = cg::this_grid();
    const int G = gridDim.x, lo = p.ph_lo, hi = p.ph_hi;
    unsigned char* ws = p.ws;
#define IN(k) (lo <= (k) && (k) < hi)
#define SEAM(k) do { if (IN(k) && IN((k) + 1)) { if ((k) == 0) { asm volatile("s_waitcnt vmcnt(0) lgkmcnt(0)" ::: "memory"); grid.sync(); __builtin_amdgcn_fence(__ATOMIC_ACQUIRE, "agent"); asm volatile("s_waitcnt vmcnt(0)" ::: "memory"); } \
    else xcd_barrier(bar); } } while (0)
    LAS unsigned* misc = (LAS unsigned*)(lds + MISC_OFF);
    if (threadIdx.x < 16) misc[threadIdx.x] = 0u;
    __syncthreads();
    XcdBarrier bar; bar.bar = (unsigned*)(ws + WS_CTL); bar.x = 0; bar.st = nullptr;
    if (hi - lo > 1) bar = xcd_barrier_post((unsigned*)(ws + WS_CTL), (volatile LAS unsigned*)misc);
#ifndef NO_P0
    if (IN(0)) { p0_prologue(p, lds, G); }
#endif
#if defined(DBG_REP) && DBG_REP == 0
    __syncthreads(); if (IN(0)) { p0_prologue(p, lds, G); }
#endif
    SEAM(0);
    if (IN(1)) {
        {
            pg8::Gemm g{(const bf16_t*)(ws + WS_A1), (const bf16_t*)(ws + WS_WIN), NTOK, NPROJ, DM}; pg8::StaticOrder S; S.init(NTOK, NPROJ, G, (int)blockIdx.x);
            pg8::EpiBf16<0> E{(bf16_t*)(ws + WS_BIG), NPROJ, nullptr, 0, 0, 1.f};
            pg8::gemm_phase<pg8::EpiBf16<0>, pg8::StaticOrder, true, true>(lds, g, S, E);
        }
        __syncthreads();
        {
            pg8::Gemm g{(const bf16_t*)(ws + WS_MEMN), (const bf16_t*)(ws + WS_WKV), NMEMROWS, 2048, DM}; pg8::StaticOrder S; S.init(NMEMROWS, 2048, G, (int)((blockIdx.x + G / 2) % G));
            pg8::EpiKV E{(bf16_t*)(ws + WS_KB), (bf16_t*)(ws + WS_VT)};
            pg8::gemm_phase<pg8::EpiKV, pg8::StaticOrder, true, true>(lds, g, S, E);
        }
        __syncthreads();
    } SEAM(1);
    #ifndef NO_P2
    if (IN(2)) { chunk_contrib(p, lds, G); }
#endif
#if defined(DBG_REP) && DBG_REP == 2
    __syncthreads(); if (IN(2)) { chunk_contrib(p, lds, G); }
#endif
    SEAM(2);
    if (IN(3)) { chunk_scan(p, G); } SEAM(3);
    #ifndef NO_P4
    if (IN(4)) { chunk_output(p, lds, G); }
#endif
#if defined(DBG_REP) && DBG_REP == 4
    __syncthreads(); if (IN(4)) { chunk_output(p, lds, G); }
#endif
    SEAM(4);
    if (IN(5)) {
        pg8::Gemm g{(const bf16_t*)(ws + WS_A1), (const bf16_t*)(ws + WS_WOUT), NTOK, DM, DM}; pg8::StaticOrder S; S.init(NTOK, DM, G, (int)blockIdx.x);
        pg8::EpiRes<false> E{p.x, (bf16_t*)(ws + WS_A2), (float*)(ws + WS_SSQ1)};
        pg8::gemm_phase<pg8::EpiRes<false>, pg8::StaticOrder, true, true>(lds, g, S, E);
        __syncthreads();
    } SEAM(5);
    if (IN(6)) {
        pg8::Gemm g{(const bf16_t*)(ws + WS_A2), (const bf16_t*)(ws + WS_WQ), NTOK, DM, DM}; pg8::StaticOrder S; S.init(NTOK, DM, G, (int)blockIdx.x);
        pg8::EpiScale<0> E{(bf16_t*)(ws + WS_A1), DM, (const float*)(ws + WS_SSQ1), 0.0625f * 1.4426950408889634f};
        pg8::gemm_phase<pg8::EpiScale<0>, pg8::StaticOrder, true, true>(lds, g, S, E);
        __syncthreads();
    } SEAM(6);
#ifndef NO_P7
    if (IN(7)) { cross_attention(p, lds, G); __syncthreads(); }
#endif
#if defined(DBG_REP) && DBG_REP == 7
    if (IN(7)) { cross_attention(p, lds, G); __syncthreads(); }
#endif
    SEAM(7);
    if (IN(8)) {
        pg8::Gemm g{(const bf16_t*)(ws + WS_BIG), (const bf16_t*)(ws + WS_WO), NTOK, DM, DM}; pg8::StaticOrder S; S.init(NTOK, DM, G, (int)blockIdx.x);
        pg8::EpiRes<true> E{(const void*)(ws + WS_A2), (bf16_t*)(ws + WS_A1), (float*)(ws + WS_SSQ2)};
        pg8::gemm_phase<pg8::EpiRes<true>, pg8::StaticOrder, true, true>(lds, g, S, E);
        __syncthreads();
    } SEAM(8);
    if (IN(9)) {
        pg8::Gemm g{(const bf16_t*)(ws + WS_A1), (const bf16_t*)(ws + WS_W1), NTOK, DFF, DM}; pg8::StaticOrder S; S.init(NTOK, DFF, G, (int)blockIdx.x);
        pg8::EpiScale<1> E{(bf16_t*)(ws + WS_BIG), DFF, (const float*)(ws + WS_SSQ2), 1.0f};
        pg8::gemm_phase<pg8::EpiScale<1>, pg8::StaticOrder, true, true>(lds, g, S, E);
        __syncthreads();
    } SEAM(9);
    if (IN(10)) {
        pg8::Gemm g{(const bf16_t*)(ws + WS_BIG), (const bf16_t*)(ws + WS_W2), NTOK, DM, DFF}; pg8::StaticOrder S; S.init(NTOK, DM, G, (int)blockIdx.x);
        pg8::EpiRes<true> E{(const void*)(ws + WS_A1), (bf16_t*)(ws + WS_A2), (float*)(ws + WS_SSQ3)};
        pg8::gemm_phase<pg8::EpiRes<true>, pg8::StaticOrder, true, true>(lds, g, S, E);
        __syncthreads();
    } SEAM(10);
    if (IN(11)) { final_norm(p, G); }
#undef IN
#undef SEAM
}

#ifndef MK_PER_PHASE
#define MK_PER_PHASE 0
#endif
#ifdef DBG_DUMP_OFF
__global__ void dump_kernel(const bf16_t* src, size_t n, float* out) {
    for (size_t i = (size_t)blockIdx.x * blockDim.x + threadIdx.x; i < (size_t)NTOK * DM; i += (size_t)gridDim.x * blockDim.x) {
        float s = 0.f; for (size_t j = i; j < n; j += (size_t)NTOK * DM) s += bf2f(src[j]); out[i] = s; }
}
#endif
extern "C" void kernel_launch(void* const* d_in, const int* in_sizes, int n_in, void* d_out, int out_size, void* d_ws, size_t ws_size, hipStream_t stream) {
    static int grid = 0;
    if (grid == 0) {
        if (n_in != 18 || ws_size < WS_NEED) { fprintf(stderr, "kernel_launch: expected 18 inputs and >= %zu bytes of workspace (got %d, %zu)\n", (size_t)WS_NEED, n_in, ws_size); grid = -1; return; }
        int dev = 0, cus = 0, per_cu = 0;
        (void)hipGetDevice(&dev); (void)hipDeviceGetAttribute(&cus, hipDeviceAttributeMultiprocessorCount, dev);
        if (hipFuncSetAttribute((const void*)fwd_megakernel, hipFuncAttributeMaxDynamicSharedMemorySize, LDS_BYTES) != hipSuccess) { fprintf(stderr, "kernel_launch: hipFuncSetAttribute failed\n"); grid = -1; return; }
        if (hipOccupancyMaxActiveBlocksPerMultiprocessor(&per_cu, (const void*)fwd_megakernel, NTHREADS, LDS_BYTES) != hipSuccess || per_cu < 1) { fprintf(stderr, "kernel_launch: occupancy query failed (%d)\n", per_cu); (void)hipGetLastError(); grid = -1; return; }
        grid = cus * per_cu;
    }
    if (grid < 0) return;
    Params p{};
    const float** pp = (const float**)&p;
    for (int i = 0; i < 18; ++i) pp[i] = (const float*)d_in[i];
    p.out = (float*)d_out; p.ws = (unsigned char*)d_ws;
#if MK_PER_PHASE
#ifndef DBG_HI
#define DBG_HI NPHASE
#endif
    for (int k = 0; k < DBG_HI; ++k) { p.ph_lo = k; p.ph_hi = k + 1; hipLaunchKernelGGL(fwd_megakernel, dim3(grid), dim3(NTHREADS), LDS_BYTES, stream, p); }
#ifdef DBG_DUMP_OFF
    hipLaunchKernelGGL(dump_kernel, dim3(2048), dim3(256), 0, stream, (const bf16_t*)((unsigned char*)d_ws + (size_t)(DBG_DUMP_OFF) * MiB), (size_t)(DBG_DUMP_N), (float*)d_out);
#endif
#else
    p.ph_lo = 0; p.ph_hi = NPHASE;
    if (hipMemsetAsync((char*)d_ws + WS_CTL, 0, 16384, stream) != hipSuccess) { fprintf(stderr, "kernel_launch: hipMemsetAsync failed\n"); return; }
    void* args[] = {&p};
    const hipError_t e = hipLaunchCooperativeKernel((const void*)fwd_megakernel, dim3(grid), dim3(NTHREADS), args, LDS_BYTES, stream);
    if (e != hipSuccess) fprintf(stderr, "kernel_launch: cooperative launch failed: %s (grid %d)\n", hipGetErrorString(e), grid);
#endif
}
```

```cpp
#include <hip/hip_runtime.h>
#include <hip/hip_cooperative_groups.h>
#include <cstdio>
#include <cstdint>
namespace cg = cooperative_groups;
namespace pg8 {
#define PG8_LAS __attribute__((address_space(3)))
typedef unsigned short bf16_t;
typedef short bf16x8 __attribute__((ext_vector_type(8)));
typedef float f32x4 __attribute__((ext_vector_type(4)));
typedef unsigned u32x4 __attribute__((ext_vector_type(4)));
constexpr int BM = 256, BK = 64, HALF = 128, HTB = HALF * BK * 2  , STAGE_BYTES = 8 * HTB, NXCD = 8, WGM = 8;

__host__ __device__ __forceinline__ int lds_byte(int r, int c) { const int st = (r >> 4) * 2 + (c >> 5), rr = r & 15, cc = c & 31, ob = rr * 64 + cc * 2; return st * 1024 + (ob ^ (((ob >> 9) & 1) << 5)); }
__host__ __device__ __forceinline__ void stage_rc(int b, int& R, int& C) { const int st = b / 1024, sb = b % 1024, swz = sb ^ (((sb >> 9) & 1) << 5); R = (st >> 1) * 16 + swz / 64; C = (st & 1) * 32 + (swz % 64) / 2; }
__host__ __device__ __forceinline__ int perm32(int rho) { const int n = rho >> 4, i = rho & 15; return 8 * (i >> 2) + 4 * n + (i & 3); }

struct Unit { int pm, pn; };
struct Gemm { const bf16_t* A; const bf16_t* Bt; int M, N, K; };

struct StaticOrder {
    int nM, nN, nwg, G, c;
    __host__ __device__ void init(int M, int N, int G_, int c_) { nM = M / BM; nN = N / BM; nwg = nM * nN; G = G_; c = c_; }
    __host__ __device__ bool next(int i, Unit& u) const {
        const long L = (long)i * G + c; if (L >= nwg) return false;
        int wgid = (int)L; { const int q = nwg / NXCD, r = nwg % NXCD, xcd = wgid % NXCD, off = wgid / NXCD; wgid = (xcd < r ? xcd * (q + 1) : r * (q + 1) + (xcd - r) * q) + off; }
        const int nig = WGM * nN, gid = wgid / nig, fm = gid * WGM, gsz = (nM - fm) < WGM ? (nM - fm) : WGM;
        u.pm = fm + ((wgid % nig) % gsz); u.pn = (wgid % nig) / gsz; return true;
    }
    __device__ __forceinline__ void a_ready(const Unit&) const {}
    __device__ __forceinline__ void done(const Unit&) const {}
};

__device__ __forceinline__ unsigned cvt_pk_bf16(float lo, float hi) { unsigned r; asm volatile("v_cvt_pk_bf16_f32 %0, %1, %2" : "=v"(r) : "v"(lo), "v"(hi)); return r; }
typedef float f32x2 __attribute__((ext_vector_type(2)));
__device__ __forceinline__ f32x2 gelu_pk(f32x2 v) {
    const f32x2 av = __builtin_elementwise_abs(v), d = av * 0.2316418882f + 1.0f;
    f32x2 t; t.x = __builtin_amdgcn_rcpf(d.x); t.y = __builtin_amdgcn_rcpf(d.y);
    f32x2 q = t * 0.5307027145f + (-0.7265760135f); q = q * t + 0.7107068705f; q = q * t + (-0.142248368f); q = q * t + 0.127414796f; q = q * t;
    const f32x2 s = (v * v) * (-0.72134752044f);
    f32x2 e; e.x = __builtin_amdgcn_exp2f(s.x); e.y = __builtin_amdgcn_exp2f(s.y);
    const f32x2 m = v * (q * e), r = v - m;
    f32x2 o; o.x = v.x < 0.f ? m.x : r.x; o.y = v.y < 0.f ? m.y : r.y; return o;
}

template <int ACT  > struct EpiBf16 {
    static constexpr bool PERM = true, AFTER_DRAIN = false; static_assert(ACT == 0 || ACT == 1, "EpiBf16: ACT is 0 (none) or 1 (gelu_pk)");
    bf16_t* O; int ldc; const float* bias; int split_cols; size_t split_stride; float scale0;
    __device__ __forceinline__ void operator()(const f32x4 (&acc)[2][2][4][2], const Unit& u, int wr, int wc, int fr, int fq) const {
        const int row0 = u.pm * BM + wr * 64 + fr; int colt = u.pn * BM; bf16_t* base = O;
        float sc = 1.f; if (split_cols) { const int t = colt / split_cols; base += (size_t)t * split_stride; colt -= t * split_cols; if (t == 0) sc = scale0; }
        const int col0 = colt + wc * 32 + 8 * fq, bcol0 = u.pn * BM + wc * 32 + 8 * fq;
        f32x4 bv[2][2];
#pragma unroll
        for (int bj = 0; bj < 2; ++bj)
#pragma unroll
            for (int n = 0; n < 2; ++n) bv[bj][n] = bias ? *(const f32x4*)(bias + bcol0 + bj * HALF + 4 * n) : (f32x4){0.f, 0.f, 0.f, 0.f};
#pragma unroll
        for (int ai = 0; ai < 2; ++ai)
#pragma unroll
            for (int m = 0; m < 4; ++m) { bf16_t* rowp = base + (size_t)(row0 + ai * HALF + m * 16) * ldc + col0;
#pragma unroll
                for (int bj = 0; bj < 2; ++bj) { f32x4 v0 = acc[ai][bj][m][0] + bv[bj][0], v1 = acc[ai][bj][m][1] + bv[bj][1];
                    if (ACT == 1) { f32x2 a = gelu_pk((f32x2){v0[0], v0[1]}), b = gelu_pk((f32x2){v0[2], v0[3]}), c = gelu_pk((f32x2){v1[0], v1[1]}), d = gelu_pk((f32x2){v1[2], v1[3]});
                        v0 = (f32x4){a.x, a.y, b.x, b.y}; v1 = (f32x4){c.x, c.y, d.x, d.y}; }
                    v0 = v0 * sc; v1 = v1 * sc; u32x4 w; w.x = cvt_pk_bf16(v0[0], v0[1]); w.y = cvt_pk_bf16(v0[2], v0[3]); w.z = cvt_pk_bf16(v1[0], v1[1]); w.w = cvt_pk_bf16(v1[2], v1[3]);
                    *(u32x4*)(rowp + bj * HALF) = w; } }
    }
};

struct PanelStats {
    unsigned* xbuf;
    unsigned* cnt;
    unsigned* tmo;
    int ntn; float eps;
    unsigned code;
    __device__ __forceinline__ bool run(const f32x4 (&v)[2][2][4][2], const Unit& u, int wr, int wc, int fr, int fq, PG8_LAS unsigned char* lds, int wid, int lane) const {
        typedef float f32x2v __attribute__((ext_vector_type(2)));
        PG8_LAS f32x2v* P = (PG8_LAS f32x2v*)lds;
        PG8_LAS f32x2v* S = (PG8_LAS f32x2v*)(lds + 8192);
        PG8_LAS unsigned* flag = (PG8_LAS unsigned*)(lds + 8192 + 2048);
#pragma unroll
        for (int ai = 0; ai < 2; ++ai)
#pragma unroll
            for (int m = 0; m < 4; ++m) {
                float s = 0.f;
#pragma unroll
                for (int bj = 0; bj < 2; ++bj)
#pragma unroll
                    for (int n = 0; n < 2; ++n) { const f32x4 x = v[ai][bj][m][n]; s += (x[0] + x[1]) + (x[2] + x[3]); }
                s += __shfl_xor(s, 16); s += __shfl_xor(s, 32);
                const float mw = s * (1.0f / 64.0f); float q = 0.f;
#pragma unroll
                for (int bj = 0; bj < 2; ++bj)
#pragma unroll
                    for (int n = 0; n < 2; ++n) { const f32x4 d = v[ai][bj][m][n] - mw; q += (d[0] * d[0] + d[1] * d[1]) + (d[2] * d[2] + d[3] * d[3]); }
                q += __shfl_xor(q, 16); q += __shfl_xor(q, 32);
                if (fq == 0) P[(ai * HALF + wr * 64 + m * 16 + fr) * 4 + wc] = (f32x2v){mw, q};
            }
        asm volatile("s_waitcnt lgkmcnt(0)" ::: "memory"); __builtin_amdgcn_s_barrier(); asm volatile("" ::: "memory");
#if defined(BROKEN_EXCHANGE_NO_WAIT)
#warning BROKEN CONTROL BUILD: the row-statistics exchange does not wait; results are wrong by design
        if (blockIdx.x >= 64) { const long long t0_ = clock64(); while (clock64() - t0_ < 60000) __builtin_amdgcn_s_sleep(8); }
#endif
        const int row = wid * 32 + (lane & 31);
        if (lane < 32) {
            const f32x2v a = P[row * 4 + 0], b = P[row * 4 + 1], c = P[row * 4 + 2], d = P[row * 4 + 3];
            const float mt = (a.x + b.x + c.x + d.x) * 0.25f;
            const float da = a.x - mt, db = b.x - mt, dc = c.x - mt, dd = d.x - mt;
            const float m2 = (a.y + b.y) + (c.y + d.y) + 64.0f * ((da * da + db * db) + (dc * dc + dd * dd));
            unsigned long long* slot = (unsigned long long*)xbuf + ((size_t)(u.pm * BM + row) * 4 + u.pn);
            __hip_atomic_store(slot, ((unsigned long long)__float_as_uint(m2) << 32) | __float_as_uint(mt), __ATOMIC_RELAXED, __HIP_MEMORY_SCOPE_AGENT);
        }
        asm volatile("s_waitcnt vmcnt(0)" ::: "memory");
        if (lane == 0) __hip_atomic_fetch_add(cnt + 64 * u.pm, 1u, __ATOMIC_RELAXED, __HIP_MEMORY_SCOPE_AGENT);
        if (wid == 0) {
            bool dead = false; const unsigned long long t0 = __builtin_amdgcn_s_memrealtime(); const unsigned want = 8u * (unsigned)ntn;
            for (;;) {
#if defined(BROKEN_EXCHANGE_NO_WAIT)
                break;
#endif
                if ((unsigned)__builtin_amdgcn_readfirstlane(__hip_atomic_load(cnt + 64 * u.pm, __ATOMIC_RELAXED, __HIP_MEMORY_SCOPE_AGENT)) >= want) break;
                if (__builtin_amdgcn_s_memrealtime() - t0 > 2000000ull) {
                    if (lane == 0) { unsigned expect = 0u; __hip_atomic_compare_exchange_strong(tmo + 1, &expect, code | (unsigned)(u.pm & 0xff), __ATOMIC_RELAXED, __ATOMIC_RELAXED, __HIP_MEMORY_SCOPE_AGENT);
                                     __hip_atomic_store(tmo, 1u, __ATOMIC_RELAXED, __HIP_MEMORY_SCOPE_AGENT); }
                    dead = true; break; }
                __builtin_amdgcn_s_sleep(2);
            }
            __builtin_amdgcn_fence(__ATOMIC_ACQUIRE, "agent");
            if (lane == 0) flag[0] = dead ? 1u : 0u;
        }
        asm volatile("s_waitcnt vmcnt(0) lgkmcnt(0)" ::: "memory"); __builtin_amdgcn_s_barrier(); asm volatile("" ::: "memory");
        const bool bad = flag[0] != 0u;
        if (lane < 32) {
            const unsigned long long* slot = (const unsigned long long*)xbuf + (size_t)(u.pm * BM + row) * 4; float mt[4], m2[4]; float ms = 0.f;
#pragma unroll
            for (int t = 0; t < 4; ++t) { if (t < ntn) { const unsigned long long w = __hip_atomic_load(slot + t, __ATOMIC_RELAXED, __HIP_MEMORY_SCOPE_AGENT); mt[t] = __uint_as_float((unsigned)w); m2[t] = __uint_as_float((unsigned)(w >> 32)); } else { mt[t] = 0.f; m2[t] = 0.f; } ms += mt[t]; }
            const float mean = ms / (float)ntn; float q = 0.f;
#pragma unroll
            for (int t = 0; t < 4; ++t) if (t < ntn) { const float dm = mt[t] - mean; q += m2[t] + 256.0f * dm * dm; }
            S[row] = (f32x2v){mean, 1.0f / sqrtf(q / (256.0f * (float)ntn) + eps)};
        }
        asm volatile("s_waitcnt lgkmcnt(0)" ::: "memory"); __builtin_amdgcn_s_barrier(); asm volatile("" ::: "memory");
        return bad;
    }
};
struct EpiLnRes {
    static constexpr bool PERM = false, AFTER_DRAIN = true;
    const float* base; float* out; int ldc; const float* bias; PanelStats st; unsigned poison;
    __device__ __forceinline__ void fused(f32x4 (&acc)[2][2][4][2], const Unit& u, int wr, int wc, int fr, int fq, PG8_LAS unsigned char* lds, int wid, int lane) const {
        typedef float f32x2v __attribute__((ext_vector_type(2)));
        const PG8_LAS f32x2v* S = (const PG8_LAS f32x2v*)(lds + 8192);
        const int col0 = u.pn * BM + wc * 32 + 4 * fq;
#pragma unroll
        for (int bj = 0; bj < 2; ++bj)
#pragma unroll
            for (int n = 0; n < 2; ++n) { const f32x4 bv = bias ? *(const f32x4*)(bias + col0 + bj * HALF + n * 16) : (f32x4){0.f, 0.f, 0.f, 0.f};
#pragma unroll
                for (int ai = 0; ai < 2; ++ai)
#pragma unroll
                    for (int m = 0; m < 4; ++m) acc[ai][bj][m][n] += bv; }
        f32x4 pre[4][2][2];
#pragma unroll
        for (int m = 0; m < 4; ++m) { const size_t off = (size_t)(u.pm * BM + wr * 64 + m * 16 + fr) * ldc + col0;
#pragma unroll
            for (int bj = 0; bj < 2; ++bj)
#pragma unroll
                for (int n = 0; n < 2; ++n) pre[m][bj][n] = *(const f32x4*)(base + off + bj * HALF + n * 16); }
        const bool bad = st.run(acc, u, wr, wc, fr, fq, lds, wid, lane) || poison != 0u;
        const float qnan = __builtin_nanf("");
#pragma unroll
        for (int ai = 0; ai < 2; ++ai)
#pragma unroll
            for (int m = 0; m < 4; ++m) { const int r = ai * HALF + wr * 64 + m * 16 + fr; const f32x2v sr = S[r]; const size_t off = (size_t)(u.pm * BM + r) * ldc + col0;
#pragma unroll
                for (int bj = 0; bj < 2; ++bj)
#pragma unroll
                    for (int n = 0; n < 2; ++n) { const f32x4 bs = ai == 0 ? pre[m][bj][n] : *(const f32x4*)(base + off + bj * HALF + n * 16); f32x4 o = bs + (acc[ai][bj][m][n] - sr.x) * sr.y;
                        if (bad) o = (f32x4){qnan, qnan, qnan, qnan}; *(f32x4*)(out + off + bj * HALF + n * 16) = o; }
                if (m & 1) asm volatile("" ::: "memory"); }
    }
};
struct EpiLnResLn {
    static constexpr bool PERM = false, AFTER_DRAIN = true;
    const float* base; float* out; bf16_t* xn; int ldc; const float* bias; PanelStats st1, st2; unsigned poison;
    __device__ __forceinline__ void fused(f32x4 (&acc)[2][2][4][2], const Unit& u, int wr, int wc, int fr, int fq, PG8_LAS unsigned char* lds, int wid, int lane) const {
        typedef float f32x2v __attribute__((ext_vector_type(2))); typedef unsigned u32x2v __attribute__((ext_vector_type(2)));
        const PG8_LAS f32x2v* S = (const PG8_LAS f32x2v*)(lds + 8192);
        const int col0 = u.pn * BM + wc * 32 + 4 * fq;
#pragma unroll
        for (int bj = 0; bj < 2; ++bj)
#pragma unroll
            for (int n = 0; n < 2; ++n) { const f32x4 bv = bias ? *(const f32x4*)(bias + col0 + bj * HALF + n * 16) : (f32x4){0.f, 0.f, 0.f, 0.f};
#pragma unroll
                for (int ai = 0; ai < 2; ++ai)
#pragma unroll
                    for (int m = 0; m < 4; ++m) acc[ai][bj][m][n] += bv; }
        bool bad = st1.run(acc, u, wr, wc, fr, fq, lds, wid, lane) || poison != 0u;
        const float qnan = __builtin_nanf("");
#pragma unroll
        for (int ai = 0; ai < 2; ++ai)
#pragma unroll
            for (int m = 0; m < 4; ++m) { const int r = ai * HALF + wr * 64 + m * 16 + fr; const f32x2v sr = S[r]; const size_t off = (size_t)(u.pm * BM + r) * ldc + col0;
#pragma unroll
                for (int bj = 0; bj < 2; ++bj)
#pragma unroll
                    for (int n = 0; n < 2; ++n) { const f32x4 bs = *(const f32x4*)(base + off + bj * HALF + n * 16); acc[ai][bj][m][n] = bs + (acc[ai][bj][m][n] - sr.x) * sr.y; }
                asm volatile("" : "+v"(acc[ai][0][m][0]), "+v"(acc[ai][0][m][1]), "+v"(acc[ai][1][m][0]), "+v"(acc[ai][1][m][1]));
                if (m & 1) asm volatile("" ::: "memory"); }
        const bool bad1 = bad;
        bad = st2.run(acc, u, wr, wc, fr, fq, lds, wid, lane) || bad;
#pragma unroll
        for (int ai = 0; ai < 2; ++ai)
#pragma unroll
            for (int m = 0; m < 4; ++m) { const int r = ai * HALF + wr * 64 + m * 16 + fr; const f32x2v sr = S[r]; const size_t off = (size_t)(u.pm * BM + r) * ldc + col0;
#pragma unroll
                for (int bj = 0; bj < 2; ++bj)
#pragma unroll
                    for (int n = 0; n < 2; ++n) { const f32x4 x1 = acc[ai][bj][m][n]; *(f32x4*)(out + off + bj * HALF + n * 16) = bad1 ? (f32x4){qnan, qnan, qnan, qnan} : x1;
                        const f32x4 o = (x1 - sr.x) * sr.y; u32x2v w; w.x = cvt_pk_bf16(o[0], o[1]); w.y = cvt_pk_bf16(o[2], o[3]);
                        if (bad) { w.x = 0x7fc07fc0u; w.y = 0x7fc07fc0u; } *(u32x2v*)(xn + off + bj * HALF + n * 16) = w; }
                asm volatile("" ::: "memory"); }
    }
};

template <class Epi, class Sched, bool ALIGN_EPI = false, bool SP2 = false>
__device__ __forceinline__ void gemm_phase(PG8_LAS unsigned char* lds, const Gemm g, const Sched& S, const Epi& E) {
    const int tid = threadIdx.x, wid = __builtin_amdgcn_readfirstlane(tid >> 6), lane = tid & 63, wr = wid >> 2, wc = wid & 3, fr = lane & 15, fq = lane >> 4;
    const int K = g.K, nt = K / BK;
    unsigned voffA[2], voffB[2];
#pragma unroll
    for (int i = 0; i < 2; ++i) { int R, C; stage_rc(tid * 16 + i * 8192, R, C); const int Rb = Epi::PERM ? ((R & ~31) + perm32(R & 31)) : R;
        voffA[i] = (unsigned)(R * K + C) * 2u; voffB[i] = (unsigned)(Rb * K + C) * 2u; }
    const size_t kstep = (size_t)(BK * 2);
    const size_t hstep = (size_t)HALF * K * 2;
    const size_t tstep = 2 * hstep;
    const unsigned ldsw = (unsigned)wid * 1024u;
    const int aoff = lds_byte(wr * 64 + fr, fq * 8), boff = lds_byte(wc * 32 + fr, fq * 8);
#define PG8_SA(b, h) (((b) * 2 + (h)) * HTB)
#define PG8_SB(b, h) ((4 + (b) * 2 + (h)) * HTB)
#define PG8_STAGE(bufoff, gbase, voff) do { _Pragma("unroll") for (int _i = 0; _i < 2; ++_i) \
        __builtin_amdgcn_global_load_lds((const unsigned*)((const char*)(gbase) + (voff)[_i]), (PG8_LAS unsigned*)(lds + (bufoff) + ldsw + _i * 8192), 16, 0, 0); } while (0)
#define PG8_LDA(dst, b, h) do { _Pragma("unroll") for (int m = 0; m < 4; ++m) _Pragma("unroll") for (int k = 0; k < 2; ++k) dst[m][k] = *(const PG8_LAS bf16x8*)(lds + PG8_SA(b, h) + aoff + m * 2048 + k * 1024); } while (0)
#define PG8_LDB(dst, b, h) do { _Pragma("unroll") for (int n = 0; n < 2; ++n) _Pragma("unroll") for (int k = 0; k < 2; ++k) dst[n][k] = *(const PG8_LAS bf16x8*)(lds + PG8_SB(b, h) + boff + n * 2048 + k * 1024); } while (0)
#define PG8_MMA(ai, bj, At, Bt) do { __builtin_amdgcn_s_setprio(1); _Pragma("unroll") for (int m = 0; m < 4; ++m) _Pragma("unroll") for (int n = 0; n < 2; ++n) _Pragma("unroll") for (int k = 0; k < 2; ++k) \
        acc[ai][bj][m][n] = __builtin_amdgcn_mfma_f32_16x16x32_bf16(Bt[n][k], At[m][k], acc[ai][bj][m][n], 0, 0, 0); __builtin_amdgcn_s_setprio(0); } while (0)
#define PG8_WAIT_V(n) asm volatile("s_waitcnt vmcnt(" #n ")" ::: "memory")
#define PG8_WAIT_L(n) asm volatile("s_waitcnt lgkmcnt(" #n ")" ::: "memory")
#define PG8_BAR __builtin_amdgcn_s_barrier()
#define PG8_SCHED __builtin_amdgcn_sched_barrier(0)
    Unit cur, nxt; int ui = 0;
    if (!S.next(0, cur)) return;
    f32x4 acc[2][2][4][2];
#pragma unroll
    for (int a = 0; a < 2; ++a)
#pragma unroll
        for (int b = 0; b < 2; ++b)
#pragma unroll
            for (int m = 0; m < 4; ++m)
#pragma unroll
                for (int n = 0; n < 2; ++n) acc[a][b][m][n] = (f32x4){0.f, 0.f, 0.f, 0.f};
    bf16x8 At[4][2], B0[2][2], B1[2][2];
    const char* cA = (const char*)g.A + (size_t)cur.pm * tstep; const char* cB = (const char*)g.Bt + (size_t)cur.pn * tstep;
    S.a_ready(cur);
    if constexpr (SP2) {
        PG8_STAGE(PG8_SB(0, 0), cB, voffB); PG8_STAGE(PG8_SB(0, 1), cB + hstep, voffB); PG8_STAGE(PG8_SA(0, 0), cA, voffA); PG8_STAGE(PG8_SA(0, 1), cA + hstep, voffA);
        if (wr == 1) PG8_BAR;
        PG8_WAIT_V(2); PG8_BAR;
        PG8_STAGE(PG8_SB(1, 0), cB + kstep, voffB); PG8_STAGE(PG8_SA(1, 0), cA + kstep, voffA); PG8_STAGE(PG8_SB(1, 1), cB + hstep + kstep, voffB);
        PG8_WAIT_V(6); PG8_BAR;
    } else {
        PG8_STAGE(PG8_SB(0, 0), cB, voffB); PG8_STAGE(PG8_SA(0, 0), cA, voffA); PG8_STAGE(PG8_SB(0, 1), cB + hstep, voffB); PG8_STAGE(PG8_SA(0, 1), cA + hstep, voffA);
        if (wr == 1) PG8_BAR;
        PG8_WAIT_V(4); PG8_BAR;
        PG8_STAGE(PG8_SB(1, 0), cB + kstep, voffB); PG8_STAGE(PG8_SA(1, 0), cA + kstep, voffA); PG8_STAGE(PG8_SB(1, 1), cB + hstep + kstep, voffB);
        PG8_WAIT_V(6); PG8_BAR;
    }
    for (;;) {
        const bool has_next = S.next(ui + 1, nxt);
        const char* nA = has_next ? (const char*)g.A + (size_t)nxt.pm * tstep : cA; const char* nB = has_next ? (const char*)g.Bt + (size_t)nxt.pn * tstep : cB;
        for (int t = 0; t < nt; t += 2) {
            const bool last = (t == nt - 2);
            const char* a1 = cA + (size_t)(t + 1) * kstep;
            const char* a2 = last ? nA : cA + (size_t)(t + 2) * kstep; const char* b2 = last ? nB : cB + (size_t)(t + 2) * kstep;
            const char* a3 = a2 + kstep; const char* b3 = b2 + kstep;
            if (last && has_next) S.a_ready(nxt);
            if constexpr (SP2) {
            PG8_LDB(B0, 0, 0); PG8_LDB(B1, 0, 1); PG8_SCHED; PG8_LDA(At, 0, 0); PG8_STAGE(PG8_SA(1, 1), a1 + hstep, voffA);
            PG8_WAIT_V(8); PG8_WAIT_L(0); PG8_BAR; PG8_MMA(0, 0, At, B0); PG8_MMA(0, 1, At, B1); PG8_BAR; PG8_SCHED;
            PG8_LDA(At, 0, 1); PG8_STAGE(PG8_SB(0, 0), b2, voffB); PG8_STAGE(PG8_SB(0, 1), b2 + hstep, voffB); PG8_STAGE(PG8_SA(0, 0), a2, voffA);
            PG8_WAIT_V(8); PG8_WAIT_L(0); PG8_BAR; PG8_MMA(1, 0, At, B0); PG8_MMA(1, 1, At, B1); PG8_BAR; PG8_SCHED;
            PG8_LDB(B0, 1, 0); PG8_LDB(B1, 1, 1); PG8_SCHED; PG8_LDA(At, 1, 0); PG8_STAGE(PG8_SA(0, 1), a2 + hstep, voffA);
            PG8_WAIT_V(8); PG8_WAIT_L(0); PG8_BAR; PG8_MMA(0, 0, At, B0); PG8_MMA(0, 1, At, B1); PG8_BAR; PG8_SCHED;
            PG8_LDA(At, 1, 1); PG8_STAGE(PG8_SB(1, 0), b3, voffB); PG8_STAGE(PG8_SB(1, 1), b3 + hstep, voffB); PG8_STAGE(PG8_SA(1, 0), a3, voffA);
            PG8_WAIT_V(8); PG8_WAIT_L(0); PG8_BAR; PG8_MMA(1, 0, At, B0); PG8_MMA(1, 1, At, B1); PG8_BAR; PG8_SCHED;
            } else {
            PG8_LDB(B0, 0, 0); PG8_SCHED; PG8_LDA(At, 0, 0); PG8_STAGE(PG8_SA(1, 1), a1 + hstep, voffA);
            PG8_WAIT_L(8); PG8_BAR; PG8_WAIT_L(0); PG8_MMA(0, 0, At, B0); PG8_BAR; PG8_SCHED;
            PG8_LDB(B1, 0, 1); PG8_STAGE(PG8_SB(0, 0), b2, voffB);
            PG8_BAR; PG8_WAIT_L(0); PG8_MMA(0, 1, At, B1); PG8_BAR;
            PG8_LDA(At, 0, 1); PG8_STAGE(PG8_SA(0, 0), a2, voffA);
            PG8_BAR; PG8_WAIT_L(0); PG8_MMA(1, 0, At, B0); PG8_BAR; PG8_SCHED;
            PG8_STAGE(PG8_SB(0, 1), b2 + hstep, voffB);
            PG8_WAIT_V(6); PG8_BAR; PG8_MMA(1, 1, At, B1); PG8_BAR;
            PG8_LDB(B0, 1, 0); PG8_SCHED; PG8_LDA(At, 1, 0); PG8_STAGE(PG8_SA(0, 1), a2 + hstep, voffA);
            PG8_WAIT_L(8); PG8_BAR; PG8_WAIT_L(0); PG8_MMA(0, 0, At, B0); PG8_BAR; PG8_SCHED;
            PG8_LDB(B1, 1, 1); PG8_STAGE(PG8_SB(1, 0), b3, voffB);
            PG8_BAR; PG8_WAIT_L(0); PG8_MMA(0, 1, At, B1); PG8_BAR;
            PG8_LDA(At, 1, 1); PG8_STAGE(PG8_SA(1, 0), a3, voffA);
            PG8_BAR; PG8_WAIT_L(0); PG8_MMA(1, 0, At, B0); PG8_BAR; PG8_SCHED;
            PG8_STAGE(PG8_SB(1, 1), b3 + hstep, voffB);
            PG8_WAIT_V(6); PG8_BAR; PG8_MMA(1, 1, At, B1); PG8_BAR;
            }
        }
        if constexpr (ALIGN_EPI) { if (wr == 0) PG8_BAR; }
        if constexpr (!Epi::AFTER_DRAIN) { E(acc, cur, wr, wc, fr, fq); S.done(cur); }
        if (!has_next) break;
#pragma unroll
        for (int a = 0; a < 2; ++a)
#pragma unroll
            for (int b = 0; b < 2; ++b)
#pragma unroll
                for (int m = 0; m < 4; ++m)
#pragma unroll
                    for (int n = 0; n < 2; ++n) acc[a][b][m][n] = (f32x4){0.f, 0.f, 0.f, 0.f};
        cur = nxt; cA = nA; cB = nB; ++ui;
        if constexpr (ALIGN_EPI) { if (wr == 1) PG8_BAR; }
    }
    PG8_WAIT_V(0);
    if constexpr (!ALIGN_EPI) { if (wr == 0) PG8_BAR; }
    PG8_BAR;
    if constexpr (Epi::AFTER_DRAIN) { E.fused(acc, cur, wr, wc, fr, fq, lds, wid, lane); S.done(cur); }
#undef PG8_SA
#undef PG8_SB
#undef PG8_STAGE
#undef PG8_LDA
#undef PG8_LDB
#undef PG8_MMA
#undef PG8_WAIT_V
#undef PG8_WAIT_L
#undef PG8_BAR
#undef PG8_SCHED
}
}

typedef float f32x2_t __attribute__((ext_vector_type(2))); typedef __bf16 bf16x2_t __attribute__((ext_vector_type(2)));
__device__ __forceinline__ unsigned cvtpk(float lo, float hi) { f32x2_t v = {lo, hi}; bf16x2_t b = __builtin_convertvector(v, bf16x2_t); return __builtin_bit_cast(unsigned, b); }

namespace pg8 {
template <bool BASE_BF16> struct EpiRes {
    static constexpr bool PERM = true, AFTER_DRAIN = false;
    const void* base; bf16_t* hb; float* ssq;
    __device__ __forceinline__ void operator()(const f32x4 (&acc)[2][2][4][2], const Unit& u, int wr, int wc, int fr, int fq) const {
        const int row0 = u.pm * BM + wr * 64 + fr, col0 = u.pn * BM + wc * 32 + 8 * fq;
#pragma unroll
        for (int ai = 0; ai < 2; ++ai) {
            f32x4 b0[4][2], b1[4][2];
#pragma unroll
            for (int m = 0; m < 4; ++m)
#pragma unroll
                for (int bj = 0; bj < 2; ++bj) {
                    const size_t off = (size_t)(row0 + ai * HALF + m * 16) * 1024 + col0 + bj * HALF;
                    if (BASE_BF16) {
                        const u32x4 w = *(const u32x4*)((const bf16_t*)base + off);
                        b0[m][bj][0] = __uint_as_float(w.x << 16); b0[m][bj][1] = __uint_as_float(w.x & 0xffff0000u); b0[m][bj][2] = __uint_as_float(w.y << 16); b0[m][bj][3] = __uint_as_float(w.y & 0xffff0000u);
                        b1[m][bj][0] = __uint_as_float(w.z << 16); b1[m][bj][1] = __uint_as_float(w.z & 0xffff0000u); b1[m][bj][2] = __uint_as_float(w.w << 16); b1[m][bj][3] = __uint_as_float(w.w & 0xffff0000u);
                    } else { b0[m][bj] = *(const f32x4*)((const float*)base + off); b1[m][bj] = *(const f32x4*)((const float*)base + off + 4); }
                }
#pragma unroll
            for (int m = 0; m < 4; ++m) {
                const size_t row = (size_t)(row0 + ai * HALF + m * 16); float s = 0.f;
#pragma unroll
                for (int bj = 0; bj < 2; ++bj) {
                    const size_t off = row * 1024 + col0 + bj * HALF;
                    const f32x4 v0 = acc[ai][bj][m][0] + b0[m][bj], v1 = acc[ai][bj][m][1] + b1[m][bj];
                    s += (v0[0] * v0[0] + v0[1] * v0[1]) + (v0[2] * v0[2] + v0[3] * v0[3]) + (v1[0] * v1[0] + v1[1] * v1[1]) + (v1[2] * v1[2] + v1[3] * v1[3]);
                    u32x4 w; w.x = cvtpk(v0[0], v0[1]); w.y = cvtpk(v0[2], v0[3]); w.z = cvtpk(v1[0], v1[1]); w.w = cvtpk(v1[2], v1[3]); *(u32x4*)(hb + off) = w;
                }
                s += __shfl_xor(s, 16); s += __shfl_xor(s, 32); if (fq == 0) ssq[row * 16 + u.pn * 4 + wc] = s;
            }
        }
    }
};
template <int MODE> struct EpiScale {
    static constexpr bool PERM = true, AFTER_DRAIN = false;
    bf16_t* O; int ldc; const float* ssq; float scale;
    __device__ __forceinline__ void operator()(const f32x4 (&acc)[2][2][4][2], const Unit& u, int wr, int wc, int fr, int fq) const {
        const int row0 = u.pm * BM + wr * 64 + fr, col0 = u.pn * BM + wc * 32 + 8 * fq;
#pragma unroll
        for (int ai = 0; ai < 2; ++ai)
#pragma unroll
            for (int m = 0; m < 4; ++m) {
                const size_t row = (size_t)(row0 + ai * HALF + m * 16);
                const f32x4 s0 = *(const f32x4*)(ssq + row * 16), s1 = *(const f32x4*)(ssq + row * 16 + 4), s2 = *(const f32x4*)(ssq + row * 16 + 8), s3 = *(const f32x4*)(ssq + row * 16 + 12);
                const f32x4 st = (s0 + s1) + (s2 + s3);
                const float rs = __builtin_amdgcn_rsqf(((st[0] + st[1]) + (st[2] + st[3])) * (1.0f / 1024.0f) + 1e-6f) * scale;
#pragma unroll
                for (int bj = 0; bj < 2; ++bj) {
                    f32x4 v0 = acc[ai][bj][m][0] * rs, v1 = acc[ai][bj][m][1] * rs;
                    if (MODE == 1) {
#pragma unroll
                        for (int e = 0; e < 4; ++e) { const float a = fmaxf(v0[e], 0.f), b = fmaxf(v1[e], 0.f); v0[e] = a * a; v1[e] = b * b; }
                    }
                    u32x4 w; w.x = cvtpk(v0[0], v0[1]); w.y = cvtpk(v0[2], v0[3]); w.z = cvtpk(v1[0], v1[1]); w.w = cvtpk(v1[2], v1[3]);
                    *(u32x4*)(O + row * ldc + col0 + bj * HALF) = w;
                }
            }
    }
};
struct EpiKV {
    static constexpr bool PERM = true, AFTER_DRAIN = false;
    bf16_t* Kb; bf16_t* Vt;
    __device__ __forceinline__ void operator()(const f32x4 (&acc)[2][2][4][2], const Unit& u, int wr, int wc, int fr, int fq) const {
        const int row0 = u.pm * BM + wr * 64 + fr, col0 = u.pn * BM + wc * 32 + 8 * fq;
#pragma unroll
        for (int ai = 0; ai < 2; ++ai)
#pragma unroll
            for (int m = 0; m < 4; ++m) {
                const int row = row0 + ai * HALF + m * 16;
#pragma unroll
                for (int bj = 0; bj < 2; ++bj) {
                    const int col = col0 + bj * HALF; const f32x4 v0 = acc[ai][bj][m][0], v1 = acc[ai][bj][m][1];
                    u32x4 w; w.x = cvtpk(v0[0], v0[1]); w.y = cvtpk(v0[2], v0[3]); w.z = cvtpk(v1[0], v1[1]); w.w = cvtpk(v1[2], v1[3]);
                    if (col < 1024) { *(u32x4*)(Kb + (size_t)row * 1024 + col) = w; }
                    else {
                        const int b = row >> 8, mm = row & 255; bf16_t* p = Vt + ((size_t)(b * 1024 + (col - 1024))) * 256 + mm;
                        p[0 * 256] = (bf16_t)(w.x & 0xffffu); p[1 * 256] = (bf16_t)(w.x >> 16); p[2 * 256] = (bf16_t)(w.y & 0xffffu); p[3 * 256] = (bf16_t)(w.y >> 16);
                        p[4 * 256] = (bf16_t)(w.z & 0xffffu); p[5 * 256] = (bf16_t)(w.z >> 16); p[6 * 256] = (bf16_t)(w.w & 0xffffu); p[7 * 256] = (bf16_t)(w.w >> 16);
                    }
                }
            }
    }
};
}

#define LAS __attribute__((address_space(3)))
typedef pg8::bf16_t bf16_t;
typedef pg8::bf16x8 bf16x8;
typedef pg8::f32x4 f32x4;
typedef pg8::u32x4 u32x4;
typedef unsigned u32x2 __attribute__((ext_vector_type(2)));

constexpr int NTOK = 32768, DM = 1024, SEQ = 8192, NBATCH = 4, NCHUNK = 128, NPROJ = 3328, DFF = 4096, NMEMROWS = 1024;
constexpr int C_GQ = 0, C_GK = 256, C_GV = 512, C_GG = 1024, C_RQ = 1536, C_RK = 1792, C_RV = 2048, C_RG = 2560, C_Z = 3072;
constexpr int NWAVES = 8, NTHREADS = 512;
constexpr int WAVE_LDS = 18432, MISC_OFF = NWAVES * WAVE_LDS, LDS_BYTES = MISC_OFF + 64;
constexpr int VPITCH = 72;
constexpr int APITCH = 528;
constexpr size_t MiB = 1u << 20;
constexpr size_t WS_WIN = 1 * MiB, WS_WOUT = 8 * MiB, WS_WQ = 10 * MiB, WS_WKV = 12 * MiB, WS_WO = 16 * MiB, WS_W1 = 18 * MiB, WS_W2 = 26 * MiB;
constexpr size_t WS_COS = 34 * MiB, WS_SIN = 35 * MiB, WS_MEMN = 36 * MiB, WS_KB = 38 * MiB, WS_VT = 40 * MiB, WS_DEC = 42 * MiB, WS_SSQ1 = 44 * MiB, WS_SSQ2 = 46 * MiB, WS_SSQ3 = 48 * MiB, WS_CTL = 0;
constexpr size_t WS_A1 = 64 * MiB;
constexpr size_t WS_A2 = 128 * MiB;
constexpr size_t WS_BIG = 192 * MiB;
constexpr size_t WS_NEED = 448 * MiB;

struct Params {
    const float *x, *mem, *norm_mix_g, *w_in, *gla_w_gate, *gla_b_gate, *gla_norm_g, *ret_norm_g, *w_out, *norm_x_g, *norm_mem_g, *xa_w_q, *xa_w_kv, *xa_w_o, *norm_ffn_g, *ffn_w1, *ffn_w2, *final_norm_g;
    float* out; unsigned char* ws; int ph_lo, ph_hi;
};

__device__ __forceinline__ float bf2f(unsigned short b) { return __uint_as_float(((unsigned)b) << 16); }
__device__ __forceinline__ unsigned short f2bf(float f) { const unsigned u = __float_as_uint(f); return (unsigned short)((u + 0x7fffu + ((u >> 16) & 1u)) >> 16); }
__device__ __forceinline__ bf16x8 pack8(f32x4 a, f32x4 b) {
    u32x4 w; w.x = cvtpk(a[0], a[1]); w.y = cvtpk(a[2], a[3]); w.z = cvtpk(b[0], b[1]); w.w = cvtpk(b[2], b[3]);
    return __builtin_bit_cast(bf16x8, w);
}
__device__ __forceinline__ void unpack8(bf16x8 v, f32x4& a, f32x4& b) {
    const u32x4 w = __builtin_bit_cast(u32x4, v);
    a[0] = __uint_as_float(w.x << 16); a[1] = __uint_as_float(w.x & 0xffff0000u); a[2] = __uint_as_float(w.y << 16); a[3] = __uint_as_float(w.y & 0xffff0000u);
    b[0] = __uint_as_float(w.z << 16); b[1] = __uint_as_float(w.z & 0xffff0000u); b[2] = __uint_as_float(w.w << 16); b[3] = __uint_as_float(w.w & 0xffff0000u);
}
__device__ __forceinline__ float wave_sum(float v) {
#pragma unroll
    for (int o = 1; o < 64; o <<= 1) v += __shfl_xor(v, o);
    return v;
}
#define MFMA16(a, b, c) __builtin_amdgcn_mfma_f32_16x16x32_bf16((a), (b), (c), 0, 0, 0)
#define LDS_FENCE() asm volatile("s_waitcnt lgkmcnt(0)" ::: "memory")
#define CFENCE() do { asm volatile("" ::: "memory"); __builtin_amdgcn_sched_barrier(0); } while (0)
__device__ __forceinline__ float scan16(float v, int r) {
#pragma unroll
    for (int off = 1; off < 16; off <<= 1) { const float t = __shfl_up(v, off, 16); if (r >= off) v += t; }
    return v;
}

#define XB_TMO      128
#define XB_XCNT(j)  (256  + 64 * (j))
#define XB_XSUB(j)  (1280 + 64 * (j))
#define XB_XGEN(j)  (2304 + 64 * (j))
#define XB_TOP      3328
#define XB_TOPGEN   3392
#define XCD_BAR_WORDS 3456
#define XB_SPIN_CAP (1u << 18)

__device__ __forceinline__ unsigned xb_ld(unsigned* p)              { return __hip_atomic_load(p, __ATOMIC_RELAXED, __HIP_MEMORY_SCOPE_AGENT); }
__device__ __forceinline__ unsigned xb_add(unsigned* p, unsigned v) { return __hip_atomic_fetch_add(p, v, __ATOMIC_RELAXED, __HIP_MEMORY_SCOPE_AGENT); }
__device__ __forceinline__ unsigned xb_xcc_id() { return (unsigned)__builtin_amdgcn_s_getreg((3 << 11) | 20) & 0xFu; }
#define XB_SPIN(cond, bar) do { unsigned _sp = 0; while (cond) { __builtin_amdgcn_s_sleep(1); \
    if ((++_sp & 255u) == 0u) { if (xb_ld(&(bar)[XB_TMO])) break; if (_sp > XB_SPIN_CAP) { atomicAdd(&(bar)[XB_TMO], 1u); break; } } } } while (0)

struct XcdBarrier {
    unsigned* bar; unsigned x;
    volatile LAS unsigned* st;
};

__device__ __forceinline__ XcdBarrier xcd_barrier_post(unsigned* bar, volatile LAS unsigned* st) {
    XcdBarrier b; b.bar = bar; b.x = xb_xcc_id(); b.st = st;
    if (threadIdx.x == 0) (void)xb_add(&bar[XB_XCNT(b.x)], 1u);
    return b;
}
__device__ __forceinline__ void xcd_barrier_complete(unsigned* bar, unsigned x, unsigned& nloc, unsigned& nx) {
    const unsigned G = gridDim.x * gridDim.y * gridDim.z;
    unsigned sum, cnt, mine, sp = 0u;
    for (;;) {
        sum = 0u; cnt = 0u; mine = 0u;
#pragma unroll
        for (unsigned j = 0; j < 16; ++j) { const unsigned c = xb_ld(&bar[XB_XCNT(j)]); sum += c; cnt += (c > 0u) ? 1u : 0u; mine = (j == x) ? c : mine; }
        if (sum == G) break;
        __builtin_amdgcn_s_sleep(1);
        if ((++sp & 255u) == 0u) { if (xb_ld(&bar[XB_TMO])) break; if (sp > XB_SPIN_CAP) { atomicAdd(&bar[XB_TMO], 1u); break; } }
    }
    nloc = mine > 0u ? mine : 1u; nx = cnt > 0u ? cnt : 1u;
}

__device__ __forceinline__ void xcd_barrier(const XcdBarrier& b) {
    asm volatile("s_waitcnt vmcnt(0)" ::: "memory");
    __syncthreads();
    if (threadIdx.x == 0) {
        unsigned* bar = b.bar;
        __builtin_amdgcn_s_waitcnt(0);
        unsigned nloc = b.st[0], nx = b.st[1];
        if (nloc == 0u) { xcd_barrier_complete(bar, b.x, nloc, nx); b.st[0] = nloc; b.st[1] = nx; }
        const unsigned old = xb_add(&bar[XB_XSUB(b.x)], 1u);
        const unsigned gen = old / nloc;
        if (old + 1u == (gen + 1u) * nloc) {
            __builtin_amdgcn_fence(__ATOMIC_RELEASE, "agent");
            asm volatile("s_waitcnt vmcnt(0)" ::: "memory");
            const unsigned og = xb_add(&bar[XB_TOP], 1u);
            const unsigned tg = og / nx;
            if (og + 1u == (tg + 1u) * nx) xb_add(&bar[XB_TOPGEN], 1u);
            else XB_SPIN(xb_ld(&bar[XB_TOPGEN]) == tg, bar);
            __builtin_amdgcn_fence(__ATOMIC_ACQUIRE, "agent");
            xb_add(&bar[XB_XGEN(b.x)], 1u);
            asm volatile("s_waitcnt vmcnt(0)" ::: "memory");
        } else {
            XB_SPIN(xb_ld(&bar[XB_XGEN(b.x)]) == gen, bar);
            __builtin_amdgcn_fence(__ATOMIC_ACQUIRE, "agent");
            asm volatile("s_waitcnt vmcnt(0)" ::: "memory");
        }
    }
    __syncthreads();
}

__device__ __forceinline__ void transpose_item(const float* W, int ldw, int col0, int K, int Nn, const float* g, bf16_t* WT, int row_off, LAS float* scr, int item, int lane) {
    const int nblk = Nn / 32, kb = item / nblk, nb = item % nblk, k0 = 64 * kb, n0 = 32 * nb;
    f32x4 v[8]; const int c4 = (lane & 7) * 4;
#pragma unroll
    for (int i = 0; i < 8; ++i) { const int kk = (lane >> 3) + 8 * i; v[i] = *(const f32x4*)(W + (size_t)(k0 + kk) * ldw + col0 + n0 + c4); }
#pragma unroll
    for (int i = 0; i < 8; ++i) { const int kk = (lane >> 3) + 8 * i; f32x4 w = v[i]; if (g) w *= g[k0 + kk];
        scr[kk * 33 + c4 + 0] = w[0]; scr[kk * 33 + c4 + 1] = w[1]; scr[kk * 33 + c4 + 2] = w[2]; scr[kk * 33 + c4 + 3] = w[3]; }
    LDS_FENCE();
    const int c = lane & 7;
#pragma unroll
    for (int j = 0; j < 4; ++j) { const int n = (lane >> 3) + 8 * j; const LAS float* s = scr + (8 * c) * 33 + n;
        u32x4 o; o.x = cvtpk(s[0 * 33], s[1 * 33]); o.y = cvtpk(s[2 * 33], s[3 * 33]); o.z = cvtpk(s[4 * 33], s[5 * 33]); o.w = cvtpk(s[6 * 33], s[7 * 33]);
        *(u32x4*)(WT + (size_t)(row_off + n0 + n) * K + k0 + 8 * c) = o; }
    LDS_FENCE();
}
__device__ __forceinline__ void rms_rows2_to_bf16(const float* xa, const float* xb, const float* g, bf16_t* oa, bf16_t* ob, int lane) {
    const f32x4* ra = (const f32x4*)xa + lane; const f32x4* rb = (const f32x4*)xb + lane; const f32x4* gr = (const f32x4*)g + lane;
    f32x4 va[4], vb[4]; float sa = 0.f, sb = 0.f;
#pragma unroll
    for (int j = 0; j < 4; ++j) { va[j] = ra[64 * j]; vb[j] = rb[64 * j]; }
#pragma unroll
    for (int j = 0; j < 4; ++j) { sa += (va[j][0] * va[j][0] + va[j][1] * va[j][1]) + (va[j][2] * va[j][2] + va[j][3] * va[j][3]); sb += (vb[j][0] * vb[j][0] + vb[j][1] * vb[j][1]) + (vb[j][2] * vb[j][2] + vb[j][3] * vb[j][3]); }
    const float rsa = 1.0f / sqrtf(wave_sum(sa) * (1.0f / 1024.0f) + 1e-6f), rsb = 1.0f / sqrtf(wave_sum(sb) * (1.0f / 1024.0f) + 1e-6f);
    u32x2* o8a = (u32x2*)oa + lane; u32x2* o8b = (u32x2*)ob + lane;
#pragma unroll
    for (int j = 0; j < 4; ++j) { const f32x4 gg = gr[64 * j];
        u32x2 w; w.x = cvtpk(va[j][0] * rsa * gg[0], va[j][1] * rsa * gg[1]); w.y = cvtpk(va[j][2] * rsa * gg[2], va[j][3] * rsa * gg[3]); o8a[64 * j] = w;
        u32x2 z; z.x = cvtpk(vb[j][0] * rsb * gg[0], vb[j][1] * rsb * gg[1]); z.y = cvtpk(vb[j][2] * rsb * gg[2], vb[j][3] * rsb * gg[3]); o8b[64 * j] = z; }
}
__device__ __forceinline__ void p0_prologue(const Params& p, LAS unsigned char* lds, int G) {
    const int tid = threadIdx.x, lane = tid & 63, wave = __builtin_amdgcn_readfirstlane(tid >> 6);
    unsigned char* ws = p.ws;
    LAS float* scr = (LAS float*)(lds + wave * WAVE_LDS);
    const int gw = blockIdx.x * NWAVES + wave, NGW = G * NWAVES;
    bf16_t* Win_t = (bf16_t*)(ws + WS_WIN);
    constexpr int I_INA = 16 * 32, I_INB = 16 * 64, I_OUT = 16 * 32, I_Q = 16 * 32, I_KV = 16 * 64, I_O = 16 * 32, I_1 = 16 * 128, I_2 = 64 * 32;
    constexpr int NITEMS = I_INA + I_INB + I_OUT + I_Q + I_KV + I_O + I_1 + I_2;
    for (int it = gw; it < NITEMS; it += NGW) {
        int r = it;
        if (r < I_INA) { transpose_item(p.w_in, 3088, 0, 1024, 1024, nullptr, Win_t, 0, scr, r, lane); continue; } r -= I_INA;
        if (r < I_INB) { transpose_item(p.w_in, 3088, 1040, 1024, 2048, nullptr, Win_t, 1024, scr, r, lane); continue; } r -= I_INB;
        if (r < I_OUT) { transpose_item(p.w_out, 1024, 0, 1024, 1024, nullptr, (bf16_t*)(ws + WS_WOUT), 0, scr, r, lane); continue; } r -= I_OUT;
        if (r < I_Q) { transpose_item(p.xa_w_q, 1024, 0, 1024, 1024, p.norm_x_g, (bf16_t*)(ws + WS_WQ), 0, scr, r, lane); continue; } r -= I_Q;
        if (r < I_KV) { transpose_item(p.xa_w_kv, 2048, 0, 1024, 2048, nullptr, (bf16_t*)(ws + WS_WKV), 0, scr, r, lane); continue; } r -= I_KV;
        if (r < I_O) { transpose_item(p.xa_w_o, 1024, 0, 1024, 1024, nullptr, (bf16_t*)(ws + WS_WO), 0, scr, r, lane); continue; } r -= I_O;
        if (r < I_1) { transpose_item(p.ffn_w1, 4096, 0, 1024, 4096, p.norm_ffn_g, (bf16_t*)(ws + WS_W1), 0, scr, r, lane); continue; } r -= I_1;
        transpose_item(p.ffn_w2, 1024, 0, 4096, 1024, nullptr, (bf16_t*)(ws + WS_W2), 0, scr, r, lane);
    }
    const int gt = blockIdx.x * NTHREADS + tid, NGT = G * NTHREADS;
    for (int o = gt; o < 256 * 1024; o += NGT) {
        const int n = o >> 10, k = o & 1023; const float* wr = p.w_in + (size_t)k * 3088 + 1024; float s = 0.f;
#pragma unroll
        for (int r = 0; r < 16; ++r) s += wr[r] * p.gla_w_gate[r * 256 + n];
        Win_t[(size_t)(3072 + n) * 1024 + k] = f2bf(s);
    }
    float* cosT = (float*)(ws + WS_COS); float* sinT = (float*)(ws + WS_SIN);
    for (int o = gt; o < SEQ * 32; o += NGT) {
        const int pos = o >> 5, i = o & 31; double f = 1.0;
        for (int k = 0; k < i; ++k) f *= 0.7498942093324559;
        const double t = (double)pos * f * 0.15915494309189535;
        const float fr = (float)(t - floor(t));
        cosT[o] = __builtin_amdgcn_cosf(fr); sinT[o] = __builtin_amdgcn_sinf(fr);
    }
    bf16_t* XN = (bf16_t*)(ws + WS_A1); bf16_t* MEMN = (bf16_t*)(ws + WS_MEMN);
    for (int m2 = gw; m2 < (NTOK + NMEMROWS) / 2; m2 += NGW) {
        const int m = 2 * m2;
        if (m < NTOK) rms_rows2_to_bf16(p.x + (size_t)m * DM, p.x + (size_t)(m + 1) * DM, p.norm_mix_g, XN + (size_t)m * DM, XN + (size_t)(m + 1) * DM, lane);
        else rms_rows2_to_bf16(p.mem + (size_t)(m - NTOK) * DM, p.mem + (size_t)(m + 1 - NTOK) * DM, p.norm_mem_g, MEMN + (size_t)(m - NTOK) * DM, MEMN + (size_t)(m + 1 - NTOK) * DM, lane);
    }
}

__device__ __forceinline__ void gla_gates(const bf16_t* P, int zcol, const float* bg, int r, int q, float (&bc)[4][2][8], float (&bl)[2][8]) {
    bf16x8 zf[4][2];
#pragma unroll
    for (int mt = 0; mt < 4; ++mt)
#pragma unroll
        for (int ks = 0; ks < 2; ++ks) zf[mt][ks] = *(const bf16x8*)(P + (size_t)(16 * mt + r) * NPROJ + zcol + 32 * ks + 8 * q);
    CFENCE();
#pragma unroll
    for (int ks = 0; ks < 2; ++ks) {
        const f32x4 b0 = *(const f32x4*)(bg + 32 * ks + 8 * q), b1 = *(const f32x4*)(bg + 32 * ks + 8 * q + 4);
#pragma unroll
        for (int mt = 0; mt < 4; ++mt) {
            f32x4 z0, z1; unpack8(zf[mt][ks], z0, z1); z0 += b0; z1 += b1;
#pragma unroll
            for (int e = 0; e < 4; ++e) {
                bc[mt][ks][e] = (fminf(z0[e], 0.f) - __logf(1.0f + __expf(-fabsf(z0[e])))) * (1.0f / 16.0f);
                bc[mt][ks][4 + e] = (fminf(z1[e], 0.f) - __logf(1.0f + __expf(-fabsf(z1[e])))) * (1.0f / 16.0f);
            }
        }
#pragma unroll
        for (int e = 0; e < 8; ++e) {
            float carry = 0.f;
#pragma unroll
            for (int mt = 0; mt < 4; ++mt) { const float v = scan16(bc[mt][ks][e], r); const float tot = __shfl(v, 15, 16); bc[mt][ks][e] = v + carry; carry += tot; }
            bl[ks][e] = carry;
        }
    }
}
__device__ __forceinline__ float ret_log2g(int hr) { return hr == 0 ? -0.04580368961312479f : hr == 1 ? -0.008973692110584325f : hr == 2 ? -0.0017761724589428754f : -0.0003522634716290214f; }
__device__ __forceinline__ void rope_tile(bf16x8 f0, bf16x8 f1, const float* cosT, const float* sinT, int pos, int q, f32x4 (&o)[4]) {
    f32x4 a0, a1, b0, b1; unpack8(f0, a0, a1); unpack8(f1, b0, b1);
    const f32x4 c0 = *(const f32x4*)(cosT + pos * 32 + 8 * q), c1 = *(const f32x4*)(cosT + pos * 32 + 8 * q + 4), s0 = *(const f32x4*)(sinT + pos * 32 + 8 * q), s1 = *(const f32x4*)(sinT + pos * 32 + 8 * q + 4);
    o[0] = a0 * c0 - b0 * s0; o[1] = a1 * c1 - b1 * s1; o[2] = a0 * s0 + b0 * c0; o[3] = a1 * s1 + b1 * c1;
}

__device__ __forceinline__ void chunk_contrib(const Params& p, LAS unsigned char* lds, int G) {
    const int tid = threadIdx.x, lane = tid & 63, wave = __builtin_amdgcn_readfirstlane(tid >> 6);
    unsigned char* ws = p.ws;
    const bf16_t* PROJ = (const bf16_t*)(ws + WS_BIG); bf16_t* CT = (bf16_t*)(ws + WS_A2); float* DEC = (float*)(ws + WS_DEC);
    const float* cosT = (const float*)(ws + WS_COS); const float* sinT = (const float*)(ws + WS_SIN);
    LAS bf16_t* Kdt = (LAS bf16_t*)(lds + wave * WAVE_LDS); LAS bf16_t* Vt = Kdt + 64 * VPITCH;
    for (int u = blockIdx.x * NWAVES + wave; u < NBATCH * NCHUNK * 8; u += G * NWAVES) {
        int h8 = u & 7; asm volatile("" : "+s"(h8));
        const int bn = u >> 3, b = bn >> 7, n = bn & 127;
        const size_t tok0 = (size_t)b * SEQ + (size_t)n * 64;
        const bf16_t* P = PROJ + tok0 * NPROJ;
        const int unit = (b * 8 + h8) * NCHUNK + n;
        int ln = lane; asm volatile("" : "+v"(ln));
        const int r = ln & 15, q = ln >> 4;
        const int vcol = (h8 < 4) ? C_GV + h8 * 128 : C_RV + (h8 - 4) * 128;
        const int kcol = (h8 < 4) ? C_GK + h8 * 64 : C_RK + (h8 - 4) * 64;
        bf16x8 kf[4][2];
#pragma unroll
        for (int mt = 0; mt < 4; ++mt)
#pragma unroll
            for (int ks = 0; ks < 2; ++ks) kf[mt][ks] = *(const bf16x8*)(P + (size_t)(16 * mt + r) * NPROJ + kcol + 32 * ks + 8 * q);
        LDS_FENCE();
        if (h8 < 4) {
            const int h = h8;
            float bc[4][2][8], bl[2][8];
            gla_gates(P, C_Z + h * 64, p.gla_b_gate + h * 64, r, q, bc, bl);
            if (r == 0) {
#pragma unroll
                for (int ks = 0; ks < 2; ++ks) {
                    f32x4 d0, d1;
#pragma unroll
                    for (int e = 0; e < 4; ++e) { d0[e] = __expf(bl[ks][e]); d1[e] = __expf(bl[ks][4 + e]); }
                    *(f32x4*)(DEC + (size_t)unit * 64 + 32 * ks + 8 * q) = d0; *(f32x4*)(DEC + (size_t)unit * 64 + 32 * ks + 8 * q + 4) = d1;
                }
            }
#pragma unroll
            for (int mt = 0; mt < 4; ++mt)
#pragma unroll
                for (int ks = 0; ks < 2; ++ks) {
                    f32x4 k0, k1; unpack8(kf[mt][ks], k0, k1);
#pragma unroll
                    for (int e = 0; e < 4; ++e) {
                        Kdt[(32 * ks + 8 * q + e) * VPITCH + 16 * mt + r] = f2bf(k0[e] * __expf(bl[ks][e] - bc[mt][ks][e]));
                        Kdt[(32 * ks + 8 * q + 4 + e) * VPITCH + 16 * mt + r] = f2bf(k1[e] * __expf(bl[ks][4 + e] - bc[mt][ks][4 + e]));
                    }
                }
        } else {
            const int hr = h8 - 4; const float l2g = ret_log2g(hr);
            if (r == 0) {
                const float d = exp2f(64.0f * l2g); const f32x4 dv = {d, d, d, d};
#pragma unroll
                for (int ks = 0; ks < 2; ++ks) { *(f32x4*)(DEC + (size_t)unit * 64 + 32 * ks + 8 * q) = dv; *(f32x4*)(DEC + (size_t)unit * 64 + 32 * ks + 8 * q + 4) = dv; }
            }
#pragma unroll
            for (int mt = 0; mt < 4; ++mt) {
                CFENCE();
                f32x4 o[4]; rope_tile(kf[mt][0], kf[mt][1], cosT, sinT, n * 64 + 16 * mt + r, q, o);
                const float sc = 0.125f * exp2f((float)(63 - (16 * mt + r)) * l2g);
#pragma unroll
                for (int e = 0; e < 4; ++e) {
                    Kdt[(8 * q + e) * VPITCH + 16 * mt + r] = f2bf(o[0][e] * sc); Kdt[(8 * q + 4 + e) * VPITCH + 16 * mt + r] = f2bf(o[1][e] * sc);
                    Kdt[(32 + 8 * q + e) * VPITCH + 16 * mt + r] = f2bf(o[2][e] * sc); Kdt[(32 + 8 * q + 4 + e) * VPITCH + 16 * mt + r] = f2bf(o[3][e] * sc);
                }
            }
        }
        bf16_t* outp = CT + (size_t)unit * 8192;
#pragma unroll 1
        for (int vh = 0; vh < 2; ++vh) {
            CFENCE();
            bf16x8 xv[8];
#pragma unroll
            for (int i = 0; i < 8; ++i) xv[i] = *(const bf16x8*)(P + (size_t)(i * 8 + (ln >> 3)) * NPROJ + vcol + vh * 64 + (ln & 7) * 8);
            LDS_FENCE();
#pragma unroll
            for (int i = 0; i < 8; ++i) {
                const int token = i * 8 + (ln >> 3), vv = (ln & 7) * 8;
#pragma unroll
                for (int e = 0; e < 8; ++e) Vt[(vv + e) * VPITCH + token] = (bf16_t)xv[i][e];
            }
            LDS_FENCE();
#pragma unroll
            for (int vt = 0; vt < 4; ++vt) {
                CFENCE();
                bf16x8 a[2];
#pragma unroll
                for (int s = 0; s < 2; ++s) a[s] = *(const LAS bf16x8*)(Vt + (16 * vt + r) * VPITCH + 32 * s + 8 * q);
#pragma unroll
                for (int dt = 0; dt < 4; ++dt) {
                    f32x4 acc = {0.f, 0.f, 0.f, 0.f};
#pragma unroll
                    for (int s = 0; s < 2; ++s) { const bf16x8 bb = *(const LAS bf16x8*)(Kdt + (16 * dt + r) * VPITCH + 32 * s + 8 * q); acc = MFMA16(a[s], bb, acc); }
#pragma unroll
                    for (int e = 0; e < 4; ++e) outp[(vh * 64 + 16 * vt + 4 * q + e) * 64 + 16 * dt + r] = f2bf(acc[e]);
                }
            }
        }
    }
}

__device__ __forceinline__ void chunk_scan(const Params& p, int G) {
    unsigned char* ws = p.ws; bf16_t* CT = (bf16_t*)(ws + WS_A2); const float* DEC = (const float*)(ws + WS_DEC);
    const int NGT = G * NTHREADS;
    for (int o = blockIdx.x * NTHREADS + threadIdx.x; o < 32 * 128 * 16; o += NGT) {
        const int d4 = o & 15, v = (o >> 4) & 127, bh = o >> 11;
        bf16_t* base = CT + (size_t)bh * NCHUNK * 8192 + v * 64 + d4 * 4; const float* dbase = DEC + (size_t)bh * NCHUNK * 64 + d4 * 4;
        f32x4 s = {0.f, 0.f, 0.f, 0.f};
#pragma unroll 1
        for (int n0 = 0; n0 < NCHUNK; n0 += 16) {
            u32x2 uu[16]; f32x4 dd[16];
#pragma unroll
            for (int j = 0; j < 16; ++j) { uu[j] = *(const u32x2*)(base + (size_t)(n0 + j) * 8192); dd[j] = *(const f32x4*)(dbase + (size_t)(n0 + j) * 64); }
#pragma unroll
            for (int j = 0; j < 16; ++j) {
                u32x2 w; w.x = cvtpk(s[0], s[1]); w.y = cvtpk(s[2], s[3]);
                *(u32x2*)(base + (size_t)(n0 + j) * 8192) = w;
                f32x4 c; c[0] = __uint_as_float(uu[j].x << 16); c[1] = __uint_as_float(uu[j].x & 0xffff0000u); c[2] = __uint_as_float(uu[j].y << 16); c[3] = __uint_as_float(uu[j].y & 0xffff0000u);
                s = dd[j] * s + c;
            }
        }
    }
}

template <bool GN> __device__ __forceinline__ void norm_gate_store(const f32x4 (&O)[8], const unsigned short (&gt)[8][4], const float (&gn)[8], int it, int r, int q, bf16_t* y) {
    f32x4 mean = {0.f, 0.f, 0.f, 0.f};
    if (GN) {
        f32x4 s = {0.f, 0.f, 0.f, 0.f};
#pragma unroll
        for (int vt = 0; vt < 8; ++vt) s += O[vt];
#pragma unroll
        for (int e = 0; e < 4; ++e) { float t = s[e]; t += __shfl_xor(t, 1); t += __shfl_xor(t, 2); t += __shfl_xor(t, 4); t += __shfl_xor(t, 8); mean[e] = t * (1.0f / 128.0f); }
    }
    f32x4 ss = {0.f, 0.f, 0.f, 0.f};
#pragma unroll
    for (int vt = 0; vt < 8; ++vt) { const f32x4 d = O[vt] - mean; ss += d * d; }
    f32x4 rstd;
#pragma unroll
    for (int e = 0; e < 4; ++e) { float t = ss[e]; t += __shfl_xor(t, 1); t += __shfl_xor(t, 2); t += __shfl_xor(t, 4); t += __shfl_xor(t, 8); rstd[e] = __builtin_amdgcn_rsqf(t * (1.0f / 128.0f) + 1e-6f); }
#pragma unroll
    for (int vt = 0; vt < 8; ++vt) {
        const int v = 16 * vt + r;
#pragma unroll
        for (int e = 0; e < 4; ++e) {
            const int i = 16 * it + 4 * q + e;
            const float g = bf2f(gt[vt][e]);
            const float sil = g * __builtin_amdgcn_rcpf(1.0f + __expf(-g));
            y[(size_t)i * DM + v] = f2bf((O[vt][e] - mean[e]) * rstd[e] * gn[vt] * sil);
        }
    }
}
__device__ __forceinline__ void out_tile(f32x4 (&O)[8], const bf16x8 (&pf)[2], const bf16x8 (&qi)[2], const LAS bf16_t* Vt, const bf16x8 (&spf)[8][2], int r, int q) {
#pragma unroll
    for (int vt = 0; vt < 8; ++vt) {
        f32x4 acc = {0.f, 0.f, 0.f, 0.f};
#pragma unroll
        for (int s = 0; s < 2; ++s) {
            const u32x2 lo = *(const LAS u32x2*)(Vt + (16 * vt + r) * VPITCH + 32 * s + 4 * q), hi = *(const LAS u32x2*)(Vt + (16 * vt + r) * VPITCH + 32 * s + 16 + 4 * q);
            const u32x4 w = {lo.x, lo.y, hi.x, hi.y};
            acc = MFMA16(pf[s], __builtin_bit_cast(bf16x8, w), acc);
        }
#pragma unroll
        for (int ks = 0; ks < 2; ++ks) acc = MFMA16(qi[ks], spf[vt][ks], acc);
        O[vt] = acc;
    }
}
template <bool GN> __device__ __forceinline__ void out_all(const bf16x8 (&pfa)[4][2], const bf16x8 (&QI)[4][2], const LAS bf16_t* Vt, const bf16_t* SP, const float* gain, const bf16_t* gate, bf16_t* y, int r, int q) {
    bf16x8 spf[8][2]; float gn[8];
#pragma unroll
    for (int vt = 0; vt < 8; ++vt) {
        gn[vt] = gain[16 * vt + r];
#pragma unroll
        for (int ks = 0; ks < 2; ++ks) spf[vt][ks] = *(const bf16x8*)(SP + (16 * vt + r) * 64 + 32 * ks + 8 * q);
    }
#pragma unroll
    for (int it = 0; it < 4; ++it) {
        CFENCE();
        unsigned short gt[8][4];
#pragma unroll
        for (int vt = 0; vt < 8; ++vt)
#pragma unroll
            for (int e = 0; e < 4; ++e) gt[vt][e] = gate[(size_t)(16 * it + 4 * q + e) * NPROJ + 16 * vt + r];
        CFENCE();
        f32x4 O[8];
        out_tile(O, pfa[it], QI[it], Vt, spf, r, q);
        CFENCE();
        norm_gate_store<GN>(O, gt, gn, it, r, q, y);
    }
}

__device__ __forceinline__ void chunk_output(const Params& p, LAS unsigned char* lds, int G) {
    const int tid = threadIdx.x, lane = tid & 63, wave = __builtin_amdgcn_readfirstlane(tid >> 6);
    unsigned char* ws = p.ws;
    const bf16_t* PROJ = (const bf16_t*)(ws + WS_BIG); const bf16_t* SPB = (const bf16_t*)(ws + WS_A2); bf16_t* Y = (bf16_t*)(ws + WS_A1);
    const float* cosT = (const float*)(ws + WS_COS); const float* sinT = (const float*)(ws + WS_SIN);
    LAS bf16_t* Vt = (LAS bf16_t*)(lds + wave * WAVE_LDS);
    for (int u = blockIdx.x * NWAVES + wave; u < NBATCH * NCHUNK * 8; u += G * NWAVES) {
        int h8 = u & 7; asm volatile("" : "+s"(h8));
        const int bn = u >> 3, b = bn >> 7, n = bn & 127;
        const size_t tok0 = (size_t)b * SEQ + (size_t)n * 64;
        const bf16_t* P = PROJ + tok0 * NPROJ;
        const int unit = (b * 8 + h8) * NCHUNK + n;
        const bf16_t* SP = SPB + (size_t)unit * 8192;
        int ln = lane; asm volatile("" : "+v"(ln));
        const int r = ln & 15, q = ln >> 4;
        const int vcol = (h8 < 4) ? C_GV + h8 * 128 : C_RV + (h8 - 4) * 128;
        LDS_FENCE();
        {
            bf16x8 xv[16];
#pragma unroll
            for (int i = 0; i < 16; ++i) xv[i] = *(const bf16x8*)(P + (size_t)(i * 4 + q) * NPROJ + vcol + r * 8);
            CFENCE();
#pragma unroll
            for (int i = 0; i < 16; ++i) {
                const int token = i * 4 + q, vv = r * 8;
#pragma unroll
                for (int e = 0; e < 8; ++e) Vt[(vv + e) * VPITCH + token] = (bf16_t)xv[i][e];
            }
        }
        LDS_FENCE();
        CFENCE();
#ifdef NO_GLA4
        if (false) {
#else
        if (h8 < 4) {
#endif
            const int h = h8;
            bf16x8 Qe[4][2], Qi[4][2], Ki[4][2], Ke[4][2], pfa[4][2];
            {
                bf16x8 qf[4][2], kf[4][2];
#pragma unroll
                for (int mt = 0; mt < 4; ++mt)
#pragma unroll
                    for (int ks = 0; ks < 2; ++ks) {
                        qf[mt][ks] = *(const bf16x8*)(P + (size_t)(16 * mt + r) * NPROJ + C_GQ + h * 64 + 32 * ks + 8 * q);
                        kf[mt][ks] = *(const bf16x8*)(P + (size_t)(16 * mt + r) * NPROJ + C_GK + h * 64 + 32 * ks + 8 * q);
                    }
                float bc[4][2][8], bl[2][8];
                gla_gates(P, C_Z + h * 64, p.gla_b_gate + h * 64, r, q, bc, bl);
#pragma unroll
                for (int mt = 0; mt < 4; ++mt)
#pragma unroll
                    for (int ks = 0; ks < 2; ++ks) {
                        CFENCE();
                        f32x4 q0, q1, k0, k1; unpack8(qf[mt][ks], q0, q1); unpack8(kf[mt][ks], k0, k1);
                        f32x4 e0, e1, i0, i1;
#pragma unroll
                        for (int e = 0; e < 4; ++e) { e0[e] = __expf(bc[mt][ks][e]); e1[e] = __expf(bc[mt][ks][4 + e]); i0[e] = __expf(-bc[mt][ks][e]); i1[e] = __expf(-bc[mt][ks][4 + e]); }
                        Qe[mt][ks] = pack8(q0 * e0 * 0.125f, q1 * e1 * 0.125f); Qi[mt][ks] = pack8(q0 * i0 * 0.125f, q1 * i1 * 0.125f);
                        Ki[mt][ks] = pack8(k0 * i0, k1 * i1); Ke[mt][ks] = pack8(k0 * e0, k1 * e1);
                    }
            }
#pragma unroll
            for (int it = 0; it < 4; ++it) {
                f32x4 Pt[4];
#pragma unroll
                for (int jt = 0; jt < 4; ++jt) {
                    f32x4 lo = {0.f, 0.f, 0.f, 0.f}, up = {0.f, 0.f, 0.f, 0.f};
                    if (jt <= it) { lo = MFMA16(Ki[jt][0], Qe[it][0], lo); lo = MFMA16(Ki[jt][1], Qe[it][1], lo); }
                    if (jt >= it) { up = MFMA16(Ke[jt][0], Qi[it][0], up); up = MFMA16(Ke[jt][1], Qi[it][1], up); }
                    if (jt < it) Pt[jt] = lo; else if (jt > it) Pt[jt] = up;
                    else {
#pragma unroll
                        for (int e = 0; e < 4; ++e) Pt[jt][e] = (4 * q + e <= r) ? lo[e] : up[e];
                    }
                }
                pfa[it][0] = pack8(Pt[0], Pt[1]); pfa[it][1] = pack8(Pt[2], Pt[3]);
                CFENCE();
            }
            out_all<false>(pfa, Qe, Vt, SP, p.gla_norm_g + h * 128, P + C_GG + h * 128, Y + tok0 * DM + h * 128, r, q);
        }
#ifdef NO_RET4
        else if (false) {
#else
        else {
#endif
            const int hr = h8 - 4; const float l2g = ret_log2g(hr);
            bf16x8 Qr[4][2], Qd[4][2], Kr[4][2], pfa[4][2];
            {
                bf16x8 qf[4][2], kf[4][2];
#pragma unroll
                for (int mt = 0; mt < 4; ++mt)
#pragma unroll
                    for (int ks = 0; ks < 2; ++ks) {
                        qf[mt][ks] = *(const bf16x8*)(P + (size_t)(16 * mt + r) * NPROJ + C_RQ + hr * 64 + 32 * ks + 8 * q);
                        kf[mt][ks] = *(const bf16x8*)(P + (size_t)(16 * mt + r) * NPROJ + C_RK + hr * 64 + 32 * ks + 8 * q);
                    }
#pragma unroll
                for (int mt = 0; mt < 4; ++mt) {
                    const int pos = n * 64 + 16 * mt + r;
                    CFENCE();
                    {
                        f32x4 o[4]; rope_tile(qf[mt][0], qf[mt][1], cosT, sinT, pos, q, o);
                        Qr[mt][0] = pack8(o[0], o[1]); Qr[mt][1] = pack8(o[2], o[3]);
                        const float qd = exp2f((float)(16 * mt + r + 1) * l2g);
                        Qd[mt][0] = pack8(o[0] * qd, o[1] * qd); Qd[mt][1] = pack8(o[2] * qd, o[3] * qd);
                    }
                    CFENCE();
                    {
                        f32x4 o[4]; rope_tile(kf[mt][0], kf[mt][1], cosT, sinT, pos, q, o);
                        Kr[mt][0] = pack8(o[0] * 0.125f, o[1] * 0.125f); Kr[mt][1] = pack8(o[2] * 0.125f, o[3] * 0.125f);
                    }
                }
            }
#pragma unroll
            for (int it = 0; it < 4; ++it) {
                f32x4 Pt[4];
#pragma unroll
                for (int jt = 0; jt < 4; ++jt) {
                    f32x4 st = {0.f, 0.f, 0.f, 0.f};
                    st = MFMA16(Kr[jt][0], Qr[it][0], st); st = MFMA16(Kr[jt][1], Qr[it][1], st);
#pragma unroll
                    for (int e = 0; e < 4; ++e) { const int dj = (16 * it + r) - (16 * jt + 4 * q + e); Pt[jt][e] = st[e] * exp2f((float)(dj < 0 ? -dj : dj) * l2g); }
                }
                pfa[it][0] = pack8(Pt[0], Pt[1]); pfa[it][1] = pack8(Pt[2], Pt[3]);
                CFENCE();
            }
            out_all<true>(pfa, Qd, Vt, SP, p.ret_norm_g + hr * 128, P + C_RG + hr * 128, Y + tok0 * DM + 512 + hr * 128, r, q);
        }
    }
}

__device__ __forceinline__ void stage_image(LAS unsigned char* lds, const bf16_t* src, int tid) {
#pragma unroll
    for (int i = 0; i < 16; ++i) { const int row = (tid >> 5) + 16 * i, c = tid & 31; const u32x4 x = *(const u32x4*)(src + (size_t)row * 256 + c * 8); *(LAS u32x4*)(lds + row * APITCH + c * 16) = x; }
}
__device__ __forceinline__ void cross_attention(const Params& p, LAS unsigned char* lds, int G) {
    const int tid = threadIdx.x, lane = tid & 63, wave = __builtin_amdgcn_readfirstlane(tid >> 6);
    unsigned char* ws = p.ws;
    const bf16_t* Q = (const bf16_t*)(ws + WS_A1); const bf16_t* Kb = (const bf16_t*)(ws + WS_KB); const bf16_t* Vtg = (const bf16_t*)(ws + WS_VT); bf16_t* OA = (bf16_t*)(ws + WS_BIG);
    for (int u = blockIdx.x; u < 512; u += G) {
        const int bh = u >> 5, b = bh >> 2, h = bh & 3, qb = u & 31;
        int ln = lane; asm volatile("" : "+v"(ln));
        const int r = ln & 15, q = ln >> 4;
        const size_t i0 = (size_t)b * SEQ + qb * 256 + wave * 32;
        __syncthreads();
        {
#pragma unroll
            for (int i = 0; i < 16; ++i) { const int row = (tid >> 5) + 16 * i, c = tid & 31; const u32x4 x = *(const u32x4*)(Kb + (size_t)(b * 256 + row) * 1024 + h * 256 + c * 8); *(LAS u32x4*)(lds + row * APITCH + c * 16) = x; }
        }
        bf16x8 Qf[2][8];
#pragma unroll
        for (int it = 0; it < 2; ++it)
#pragma unroll
            for (int ks = 0; ks < 8; ++ks) Qf[it][ks] = *(const bf16x8*)(Q + (i0 + 16 * it + r) * DM + h * 256 + 32 * ks + 8 * q);
        __syncthreads();
        bf16x8 pf[2][8];
        {
            f32x4 S[2][16];
#pragma unroll
            for (int mt = 0; mt < 16; ++mt) {
                f32x4 a0 = {0.f, 0.f, 0.f, 0.f}, a1 = {0.f, 0.f, 0.f, 0.f};
                CFENCE();
#pragma unroll
                for (int ks = 0; ks < 8; ++ks) { const bf16x8 a = *(const LAS bf16x8*)(lds + (16 * mt + r) * APITCH + (32 * ks + 8 * q) * 2); a0 = MFMA16(a, Qf[0][ks], a0); a1 = MFMA16(a, Qf[1][ks], a1); }
                S[0][mt] = a0; S[1][mt] = a1;
            }
#pragma unroll
            for (int it = 0; it < 2; ++it) {
                CFENCE();
                float mx = -3.0e38f;
#pragma unroll
                for (int mt = 0; mt < 16; ++mt) mx = fmaxf(fmaxf(fmaxf(S[it][mt][0], S[it][mt][1]), fmaxf(S[it][mt][2], S[it][mt][3])), mx);
                mx = fmaxf(mx, __shfl_xor(mx, 16)); mx = fmaxf(mx, __shfl_xor(mx, 32));
                CFENCE();
                float sum = 0.f;
#pragma unroll
                for (int mt = 0; mt < 16; ++mt) {
#pragma unroll
                    for (int e = 0; e < 4; ++e) { S[it][mt][e] = __builtin_amdgcn_exp2f(S[it][mt][e] - mx); sum += S[it][mt][e]; }
                }
                sum += __shfl_xor(sum, 16); sum += __shfl_xor(sum, 32);
                const float inv = 1.0f / sum;
                CFENCE();
#pragma unroll
                for (int s = 0; s < 8; ++s) { pf[it][s] = pack8(S[it][2 * s] * inv, S[it][2 * s + 1] * inv); CFENCE(); }
            }
        }
        __syncthreads();
        stage_image(lds, Vtg + (size_t)(b * 1024 + h * 256) * 256, tid);
        __syncthreads();
#pragma unroll
        for (int nt = 0; nt < 16; ++nt) {
            f32x4 a0 = {0.f, 0.f, 0.f, 0.f}, a1 = {0.f, 0.f, 0.f, 0.f};
            CFENCE();
#pragma unroll
            for (int s = 0; s < 8; ++s) {
                const u32x2 lo = *(const LAS u32x2*)(lds + (16 * nt + r) * APITCH + (32 * s + 4 * q) * 2), hi = *(const LAS u32x2*)(lds + (16 * nt + r) * APITCH + (32 * s + 16 + 4 * q) * 2);
                const u32x4 w = {lo.x, lo.y, hi.x, hi.y};
                a0 = MFMA16(pf[0][s], __builtin_bit_cast(bf16x8, w), a0); a1 = MFMA16(pf[1][s], __builtin_bit_cast(bf16x8, w), a1);
            }
#pragma unroll
            for (int e = 0; e < 4; ++e) { OA[(i0 + 4 * q + e) * DM + h * 256 + 16 * nt + r] = f2bf(a0[e]); OA[(i0 + 16 + 4 * q + e) * DM + h * 256 + 16 * nt + r] = f2bf(a1[e]); }
        }
    }
}

__device__ __forceinline__ void final_norm(const Params& p, int G) {
    const int lane = threadIdx.x & 63, wave = __builtin_amdgcn_readfirstlane(threadIdx.x >> 6);
    const bf16_t* H = (const bf16_t*)(p.ws + WS_A2); const float* SSQ = (const float*)(p.ws + WS_SSQ3);
    const f32x4 g0 = *(const f32x4*)(p.final_norm_g + lane * 8), g1 = *(const f32x4*)(p.final_norm_g + lane * 8 + 4), g2 = *(const f32x4*)(p.final_norm_g + 512 + lane * 8), g3 = *(const f32x4*)(p.final_norm_g + 512 + lane * 8 + 4);
    for (int m = blockIdx.x * NWAVES + wave; m < NTOK; m += G * NWAVES) {
        const bf16x8 h0 = *(const bf16x8*)(H + (size_t)m * DM + lane * 8), h1 = *(const bf16x8*)(H + (size_t)m * DM + 512 + lane * 8);
        const f32x4 s0 = *(const f32x4*)(SSQ + (size_t)m * 16), s1 = *(const f32x4*)(SSQ + (size_t)m * 16 + 4), s2 = *(const f32x4*)(SSQ + (size_t)m * 16 + 8), s3 = *(const f32x4*)(SSQ + (size_t)m * 16 + 12);
        const f32x4 st = (s0 + s1) + (s2 + s3);
        const float rstd = 1.0f / sqrtf(((st[0] + st[1]) + (st[2] + st[3])) * (1.0f / 1024.0f) + 1e-6f);
        f32x4 a0, a1, b0, b1; unpack8(h0, a0, a1); unpack8(h1, b0, b1);
        float* o = p.out + (size_t)m * DM + lane * 8;
        *(f32x4*)(o) = a0 * rstd * g0; *(f32x4*)(o + 4) = a1 * rstd * g1; *(f32x4*)(o + 512) = b0 * rstd * g2; *(f32x4*)(o + 516) = b1 * rstd * g3;
    }
}

constexpr int NPHASE = 12;
__global__ void __launch_bounds__(NTHREADS, 2) fwd_megakernel(Params p) {
    extern __shared__ __attribute__((aligned(16))) unsigned char lds_raw[];
    LAS unsigned char* lds = (LAS unsigned char*)lds_raw;
    cg::grid_group grid = cg::this_grid();
    const int G = gridDim.x, lo = p.ph_lo, hi = p.ph_hi;
    unsigned char* ws = p.ws;
#define IN(k) (lo <= (k) && (k) < hi)
#ifndef DBG_REP
#define DBG_REP (-1)
#endif
#define REPS(k) ((DBG_REP) == (k) ? 2 : 1)
#define SEAM(k) do { if (IN(k) && IN((k) + 1)) { if ((k) == 0) { asm volatile("s_waitcnt vmcnt(0) lgkmcnt(0)" ::: "memory"); grid.sync(); __builtin_amdgcn_fence(__ATOMIC_ACQUIRE, "agent"); asm volatile("s_waitcnt vmcnt(0)" ::: "memory"); } \
    else xcd_barrier(bar); } } while (0)
    LAS unsigned* misc = (LAS unsigned*)(lds + MISC_OFF);
    if (threadIdx.x < 16) misc[threadIdx.x] = 0u;
    __syncthreads();
    XcdBarrier bar; bar.bar = (unsigned*)(ws + WS_CTL); bar.x = 0; bar.st = nullptr;
    if (hi - lo > 1) bar = xcd_barrier_post((unsigned*)(ws + WS_CTL), (volatile LAS unsigned*)misc);
#ifndef NO_P0
    if (IN(0)) { p0_prologue(p, lds, G); }
#endif
#if defined(DBG_REP) && DBG_REP == 0
    __syncthreads(); if (IN(0)) { p0_prologue(p, lds, G); }
#endif
    SEAM(0);
    if (IN(1)) {
        {
            pg8::Gemm g{(const bf16_t*)(ws + WS_A1), (const bf16_t*)(ws + WS_WIN), NTOK, NPROJ, DM}; pg8::StaticOrder S; S.init(NTOK, NPROJ, G, (int)blockIdx.x);
            pg8::EpiBf16<0> E{(bf16_t*)(ws + WS_BIG), NPROJ, nullptr, 0, 0, 1.f};
            pg8::gemm_phase<pg8::EpiBf16<0>, pg8::StaticOrder, true, true>(lds, g, S, E);
        }
        __syncthreads();
        {
            pg8::Gemm g{(const bf16_t*)(ws + WS_MEMN), (const bf16_t*)(ws + WS_WKV), NMEMROWS, 2048, DM}; pg8::StaticOrder S; S.init(NMEMROWS, 2048, G, (int)((blockIdx.x + G / 2) % G));
            pg8::EpiKV E{(bf16_t*)(ws + WS_KB), (bf16_t*)(ws + WS_VT)};
            pg8::gemm_phase<pg8::EpiKV, pg8::StaticOrder, true, true>(lds, g, S, E);
        }
        __syncthreads();
    } SEAM(1);
    #ifndef NO_P2
    if (IN(2)) { chunk_contrib(p, lds, G); }
#endif
#if defined(DBG_REP) && DBG_REP == 2
    __syncthreads(); if (IN(2)) { chunk_contrib(p, lds, G); }
#endif
    SEAM(2);
    if (IN(3)) { chunk_scan(p, G); } SEAM(3);
    #ifndef NO_P4
    if (IN(4)) { chunk_output(p, lds, G); }
#endif
#if defined(DBG_REP) && DBG_REP == 4
    __syncthreads(); if (IN(4)) { chunk_output(p, lds, G); }
#endif
    SEAM(4);
    if (IN(5)) {
        pg8::Gemm g{(const bf16_t*)(ws + WS_A1), (const bf16_t*)(ws + WS_WOUT), NTOK, DM, DM}; pg8::StaticOrder S; S.init(NTOK, DM, G, (int)blockIdx.x);
        pg8::EpiRes<false> E{p.x, (bf16_t*)(ws + WS_A2), (float*)(ws + WS_SSQ1)};
        pg8::gemm_phase<pg8::EpiRes<false>, pg8::StaticOrder, true, true>(lds, g, S, E);
        __syncthreads();
    } SEAM(5);
    if (IN(6)) {
        pg8::Gemm g{(const bf16_t*)(ws + WS_A2), (const bf16_t*)(ws + WS_WQ), NTOK, DM, DM}; pg8::StaticOrder S; S.init(NTOK, DM, G, (int)blockIdx.x);
        pg8::EpiScale<0> E{(bf16_t*)(ws + WS_A1), DM, (const float*)(ws + WS_SSQ1), 0.0625f * 1.4426950408889634f};
        pg8::gemm_phase<pg8::EpiScale<0>, pg8::StaticOrder, true, true>(lds, g, S, E);
        __syncthreads();
    } SEAM(6);
#ifndef NO_P7
    if (IN(7)) { cross_attention(p, lds, G); __syncthreads(); }
#endif
#if defined(DBG_REP) && DBG_REP == 7
    if (IN(7)) { cross_attention(p, lds, G); __syncthreads(); }
#endif
    SEAM(7);
    if (IN(8)) {
        pg8::Gemm g{(const bf16_t*)(ws + WS_BIG), (const bf16_t*)(ws + WS_WO), NTOK, DM, DM}; pg8::StaticOrder S; S.init(NTOK, DM, G, (int)blockIdx.x);
        pg8::EpiRes<true> E{(const void*)(ws + WS_A2), (bf16_t*)(ws + WS_A1), (float*)(ws + WS_SSQ2)};
        pg8::gemm_phase<pg8::EpiRes<true>, pg8::StaticOrder, true, true>(lds, g, S, E);
        __syncthreads();
    } SEAM(8);
    if (IN(9)) {
        pg8::Gemm g{(const bf16_t*)(ws + WS_A1), (const bf16_t*)(ws + WS_W1), NTOK, DFF, DM}; pg8::StaticOrder S; S.init(NTOK, DFF, G, (int)blockIdx.x);
        pg8::EpiScale<1> E{(bf16_t*)(ws + WS_BIG), DFF, (const float*)(ws + WS_SSQ2), 1.0f};
        pg8::gemm_phase<pg8::EpiScale<1>, pg8::StaticOrder, true, true>(lds, g, S, E);
        __syncthreads();
    } SEAM(9);
    if (IN(10)) {
        pg8::Gemm g{(const bf16_t*)(ws + WS_BIG), (const bf16_t*)(ws + WS_W2), NTOK, DM, DFF}; pg8::StaticOrder S; S.init(NTOK, DM, G, (int)blockIdx.x);
        pg8::EpiRes<true> E{(const void*)(ws + WS_A1), (bf16_t*)(ws + WS_A2), (float*)(ws + WS_SSQ3)};
        pg8::gemm_phase<pg8::EpiRes<true>, pg8::StaticOrder, true, true>(lds, g, S, E);
        __syncthreads();
    } SEAM(10);
    if (IN(11)) { final_norm(p, G); }
#undef IN
#undef SEAM
}

#ifndef MK_PER_PHASE
#define MK_PER_PHASE 0
#endif
#ifdef DBG_DUMP_OFF
__global__ void dump_kernel(const bf16_t* src, size_t n, float* out) {
    for (size_t i = (size_t)blockIdx.x * blockDim.x + threadIdx.x; i < (size_t)NTOK * DM; i += (size_t)gridDim.x * blockDim.x) {
        float s = 0.f; for (size_t j = i; j < n; j += (size_t)NTOK * DM) s += bf2f(src[j]); out[i] = s; }
}
#endif
extern "C" void kernel_launch(void* const* d_in, const int* in_sizes, int n_in, void* d_out, int out_size, void* d_ws, size_t ws_size, hipStream_t stream) {
    static int grid = 0;
    if (grid == 0) {
        if (n_in != 18 || ws_size < WS_NEED) { fprintf(stderr, "kernel_launch: expected 18 inputs and >= %zu bytes of workspace (got %d, %zu)\n", (size_t)WS_NEED, n_in, ws_size); grid = -1; return; }
        int dev = 0, cus = 0, per_cu = 0;
        (void)hipGetDevice(&dev); (void)hipDeviceGetAttribute(&cus, hipDeviceAttributeMultiprocessorCount, dev);
        if (hipFuncSetAttribute((const void*)fwd_megakernel, hipFuncAttributeMaxDynamicSharedMemorySize, LDS_BYTES) != hipSuccess) { fprintf(stderr, "kernel_launch: hipFuncSetAttribute failed\n"); grid = -1; return; }
        if (hipOccupancyMaxActiveBlocksPerMultiprocessor(&per_cu, (const void*)fwd_megakernel, NTHREADS, LDS_BYTES) != hipSuccess || per_cu < 1) { fprintf(stderr, "kernel_launch: occupancy query failed (%d)\n", per_cu); (void)hipGetLastError(); grid = -1; return; }
        grid = cus * per_cu;
    }
    if (grid < 0) return;
    Params p{};
    const float** pp = (const float**)&p;
    for (int i = 0; i < 18; ++i) pp[i] = (const float*)d_in[i];
    p.out = (float*)d_out; p.ws = (unsigned char*)d_ws;
#if MK_PER_PHASE
#ifndef DBG_HI
#define DBG_HI NPHASE
#endif
    for (int k = 0; k < DBG_HI; ++k) { p.ph_lo = k; p.ph_hi = k + 1; hipLaunchKernelGGL(fwd_megakernel, dim3(grid), dim3(NTHREADS), LDS_BYTES, stream, p);
#ifdef DBG_HOSTREP
        if (k == DBG_HOSTREP) hipLaunchKernelGGL(fwd_megakernel, dim3(grid), dim3(NTHREADS), LDS_BYTES, stream, p);
#endif
    }
#ifdef DBG_DUMP_OFF
    hipLaunchKernelGGL(dump_kernel, dim3(2048), dim3(256), 0, stream, (const bf16_t*)((unsigned char*)d_ws + (size_t)(DBG_DUMP_OFF) * MiB), (size_t)(DBG_DUMP_N), (float*)d_out);
#endif
#else
    p.ph_lo = 0; p.ph_hi = NPHASE;
    if (hipMemsetAsync((char*)d_ws + WS_CTL, 0, 16384, stream) != hipSuccess) { fprintf(stderr, "kernel_launch: hipMemsetAsync failed\n"); return; }
    void* args[] = {&p};
    const hipError_t e = hipLaunchCooperativeKernel((const void*)fwd_megakernel, dim3(grid), dim3(NTHREADS), args, LDS_BYTES, stream);
    if (e != hipSuccess) fprintf(stderr, "kernel_launch: cooperative launch failed: %s (grid %d)\n", hipGetErrorString(e), grid);
#endif
}
```

```cpp
#include <hip/hip_runtime.h>
#include <hip/hip_cooperative_groups.h>
#include <cstdio>
#include <cstdint>
namespace cg = cooperative_groups;
namespace pg8 {
#define PG8_LAS __attribute__((address_space(3)))
typedef unsigned short bf16_t;
typedef short bf16x8 __attribute__((ext_vector_type(8)));
typedef float f32x4 __attribute__((ext_vector_type(4)));
typedef unsigned u32x4 __attribute__((ext_vector_type(4)));
constexpr int BM = 256, BK = 64, HALF = 128, HTB = HALF * BK * 2  , STAGE_BYTES = 8 * HTB, NXCD = 8, WGM = 8;

__host__ __device__ __forceinline__ int lds_byte(int r, int c) { const int st = (r >> 4) * 2 + (c >> 5), rr = r & 15, cc = c & 31, ob = rr * 64 + cc * 2; return st * 1024 + (ob ^ (((ob >> 9) & 1) << 5)); }
__host__ __device__ __forceinline__ void stage_rc(int b, int& R, int& C) { const int st = b / 1024, sb = b % 1024, swz = sb ^ (((sb >> 9) & 1) << 5); R = (st >> 1) * 16 + swz / 64; C = (st & 1) * 32 + (swz % 64) / 2; }
__host__ __device__ __forceinline__ int perm32(int rho) { const int n = rho >> 4, i = rho & 15; return 8 * (i >> 2) + 4 * n + (i & 3); }

struct Unit { int pm, pn; };
struct Gemm { const bf16_t* A; const bf16_t* Bt; int M, N, K; };

struct StaticOrder {
    int nM, nN, nwg, G, c;
    __host__ __device__ void init(int M, int N, int G_, int c_) { nM = M / BM; nN = N / BM; nwg = nM * nN; G = G_; c = c_; }
    __host__ __device__ bool next(int i, Unit& u) const {
        const long L = (long)i * G + c; if (L >= nwg) return false;
        int wgid = (int)L; { const int q = nwg / NXCD, r = nwg % NXCD, xcd = wgid % NXCD, off = wgid / NXCD; wgid = (xcd < r ? xcd * (q + 1) : r * (q + 1) + (xcd - r) * q) + off; }
        const int nig = WGM * nN, gid = wgid / nig, fm = gid * WGM, gsz = (nM - fm) < WGM ? (nM - fm) : WGM;
        u.pm = fm + ((wgid % nig) % gsz); u.pn = (wgid % nig) / gsz; return true;
    }
    __device__ __forceinline__ void a_ready(const Unit&) const {}
    __device__ __forceinline__ void done(const Unit&) const {}
};

__device__ __forceinline__ unsigned cvt_pk_bf16(float lo, float hi) { unsigned r; asm volatile("v_cvt_pk_bf16_f32 %0, %1, %2" : "=v"(r) : "v"(lo), "v"(hi)); return r; }
typedef float f32x2 __attribute__((ext_vector_type(2)));
__device__ __forceinline__ f32x2 gelu_pk(f32x2 v) {
    const f32x2 av = __builtin_elementwise_abs(v), d = av * 0.2316418882f + 1.0f;
    f32x2 t; t.x = __builtin_amdgcn_rcpf(d.x); t.y = __builtin_amdgcn_rcpf(d.y);
    f32x2 q = t * 0.5307027145f + (-0.7265760135f); q = q * t + 0.7107068705f; q = q * t + (-0.142248368f); q = q * t + 0.127414796f; q = q * t;
    const f32x2 s = (v * v) * (-0.72134752044f);
    f32x2 e; e.x = __builtin_amdgcn_exp2f(s.x); e.y = __builtin_amdgcn_exp2f(s.y);
    const f32x2 m = v * (q * e), r = v - m;
    f32x2 o; o.x = v.x < 0.f ? m.x : r.x; o.y = v.y < 0.f ? m.y : r.y; return o;
}

template <int ACT  > struct EpiBf16 {
    static constexpr bool PERM = true, AFTER_DRAIN = false; static_assert(ACT == 0 || ACT == 1, "EpiBf16: ACT is 0 (none) or 1 (gelu_pk)");
    bf16_t* O; int ldc; const float* bias; int split_cols; size_t split_stride; float scale0;
    __device__ __forceinline__ void operator()(const f32x4 (&acc)[2][2][4][2], const Unit& u, int wr, int wc, int fr, int fq) const {
        const int row0 = u.pm * BM + wr * 64 + fr; int colt = u.pn * BM; bf16_t* base = O;
        float sc = 1.f; if (split_cols) { const int t = colt / split_cols; base += (size_t)t * split_stride; colt -= t * split_cols; if (t == 0) sc = scale0; }
        const int col0 = colt + wc * 32 + 8 * fq, bcol0 = u.pn * BM + wc * 32 + 8 * fq;
        f32x4 bv[2][2];
#pragma unroll
        for (int bj = 0; bj < 2; ++bj)
#pragma unroll
            for (int n = 0; n < 2; ++n) bv[bj][n] = bias ? *(const f32x4*)(bias + bcol0 + bj * HALF + 4 * n) : (f32x4){0.f, 0.f, 0.f, 0.f};
#pragma unroll
        for (int ai = 0; ai < 2; ++ai)
#pragma unroll
            for (int m = 0; m < 4; ++m) { bf16_t* rowp = base + (size_t)(row0 + ai * HALF + m * 16) * ldc + col0;
#pragma unroll
                for (int bj = 0; bj < 2; ++bj) { f32x4 v0 = acc[ai][bj][m][0] + bv[bj][0], v1 = acc[ai][bj][m][1] + bv[bj][1];
                    if (ACT == 1) { f32x2 a = gelu_pk((f32x2){v0[0], v0[1]}), b = gelu_pk((f32x2){v0[2], v0[3]}), c = gelu_pk((f32x2){v1[0], v1[1]}), d = gelu_pk((f32x2){v1[2], v1[3]});
                        v0 = (f32x4){a.x, a.y, b.x, b.y}; v1 = (f32x4){c.x, c.y, d.x, d.y}; }
                    v0 = v0 * sc; v1 = v1 * sc; u32x4 w; w.x = cvt_pk_bf16(v0[0], v0[1]); w.y = cvt_pk_bf16(v0[2], v0[3]); w.z = cvt_pk_bf16(v1[0], v1[1]); w.w = cvt_pk_bf16(v1[2], v1[3]);
                    *(u32x4*)(rowp + bj * HALF) = w; } }
    }
};

struct PanelStats {
    unsigned* xbuf;
    unsigned* cnt;
    unsigned* tmo;
    int ntn; float eps;
    unsigned code;
    __device__ __forceinline__ bool run(const f32x4 (&v)[2][2][4][2], const Unit& u, int wr, int wc, int fr, int fq, PG8_LAS unsigned char* lds, int wid, int lane) const {
        typedef float f32x2v __attribute__((ext_vector_type(2)));
        PG8_LAS f32x2v* P = (PG8_LAS f32x2v*)lds;
        PG8_LAS f32x2v* S = (PG8_LAS f32x2v*)(lds + 8192);
        PG8_LAS unsigned* flag = (PG8_LAS unsigned*)(lds + 8192 + 2048);
#pragma unroll
        for (int ai = 0; ai < 2; ++ai)
#pragma unroll
            for (int m = 0; m < 4; ++m) {
                float s = 0.f;
#pragma unroll
                for (int bj = 0; bj < 2; ++bj)
#pragma unroll
                    for (int n = 0; n < 2; ++n) { const f32x4 x = v[ai][bj][m][n]; s += (x[0] + x[1]) + (x[2] + x[3]); }
                s += __shfl_xor(s, 16); s += __shfl_xor(s, 32);
                const float mw = s * (1.0f / 64.0f); float q = 0.f;
#pragma unroll
                for (int bj = 0; bj < 2; ++bj)
#pragma unroll
                    for (int n = 0; n < 2; ++n) { const f32x4 d = v[ai][bj][m][n] - mw; q += (d[0] * d[0] + d[1] * d[1]) + (d[2] * d[2] + d[3] * d[3]); }
                q += __shfl_xor(q, 16); q += __shfl_xor(q, 32);
                if (fq == 0) P[(ai * HALF + wr * 64 + m * 16 + fr) * 4 + wc] = (f32x2v){mw, q};
            }
        asm volatile("s_waitcnt lgkmcnt(0)" ::: "memory"); __builtin_amdgcn_s_barrier(); asm volatile("" ::: "memory");
#if defined(BROKEN_EXCHANGE_NO_WAIT)
#warning BROKEN CONTROL BUILD: the row-statistics exchange does not wait; results are wrong by design
        if (blockIdx.x >= 64) { const long long t0_ = clock64(); while (clock64() - t0_ < 60000) __builtin_amdgcn_s_sleep(8); }
#endif
        const int row = wid * 32 + (lane & 31);
        if (lane < 32) {
            const f32x2v a = P[row * 4 + 0], b = P[row * 4 + 1], c = P[row * 4 + 2], d = P[row * 4 + 3];
            const float mt = (a.x + b.x + c.x + d.x) * 0.25f;
            const float da = a.x - mt, db = b.x - mt, dc = c.x - mt, dd = d.x - mt;
            const float m2 = (a.y + b.y) + (c.y + d.y) + 64.0f * ((da * da + db * db) + (dc * dc + dd * dd));
            unsigned long long* slot = (unsigned long long*)xbuf + ((size_t)(u.pm * BM + row) * 4 + u.pn);
            __hip_atomic_store(slot, ((unsigned long long)__float_as_uint(m2) << 32) | __float_as_uint(mt), __ATOMIC_RELAXED, __HIP_MEMORY_SCOPE_AGENT);
        }
        asm volatile("s_waitcnt vmcnt(0)" ::: "memory");
        if (lane == 0) __hip_atomic_fetch_add(cnt + 64 * u.pm, 1u, __ATOMIC_RELAXED, __HIP_MEMORY_SCOPE_AGENT);
        if (wid == 0) {
            bool dead = false; const unsigned long long t0 = __builtin_amdgcn_s_memrealtime(); const unsigned want = 8u * (unsigned)ntn;
            for (;;) {
#if defined(BROKEN_EXCHANGE_NO_WAIT)
                break;
#endif
                if ((unsigned)__builtin_amdgcn_readfirstlane(__hip_atomic_load(cnt + 64 * u.pm, __ATOMIC_RELAXED, __HIP_MEMORY_SCOPE_AGENT)) >= want) break;
                if (__builtin_amdgcn_s_memrealtime() - t0 > 2000000ull) {
                    if (lane == 0) { unsigned expect = 0u; __hip_atomic_compare_exchange_strong(tmo + 1, &expect, code | (unsigned)(u.pm & 0xff), __ATOMIC_RELAXED, __ATOMIC_RELAXED, __HIP_MEMORY_SCOPE_AGENT);
                                     __hip_atomic_store(tmo, 1u, __ATOMIC_RELAXED, __HIP_MEMORY_SCOPE_AGENT); }
                    dead = true; break; }
                __builtin_amdgcn_s_sleep(2);
            }
            __builtin_amdgcn_fence(__ATOMIC_ACQUIRE, "agent");
            if (lane == 0) flag[0] = dead ? 1u : 0u;
        }
        asm volatile("s_waitcnt vmcnt(0) lgkmcnt(0)" ::: "memory"); __builtin_amdgcn_s_barrier(); asm volatile("" ::: "memory");
        const bool bad = flag[0] != 0u;
        if (lane < 32) {
            const unsigned long long* slot = (const unsigned long long*)xbuf + (size_t)(u.pm * BM + row) * 4; float mt[4], m2[4]; float ms = 0.f;
#pragma unroll
            for (int t = 0; t < 4; ++t) { if (t < ntn) { const unsigned long long w = __hip_atomic_load(slot + t, __ATOMIC_RELAXED, __HIP_MEMORY_SCOPE_AGENT); mt[t] = __uint_as_float((unsigned)w); m2[t] = __uint_as_float((unsigned)(w >> 32)); } else { mt[t] = 0.f; m2[t] = 0.f; } ms += mt[t]; }
            const float mean = ms / (float)ntn; float q = 0.f;
#pragma unroll
            for (int t = 0; t < 4; ++t) if (t < ntn) { const float dm = mt[t] - mean; q += m2[t] + 256.0f * dm * dm; }
            S[row] = (f32x2v){mean, 1.0f / sqrtf(q / (256.0f * (float)ntn) + eps)};
        }
        asm volatile("s_waitcnt lgkmcnt(0)" ::: "memory"); __builtin_amdgcn_s_barrier(); asm volatile("" ::: "memory");
        return bad;
    }
};
struct EpiLnRes {
    static constexpr bool PERM = false, AFTER_DRAIN = true;
    const float* base; float* out; int ldc; const float* bias; PanelStats st; unsigned poison;
    __device__ __forceinline__ void fused(f32x4 (&acc)[2][2][4][2], const Unit& u, int wr, int wc, int fr, int fq, PG8_LAS unsigned char* lds, int wid, int lane) const {
        typedef float f32x2v __attribute__((ext_vector_type(2)));
        const PG8_LAS f32x2v* S = (const PG8_LAS f32x2v*)(lds + 8192);
        const int col0 = u.pn * BM + wc * 32 + 4 * fq;
#pragma unroll
        for (int bj = 0; bj < 2; ++bj)
#pragma unroll
            for (int n = 0; n < 2; ++n) { const f32x4 bv = bias ? *(const f32x4*)(bias + col0 + bj * HALF + n * 16) : (f32x4){0.f, 0.f, 0.f, 0.f};
#pragma unroll
                for (int ai = 0; ai < 2; ++ai)
#pragma unroll
                    for (int m = 0; m < 4; ++m) acc[ai][bj][m][n] += bv; }
        f32x4 pre[4][2][2];
#pragma unroll
        for (int m = 0; m < 4; ++m) { const size_t off = (size_t)(u.pm * BM + wr * 64 + m * 16 + fr) * ldc + col0;
#pragma unroll
            for (int bj = 0; bj < 2; ++bj)
#pragma unroll
                for (int n = 0; n < 2; ++n) pre[m][bj][n] = *(const f32x4*)(base + off + bj * HALF + n * 16); }
        const bool bad = st.run(acc, u, wr, wc, fr, fq, lds, wid, lane) || poison != 0u;
        const float qnan = __builtin_nanf("");
#pragma unroll
        for (int ai = 0; ai < 2; ++ai)
#pragma unroll
            for (int m = 0; m < 4; ++m) { const int r = ai * HALF + wr * 64 + m * 16 + fr; const f32x2v sr = S[r]; const size_t off = (size_t)(u.pm * BM + r) * ldc + col0;
#pragma unroll
                for (int bj = 0; bj < 2; ++bj)
#pragma unroll
                    for (int n = 0; n < 2; ++n) { const f32x4 bs = ai == 0 ? pre[m][bj][n] : *(const f32x4*)(base + off + bj * HALF + n * 16); f32x4 o = bs + (acc[ai][bj][m][n] - sr.x) * sr.y;
                        if (bad) o = (f32x4){qnan, qnan, qnan, qnan}; *(f32x4*)(out + off + bj * HALF + n * 16) = o; }
                if (m & 1) asm volatile("" ::: "memory"); }
    }
};
struct EpiLnResLn {
    static constexpr bool PERM = false, AFTER_DRAIN = true;
    const float* base; float* out; bf16_t* xn; int ldc; const float* bias; PanelStats st1, st2; unsigned poison;
    __device__ __forceinline__ void fused(f32x4 (&acc)[2][2][4][2], const Unit& u, int wr, int wc, int fr, int fq, PG8_LAS unsigned char* lds, int wid, int lane) const {
        typedef float f32x2v __attribute__((ext_vector_type(2))); typedef unsigned u32x2v __attribute__((ext_vector_type(2)));
        const PG8_LAS f32x2v* S = (const PG8_LAS f32x2v*)(lds + 8192);
        const int col0 = u.pn * BM + wc * 32 + 4 * fq;
#pragma unroll
        for (int bj = 0; bj < 2; ++bj)
#pragma unroll
            for (int n = 0; n < 2; ++n) { const f32x4 bv = bias ? *(const f32x4*)(bias + col0 + bj * HALF + n * 16) : (f32x4){0.f, 0.f, 0.f, 0.f};
#pragma unroll
                for (int ai = 0; ai < 2; ++ai)
#pragma unroll
                    for (int m = 0; m < 4; ++m) acc[ai][bj][m][n] += bv; }
        bool bad = st1.run(acc, u, wr, wc, fr, fq, lds, wid, lane) || poison != 0u;
        const float qnan = __builtin_nanf("");
#pragma unroll
        for (int ai = 0; ai < 2; ++ai)
#pragma unroll
            for (int m = 0; m < 4; ++m) { const int r = ai * HALF + wr * 64 + m * 16 + fr; const f32x2v sr = S[r]; const size_t off = (size_t)(u.pm * BM + r) * ldc + col0;
#pragma unroll
                for (int bj = 0; bj < 2; ++bj)
#pragma unroll
                    for (int n = 0; n < 2; ++n) { const f32x4 bs = *(const f32x4*)(base + off + bj * HALF + n * 16); acc[ai][bj][m][n] = bs + (acc[ai][bj][m][n] - sr.x) * sr.y; }
                asm volatile("" : "+v"(acc[ai][0][m][0]), "+v"(acc[ai][0][m][1]), "+v"(acc[ai][1][m][0]), "+v"(acc[ai][1][m][1]));
                if (m & 1) asm volatile("" ::: "memory"); }
        const bool bad1 = bad;
        bad = st2.run(acc, u, wr, wc, fr, fq, lds, wid, lane) || bad;
#pragma unroll
        for (int ai = 0; ai < 2; ++ai)
#pragma unroll
            for (int m = 0; m < 4; ++m) { const int r = ai * HALF + wr * 64 + m * 16 + fr; const f32x2v sr = S[r]; const size_t off = (size_t)(u.pm * BM + r) * ldc + col0;
#pragma unroll
                for (int bj = 0; bj < 2; ++bj)
#pragma unroll
                    for (int n = 0; n < 2; ++n) { const f32x4 x1 = acc[ai][bj][m][n]; *(f32x4*)(out + off + bj * HALF + n * 16) = bad1 ? (f32x4){qnan, qnan, qnan, qnan} : x1;
                        const f32x4 o = (x1 - sr.x) * sr.y; u32x2v w; w.x = cvt_pk_bf16(o[0], o[1]); w.y = cvt_pk_bf16(o[2], o[3]);
                        if (bad) { w.x = 0x7fc07fc0u; w.y = 0x7fc07fc0u; } *(u32x2v*)(xn + off + bj * HALF + n * 16) = w; }
                asm volatile("" ::: "memory"); }
    }
};

template <class Epi, class Sched, bool ALIGN_EPI = false, bool SP2 = false>
__device__ __forceinline__ void gemm_phase(PG8_LAS unsigned char* lds, const Gemm g, const Sched& S, const Epi& E) {
    const int tid = threadIdx.x, wid = __builtin_amdgcn_readfirstlane(tid >> 6), lane = tid & 63, wr = wid >> 2, wc = wid & 3, fr = lane & 15, fq = lane >> 4;
    const int K = g.K, nt = K / BK;
    unsigned voffA[2], voffB[2];
#pragma unroll
    for (int i = 0; i < 2; ++i) { int R, C; stage_rc(tid * 16 + i * 8192, R, C); const int Rb = Epi::PERM ? ((R & ~31) + perm32(R & 31)) : R;
        voffA[i] = (unsigned)(R * K + C) * 2u; voffB[i] = (unsigned)(Rb * K + C) * 2u; }
    const size_t kstep = (size_t)(BK * 2);
    const size_t hstep = (size_t)HALF * K * 2;
    const size_t tstep = 2 * hstep;
    const unsigned ldsw = (unsigned)wid * 1024u;
    const int aoff = lds_byte(wr * 64 + fr, fq * 8), boff = lds_byte(wc * 32 + fr, fq * 8);
#define PG8_SA(b, h) (((b) * 2 + (h)) * HTB)
#define PG8_SB(b, h) ((4 + (b) * 2 + (h)) * HTB)
#define PG8_STAGE(bufoff, gbase, voff) do { _Pragma("unroll") for (int _i = 0; _i < 2; ++_i) \
        __builtin_amdgcn_global_load_lds((const unsigned*)((const char*)(gbase) + (voff)[_i]), (PG8_LAS unsigned*)(lds + (bufoff) + ldsw + _i * 8192), 16, 0, 0); } while (0)
#define PG8_LDA(dst, b, h) do { _Pragma("unroll") for (int m = 0; m < 4; ++m) _Pragma("unroll") for (int k = 0; k < 2; ++k) dst[m][k] = *(const PG8_LAS bf16x8*)(lds + PG8_SA(b, h) + aoff + m * 2048 + k * 1024); } while (0)
#define PG8_LDB(dst, b, h) do { _Pragma("unroll") for (int n = 0; n < 2; ++n) _Pragma("unroll") for (int k = 0; k < 2; ++k) dst[n][k] = *(const PG8_LAS bf16x8*)(lds + PG8_SB(b, h) + boff + n * 2048 + k * 1024); } while (0)
#define PG8_MMA(ai, bj, At, Bt) do { __builtin_amdgcn_s_setprio(1); _Pragma("unroll") for (int m = 0; m < 4; ++m) _Pragma("unroll") for (int n = 0; n < 2; ++n) _Pragma("unroll") for (int k = 0; k < 2; ++k) \
        acc[ai][bj][m][n] = __builtin_amdgcn_mfma_f32_16x16x32_bf16(Bt[n][k], At[m][k], acc[ai][bj][m][n], 0, 0, 0); __builtin_amdgcn_s_setprio(0); } while (0)
#define PG8_WAIT_V(n) asm volatile("s_waitcnt vmcnt(" #n ")" ::: "memory")
#define PG8_WAIT_L(n) asm volatile("s_waitcnt lgkmcnt(" #n ")" ::: "memory")
#define PG8_BAR __builtin_amdgcn_s_barrier()
#define PG8_SCHED __builtin_amdgcn_sched_barrier(0)
    Unit cur, nxt; int ui = 0;
    if (!S.next(0, cur)) return;
    f32x4 acc[2][2][4][2];
#pragma unroll
    for (int a = 0; a < 2; ++a)
#pragma unroll
        for (int b = 0; b < 2; ++b)
#pragma unroll
            for (int m = 0; m < 4; ++m)
#pragma unroll
                for (int n = 0; n < 2; ++n) acc[a][b][m][n] = (f32x4){0.f, 0.f, 0.f, 0.f};
    bf16x8 At[4][2], B0[2][2], B1[2][2];
    const char* cA = (const char*)g.A + (size_t)cur.pm * tstep; const char* cB = (const char*)g.Bt + (size_t)cur.pn * tstep;
    S.a_ready(cur);
    if constexpr (SP2) {
        PG8_STAGE(PG8_SB(0, 0), cB, voffB); PG8_STAGE(PG8_SB(0, 1), cB + hstep, voffB); PG8_STAGE(PG8_SA(0, 0), cA, voffA); PG8_STAGE(PG8_SA(0, 1), cA + hstep, voffA);
        if (wr == 1) PG8_BAR;
        PG8_WAIT_V(2); PG8_BAR;
        PG8_STAGE(PG8_SB(1, 0), cB + kstep, voffB); PG8_STAGE(PG8_SA(1, 0), cA + kstep, voffA); PG8_STAGE(PG8_SB(1, 1), cB + hstep + kstep, voffB);
        PG8_WAIT_V(6); PG8_BAR;
    } else {
        PG8_STAGE(PG8_SB(0, 0), cB, voffB); PG8_STAGE(PG8_SA(0, 0), cA, voffA); PG8_STAGE(PG8_SB(0, 1), cB + hstep, voffB); PG8_STAGE(PG8_SA(0, 1), cA + hstep, voffA);
        if (wr == 1) PG8_BAR;
        PG8_WAIT_V(4); PG8_BAR;
        PG8_STAGE(PG8_SB(1, 0), cB + kstep, voffB); PG8_STAGE(PG8_SA(1, 0), cA + kstep, voffA); PG8_STAGE(PG8_SB(1, 1), cB + hstep + kstep, voffB);
        PG8_WAIT_V(6); PG8_BAR;
    }
    for (;;) {
        const bool has_next = S.next(ui + 1, nxt);
        const char* nA = has_next ? (const char*)g.A + (size_t)nxt.pm * tstep : cA; const char* nB = has_next ? (const char*)g.Bt + (size_t)nxt.pn * tstep : cB;
        for (int t = 0; t < nt; t += 2) {
            const bool last = (t == nt - 2);
            const char* a1 = cA + (size_t)(t + 1) * kstep;
            const char* a2 = last ? nA : cA + (size_t)(t + 2) * kstep; const char* b2 = last ? nB : cB + (size_t)(t + 2) * kstep;
            const char* a3 = a2 + kstep; const char* b3 = b2 + kstep;
            if (last && has_next) S.a_ready(nxt);
            if constexpr (SP2) {
            PG8_LDB(B0, 0, 0); PG8_LDB(B1, 0, 1); PG8_SCHED; PG8_LDA(At, 0, 0); PG8_STAGE(PG8_SA(1, 1), a1 + hstep, voffA);
            PG8_WAIT_V(8); PG8_WAIT_L(0); PG8_BAR; PG8_MMA(0, 0, At, B0); PG8_MMA(0, 1, At, B1); PG8_BAR; PG8_SCHED;
            PG8_LDA(At, 0, 1); PG8_STAGE(PG8_SB(0, 0), b2, voffB); PG8_STAGE(PG8_SB(0, 1), b2 + hstep, voffB); PG8_STAGE(PG8_SA(0, 0), a2, voffA);
            PG8_WAIT_V(8); PG8_WAIT_L(0); PG8_BAR; PG8_MMA(1, 0, At, B0); PG8_MMA(1, 1, At, B1); PG8_BAR; PG8_SCHED;
            PG8_LDB(B0, 1, 0); PG8_LDB(B1, 1, 1); PG8_SCHED; PG8_LDA(At, 1, 0); PG8_STAGE(PG8_SA(0, 1), a2 + hstep, voffA);
            PG8_WAIT_V(8); PG8_WAIT_L(0); PG8_BAR; PG8_MMA(0, 0, At, B0); PG8_MMA(0, 1, At, B1); PG8_BAR; PG8_SCHED;
            PG8_LDA(At, 1, 1); PG8_STAGE(PG8_SB(1, 0), b3, voffB); PG8_STAGE(PG8_SB(1, 1), b3 + hstep, voffB); PG8_STAGE(PG8_SA(1, 0), a3, voffA);
            PG8_WAIT_V(8); PG8_WAIT_L(0); PG8_BAR; PG8_MMA(1, 0, At, B0); PG8_MMA(1, 1, At, B1); PG8_BAR; PG8_SCHED;
            } else {
            PG8_LDB(B0, 0, 0); PG8_SCHED; PG8_LDA(At, 0, 0); PG8_STAGE(PG8_SA(1, 1), a1 + hstep, voffA);
            PG8_WAIT_L(8); PG8_BAR; PG8_WAIT_L(0); PG8_MMA(0, 0, At, B0); PG8_BAR; PG8_SCHED;
            PG8_LDB(B1, 0, 1); PG8_STAGE(PG8_SB(0, 0), b2, voffB);
            PG8_BAR; PG8_WAIT_L(0); PG8_MMA(0, 1, At, B1); PG8_BAR;
            PG8_LDA(At, 0, 1); PG8_STAGE(PG8_SA(0, 0), a2, voffA);
            PG8_BAR; PG8_WAIT_L(0); PG8_MMA(1, 0, At, B0); PG8_BAR; PG8_SCHED;
            PG8_STAGE(PG8_SB(0, 1), b2 + hstep, voffB);
            PG8_WAIT_V(6); PG8_BAR; PG8_MMA(1, 1, At, B1); PG8_BAR;
            PG8_LDB(B0, 1, 0); PG8_SCHED; PG8_LDA(At, 1, 0); PG8_STAGE(PG8_SA(0, 1), a2 + hstep, voffA);
            PG8_WAIT_L(8); PG8_BAR; PG8_WAIT_L(0); PG8_MMA(0, 0, At, B0); PG8_BAR; PG8_SCHED;
            PG8_LDB(B1, 1, 1); PG8_STAGE(PG8_SB(1, 0), b3, voffB);
            PG8_BAR; PG8_WAIT_L(0); PG8_MMA(0, 1, At, B1); PG8_BAR;
            PG8_LDA(At, 1, 1); PG8_STAGE(PG8_SA(1, 0), a3, voffA);
            PG8_BAR; PG8_WAIT_L(0); PG8_MMA(1, 0, At, B0); PG8_BAR; PG8_SCHED;
            PG8_STAGE(PG8_SB(1, 1), b3 + hstep, voffB);
            PG8_WAIT_V(6); PG8_BAR; PG8_MMA(1, 1, At, B1); PG8_BAR;
            }
        }
        if constexpr (ALIGN_EPI) { if (wr == 0) PG8_BAR; }
        if constexpr (!Epi::AFTER_DRAIN) { E(acc, cur, wr, wc, fr, fq); S.done(cur); }
        if (!has_next) break;
#pragma unroll
        for (int a = 0; a < 2; ++a)
#pragma unroll
            for (int b = 0; b < 2; ++b)
#pragma unroll
                for (int m = 0; m < 4; ++m)
#pragma unroll
                    for (int n = 0; n < 2; ++n) acc[a][b][m][n] = (f32x4){0.f, 0.f, 0.f, 0.f};
        cur = nxt; cA = nA; cB = nB; ++ui;
        if constexpr (ALIGN_EPI) { if (wr == 1) PG8_BAR; }
    }
    PG8_WAIT_V(0);
    if constexpr (!ALIGN_EPI) { if (wr == 0) PG8_BAR; }
    PG8_BAR;
    if constexpr (Epi::AFTER_DRAIN) { E.fused(acc, cur, wr, wc, fr, fq, lds, wid, lane); S.done(cur); }
#undef PG8_SA
#undef PG8_SB
#undef PG8_STAGE
#undef PG8_LDA
#undef PG8_LDB
#undef PG8_MMA
#undef PG8_WAIT_V
#undef PG8_WAIT_L
#undef PG8_BAR
#undef PG8_SCHED
}
}

typedef float f32x2_t __attribute__((ext_vector_type(2))); typedef __bf16 bf16x2_t __attribute__((ext_vector_type(2)));
__device__ __forceinline__ unsigned cvtpk(float lo, float hi) { f32x2_t v = {lo, hi}; bf16x2_t b = __builtin_convertvector(v, bf16x2_t); return __builtin_bit_cast(unsigned, b); }

namespace pg8 {
template <bool BASE_BF16> struct EpiRes {
    static constexpr bool PERM = true, AFTER_DRAIN = false;
    const void* base; bf16_t* hb; float* ssq;
    __device__ __forceinline__ void operator()(const f32x4 (&acc)[2][2][4][2], const Unit& u, int wr, int wc, int fr, int fq) const {
        const int row0 = u.pm * BM + wr * 64 + fr, col0 = u.pn * BM + wc * 32 + 8 * fq;
#pragma unroll
        for (int ai = 0; ai < 2; ++ai) {
            f32x4 b0[4][2], b1[4][2];
#pragma unroll
            for (int m = 0; m < 4; ++m)
#pragma unroll
                for (int bj = 0; bj < 2; ++bj) {
                    const size_t off = (size_t)(row0 + ai * HALF + m * 16) * 1024 + col0 + bj * HALF;
                    if (BASE_BF16) {
                        const u32x4 w = *(const u32x4*)((const bf16_t*)base + off);
                        b0[m][bj][0] = __uint_as_float(w.x << 16); b0[m][bj][1] = __uint_as_float(w.x & 0xffff0000u); b0[m][bj][2] = __uint_as_float(w.y << 16); b0[m][bj][3] = __uint_as_float(w.y & 0xffff0000u);
                        b1[m][bj][0] = __uint_as_float(w.z << 16); b1[m][bj][1] = __uint_as_float(w.z & 0xffff0000u); b1[m][bj][2] = __uint_as_float(w.w << 16); b1[m][bj][3] = __uint_as_float(w.w & 0xffff0000u);
                    } else { b0[m][bj] = *(const f32x4*)((const float*)base + off); b1[m][bj] = *(const f32x4*)((const float*)base + off + 4); }
                }
#pragma unroll
            for (int m = 0; m < 4; ++m) {
                const size_t row = (size_t)(row0 + ai * HALF + m * 16); float s = 0.f;
#pragma unroll
                for (int bj = 0; bj < 2; ++bj) {
                    const size_t off = row * 1024 + col0 + bj * HALF;
                    const f32x4 v0 = acc[ai][bj][m][0] + b0[m][bj], v1 = acc[ai][bj][m][1] + b1[m][bj];
                    s += (v0[0] * v0[0] + v0[1] * v0[1]) + (v0[2] * v0[2] + v0[3] * v0[3]) + (v1[0] * v1[0] + v1[1] * v1[1]) + (v1[2] * v1[2] + v1[3] * v1[3]);
                    u32x4 w; w.x = cvtpk(v0[0], v0[1]); w.y = cvtpk(v0[2], v0[3]); w.z = cvtpk(v1[0], v1[1]); w.w = cvtpk(v1[2], v1[3]); *(u32x4*)(hb + off) = w;
                }
                s += __shfl_xor(s, 16); s += __shfl_xor(s, 32); if (fq == 0) ssq[row * 16 + u.pn * 4 + wc] = s;
            }
        }
    }
};
template <int MODE> struct EpiScale {
    static constexpr bool PERM = true, AFTER_DRAIN = false;
    bf16_t* O; int ldc; const float* ssq; float scale;
    __device__ __forceinline__ void operator()(const f32x4 (&acc)[2][2][4][2], const Unit& u, int wr, int wc, int fr, int fq) const {
        const int row0 = u.pm * BM + wr * 64 + fr, col0 = u.pn * BM + wc * 32 + 8 * fq;
        f32x4 sp[2][4];
#pragma unroll
        for (int ai = 0; ai < 2; ++ai)
#pragma unroll
            for (int m = 0; m < 4; ++m) sp[ai][m] = *(const f32x4*)(ssq + (size_t)(row0 + ai * HALF + m * 16) * 16 + 4 * fq);
#pragma unroll
        for (int ai = 0; ai < 2; ++ai)
#pragma unroll
            for (int m = 0; m < 4; ++m) {
                const size_t row = (size_t)(row0 + ai * HALF + m * 16);
                float t = (sp[ai][m][0] + sp[ai][m][1]) + (sp[ai][m][2] + sp[ai][m][3]);
                t += __shfl_xor(t, 16); t += __shfl_xor(t, 32);
                const float rs = __builtin_amdgcn_rsqf(t * (1.0f / 1024.0f) + 1e-6f) * scale;
#pragma unroll
                for (int bj = 0; bj < 2; ++bj) {
                    f32x4 v0 = acc[ai][bj][m][0] * rs, v1 = acc[ai][bj][m][1] * rs;
                    if (MODE == 1) {
#pragma unroll
                        for (int e = 0; e < 4; ++e) { const float a = fmaxf(v0[e], 0.f), b = fmaxf(v1[e], 0.f); v0[e] = a * a; v1[e] = b * b; }
                    }
                    u32x4 w; w.x = cvtpk(v0[0], v0[1]); w.y = cvtpk(v0[2], v0[3]); w.z = cvtpk(v1[0], v1[1]); w.w = cvtpk(v1[2], v1[3]);
                    *(u32x4*)(O + row * ldc + col0 + bj * HALF) = w;
                }
            }
    }
};
struct EpiKV {
    static constexpr bool PERM = true, AFTER_DRAIN = false;
    bf16_t* Kb; bf16_t* Vt;
    __device__ __forceinline__ void operator()(const f32x4 (&acc)[2][2][4][2], const Unit& u, int wr, int wc, int fr, int fq) const {
        const int row0 = u.pm * BM + wr * 64 + fr, col0 = u.pn * BM + wc * 32 + 8 * fq;
#pragma unroll
        for (int ai = 0; ai < 2; ++ai)
#pragma unroll
            for (int m = 0; m < 4; ++m) {
                const int row = row0 + ai * HALF + m * 16;
#pragma unroll
                for (int bj = 0; bj < 2; ++bj) {
                    const int col = col0 + bj * HALF; const f32x4 v0 = acc[ai][bj][m][0], v1 = acc[ai][bj][m][1];
                    u32x4 w; w.x = cvtpk(v0[0], v0[1]); w.y = cvtpk(v0[2], v0[3]); w.z = cvtpk(v1[0], v1[1]); w.w = cvtpk(v1[2], v1[3]);
                    if (col < 1024) { *(u32x4*)(Kb + (size_t)row * 1024 + col) = w; }
                    else {
                        const int b = row >> 8, mm = row & 255; bf16_t* p = Vt + ((size_t)(b * 1024 + (col - 1024))) * 256 + mm;
                        p[0 * 256] = (bf16_t)(w.x & 0xffffu); p[1 * 256] = (bf16_t)(w.x >> 16); p[2 * 256] = (bf16_t)(w.y & 0xffffu); p[3 * 256] = (bf16_t)(w.y >> 16);
                        p[4 * 256] = (bf16_t)(w.z & 0xffffu); p[5 * 256] = (bf16_t)(w.z >> 16); p[6 * 256] = (bf16_t)(w.w & 0xffffu); p[7 * 256] = (bf16_t)(w.w >> 16);
                    }
                }
            }
    }
};
}

#define LAS __attribute__((address_space(3)))
typedef pg8::bf16_t bf16_t;
typedef pg8::bf16x8 bf16x8;
typedef pg8::f32x4 f32x4;
typedef pg8::u32x4 u32x4;
typedef unsigned u32x2 __attribute__((ext_vector_type(2)));

constexpr int NTOK = 32768, DM = 1024, SEQ = 8192, NBATCH = 4, NCHUNK = 128, NPROJ = 3328, DFF = 4096, NMEMROWS = 1024;
constexpr int C_GQ = 0, C_GK = 256, C_GV = 512, C_GG = 1024, C_RQ = 1536, C_RK = 1792, C_RV = 2048, C_RG = 2560, C_Z = 3072;
constexpr int NWAVES = 8, NTHREADS = 512;
constexpr int WAVE_LDS = 18432, MISC_OFF = NWAVES * WAVE_LDS, LDS_BYTES = MISC_OFF + 64;
constexpr int VPITCH = 72;
constexpr int APITCH = 528;
constexpr size_t MiB = 1u << 20;
constexpr size_t WS_WIN = 1 * MiB, WS_WOUT = 8 * MiB, WS_WQ = 10 * MiB, WS_WKV = 12 * MiB, WS_WO = 16 * MiB, WS_W1 = 18 * MiB, WS_W2 = 26 * MiB;
constexpr size_t WS_COS = 34 * MiB, WS_SIN = 35 * MiB, WS_MEMN = 36 * MiB, WS_KB = 38 * MiB, WS_VT = 40 * MiB, WS_DEC = 42 * MiB, WS_SSQ1 = 44 * MiB, WS_SSQ2 = 46 * MiB, WS_SSQ3 = 48 * MiB, WS_CTL = 0;
constexpr size_t WS_A1 = 64 * MiB;
constexpr size_t WS_A2 = 128 * MiB;
constexpr size_t WS_BIG = 192 * MiB;
constexpr size_t WS_NEED = 448 * MiB;

struct Params {
    const float *x, *mem, *norm_mix_g, *w_in, *gla_w_gate, *gla_b_gate, *gla_norm_g, *ret_norm_g, *w_out, *norm_x_g, *norm_mem_g, *xa_w_q, *xa_w_kv, *xa_w_o, *norm_ffn_g, *ffn_w1, *ffn_w2, *final_norm_g;
    float* out; unsigned char* ws; int ph_lo, ph_hi;
};

__device__ __forceinline__ float bf2f(unsigned short b) { return __uint_as_float(((unsigned)b) << 16); }
__device__ __forceinline__ unsigned short f2bf(float f) { const unsigned u = __float_as_uint(f); return (unsigned short)((u + 0x7fffu + ((u >> 16) & 1u)) >> 16); }
__device__ __forceinline__ bf16x8 pack8(f32x4 a, f32x4 b) {
    u32x4 w; w.x = cvtpk(a[0], a[1]); w.y = cvtpk(a[2], a[3]); w.z = cvtpk(b[0], b[1]); w.w = cvtpk(b[2], b[3]);
    return __builtin_bit_cast(bf16x8, w);
}
__device__ __forceinline__ void unpack8(bf16x8 v, f32x4& a, f32x4& b) {
    const u32x4 w = __builtin_bit_cast(u32x4, v);
    a[0] = __uint_as_float(w.x << 16); a[1] = __uint_as_float(w.x & 0xffff0000u); a[2] = __uint_as_float(w.y << 16); a[3] = __uint_as_float(w.y & 0xffff0000u);
    b[0] = __uint_as_float(w.z << 16); b[1] = __uint_as_float(w.z & 0xffff0000u); b[2] = __uint_as_float(w.w << 16); b[3] = __uint_as_float(w.w & 0xffff0000u);
}
__device__ __forceinline__ float wave_sum(float v) {
#pragma unroll
    for (int o = 1; o < 64; o <<= 1) v += __shfl_xor(v, o);
    return v;
}
#define MFMA16(a, b, c) __builtin_amdgcn_mfma_f32_16x16x32_bf16((a), (b), (c), 0, 0, 0)
#define LDS_FENCE() asm volatile("s_waitcnt lgkmcnt(0)" ::: "memory")
#define CFENCE() do { asm volatile("" ::: "memory"); __builtin_amdgcn_sched_barrier(0); } while (0)
__device__ __forceinline__ float scan16(float v, int r) {
#pragma unroll
    for (int off = 1; off < 16; off <<= 1) { const float t = __shfl_up(v, off, 16); if (r >= off) v += t; }
    return v;
}

#define XB_TMO      128
#define XB_XCNT(j)  (256  + 64 * (j))
#define XB_XSUB(j)  (1280 + 64 * (j))
#define XB_XGEN(j)  (2304 + 64 * (j))
#define XB_TOP      3328
#define XB_TOPGEN   3392
#define XCD_BAR_WORDS 3456
#define XB_SPIN_CAP (1u << 18)

__device__ __forceinline__ unsigned xb_ld(unsigned* p)              { return __hip_atomic_load(p, __ATOMIC_RELAXED, __HIP_MEMORY_SCOPE_AGENT); }
__device__ __forceinline__ unsigned xb_add(unsigned* p, unsigned v) { return __hip_atomic_fetch_add(p, v, __ATOMIC_RELAXED, __HIP_MEMORY_SCOPE_AGENT); }
__device__ __forceinline__ unsigned xb_xcc_id() { return (unsigned)__builtin_amdgcn_s_getreg((3 << 11) | 20) & 0xFu; }
#define XB_SPIN(cond, bar) do { unsigned _sp = 0; while (cond) { __builtin_amdgcn_s_sleep(1); \
    if ((++_sp & 255u) == 0u) { if (xb_ld(&(bar)[XB_TMO])) break; if (_sp > XB_SPIN_CAP) { atomicAdd(&(bar)[XB_TMO], 1u); break; } } } } while (0)

struct XcdBarrier {
    unsigned* bar; unsigned x;
    volatile LAS unsigned* st;
};

__device__ __forceinline__ XcdBarrier xcd_barrier_post(unsigned* bar, volatile LAS unsigned* st) {
    XcdBarrier b; b.bar = bar; b.x = xb_xcc_id(); b.st = st;
    if (threadIdx.x == 0) (void)xb_add(&bar[XB_XCNT(b.x)], 1u);
    return b;
}
__device__ __forceinline__ void xcd_barrier_complete(unsigned* bar, unsigned x, unsigned& nloc, unsigned& nx) {
    const unsigned G = gridDim.x * gridDim.y * gridDim.z;
    unsigned sum, cnt, mine, sp = 0u;
    for (;;) {
        sum = 0u; cnt = 0u; mine = 0u;
#pragma unroll
        for (unsigned j = 0; j < 16; ++j) { const unsigned c = xb_ld(&bar[XB_XCNT(j)]); sum += c; cnt += (c > 0u) ? 1u : 0u; mine = (j == x) ? c : mine; }
        if (sum == G) break;
        __builtin_amdgcn_s_sleep(1);
        if ((++sp & 255u) == 0u) { if (xb_ld(&bar[XB_TMO])) break; if (sp > XB_SPIN_CAP) { atomicAdd(&bar[XB_TMO], 1u); break; } }
    }
    nloc = mine > 0u ? mine : 1u; nx = cnt > 0u ? cnt : 1u;
}

__device__ __forceinline__ void xcd_barrier(const XcdBarrier& b) {
    asm volatile("s_waitcnt vmcnt(0)" ::: "memory");
    __syncthreads();
    if (threadIdx.x == 0) {
        unsigned* bar = b.bar;
        __builtin_amdgcn_s_waitcnt(0);
        unsigned nloc = b.st[0], nx = b.st[1];
        if (nloc == 0u) { xcd_barrier_complete(bar, b.x, nloc, nx); b.st[0] = nloc; b.st[1] = nx; }
        const unsigned old = xb_add(&bar[XB_XSUB(b.x)], 1u);
        const unsigned gen = old / nloc;
        if (old + 1u == (gen + 1u) * nloc) {
            __builtin_amdgcn_fence(__ATOMIC_RELEASE, "agent");
            asm volatile("s_waitcnt vmcnt(0)" ::: "memory");
            const unsigned og = xb_add(&bar[XB_TOP], 1u);
            const unsigned tg = og / nx;
            if (og + 1u == (tg + 1u) * nx) xb_add(&bar[XB_TOPGEN], 1u);
            else XB_SPIN(xb_ld(&bar[XB_TOPGEN]) == tg, bar);
            __builtin_amdgcn_fence(__ATOMIC_ACQUIRE, "agent");
            xb_add(&bar[XB_XGEN(b.x)], 1u);
            asm volatile("s_waitcnt vmcnt(0)" ::: "memory");
        } else {
            XB_SPIN(xb_ld(&bar[XB_XGEN(b.x)]) == gen, bar);
            __builtin_amdgcn_fence(__ATOMIC_ACQUIRE, "agent");
            asm volatile("s_waitcnt vmcnt(0)" ::: "memory");
        }
    }
    __syncthreads();
}

__device__ __forceinline__ void transpose_item(const float* W, int ldw, int col0, int K, int Nn, const float* g, bf16_t* WT, int row_off, LAS float* scr, int item, int lane) {
    const int nblk = Nn / 32, kb = item / nblk, nb = item % nblk, k0 = 64 * kb, n0 = 32 * nb;
    f32x4 v[8]; const int c4 = (lane & 7) * 4;
#pragma unroll
    for (int i = 0; i < 8; ++i) { const int kk = (lane >> 3) + 8 * i; v[i] = *(const f32x4*)(W + (size_t)(k0 + kk) * ldw + col0 + n0 + c4); }
#pragma unroll
    for (int i = 0; i < 8; ++i) { const int kk = (lane >> 3) + 8 * i; f32x4 w = v[i]; if (g) w *= g[k0 + kk];
        scr[kk * 33 + c4 + 0] = w[0]; scr[kk * 33 + c4 + 1] = w[1]; scr[kk * 33 + c4 + 2] = w[2]; scr[kk * 33 + c4 + 3] = w[3]; }
    LDS_FENCE();
    const int c = lane & 7;
#pragma unroll
    for (int j = 0; j < 4; ++j) { const int n = (lane >> 3) + 8 * j; const LAS float* s = scr + (8 * c) * 33 + n;
        u32x4 o; o.x = cvtpk(s[0 * 33], s[1 * 33]); o.y = cvtpk(s[2 * 33], s[3 * 33]); o.z = cvtpk(s[4 * 33], s[5 * 33]); o.w = cvtpk(s[6 * 33], s[7 * 33]);
        *(u32x4*)(WT + (size_t)(row_off + n0 + n) * K + k0 + 8 * c) = o; }
    LDS_FENCE();
}
template <int NR> __device__ __forceinline__ void rms_rows_to_bf16(const float* x, const float* g, bf16_t* o, int lane) {
    const f32x4* gr = (const f32x4*)g + lane;
    f32x4 v[NR][4]; float rs[NR];
#pragma unroll
    for (int i = 0; i < NR; ++i)
#pragma unroll
        for (int j = 0; j < 4; ++j) v[i][j] = ((const f32x4*)(x + (size_t)i * DM) + lane)[64 * j];
#pragma unroll
    for (int i = 0; i < NR; ++i) {
        float s = 0.f;
#pragma unroll
        for (int j = 0; j < 4; ++j) s += (v[i][j][0] * v[i][j][0] + v[i][j][1] * v[i][j][1]) + (v[i][j][2] * v[i][j][2] + v[i][j][3] * v[i][j][3]);
        rs[i] = 1.0f / sqrtf(wave_sum(s) * (1.0f / 1024.0f) + 1e-6f);
    }
#pragma unroll
    for (int j = 0; j < 4; ++j) { const f32x4 gg = gr[64 * j];
#pragma unroll
        for (int i = 0; i < NR; ++i) { u32x2 w; w.x = cvtpk(v[i][j][0] * rs[i] * gg[0], v[i][j][1] * rs[i] * gg[1]); w.y = cvtpk(v[i][j][2] * rs[i] * gg[2], v[i][j][3] * rs[i] * gg[3]); ((u32x2*)(o + (size_t)i * DM) + lane)[64 * j] = w; } }
}
__device__ __forceinline__ void p0_prologue(const Params& p, LAS unsigned char* lds, int G) {
    const int tid = threadIdx.x, lane = tid & 63, wave = __builtin_amdgcn_readfirstlane(tid >> 6);
    unsigned char* ws = p.ws;
    LAS float* scr = (LAS float*)(lds + wave * WAVE_LDS);
    const int gw = blockIdx.x * NWAVES + wave, NGW = G * NWAVES;
    bf16_t* Win_t = (bf16_t*)(ws + WS_WIN);
    constexpr int I_INA = 16 * 32, I_INB = 16 * 64, I_OUT = 16 * 32, I_Q = 16 * 32, I_KV = 16 * 64, I_O = 16 * 32, I_1 = 16 * 128, I_2 = 64 * 32;
    constexpr int NITEMS = I_INA + I_INB + I_OUT + I_Q + I_KV + I_O + I_1 + I_2;
    for (int it = gw; it < NITEMS; it += NGW) {
        int r = it;
        if (r < I_INA) { transpose_item(p.w_in, 3088, 0, 1024, 1024, nullptr, Win_t, 0, scr, r, lane); continue; } r -= I_INA;
        if (r < I_INB) { transpose_item(p.w_in, 3088, 1040, 1024, 2048, nullptr, Win_t, 1024, scr, r, lane); continue; } r -= I_INB;
        if (r < I_OUT) { transpose_item(p.w_out, 1024, 0, 1024, 1024, nullptr, (bf16_t*)(ws + WS_WOUT), 0, scr, r, lane); continue; } r -= I_OUT;
        if (r < I_Q) { transpose_item(p.xa_w_q, 1024, 0, 1024, 1024, p.norm_x_g, (bf16_t*)(ws + WS_WQ), 0, scr, r, lane); continue; } r -= I_Q;
        if (r < I_KV) { transpose_item(p.xa_w_kv, 2048, 0, 1024, 2048, nullptr, (bf16_t*)(ws + WS_WKV), 0, scr, r, lane); continue; } r -= I_KV;
        if (r < I_O) { transpose_item(p.xa_w_o, 1024, 0, 1024, 1024, nullptr, (bf16_t*)(ws + WS_WO), 0, scr, r, lane); continue; } r -= I_O;
        if (r < I_1) { transpose_item(p.ffn_w1, 4096, 0, 1024, 4096, p.norm_ffn_g, (bf16_t*)(ws + WS_W1), 0, scr, r, lane); continue; } r -= I_1;
        transpose_item(p.ffn_w2, 1024, 0, 4096, 1024, nullptr, (bf16_t*)(ws + WS_W2), 0, scr, r, lane);
    }
    const int gt = blockIdx.x * NTHREADS + tid, NGT = G * NTHREADS;
    for (int o = gt; o < 256 * 1024; o += NGT) {
        const int n = o >> 10, k = o & 1023; const float* wr = p.w_in + (size_t)k * 3088 + 1024; float s = 0.f;
#pragma unroll
        for (int r = 0; r < 16; ++r) s += wr[r] * p.gla_w_gate[r * 256 + n];
        Win_t[(size_t)(3072 + n) * 1024 + k] = f2bf(s);
    }
    float* cosT = (float*)(ws + WS_COS); float* sinT = (float*)(ws + WS_SIN);
    for (int o = gt; o < SEQ * 32; o += NGT) {
        const int pos = o >> 5, i = o & 31; double f = 1.0;
        for (int k = 0; k < i; ++k) f *= 0.7498942093324559;
        const double t = (double)pos * f * 0.15915494309189535;
        const float fr = (float)(t - floor(t));
        cosT[o] = __builtin_amdgcn_cosf(fr); sinT[o] = __builtin_amdgcn_sinf(fr);
    }
    bf16_t* XN = (bf16_t*)(ws + WS_A1); bf16_t* MEMN = (bf16_t*)(ws + WS_MEMN);
    for (int m4 = gw; m4 < (NTOK + NMEMROWS) / 4; m4 += NGW) {
        const int m = 4 * m4;
        if (m < NTOK) rms_rows_to_bf16<4>(p.x + (size_t)m * DM, p.norm_mix_g, XN + (size_t)m * DM, lane);
        else rms_rows_to_bf16<4>(p.mem + (size_t)(m - NTOK) * DM, p.norm_mem_g, MEMN + (size_t)(m - NTOK) * DM, lane);
    }
}

__device__ __forceinline__ void gla_gates(const bf16_t* P, int zcol, const float* bg, int r, int q, float (&bc)[4][2][8], float (&bl)[2][8]) {
    bf16x8 zf[4][2];
#pragma unroll
    for (int mt = 0; mt < 4; ++mt)
#pragma unroll
        for (int ks = 0; ks < 2; ++ks) zf[mt][ks] = *(const bf16x8*)(P + (size_t)(16 * mt + r) * NPROJ + zcol + 32 * ks + 8 * q);
    CFENCE();
#pragma unroll
    for (int ks = 0; ks < 2; ++ks) {
        const f32x4 b0 = *(const f32x4*)(bg + 32 * ks + 8 * q), b1 = *(const f32x4*)(bg + 32 * ks + 8 * q + 4);
#pragma unroll
        for (int mt = 0; mt < 4; ++mt) {
            f32x4 z0, z1; unpack8(zf[mt][ks], z0, z1); z0 += b0; z1 += b1;
#pragma unroll
            for (int e = 0; e < 4; ++e) {
                bc[mt][ks][e] = (fminf(z0[e], 0.f) - __logf(1.0f + __expf(-fabsf(z0[e])))) * (1.0f / 16.0f);
                bc[mt][ks][4 + e] = (fminf(z1[e], 0.f) - __logf(1.0f + __expf(-fabsf(z1[e])))) * (1.0f / 16.0f);
            }
        }
#pragma unroll
        for (int e = 0; e < 8; ++e) {
            float carry = 0.f;
#pragma unroll
            for (int mt = 0; mt < 4; ++mt) { const float v = scan16(bc[mt][ks][e], r); const float tot = __shfl(v, 15, 16); bc[mt][ks][e] = v + carry; carry += tot; }
            bl[ks][e] = carry;
        }
    }
}
__device__ __forceinline__ float ret_log2g(int hr) { return hr == 0 ? -0.04580368961312479f : hr == 1 ? -0.008973692110584325f : hr == 2 ? -0.0017761724589428754f : -0.0003522634716290214f; }
__device__ __forceinline__ void rope_tile(bf16x8 f0, bf16x8 f1, const float* cosT, const float* sinT, int pos, int q, f32x4 (&o)[4]) {
    f32x4 a0, a1, b0, b1; unpack8(f0, a0, a1); unpack8(f1, b0, b1);
    const f32x4 c0 = *(const f32x4*)(cosT + pos * 32 + 8 * q), c1 = *(const f32x4*)(cosT + pos * 32 + 8 * q + 4), s0 = *(const f32x4*)(sinT + pos * 32 + 8 * q), s1 = *(const f32x4*)(sinT + pos * 32 + 8 * q + 4);
    o[0] = a0 * c0 - b0 * s0; o[1] = a1 * c1 - b1 * s1; o[2] = a0 * s0 + b0 * c0; o[3] = a1 * s1 + b1 * c1;
}

__device__ __forceinline__ void chunk_contrib(const Params& p, LAS unsigned char* lds, int G) {
    const int tid = threadIdx.x, lane = tid & 63, wave = __builtin_amdgcn_readfirstlane(tid >> 6);
    unsigned char* ws = p.ws;
    const bf16_t* PROJ = (const bf16_t*)(ws + WS_BIG); bf16_t* CT = (bf16_t*)(ws + WS_A2); float* DEC = (float*)(ws + WS_DEC);
    const float* cosT = (const float*)(ws + WS_COS); const float* sinT = (const float*)(ws + WS_SIN);
    LAS bf16_t* Kdt = (LAS bf16_t*)(lds + wave * WAVE_LDS); LAS bf16_t* Vt = Kdt + 64 * VPITCH;
    for (int u = blockIdx.x * NWAVES + wave; u < NBATCH * NCHUNK * 8; u += G * NWAVES) {
        int h8 = u & 7; asm volatile("" : "+s"(h8));
        const int bn = u >> 3, b = bn >> 7, n = bn & 127;
        const size_t tok0 = (size_t)b * SEQ + (size_t)n * 64;
        const bf16_t* P = PROJ + tok0 * NPROJ;
        const int unit = (b * 8 + h8) * NCHUNK + n;
        int ln = lane; asm volatile("" : "+v"(ln));
        const int r = ln & 15, q = ln >> 4;
        const int vcol = (h8 < 4) ? C_GV + h8 * 128 : C_RV + (h8 - 4) * 128;
        const int kcol = (h8 < 4) ? C_GK + h8 * 64 : C_RK + (h8 - 4) * 64;
        bf16x8 kf[4][2];
#pragma unroll
        for (int mt = 0; mt < 4; ++mt)
#pragma unroll
            for (int ks = 0; ks < 2; ++ks) kf[mt][ks] = *(const bf16x8*)(P + (size_t)(16 * mt + r) * NPROJ + kcol + 32 * ks + 8 * q);
        LDS_FENCE();
        if (h8 < 4) {
            const int h = h8;
            float bc[4][2][8], bl[2][8];
            gla_gates(P, C_Z + h * 64, p.gla_b_gate + h * 64, r, q, bc, bl);
            if (r == 0) {
#pragma unroll
                for (int ks = 0; ks < 2; ++ks) {
                    f32x4 d0, d1;
#pragma unroll
                    for (int e = 0; e < 4; ++e) { d0[e] = __expf(bl[ks][e]); d1[e] = __expf(bl[ks][4 + e]); }
                    *(f32x4*)(DEC + (size_t)unit * 64 + 32 * ks + 8 * q) = d0; *(f32x4*)(DEC + (size_t)unit * 64 + 32 * ks + 8 * q + 4) = d1;
                }
            }
#pragma unroll
            for (int mt = 0; mt < 4; ++mt)
#pragma unroll
                for (int ks = 0; ks < 2; ++ks) {
                    f32x4 k0, k1; unpack8(kf[mt][ks], k0, k1);
#pragma unroll
                    for (int e = 0; e < 4; ++e) {
                        Kdt[(32 * ks + 8 * q + e) * VPITCH + 16 * mt + r] = f2bf(k0[e] * __expf(bl[ks][e] - bc[mt][ks][e]));
                        Kdt[(32 * ks + 8 * q + 4 + e) * VPITCH + 16 * mt + r] = f2bf(k1[e] * __expf(bl[ks][4 + e] - bc[mt][ks][4 + e]));
                    }
                }
        } else {
            const int hr = h8 - 4; const float l2g = ret_log2g(hr);
            if (r == 0) {
                const float d = exp2f(64.0f * l2g); const f32x4 dv = {d, d, d, d};
#pragma unroll
                for (int ks = 0; ks < 2; ++ks) { *(f32x4*)(DEC + (size_t)unit * 64 + 32 * ks + 8 * q) = dv; *(f32x4*)(DEC + (size_t)unit * 64 + 32 * ks + 8 * q + 4) = dv; }
            }
#pragma unroll
            for (int mt = 0; mt < 4; ++mt) {
                CFENCE();
                f32x4 o[4]; rope_tile(kf[mt][0], kf[mt][1], cosT, sinT, n * 64 + 16 * mt + r, q, o);
                const float sc = 0.125f * exp2f((float)(63 - (16 * mt + r)) * l2g);
#pragma unroll
                for (int e = 0; e < 4; ++e) {
                    Kdt[(8 * q + e) * VPITCH + 16 * mt + r] = f2bf(o[0][e] * sc); Kdt[(8 * q + 4 + e) * VPITCH + 16 * mt + r] = f2bf(o[1][e] * sc);
                    Kdt[(32 + 8 * q + e) * VPITCH + 16 * mt + r] = f2bf(o[2][e] * sc); Kdt[(32 + 8 * q + 4 + e) * VPITCH + 16 * mt + r] = f2bf(o[3][e] * sc);
                }
            }
        }
        bf16_t* outp = CT + (size_t)unit * 8192;
#pragma unroll 1
        for (int vh = 0; vh < 2; ++vh) {
            CFENCE();
            bf16x8 xv[8];
#pragma unroll
            for (int i = 0; i < 8; ++i) xv[i] = *(const bf16x8*)(P + (size_t)(i * 8 + (ln >> 3)) * NPROJ + vcol + vh * 64 + (ln & 7) * 8);
            LDS_FENCE();
#pragma unroll
            for (int i = 0; i < 8; ++i) {
                const int token = i * 8 + (ln >> 3), vv = (ln & 7) * 8;
#pragma unroll
                for (int e = 0; e < 8; ++e) Vt[(vv + e) * VPITCH + token] = (bf16_t)xv[i][e];
            }
            LDS_FENCE();
#pragma unroll
            for (int vt = 0; vt < 4; ++vt) {
                CFENCE();
                bf16x8 a[2];
#pragma unroll
                for (int s = 0; s < 2; ++s) a[s] = *(const LAS bf16x8*)(Vt + (16 * vt + r) * VPITCH + 32 * s + 8 * q);
#pragma unroll
                for (int dt = 0; dt < 4; ++dt) {
                    f32x4 acc = {0.f, 0.f, 0.f, 0.f};
#pragma unroll
                    for (int s = 0; s < 2; ++s) { const bf16x8 bb = *(const LAS bf16x8*)(Kdt + (16 * dt + r) * VPITCH + 32 * s + 8 * q); acc = MFMA16(a[s], bb, acc); }
#pragma unroll
                    for (int e = 0; e < 4; ++e) outp[(vh * 64 + 16 * vt + 4 * q + e) * 64 + 16 * dt + r] = f2bf(acc[e]);
                }
            }
        }
    }
}

__device__ __forceinline__ void chunk_scan(const Params& p, int G) {
    unsigned char* ws = p.ws; bf16_t* CT = (bf16_t*)(ws + WS_A2); const float* DEC = (const float*)(ws + WS_DEC);
    const int NGT = G * NTHREADS;
    for (int o = blockIdx.x * NTHREADS + threadIdx.x; o < 32 * 128 * 16; o += NGT) {
        const int d4 = o & 15, v = (o >> 4) & 127, bh = o >> 11;
        bf16_t* base = CT + (size_t)bh * NCHUNK * 8192 + v * 64 + d4 * 4; const float* dbase = DEC + (size_t)bh * NCHUNK * 64 + d4 * 4;
        f32x4 s = {0.f, 0.f, 0.f, 0.f};
#pragma unroll 1
        for (int n0 = 0; n0 < NCHUNK; n0 += 16) {
            u32x2 uu[16]; f32x4 dd[16];
#pragma unroll
            for (int j = 0; j < 16; ++j) { uu[j] = *(const u32x2*)(base + (size_t)(n0 + j) * 8192); dd[j] = *(const f32x4*)(dbase + (size_t)(n0 + j) * 64); }
#pragma unroll
            for (int j = 0; j < 16; ++j) {
                u32x2 w; w.x = cvtpk(s[0], s[1]); w.y = cvtpk(s[2], s[3]);
                *(u32x2*)(base + (size_t)(n0 + j) * 8192) = w;
                f32x4 c; c[0] = __uint_as_float(uu[j].x << 16); c[1] = __uint_as_float(uu[j].x & 0xffff0000u); c[2] = __uint_as_float(uu[j].y << 16); c[3] = __uint_as_float(uu[j].y & 0xffff0000u);
                s = dd[j] * s + c;
            }
        }
    }
}

template <bool GN> __device__ __forceinline__ void norm_gate_store(const f32x4 (&O)[8], const unsigned short (&gt)[8][4], const float (&gn)[8], int it, int r, int q, bf16_t* y) {
    f32x4 mean = {0.f, 0.f, 0.f, 0.f};
    if (GN) {
        f32x4 s = {0.f, 0.f, 0.f, 0.f};
#pragma unroll
        for (int vt = 0; vt < 8; ++vt) s += O[vt];
#pragma unroll
        for (int e = 0; e < 4; ++e) { float t = s[e]; t += __shfl_xor(t, 1); t += __shfl_xor(t, 2); t += __shfl_xor(t, 4); t += __shfl_xor(t, 8); mean[e] = t * (1.0f / 128.0f); }
    }
    f32x4 ss = {0.f, 0.f, 0.f, 0.f};
#pragma unroll
    for (int vt = 0; vt < 8; ++vt) { const f32x4 d = O[vt] - mean; ss += d * d; }
    f32x4 rstd;
#pragma unroll
    for (int e = 0; e < 4; ++e) { float t = ss[e]; t += __shfl_xor(t, 1); t += __shfl_xor(t, 2); t += __shfl_xor(t, 4); t += __shfl_xor(t, 8); rstd[e] = __builtin_amdgcn_rsqf(t * (1.0f / 128.0f) + 1e-6f); }
#pragma unroll
    for (int vt = 0; vt < 8; ++vt) {
        const int v = 16 * vt + r;
#pragma unroll
        for (int e = 0; e < 4; ++e) {
            const int i = 16 * it + 4 * q + e;
            const float g = bf2f(gt[vt][e]);
            const float sil = g * __builtin_amdgcn_rcpf(1.0f + __expf(-g));
            y[(size_t)i * DM + v] = f2bf((O[vt][e] - mean[e]) * rstd[e] * gn[vt] * sil);
        }
    }
}
__device__ __forceinline__ void out_tile(f32x4 (&O)[8], const bf16x8 (&pf)[2], const bf16x8 (&qi)[2], const LAS bf16_t* Vt, const bf16x8 (&spf)[8][2], int r, int q) {
#pragma unroll
    for (int vt = 0; vt < 8; ++vt) {
        f32x4 acc = {0.f, 0.f, 0.f, 0.f};
#pragma unroll
        for (int s = 0; s < 2; ++s) {
            const u32x2 lo = *(const LAS u32x2*)(Vt + (16 * vt + r) * VPITCH + 32 * s + 4 * q), hi = *(const LAS u32x2*)(Vt + (16 * vt + r) * VPITCH + 32 * s + 16 + 4 * q);
            const u32x4 w = {lo.x, lo.y, hi.x, hi.y};
            acc = MFMA16(pf[s], __builtin_bit_cast(bf16x8, w), acc);
        }
#pragma unroll
        for (int ks = 0; ks < 2; ++ks) acc = MFMA16(qi[ks], spf[vt][ks], acc);
        O[vt] = acc;
    }
}
template <bool GN> __device__ __forceinline__ void out_all(const bf16x8 (&pfa)[4][2], const bf16x8 (&QI)[4][2], const LAS bf16_t* Vt, const bf16_t* SP, const float* gain, const bf16_t* gate, bf16_t* y, int r, int q) {
    bf16x8 spf[8][2]; float gn[8];
#pragma unroll
    for (int vt = 0; vt < 8; ++vt) {
        gn[vt] = gain[16 * vt + r];
#pragma unroll
        for (int ks = 0; ks < 2; ++ks) spf[vt][ks] = *(const bf16x8*)(SP + (16 * vt + r) * 64 + 32 * ks + 8 * q);
    }
#pragma unroll
    for (int it = 0; it < 4; ++it) {
        CFENCE();
        unsigned short gt[8][4];
#pragma unroll
        for (int vt = 0; vt < 8; ++vt)
#pragma unroll
            for (int e = 0; e < 4; ++e) gt[vt][e] = gate[(size_t)(16 * it + 4 * q + e) * NPROJ + 16 * vt + r];
        CFENCE();
        f32x4 O[8];
        out_tile(O, pfa[it], QI[it], Vt, spf, r, q);
        CFENCE();
        norm_gate_store<GN>(O, gt, gn, it, r, q, y);
    }
}

__device__ __forceinline__ void chunk_output(const Params& p, LAS unsigned char* lds, int G) {
    const int tid = threadIdx.x, lane = tid & 63, wave = __builtin_amdgcn_readfirstlane(tid >> 6);
    unsigned char* ws = p.ws;
    const bf16_t* PROJ = (const bf16_t*)(ws + WS_BIG); const bf16_t* SPB = (const bf16_t*)(ws + WS_A2); bf16_t* Y = (bf16_t*)(ws + WS_A1);
    const float* cosT = (const float*)(ws + WS_COS); const float* sinT = (const float*)(ws + WS_SIN);
    LAS bf16_t* Vt = (LAS bf16_t*)(lds + wave * WAVE_LDS);
    for (int u = blockIdx.x * NWAVES + wave; u < NBATCH * NCHUNK * 8; u += G * NWAVES) {
        int h8 = u & 7; asm volatile("" : "+s"(h8));
        const int bn = u >> 3, b = bn >> 7, n = bn & 127;
        const size_t tok0 = (size_t)b * SEQ + (size_t)n * 64;
        const bf16_t* P = PROJ + tok0 * NPROJ;
        const int unit = (b * 8 + h8) * NCHUNK + n;
        const bf16_t* SP = SPB + (size_t)unit * 8192;
        int ln = lane; asm volatile("" : "+v"(ln));
        const int r = ln & 15, q = ln >> 4;
        const int vcol = (h8 < 4) ? C_GV + h8 * 128 : C_RV + (h8 - 4) * 128;
        LDS_FENCE();
        {
            bf16x8 xv[16];
#pragma unroll
            for (int i = 0; i < 16; ++i) xv[i] = *(const bf16x8*)(P + (size_t)(i * 4 + q) * NPROJ + vcol + r * 8);
            CFENCE();
#pragma unroll
            for (int i = 0; i < 16; ++i) {
                const int token = i * 4 + q, vv = r * 8;
#pragma unroll
                for (int e = 0; e < 8; ++e) Vt[(vv + e) * VPITCH + token] = (bf16_t)xv[i][e];
            }
        }
        LDS_FENCE();
        CFENCE();
#ifdef NO_GLA4
        if (false) {
#else
        if (h8 < 4) {
#endif
            const int h = h8;
            bf16x8 Qe[4][2], Qi[4][2], Ki[4][2], Ke[4][2], pfa[4][2];
            {
                bf16x8 qf[4][2], kf[4][2];
#pragma unroll
                for (int mt = 0; mt < 4; ++mt)
#pragma unroll
                    for (int ks = 0; ks < 2; ++ks) {
                        qf[mt][ks] = *(const bf16x8*)(P + (size_t)(16 * mt + r) * NPROJ + C_GQ + h * 64 + 32 * ks + 8 * q);
                        kf[mt][ks] = *(const bf16x8*)(P + (size_t)(16 * mt + r) * NPROJ + C_GK + h * 64 + 32 * ks + 8 * q);
                    }
                float bc[4][2][8], bl[2][8];
                gla_gates(P, C_Z + h * 64, p.gla_b_gate + h * 64, r, q, bc, bl);
#pragma unroll
                for (int mt = 0; mt < 4; ++mt)
#pragma unroll
                    for (int ks = 0; ks < 2; ++ks) {
                        CFENCE();
                        f32x4 q0, q1, k0, k1; unpack8(qf[mt][ks], q0, q1); unpack8(kf[mt][ks], k0, k1);
                        f32x4 e0, e1, i0, i1;
#pragma unroll
                        for (int e = 0; e < 4; ++e) { e0[e] = __expf(bc[mt][ks][e]); e1[e] = __expf(bc[mt][ks][4 + e]); i0[e] = __expf(-bc[mt][ks][e]); i1[e] = __expf(-bc[mt][ks][4 + e]); }
                        Qe[mt][ks] = pack8(q0 * e0 * 0.125f, q1 * e1 * 0.125f); Qi[mt][ks] = pack8(q0 * i0 * 0.125f, q1 * i1 * 0.125f);
                        Ki[mt][ks] = pack8(k0 * i0, k1 * i1); Ke[mt][ks] = pack8(k0 * e0, k1 * e1);
                    }
            }
#pragma unroll
            for (int it = 0; it < 4; ++it) {
                f32x4 Pt[4];
#pragma unroll
                for (int jt = 0; jt < 4; ++jt) {
                    f32x4 lo = {0.f, 0.f, 0.f, 0.f}, up = {0.f, 0.f, 0.f, 0.f};
                    if (jt <= it) { lo = MFMA16(Ki[jt][0], Qe[it][0], lo); lo = MFMA16(Ki[jt][1], Qe[it][1], lo); }
                    if (jt >= it) { up = MFMA16(Ke[jt][0], Qi[it][0], up); up = MFMA16(Ke[jt][1], Qi[it][1], up); }
                    if (jt < it) Pt[jt] = lo; else if (jt > it) Pt[jt] = up;
                    else {
#pragma unroll
                        for (int e = 0; e < 4; ++e) Pt[jt][e] = (4 * q + e <= r) ? lo[e] : up[e];
                    }
                }
                pfa[it][0] = pack8(Pt[0], Pt[1]); pfa[it][1] = pack8(Pt[2], Pt[3]);
                CFENCE();
            }
            out_all<false>(pfa, Qe, Vt, SP, p.gla_norm_g + h * 128, P + C_GG + h * 128, Y + tok0 * DM + h * 128, r, q);
        }
#ifdef NO_RET4
        else if (false) {
#else
        else {
#endif
            const int hr = h8 - 4; const float l2g = ret_log2g(hr);
            bf16x8 Qr[4][2], Qd[4][2], Kr[4][2], pfa[4][2];
            {
                bf16x8 qf[4][2], kf[4][2];
#pragma unroll
                for (int mt = 0; mt < 4; ++mt)
#pragma unroll
                    for (int ks = 0; ks < 2; ++ks) {
                        qf[mt][ks] = *(const bf16x8*)(P + (size_t)(16 * mt + r) * NPROJ + C_RQ + hr * 64 + 32 * ks + 8 * q);
                        kf[mt][ks] = *(const bf16x8*)(P + (size_t)(16 * mt + r) * NPROJ + C_RK + hr * 64 + 32 * ks + 8 * q);
                    }
#pragma unroll
                for (int mt = 0; mt < 4; ++mt) {
                    const int pos = n * 64 + 16 * mt + r;
                    CFENCE();
                    {
                        f32x4 o[4]; rope_tile(qf[mt][0], qf[mt][1], cosT, sinT, pos, q, o);
                        Qr[mt][0] = pack8(o[0], o[1]); Qr[mt][1] = pack8(o[2], o[3]);
                        const float qd = exp2f((float)(16 * mt + r + 1) * l2g);
                        Qd[mt][0] = pack8(o[0] * qd, o[1] * qd); Qd[mt][1] = pack8(o[2] * qd, o[3] * qd);
                    }
                    CFENCE();
                    {
                        f32x4 o[4]; rope_tile(kf[mt][0], kf[mt][1], cosT, sinT, pos, q, o);
                        Kr[mt][0] = pack8(o[0] * 0.125f, o[1] * 0.125f); Kr[mt][1] = pack8(o[2] * 0.125f, o[3] * 0.125f);
                    }
                }
            }
#pragma unroll
            for (int it = 0; it < 4; ++it) {
                f32x4 Pt[4];
#pragma unroll
                for (int jt = 0; jt < 4; ++jt) {
                    f32x4 st = {0.f, 0.f, 0.f, 0.f};
                    st = MFMA16(Kr[jt][0], Qr[it][0], st); st = MFMA16(Kr[jt][1], Qr[it][1], st);
#pragma unroll
                    for (int e = 0; e < 4; ++e) { const int dj = (16 * it + r) - (16 * jt + 4 * q + e); Pt[jt][e] = st[e] * exp2f((float)(dj < 0 ? -dj : dj) * l2g); }
                }
                pfa[it][0] = pack8(Pt[0], Pt[1]); pfa[it][1] = pack8(Pt[2], Pt[3]);
                CFENCE();
            }
            out_all<true>(pfa, Qd, Vt, SP, p.ret_norm_g + hr * 128, P + C_RG + hr * 128, Y + tok0 * DM + 512 + hr * 128, r, q);
        }
    }
}

__device__ __forceinline__ void stage_image(LAS unsigned char* lds, const bf16_t* src, int tid) {
#pragma unroll
    for (int i = 0; i < 16; ++i) { const int row = (tid >> 5) + 16 * i, c = tid & 31; const u32x4 x = *(const u32x4*)(src + (size_t)row * 256 + c * 8); *(LAS u32x4*)(lds + row * APITCH + c * 16) = x; }
}
__device__ __forceinline__ void cross_attention(const Params& p, LAS unsigned char* lds, int G) {
    const int tid = threadIdx.x, lane = tid & 63, wave = __builtin_amdgcn_readfirstlane(tid >> 6);
    unsigned char* ws = p.ws;
    const bf16_t* Q = (const bf16_t*)(ws + WS_A1); const bf16_t* Kb = (const bf16_t*)(ws + WS_KB); const bf16_t* Vtg = (const bf16_t*)(ws + WS_VT); bf16_t* OA = (bf16_t*)(ws + WS_BIG);
    for (int u = blockIdx.x; u < 512; u += G) {
        const int bh = u >> 5, b = bh >> 2, h = bh & 3, qb = u & 31;
        int ln = lane; asm volatile("" : "+v"(ln));
        const int r = ln & 15, q = ln >> 4;
        const size_t i0 = (size_t)b * SEQ + qb * 256 + wave * 32;
        __syncthreads();
        {
#pragma unroll
            for (int i = 0; i < 16; ++i) { const int row = (tid >> 5) + 16 * i, c = tid & 31; const u32x4 x = *(const u32x4*)(Kb + (size_t)(b * 256 + row) * 1024 + h * 256 + c * 8); *(LAS u32x4*)(lds + row * APITCH + c * 16) = x; }
        }
        bf16x8 Qf[2][8];
#pragma unroll
        for (int it = 0; it < 2; ++it)
#pragma unroll
            for (int ks = 0; ks < 8; ++ks) Qf[it][ks] = *(const bf16x8*)(Q + (i0 + 16 * it + r) * DM + h * 256 + 32 * ks + 8 * q);
        __syncthreads();
        bf16x8 pf[2][8];
        {
            f32x4 S[2][16];
#pragma unroll
            for (int mt = 0; mt < 16; ++mt) {
                f32x4 a0 = {0.f, 0.f, 0.f, 0.f}, a1 = {0.f, 0.f, 0.f, 0.f};
                CFENCE();
#pragma unroll
                for (int ks = 0; ks < 8; ++ks) { const bf16x8 a = *(const LAS bf16x8*)(lds + (16 * mt + r) * APITCH + (32 * ks + 8 * q) * 2); a0 = MFMA16(a, Qf[0][ks], a0); a1 = MFMA16(a, Qf[1][ks], a1); }
                S[0][mt] = a0; S[1][mt] = a1;
            }
#pragma unroll
            for (int it = 0; it < 2; ++it) {
                CFENCE();
                float mx = -3.0e38f;
#pragma unroll
                for (int mt = 0; mt < 16; ++mt) mx = fmaxf(fmaxf(fmaxf(S[it][mt][0], S[it][mt][1]), fmaxf(S[it][mt][2], S[it][mt][3])), mx);
                mx = fmaxf(mx, __shfl_xor(mx, 16)); mx = fmaxf(mx, __shfl_xor(mx, 32));
                CFENCE();
                float sum = 0.f;
#pragma unroll
                for (int mt = 0; mt < 16; ++mt) {
#pragma unroll
                    for (int e = 0; e < 4; ++e) { S[it][mt][e] = __builtin_amdgcn_exp2f(S[it][mt][e] - mx); sum += S[it][mt][e]; }
                }
                sum += __shfl_xor(sum, 16); sum += __shfl_xor(sum, 32);
                const float inv = 1.0f / sum;
                CFENCE();
#pragma unroll
                for (int s = 0; s < 8; ++s) { pf[it][s] = pack8(S[it][2 * s] * inv, S[it][2 * s + 1] * inv); CFENCE(); }
            }
        }
        __syncthreads();
        stage_image(lds, Vtg + (size_t)(b * 1024 + h * 256) * 256, tid);
        __syncthreads();
#pragma unroll
        for (int nt = 0; nt < 16; ++nt) {
            f32x4 a0 = {0.f, 0.f, 0.f, 0.f}, a1 = {0.f, 0.f, 0.f, 0.f};
            CFENCE();
#pragma unroll
            for (int s = 0; s < 8; ++s) {
                const u32x2 lo = *(const LAS u32x2*)(lds + (16 * nt + r) * APITCH + (32 * s + 4 * q) * 2), hi = *(const LAS u32x2*)(lds + (16 * nt + r) * APITCH + (32 * s + 16 + 4 * q) * 2);
                const u32x4 w = {lo.x, lo.y, hi.x, hi.y};
                a0 = MFMA16(pf[0][s], __builtin_bit_cast(bf16x8, w), a0); a1 = MFMA16(pf[1][s], __builtin_bit_cast(bf16x8, w), a1);
            }
#pragma unroll
            for (int e = 0; e < 4; ++e) { OA[(i0 + 4 * q + e) * DM + h * 256 + 16 * nt + r] = f2bf(a0[e]); OA[(i0 + 16 + 4 * q + e) * DM + h * 256 + 16 * nt + r] = f2bf(a1[e]); }
        }
    }
}

__device__ __forceinline__ void final_norm(const Params& p, int G) {
    const int lane = threadIdx.x & 63, wave = __builtin_amdgcn_readfirstlane(threadIdx.x >> 6);
    const bf16_t* H = (const bf16_t*)(p.ws + WS_A2); const float* SSQ = (const float*)(p.ws + WS_SSQ3);
    const f32x4 g0 = *(const f32x4*)(p.final_norm_g + lane * 8), g1 = *(const f32x4*)(p.final_norm_g + lane * 8 + 4), g2 = *(const f32x4*)(p.final_norm_g + 512 + lane * 8), g3 = *(const f32x4*)(p.final_norm_g + 512 + lane * 8 + 4);
    for (int m4 = blockIdx.x * NWAVES + wave; m4 < NTOK / 4; m4 += G * NWAVES) {
        bf16x8 h0[4], h1[4]; f32x4 sp[4];
#pragma unroll
        for (int j = 0; j < 4; ++j) {
            const size_t m = (size_t)m4 * 4 + j;
            h0[j] = *(const bf16x8*)(H + m * DM + lane * 8); h1[j] = *(const bf16x8*)(H + m * DM + 512 + lane * 8);
            sp[j] = *(const f32x4*)(SSQ + m * 16 + 4 * (lane & 3));
        }
#pragma unroll
        for (int j = 0; j < 4; ++j) {
            const size_t m = (size_t)m4 * 4 + j;
            float t = (sp[j][0] + sp[j][1]) + (sp[j][2] + sp[j][3]);
            t += __shfl_xor(t, 1); t += __shfl_xor(t, 2);
            const float rstd = 1.0f / sqrtf(t * (1.0f / 1024.0f) + 1e-6f);
            f32x4 a0, a1, b0, b1; unpack8(h0[j], a0, a1); unpack8(h1[j], b0, b1);
            float* o = p.out + m * DM + lane * 8;
            *(f32x4*)(o) = a0 * rstd * g0; *(f32x4*)(o + 4) = a1 * rstd * g1; *(f32x4*)(o + 512) = b0 * rstd * g2; *(f32x4*)(o + 516) = b1 * rstd * g3;
        }
    }
}

constexpr int NPHASE = 12;
__global__ void __launch_bounds__(NTHREADS, 2) fwd_megakernel(Params p) {
    extern __shared__ __attribute__((aligned(16))) unsigned char lds_raw[];
    LAS unsigned char* lds = (LAS unsigned char*)lds_raw;
    cg::grid_group grid = cg::this_grid();
    const int G = gridDim.x, lo = p.ph_lo, hi = p.ph_hi;
    unsigned char* ws = p.ws;
#define IN(k) (lo <= (k) && (k) < hi)
#ifndef DBG_REP
#define DBG_REP (-1)
#endif
#define REPS(k) ((DBG_REP) == (k) ? 2 : 1)
#define SEAM(k) do { if (IN(k) && IN((k) + 1)) { if ((k) == 0) { asm volatile("s_waitcnt vmcnt(0) lgkmcnt(0)" ::: "memory"); grid.sync(); __builtin_amdgcn_fence(__ATOMIC_ACQUIRE, "agent"); asm volatile("s_waitcnt vmcnt(0)" ::: "memory"); } \
    else xcd_barrier(bar); } } while (0)
    LAS unsigned* misc = (LAS unsigned*)(lds + MISC_OFF);
    if (threadIdx.x < 16) misc[threadIdx.x] = 0u;
    __syncthreads();
    XcdBarrier bar; bar.bar = (unsigned*)(ws + WS_CTL); bar.x = 0; bar.st = nullptr;
    if (hi - lo > 1) bar = xcd_barrier_post((unsigned*)(ws + WS_CTL), (volatile LAS unsigned*)misc);
#ifndef NO_P0
    if (IN(0)) { p0_prologue(p, lds, G); }
#endif
#if defined(DBG_REP) && DBG_REP == 0
    __syncthreads(); if (IN(0)) { p0_prologue(p, lds, G); }
#endif
    SEAM(0);
    if (IN(1)) {
        {
            pg8::Gemm g{(const bf16_t*)(ws + WS_A1), (const bf16_t*)(ws + WS_WIN), NTOK, NPROJ, DM}; pg8::StaticOrder S; S.init(NTOK, NPROJ, G, (int)blockIdx.x);
            pg8::EpiBf16<0> E{(bf16_t*)(ws + WS_BIG), NPROJ, nullptr, 0, 0, 1.f};
            pg8::gemm_phase<pg8::EpiBf16<0>, pg8::StaticOrder, true, true>(lds, g, S, E);
        }
        __syncthreads();
        {
            pg8::Gemm g{(const bf16_t*)(ws + WS_MEMN), (const bf16_t*)(ws + WS_WKV), NMEMROWS, 2048, DM}; pg8::StaticOrder S; S.init(NMEMROWS, 2048, G, (int)((blockIdx.x + G / 2) % G));
            pg8::EpiKV E{(bf16_t*)(ws + WS_KB), (bf16_t*)(ws + WS_VT)};
            pg8::gemm_phase<pg8::EpiKV, pg8::StaticOrder, true, true>(lds, g, S, E);
        }
        __syncthreads();
    } SEAM(1);
    #ifndef NO_P2
    if (IN(2)) { chunk_contrib(p, lds, G); }
#endif
#if defined(DBG_REP) && DBG_REP == 2
    __syncthreads(); if (IN(2)) { chunk_contrib(p, lds, G); }
#endif
    SEAM(2);
    if (IN(3)) { chunk_scan(p, G); } SEAM(3);
    #ifndef NO_P4
    if (IN(4)) { chunk_output(p, lds, G); }
#endif
#if defined(DBG_REP) && DBG_REP == 4
    __syncthreads(); if (IN(4)) { chunk_output(p, lds, G); }
#endif
    SEAM(4);
    if (IN(5)) {
        pg8::Gemm g{(const bf16_t*)(ws + WS_A1), (const bf16_t*)(ws + WS_WOUT), NTOK, DM, DM}; pg8::StaticOrder S; S.init(NTOK, DM, G, (int)blockIdx.x);
        pg8::EpiRes<false> E{p.x, (bf16_t*)(ws + WS_A2), (float*)(ws + WS_SSQ1)};
        pg8::gemm_phase<pg8::EpiRes<false>, pg8::StaticOrder, true, true>(lds, g, S, E);
        __syncthreads();
    } SEAM(5);
#ifdef DBG_XBAR
    if (IN(5) && IN(6)) { for (int i_ = 0; i_ < 10; ++i_) xcd_barrier(bar); }
#endif
    if (IN(6)) {
        pg8::Gemm g{(const bf16_t*)(ws + WS_A2), (const bf16_t*)(ws + WS_WQ), NTOK, DM, DM}; pg8::StaticOrder S; S.init(NTOK, DM, G, (int)blockIdx.x);
        pg8::EpiScale<0> E{(bf16_t*)(ws + WS_A1), DM, (const float*)(ws + WS_SSQ1), 0.0625f * 1.4426950408889634f};
        pg8::gemm_phase<pg8::EpiScale<0>, pg8::StaticOrder, true, true>(lds, g, S, E);
        __syncthreads();
    } SEAM(6);
#ifndef NO_P7
    if (IN(7)) { cross_attention(p, lds, G); __syncthreads(); }
#endif
#if defined(DBG_REP) && DBG_REP == 7
    if (IN(7)) { cross_attention(p, lds, G); __syncthreads(); }
#endif
    SEAM(7);
    if (IN(8)) {
        pg8::Gemm g{(const bf16_t*)(ws + WS_BIG), (const bf16_t*)(ws + WS_WO), NTOK, DM, DM}; pg8::StaticOrder S; S.init(NTOK, DM, G, (int)blockIdx.x);
        pg8::EpiRes<true> E{(const void*)(ws + WS_A2), (bf16_t*)(ws + WS_A1), (float*)(ws + WS_SSQ2)};
        pg8::gemm_phase<pg8::EpiRes<true>, pg8::StaticOrder, true, true>(lds, g, S, E);
        __syncthreads();
    } SEAM(8);
    if (IN(9)) {
        pg8::Gemm g{(const bf16_t*)(ws + WS_A1), (const bf16_t*)(ws + WS_W1), NTOK, DFF, DM}; pg8::StaticOrder S; S.init(NTOK, DFF, G, (int)blockIdx.x);
        pg8::EpiScale<1> E{(bf16_t*)(ws + WS_BIG), DFF, (const float*)(ws + WS_SSQ2), 1.0f};
        pg8::gemm_phase<pg8::EpiScale<1>, pg8::StaticOrder, true, true>(lds, g, S, E);
        __syncthreads();
    } SEAM(9);
    if (IN(10)) {
        pg8::Gemm g{(const bf16_t*)(ws + WS_BIG), (const bf16_t*)(ws + WS_W2), NTOK, DM, DFF}; pg8::StaticOrder S; S.init(NTOK, DM, G, (int)blockIdx.x);
        pg8::EpiRes<true> E{(const void*)(ws + WS_A1), (bf16_t*)(ws + WS_A2), (float*)(ws + WS_SSQ3)};
        pg8::gemm_phase<pg8::EpiRes<true>, pg8::StaticOrder, true, true>(lds, g, S, E);
        __syncthreads();
    } SEAM(10);
    if (IN(11)) { final_norm(p, G); }
#undef IN
#undef SEAM
}

#ifndef MK_PER_PHASE
#define MK_PER_PHASE 0
#endif
#ifdef DBG_DUMP_OFF
__global__ void dump_kernel(const bf16_t* src, size_t n, float* out) {
    for (size_t i = (size_t)blockIdx.x * blockDim.x + threadIdx.x; i < (size_t)NTOK * DM; i += (size_t)gridDim.x * blockDim.x) {
        float s = 0.f; for (size_t j = i; j < n; j += (size_t)NTOK * DM) s += bf2f(src[j]); out[i] = s; }
}
#endif
extern "C" void kernel_launch(void* const* d_in, const int* in_sizes, int n_in, void* d_out, int out_size, void* d_ws, size_t ws_size, hipStream_t stream) {
    static int grid = 0;
    if (grid == 0) {
        if (n_in != 18 || ws_size < WS_NEED) { fprintf(stderr, "kernel_launch: expected 18 inputs and >= %zu bytes of workspace (got %d, %zu)\n", (size_t)WS_NEED, n_in, ws_size); grid = -1; return; }
        int dev = 0, cus = 0, per_cu = 0;
        (void)hipGetDevice(&dev); (void)hipDeviceGetAttribute(&cus, hipDeviceAttributeMultiprocessorCount, dev);
        if (hipFuncSetAttribute((const void*)fwd_megakernel, hipFuncAttributeMaxDynamicSharedMemorySize, LDS_BYTES) != hipSuccess) { fprintf(stderr, "kernel_launch: hipFuncSetAttribute failed\n"); grid = -1; return; }
        if (hipOccupancyMaxActiveBlocksPerMultiprocessor(&per_cu, (const void*)fwd_megakernel, NTHREADS, LDS_BYTES) != hipSuccess || per_cu < 1) { fprintf(stderr, "kernel_launch: occupancy query failed (%d)\n", per_cu); (void)hipGetLastError(); grid = -1; return; }
        grid = cus * per_cu;
    }
    if (grid < 0) return;
    Params p{};
    const float** pp = (const float**)&p;
    for (int i = 0; i < 18; ++i) pp[i] = (const float*)d_in[i];
    p.out = (float*)d_out; p.ws = (unsigned char*)d_ws;
#if MK_PER_PHASE
#ifndef DBG_HI
#define DBG_HI NPHASE
#endif
    for (int k = 0; k < DBG_HI; ++k) { p.ph_lo = k; p.ph_hi = k + 1; hipLaunchKernelGGL(fwd_megakernel, dim3(grid), dim3(NTHREADS), LDS_BYTES, stream, p);
#ifdef DBG_HOSTREP
        if (k == DBG_HOSTREP) hipLaunchKernelGGL(fwd_megakernel, dim3(grid), dim3(NTHREADS), LDS_BYTES, stream, p);
#endif
    }
#ifdef DBG_DUMP_OFF
    hipLaunchKernelGGL(dump_kernel, dim3(2048), dim3(256), 0, stream, (const bf16_t*)((unsigned char*)d_ws + (size_t)(DBG_DUMP_OFF) * MiB), (size_t)(DBG_DUMP_N), (float*)d_out);
#endif
#else
    p.ph_lo = 0; p.ph_hi = NPHASE;
    if (hipMemsetAsync((char*)d_ws + WS_CTL, 0, 16384, stream) != hipSuccess) { fprintf(stderr, "kernel_launch: hipMemsetAsync failed\n"); return; }
    void* args[] = {&p};
    const hipError_t e = hipLaunchCooperativeKernel((const void*)fwd_megakernel, dim3(grid), dim3(NTHREADS), args, LDS_BYTES, stream);
    if (e != hipSuccess) fprintf(stderr, "kernel_launch: cooperative launch failed: %s (grid %d)\n", hipGetErrorString(e), grid);
#endif
}
```

```cpp
#include <hip/hip_runtime.h>
#include <hip/hip_cooperative_groups.h>
#include <cstdio>
#include <cstdint>
namespace cg = cooperative_groups;
namespace pg8 {
#define PG8_LAS __attribute__((address_space(3)))
typedef unsigned short bf16_t;
typedef short bf16x8 __attribute__((ext_vector_type(8)));
typedef float f32x4 __attribute__((ext_vector_type(4)));
typedef unsigned u32x4 __attribute__((ext_vector_type(4)));
constexpr int BM = 256, BK = 64, HALF = 128, HTB = HALF * BK * 2  , STAGE_BYTES = 8 * HTB, NXCD = 8, WGM = 8;

__host__ __device__ __forceinline__ int lds_byte(int r, int c) { const int st = (r >> 4) * 2 + (c >> 5), rr = r & 15, cc = c & 31, ob = rr * 64 + cc * 2; return st * 1024 + (ob ^ (((ob >> 9) & 1) << 5)); }
__host__ __device__ __forceinline__ void stage_rc(int b, int& R, int& C) { const int st = b / 1024, sb = b % 1024, swz = sb ^ (((sb >> 9) & 1) << 5); R = (st >> 1) * 16 + swz / 64; C = (st & 1) * 32 + (swz % 64) / 2; }
__host__ __device__ __forceinline__ int perm32(int rho) { const int n = rho >> 4, i = rho & 15; return 8 * (i >> 2) + 4 * n + (i & 3); }

struct Unit { int pm, pn; };
struct Gemm { const bf16_t* A; const bf16_t* Bt; int M, N, K; };

struct StaticOrder {
    int nM, nN, nwg, G, c;
    __host__ __device__ void init(int M, int N, int G_, int c_) { nM = M / BM; nN = N / BM; nwg = nM * nN; G = G_; c = c_; }
    __host__ __device__ bool next(int i, Unit& u) const {
        const long L = (long)i * G + c; if (L >= nwg) return false;
        int wgid = (int)L; { const int q = nwg / NXCD, r = nwg % NXCD, xcd = wgid % NXCD, off = wgid / NXCD; wgid = (xcd < r ? xcd * (q + 1) : r * (q + 1) + (xcd - r) * q) + off; }
        const int nig = WGM * nN, gid = wgid / nig, fm = gid * WGM, gsz = (nM - fm) < WGM ? (nM - fm) : WGM;
        u.pm = fm + ((wgid % nig) % gsz); u.pn = (wgid % nig) / gsz; return true;
    }
    __device__ __forceinline__ void a_ready(const Unit&) const {}
    __device__ __forceinline__ void done(const Unit&) const {}
};

__device__ __forceinline__ unsigned cvt_pk_bf16(float lo, float hi) { unsigned r; asm volatile("v_cvt_pk_bf16_f32 %0, %1, %2" : "=v"(r) : "v"(lo), "v"(hi)); return r; }
typedef float f32x2 __attribute__((ext_vector_type(2)));
__device__ __forceinline__ f32x2 gelu_pk(f32x2 v) {
    const f32x2 av = __builtin_elementwise_abs(v), d = av * 0.2316418882f + 1.0f;
    f32x2 t; t.x = __builtin_amdgcn_rcpf(d.x); t.y = __builtin_amdgcn_rcpf(d.y);
    f32x2 q = t * 0.5307027145f + (-0.7265760135f); q = q * t + 0.7107068705f; q = q * t + (-0.142248368f); q = q * t + 0.127414796f; q = q * t;
    const f32x2 s = (v * v) * (-0.72134752044f);
    f32x2 e; e.x = __builtin_amdgcn_exp2f(s.x); e.y = __builtin_amdgcn_exp2f(s.y);
    const f32x2 m = v * (q * e), r = v - m;
    f32x2 o; o.x = v.x < 0.f ? m.x : r.x; o.y = v.y < 0.f ? m.y : r.y; return o;
}

template <int ACT  > struct EpiBf16 {
    static constexpr bool PERM = true, AFTER_DRAIN = false; static_assert(ACT == 0 || ACT == 1, "EpiBf16: ACT is 0 (none) or 1 (gelu_pk)");
    bf16_t* O; int ldc; const float* bias; int split_cols; size_t split_stride; float scale0;
    __device__ __forceinline__ void operator()(const f32x4 (&acc)[2][2][4][2], const Unit& u, int wr, int wc, int fr, int fq) const {
        const int row0 = u.pm * BM + wr * 64 + fr; int colt = u.pn * BM; bf16_t* base = O;
        float sc = 1.f; if (split_cols) { const int t = colt / split_cols; base += (size_t)t * split_stride; colt -= t * split_cols; if (t == 0) sc = scale0; }
        const int col0 = colt + wc * 32 + 8 * fq, bcol0 = u.pn * BM + wc * 32 + 8 * fq;
        f32x4 bv[2][2];
#pragma unroll
        for (int bj = 0; bj < 2; ++bj)
#pragma unroll
            for (int n = 0; n < 2; ++n) bv[bj][n] = bias ? *(const f32x4*)(bias + bcol0 + bj * HALF + 4 * n) : (f32x4){0.f, 0.f, 0.f, 0.f};
#pragma unroll
        for (int ai = 0; ai < 2; ++ai)
#pragma unroll
            for (int m = 0; m < 4; ++m) { bf16_t* rowp = base + (size_t)(row0 + ai * HALF + m * 16) * ldc + col0;
#pragma unroll
                for (int bj = 0; bj < 2; ++bj) { f32x4 v0 = acc[ai][bj][m][0] + bv[bj][0], v1 = acc[ai][bj][m][1] + bv[bj][1];
                    if (ACT == 1) { f32x2 a = gelu_pk((f32x2){v0[0], v0[1]}), b = gelu_pk((f32x2){v0[2], v0[3]}), c = gelu_pk((f32x2){v1[0], v1[1]}), d = gelu_pk((f32x2){v1[2], v1[3]});
                        v0 = (f32x4){a.x, a.y, b.x, b.y}; v1 = (f32x4){c.x, c.y, d.x, d.y}; }
                    v0 = v0 * sc; v1 = v1 * sc; u32x4 w; w.x = cvt_pk_bf16(v0[0], v0[1]); w.y = cvt_pk_bf16(v0[2], v0[3]); w.z = cvt_pk_bf16(v1[0], v1[1]); w.w = cvt_pk_bf16(v1[2], v1[3]);
                    *(u32x4*)(rowp + bj * HALF) = w; } }
    }
};

struct PanelStats {
    unsigned* xbuf;
    unsigned* cnt;
    unsigned* tmo;
    int ntn; float eps;
    unsigned code;
    __device__ __forceinline__ bool run(const f32x4 (&v)[2][2][4][2], const Unit& u, int wr, int wc, int fr, int fq, PG8_LAS unsigned char* lds, int wid, int lane) const {
        typedef float f32x2v __attribute__((ext_vector_type(2)));
        PG8_LAS f32x2v* P = (PG8_LAS f32x2v*)lds;
        PG8_LAS f32x2v* S = (PG8_LAS f32x2v*)(lds + 8192);
        PG8_LAS unsigned* flag = (PG8_LAS unsigned*)(lds + 8192 + 2048);
#pragma unroll
        for (int ai = 0; ai < 2; ++ai)
#pragma unroll
            for (int m = 0; m < 4; ++m) {
                float s = 0.f;
#pragma unroll
                for (int bj = 0; bj < 2; ++bj)
#pragma unroll
                    for (int n = 0; n < 2; ++n) { const f32x4 x = v[ai][bj][m][n]; s += (x[0] + x[1]) + (x[2] + x[3]); }
                s += __shfl_xor(s, 16); s += __shfl_xor(s, 32);
                const float mw = s * (1.0f / 64.0f); float q = 0.f;
#pragma unroll
                for (int bj = 0; bj < 2; ++bj)
#pragma unroll
                    for (int n = 0; n < 2; ++n) { const f32x4 d = v[ai][bj][m][n] - mw; q += (d[0] * d[0] + d[1] * d[1]) + (d[2] * d[2] + d[3] * d[3]); }
                q += __shfl_xor(q, 16); q += __shfl_xor(q, 32);
                if (fq == 0) P[(ai * HALF + wr * 64 + m * 16 + fr) * 4 + wc] = (f32x2v){mw, q};
            }
        asm volatile("s_waitcnt lgkmcnt(0)" ::: "memory"); __builtin_amdgcn_s_barrier(); asm volatile("" ::: "memory");
#if defined(BROKEN_EXCHANGE_NO_WAIT)
#warning BROKEN CONTROL BUILD: the row-statistics exchange does not wait; results are wrong by design
        if (blockIdx.x >= 64) { const long long t0_ = clock64(); while (clock64() - t0_ < 60000) __builtin_amdgcn_s_sleep(8); }
#endif
        const int row = wid * 32 + (lane & 31);
        if (lane < 32) {
            const f32x2v a = P[row * 4 + 0], b = P[row * 4 + 1], c = P[row * 4 + 2], d = P[row * 4 + 3];
            const float mt = (a.x + b.x + c.x + d.x) * 0.25f;
            const float da = a.x - mt, db = b.x - mt, dc = c.x - mt, dd = d.x - mt;
            const float m2 = (a.y + b.y) + (c.y + d.y) + 64.0f * ((da * da + db * db) + (dc * dc + dd * dd));
            unsigned long long* slot = (unsigned long long*)xbuf + ((size_t)(u.pm * BM + row) * 4 + u.pn);
            __hip_atomic_store(slot, ((unsigned long long)__float_as_uint(m2) << 32) | __float_as_uint(mt), __ATOMIC_RELAXED, __HIP_MEMORY_SCOPE_AGENT);
        }
        asm volatile("s_waitcnt vmcnt(0)" ::: "memory");
        if (lane == 0) __hip_atomic_fetch_add(cnt + 64 * u.pm, 1u, __ATOMIC_RELAXED, __HIP_MEMORY_SCOPE_AGENT);
        if (wid == 0) {
            bool dead = false; const unsigned long long t0 = __builtin_amdgcn_s_memrealtime(); const unsigned want = 8u * (unsigned)ntn;
            for (;;) {
#if defined(BROKEN_EXCHANGE_NO_WAIT)
                break;
#endif
                if ((unsigned)__builtin_amdgcn_readfirstlane(__hip_atomic_load(cnt + 64 * u.pm, __ATOMIC_RELAXED, __HIP_MEMORY_SCOPE_AGENT)) >= want) break;
                if (__builtin_amdgcn_s_memrealtime() - t0 > 2000000ull) {
                    if (lane == 0) { unsigned expect = 0u; __hip_atomic_compare_exchange_strong(tmo + 1, &expect, code | (unsigned)(u.pm & 0xff), __ATOMIC_RELAXED, __ATOMIC_RELAXED, __HIP_MEMORY_SCOPE_AGENT);
                                     __hip_atomic_store(tmo, 1u, __ATOMIC_RELAXED, __HIP_MEMORY_SCOPE_AGENT); }
                    dead = true; break; }
                __builtin_amdgcn_s_sleep(2);
            }
            __builtin_amdgcn_fence(__ATOMIC_ACQUIRE, "agent");
            if (lane == 0) flag[0] = dead ? 1u : 0u;
        }
        asm volatile("s_waitcnt vmcnt(0) lgkmcnt(0)" ::: "memory"); __builtin_amdgcn_s_barrier(); asm volatile("" ::: "memory");
        const bool bad = flag[0] != 0u;
        if (lane < 32) {
            const unsigned long long* slot = (const unsigned long long*)xbuf + (size_t)(u.pm * BM + row) * 4; float mt[4], m2[4]; float ms = 0.f;
#pragma unroll
            for (int t = 0; t < 4; ++t) { if (t < ntn) { const unsigned long long w = __hip_atomic_load(slot + t, __ATOMIC_RELAXED, __HIP_MEMORY_SCOPE_AGENT); mt[t] = __uint_as_float((unsigned)w); m2[t] = __uint_as_float((unsigned)(w >> 32)); } else { mt[t] = 0.f; m2[t] = 0.f; } ms += mt[t]; }
            const float mean = ms / (float)ntn; float q = 0.f;
#pragma unroll
            for (int t = 0; t < 4; ++t) if (t < ntn) { const float dm = mt[t] - mean; q += m2[t] + 256.0f * dm * dm; }
            S[row] = (f32x2v){mean, 1.0f / sqrtf(q / (256.0f * (float)ntn) + eps)};
        }
        asm volatile("s_waitcnt lgkmcnt(0)" ::: "memory"); __builtin_amdgcn_s_barrier(); asm volatile("" ::: "memory");
        return bad;
    }
};
struct EpiLnRes {
    static constexpr bool PERM = false, AFTER_DRAIN = true;
    const float* base; float* out; int ldc; const float* bias; PanelStats st; unsigned poison;
    __device__ __forceinline__ void fused(f32x4 (&acc)[2][2][4][2], const Unit& u, int wr, int wc, int fr, int fq, PG8_LAS unsigned char* lds, int wid, int lane) const {
        typedef float f32x2v __attribute__((ext_vector_type(2)));
        const PG8_LAS f32x2v* S = (const PG8_LAS f32x2v*)(lds + 8192);
        const int col0 = u.pn * BM + wc * 32 + 4 * fq;
#pragma unroll
        for (int bj = 0; bj < 2; ++bj)
#pragma unroll
            for (int n = 0; n < 2; ++n) { const f32x4 bv = bias ? *(const f32x4*)(bias + col0 + bj * HALF + n * 16) : (f32x4){0.f, 0.f, 0.f, 0.f};
#pragma unroll
                for (int ai = 0; ai < 2; ++ai)
#pragma unroll
                    for (int m = 0; m < 4; ++m) acc[ai][bj][m][n] += bv; }
        f32x4 pre[4][2][2];
#pragma unroll
        for (int m = 0; m < 4; ++m) { const size_t off = (size_t)(u.pm * BM + wr * 64 + m * 16 + fr) * ldc + col0;
#pragma unroll
            for (int bj = 0; bj < 2; ++bj)
#pragma unroll
                for (int n = 0; n < 2; ++n) pre[m][bj][n] = *(const f32x4*)(base + off + bj * HALF + n * 16); }
        const bool bad = st.run(acc, u, wr, wc, fr, fq, lds, wid, lane) || poison != 0u;
        const float qnan = __builtin_nanf("");
#pragma unroll
        for (int ai = 0; ai < 2; ++ai)
#pragma unroll
            for (int m = 0; m < 4; ++m) { const int r = ai * HALF + wr * 64 + m * 16 + fr; const f32x2v sr = S[r]; const size_t off = (size_t)(u.pm * BM + r) * ldc + col0;
#pragma unroll
                for (int bj = 0; bj < 2; ++bj)
#pragma unroll
                    for (int n = 0; n < 2; ++n) { const f32x4 bs = ai == 0 ? pre[m][bj][n] : *(const f32x4*)(base + off + bj * HALF + n * 16); f32x4 o = bs + (acc[ai][bj][m][n] - sr.x) * sr.y;
                        if (bad) o = (f32x4){qnan, qnan, qnan, qnan}; *(f32x4*)(out + off + bj * HALF + n * 16) = o; }
                if (m & 1) asm volatile("" ::: "memory"); }
    }
};
struct EpiLnResLn {
    static constexpr bool PERM = false, AFTER_DRAIN = true;
    const float* base; float* out; bf16_t* xn; int ldc; const float* bias; PanelStats st1, st2; unsigned poison;
    __device__ __forceinline__ void fused(f32x4 (&acc)[2][2][4][2], const Unit& u, int wr, int wc, int fr, int fq, PG8_LAS unsigned char* lds, int wid, int lane) const {
        typedef float f32x2v __attribute__((ext_vector_type(2))); typedef unsigned u32x2v __attribute__((ext_vector_type(2)));
        const PG8_LAS f32x2v* S = (const PG8_LAS f32x2v*)(lds + 8192);
        const int col0 = u.pn * BM + wc * 32 + 4 * fq;
#pragma unroll
        for (int bj = 0; bj < 2; ++bj)
#pragma unroll
            for (int n = 0; n < 2; ++n) { const f32x4 bv = bias ? *(const f32x4*)(bias + col0 + bj * HALF + n * 16) : (f32x4){0.f, 0.f, 0.f, 0.f};
#pragma unroll
                for (int ai = 0; ai < 2; ++ai)
#pragma unroll
                    for (int m = 0; m < 4; ++m) acc[ai][bj][m][n] += bv; }
        bool bad = st1.run(acc, u, wr, wc, fr, fq, lds, wid, lane) || poison != 0u;
        const float qnan = __builtin_nanf("");
#pragma unroll
        for (int ai = 0; ai < 2; ++ai)
#pragma unroll
            for (int m = 0; m < 4; ++m) { const int r = ai * HALF + wr * 64 + m * 16 + fr; const f32x2v sr = S[r]; const size_t off = (size_t)(u.pm * BM + r) * ldc + col0;
#pragma unroll
                for (int bj = 0; bj < 2; ++bj)
#pragma unroll
                    for (int n = 0; n < 2; ++n) { const f32x4 bs = *(const f32x4*)(base + off + bj * HALF + n * 16); acc[ai][bj][m][n] = bs + (acc[ai][bj][m][n] - sr.x) * sr.y; }
                asm volatile("" : "+v"(acc[ai][0][m][0]), "+v"(acc[ai][0][m][1]), "+v"(acc[ai][1][m][0]), "+v"(acc[ai][1][m][1]));
                if (m & 1) asm volatile("" ::: "memory"); }
        const bool bad1 = bad;
        bad = st2.run(acc, u, wr, wc, fr, fq, lds, wid, lane) || bad;
#pragma unroll
        for (int ai = 0; ai < 2; ++ai)
#pragma unroll
            for (int m = 0; m < 4; ++m) { const int r = ai * HALF + wr * 64 + m * 16 + fr; const f32x2v sr = S[r]; const size_t off = (size_t)(u.pm * BM + r) * ldc + col0;
#pragma unroll
                for (int bj = 0; bj < 2; ++bj)
#pragma unroll
                    for (int n = 0; n < 2; ++n) { const f32x4 x1 = acc[ai][bj][m][n]; *(f32x4*)(out + off + bj * HALF + n * 16) = bad1 ? (f32x4){qnan, qnan, qnan, qnan} : x1;
                        const f32x4 o = (x1 - sr.x) * sr.y; u32x2v w; w.x = cvt_pk_bf16(o[0], o[1]); w.y = cvt_pk_bf16(o[2], o[3]);
                        if (bad) { w.x = 0x7fc07fc0u; w.y = 0x7fc07fc0u; } *(u32x2v*)(xn + off + bj * HALF + n * 16) = w; }
                asm volatile("" ::: "memory"); }
    }
};

template <class Epi, class Sched, bool ALIGN_EPI = false, bool SP2 = false>
__device__ __forceinline__ void gemm_phase(PG8_LAS unsigned char* lds, const Gemm g, const Sched& S, const Epi& E) {
    const int tid = threadIdx.x, wid = __builtin_amdgcn_readfirstlane(tid >> 6), lane = tid & 63, wr = wid >> 2, wc = wid & 3, fr = lane & 15, fq = lane >> 4;
    const int K = g.K, nt = K / BK;
    unsigned voffA[2], voffB[2];
#pragma unroll
    for (int i = 0; i < 2; ++i) { int R, C; stage_rc(tid * 16 + i * 8192, R, C); const int Rb = Epi::PERM ? ((R & ~31) + perm32(R & 31)) : R;
        voffA[i] = (unsigned)(R * K + C) * 2u; voffB[i] = (unsigned)(Rb * K + C) * 2u; }
    const size_t kstep = (size_t)(BK * 2);
    const size_t hstep = (size_t)HALF * K * 2;
    const size_t tstep = 2 * hstep;
    const unsigned ldsw = (unsigned)wid * 1024u;
    const int aoff = lds_byte(wr * 64 + fr, fq * 8), boff = lds_byte(wc * 32 + fr, fq * 8);
#define PG8_SA(b, h) (((b) * 2 + (h)) * HTB)
#define PG8_SB(b, h) ((4 + (b) * 2 + (h)) * HTB)
#define PG8_STAGE(bufoff, gbase, voff) do { _Pragma("unroll") for (int _i = 0; _i < 2; ++_i) \
        __builtin_amdgcn_global_load_lds((const unsigned*)((const char*)(gbase) + (voff)[_i]), (PG8_LAS unsigned*)(lds + (bufoff) + ldsw + _i * 8192), 16, 0, 0); } while (0)
#define PG8_LDA(dst, b, h) do { _Pragma("unroll") for (int m = 0; m < 4; ++m) _Pragma("unroll") for (int k = 0; k < 2; ++k) dst[m][k] = *(const PG8_LAS bf16x8*)(lds + PG8_SA(b, h) + aoff + m * 2048 + k * 1024); } while (0)
#define PG8_LDB(dst, b, h) do { _Pragma("unroll") for (int n = 0; n < 2; ++n) _Pragma("unroll") for (int k = 0; k < 2; ++k) dst[n][k] = *(const PG8_LAS bf16x8*)(lds + PG8_SB(b, h) + boff + n * 2048 + k * 1024); } while (0)
#define PG8_MMA(ai, bj, At, Bt) do { __builtin_amdgcn_s_setprio(1); _Pragma("unroll") for (int m = 0; m < 4; ++m) _Pragma("unroll") for (int n = 0; n < 2; ++n) _Pragma("unroll") for (int k = 0; k < 2; ++k) \
        acc[ai][bj][m][n] = __builtin_amdgcn_mfma_f32_16x16x32_bf16(Bt[n][k], At[m][k], acc[ai][bj][m][n], 0, 0, 0); __builtin_amdgcn_s_setprio(0); } while (0)
#define PG8_WAIT_V(n) asm volatile("s_waitcnt vmcnt(" #n ")" ::: "memory")
#define PG8_WAIT_L(n) asm volatile("s_waitcnt lgkmcnt(" #n ")" ::: "memory")
#define PG8_BAR __builtin_amdgcn_s_barrier()
#define PG8_SCHED __builtin_amdgcn_sched_barrier(0)
    Unit cur, nxt; int ui = 0;
    if (!S.next(0, cur)) return;
    f32x4 acc[2][2][4][2];
#pragma unroll
    for (int a = 0; a < 2; ++a)
#pragma unroll
        for (int b = 0; b < 2; ++b)
#pragma unroll
            for (int m = 0; m < 4; ++m)
#pragma unroll
                for (int n = 0; n < 2; ++n) acc[a][b][m][n] = (f32x4){0.f, 0.f, 0.f, 0.f};
    bf16x8 At[4][2], B0[2][2], B1[2][2];
    const char* cA = (const char*)g.A + (size_t)cur.pm * tstep; const char* cB = (const char*)g.Bt + (size_t)cur.pn * tstep;
    S.a_ready(cur);
    if constexpr (SP2) {
        PG8_STAGE(PG8_SB(0, 0), cB, voffB); PG8_STAGE(PG8_SB(0, 1), cB + hstep, voffB); PG8_STAGE(PG8_SA(0, 0), cA, voffA); PG8_STAGE(PG8_SA(0, 1), cA + hstep, voffA);
        if (wr == 1) PG8_BAR;
        PG8_WAIT_V(2); PG8_BAR;
        PG8_STAGE(PG8_SB(1, 0), cB + kstep, voffB); PG8_STAGE(PG8_SA(1, 0), cA + kstep, voffA); PG8_STAGE(PG8_SB(1, 1), cB + hstep + kstep, voffB);
        PG8_WAIT_V(6); PG8_BAR;
    } else {
        PG8_STAGE(PG8_SB(0, 0), cB, voffB); PG8_STAGE(PG8_SA(0, 0), cA, voffA); PG8_STAGE(PG8_SB(0, 1), cB + hstep, voffB); PG8_STAGE(PG8_SA(0, 1), cA + hstep, voffA);
        if (wr == 1) PG8_BAR;
        PG8_WAIT_V(4); PG8_BAR;
        PG8_STAGE(PG8_SB(1, 0), cB + kstep, voffB); PG8_STAGE(PG8_SA(1, 0), cA + kstep, voffA); PG8_STAGE(PG8_SB(1, 1), cB + hstep + kstep, voffB);
        PG8_WAIT_V(6); PG8_BAR;
    }
    for (;;) {
        const bool has_next = S.next(ui + 1, nxt);
        const char* nA = has_next ? (const char*)g.A + (size_t)nxt.pm * tstep : cA; const char* nB = has_next ? (const char*)g.Bt + (size_t)nxt.pn * tstep : cB;
        for (int t = 0; t < nt; t += 2) {
            const bool last = (t == nt - 2);
            const char* a1 = cA + (size_t)(t + 1) * kstep;
            const char* a2 = last ? nA : cA + (size_t)(t + 2) * kstep; const char* b2 = last ? nB : cB + (size_t)(t + 2) * kstep;
            const char* a3 = a2 + kstep; const char* b3 = b2 + kstep;
            if (last && has_next) S.a_ready(nxt);
            if constexpr (SP2) {
            PG8_LDB(B0, 0, 0); PG8_LDB(B1, 0, 1); PG8_SCHED; PG8_LDA(At, 0, 0); PG8_STAGE(PG8_SA(1, 1), a1 + hstep, voffA);
            PG8_WAIT_V(8); PG8_WAIT_L(0); PG8_BAR; PG8_MMA(0, 0, At, B0); PG8_MMA(0, 1, At, B1); PG8_BAR; PG8_SCHED;
            PG8_LDA(At, 0, 1); PG8_STAGE(PG8_SB(0, 0), b2, voffB); PG8_STAGE(PG8_SB(0, 1), b2 + hstep, voffB); PG8_STAGE(PG8_SA(0, 0), a2, voffA);
            PG8_WAIT_V(8); PG8_WAIT_L(0); PG8_BAR; PG8_MMA(1, 0, At, B0); PG8_MMA(1, 1, At, B1); PG8_BAR; PG8_SCHED;
            PG8_LDB(B0, 1, 0); PG8_LDB(B1, 1, 1); PG8_SCHED; PG8_LDA(At, 1, 0); PG8_STAGE(PG8_SA(0, 1), a2 + hstep, voffA);
            PG8_WAIT_V(8); PG8_WAIT_L(0); PG8_BAR; PG8_MMA(0, 0, At, B0); PG8_MMA(0, 1, At, B1); PG8_BAR; PG8_SCHED;
            PG8_LDA(At, 1, 1); PG8_STAGE(PG8_SB(1, 0), b3, voffB); PG8_STAGE(PG8_SB(1, 1), b3 + hstep, voffB); PG8_STAGE(PG8_SA(1, 0), a3, voffA);
            PG8_WAIT_V(8); PG8_WAIT_L(0); PG8_BAR; PG8_MMA(1, 0, At, B0); PG8_MMA(1, 1, At, B1); PG8_BAR; PG8_SCHED;
            } else {
            PG8_LDB(B0, 0, 0); PG8_SCHED; PG8_LDA(At, 0, 0); PG8_STAGE(PG8_SA(1, 1), a1 + hstep, voffA);
            PG8_WAIT_L(8); PG8_BAR; PG8_WAIT_L(0); PG8_MMA(0, 0, At, B0); PG8_BAR; PG8_SCHED;
            PG8_LDB(B1, 0, 1); PG8_STAGE(PG8_SB(0, 0), b2, voffB);
            PG8_BAR; PG8_WAIT_L(0); PG8_MMA(0, 1, At, B1); PG8_BAR;
            PG8_LDA(At, 0, 1); PG8_STAGE(PG8_SA(0, 0), a2, voffA);
            PG8_BAR; PG8_WAIT_L(0); PG8_MMA(1, 0, At, B0); PG8_BAR; PG8_SCHED;
            PG8_STAGE(PG8_SB(0, 1), b2 + hstep, voffB);
            PG8_WAIT_V(6); PG8_BAR; PG8_MMA(1, 1, At, B1); PG8_BAR;
            PG8_LDB(B0, 1, 0); PG8_SCHED; PG8_LDA(At, 1, 0); PG8_STAGE(PG8_SA(0, 1), a2 + hstep, voffA);
            PG8_WAIT_L(8); PG8_BAR; PG8_WAIT_L(0); PG8_MMA(0, 0, At, B0); PG8_BAR; PG8_SCHED;
            PG8_LDB(B1, 1, 1); PG8_STAGE(PG8_SB(1, 0), b3, voffB);
            PG8_BAR; PG8_WAIT_L(0); PG8_MMA(0, 1, At, B1); PG8_BAR;
            PG8_LDA(At, 1, 1); PG8_STAGE(PG8_SA(1, 0), a3, voffA);
            PG8_BAR; PG8_WAIT_L(0); PG8_MMA(1, 0, At, B0); PG8_BAR; PG8_SCHED;
            PG8_STAGE(PG8_SB(1, 1), b3 + hstep, voffB);
            PG8_WAIT_V(6); PG8_BAR; PG8_MMA(1, 1, At, B1); PG8_BAR;
            }
        }
        if constexpr (ALIGN_EPI) { if (wr == 0) PG8_BAR; }
        if constexpr (!Epi::AFTER_DRAIN) { E(acc, cur, wr, wc, fr, fq); S.done(cur); }
        if (!has_next) break;
#pragma unroll
        for (int a = 0; a < 2; ++a)
#pragma unroll
            for (int b = 0; b < 2; ++b)
#pragma unroll
                for (int m = 0; m < 4; ++m)
#pragma unroll
                    for (int n = 0; n < 2; ++n) acc[a][b][m][n] = (f32x4){0.f, 0.f, 0.f, 0.f};
        cur = nxt; cA = nA; cB = nB; ++ui;
        if constexpr (ALIGN_EPI) { if (wr == 1) PG8_BAR; }
    }
    PG8_WAIT_V(0);
    if constexpr (!ALIGN_EPI) { if (wr == 0) PG8_BAR; }
    PG8_BAR;
    if constexpr (Epi::AFTER_DRAIN) { E.fused(acc, cur, wr, wc, fr, fq, lds, wid, lane); S.done(cur); }
#undef PG8_SA
#undef PG8_SB
#undef PG8_STAGE
#undef PG8_LDA
#undef PG8_LDB
#undef PG8_MMA
#undef PG8_WAIT_V
#undef PG8_WAIT_L
#undef PG8_BAR
#undef PG8_SCHED
}
}

typedef float f32x2_t __attribute__((ext_vector_type(2))); typedef __bf16 bf16x2_t __attribute__((ext_vector_type(2)));
__device__ __forceinline__ unsigned cvtpk(float lo, float hi) { f32x2_t v = {lo, hi}; bf16x2_t b = __builtin_convertvector(v, bf16x2_t); return __builtin_bit_cast(unsigned, b); }

namespace pg8 {
template <bool BASE_BF16> struct EpiRes {
    static constexpr bool PERM = true, AFTER_DRAIN = false;
    const void* base; bf16_t* hb; float* ssq;
    __device__ __forceinline__ void operator()(const f32x4 (&acc)[2][2][4][2], const Unit& u, int wr, int wc, int fr, int fq) const {
        const int row0 = u.pm * BM + wr * 64 + fr, col0 = u.pn * BM + wc * 32 + 8 * fq;
#pragma unroll
        for (int ai = 0; ai < 2; ++ai) {
            f32x4 b0[4][2], b1[4][2];
#pragma unroll
            for (int m = 0; m < 4; ++m)
#pragma unroll
                for (int bj = 0; bj < 2; ++bj) {
                    const size_t off = (size_t)(row0 + ai * HALF + m * 16) * 1024 + col0 + bj * HALF;
                    if (BASE_BF16) {
                        const u32x4 w = *(const u32x4*)((const bf16_t*)base + off);
                        b0[m][bj][0] = __uint_as_float(w.x << 16); b0[m][bj][1] = __uint_as_float(w.x & 0xffff0000u); b0[m][bj][2] = __uint_as_float(w.y << 16); b0[m][bj][3] = __uint_as_float(w.y & 0xffff0000u);
                        b1[m][bj][0] = __uint_as_float(w.z << 16); b1[m][bj][1] = __uint_as_float(w.z & 0xffff0000u); b1[m][bj][2] = __uint_as_float(w.w << 16); b1[m][bj][3] = __uint_as_float(w.w & 0xffff0000u);
                    } else { b0[m][bj] = *(const f32x4*)((const float*)base + off); b1[m][bj] = *(const f32x4*)((const float*)base + off + 4); }
                }
#pragma unroll
            for (int m = 0; m < 4; ++m) {
                const size_t row = (size_t)(row0 + ai * HALF + m * 16); float s = 0.f;
#pragma unroll
                for (int bj = 0; bj < 2; ++bj) {
                    const size_t off = row * 1024 + col0 + bj * HALF;
                    const f32x4 v0 = acc[ai][bj][m][0] + b0[m][bj], v1 = acc[ai][bj][m][1] + b1[m][bj];
                    s += (v0[0] * v0[0] + v0[1] * v0[1]) + (v0[2] * v0[2] + v0[3] * v0[3]) + (v1[0] * v1[0] + v1[1] * v1[1]) + (v1[2] * v1[2] + v1[3] * v1[3]);
                    u32x4 w; w.x = cvtpk(v0[0], v0[1]); w.y = cvtpk(v0[2], v0[3]); w.z = cvtpk(v1[0], v1[1]); w.w = cvtpk(v1[2], v1[3]); *(u32x4*)(hb + off) = w;
                }
                s += __shfl_xor(s, 16); s += __shfl_xor(s, 32); if (fq == 0) ssq[row * 16 + u.pn * 4 + wc] = s;
            }
        }
    }
};
template <int MODE> struct EpiScale {
    static constexpr bool PERM = true, AFTER_DRAIN = false;
    bf16_t* O; int ldc; const float* ssq; float scale;
    __device__ __forceinline__ void operator()(const f32x4 (&acc)[2][2][4][2], const Unit& u, int wr, int wc, int fr, int fq) const {
        const int row0 = u.pm * BM + wr * 64 + fr, col0 = u.pn * BM + wc * 32 + 8 * fq;
        f32x4 sp[2][4];
#pragma unroll
        for (int ai = 0; ai < 2; ++ai)
#pragma unroll
            for (int m = 0; m < 4; ++m) sp[ai][m] = *(const f32x4*)(ssq + (size_t)(row0 + ai * HALF + m * 16) * 16 + 4 * fq);
#pragma unroll
        for (int ai = 0; ai < 2; ++ai)
#pragma unroll
            for (int m = 0; m < 4; ++m) {
                const size_t row = (size_t)(row0 + ai * HALF + m * 16);
                float t = (sp[ai][m][0] + sp[ai][m][1]) + (sp[ai][m][2] + sp[ai][m][3]);
                t += __shfl_xor(t, 16); t += __shfl_xor(t, 32);
                const float rs = __builtin_amdgcn_rsqf(t * (1.0f / 1024.0f) + 1e-6f) * scale;
#pragma unroll
                for (int bj = 0; bj < 2; ++bj) {
                    f32x4 v0 = acc[ai][bj][m][0] * rs, v1 = acc[ai][bj][m][1] * rs;
                    if (MODE == 1) {
#pragma unroll
                        for (int e = 0; e < 4; ++e) { const float a = fmaxf(v0[e], 0.f), b = fmaxf(v1[e], 0.f); v0[e] = a * a; v1[e] = b * b; }
                    }
                    u32x4 w; w.x = cvtpk(v0[0], v0[1]); w.y = cvtpk(v0[2], v0[3]); w.z = cvtpk(v1[0], v1[1]); w.w = cvtpk(v1[2], v1[3]);
                    *(u32x4*)(O + row * ldc + col0 + bj * HALF) = w;
                }
            }
    }
};
struct EpiKV {
    static constexpr bool PERM = true, AFTER_DRAIN = false;
    bf16_t* Kb; bf16_t* Vt;
    __device__ __forceinline__ void operator()(const f32x4 (&acc)[2][2][4][2], const Unit& u, int wr, int wc, int fr, int fq) const {
        const int row0 = u.pm * BM + wr * 64 + fr, col0 = u.pn * BM + wc * 32 + 8 * fq;
#pragma unroll
        for (int ai = 0; ai < 2; ++ai)
#pragma unroll
            for (int m = 0; m < 4; ++m) {
                const int row = row0 + ai * HALF + m * 16;
#pragma unroll
                for (int bj = 0; bj < 2; ++bj) {
                    const int col = col0 + bj * HALF; const f32x4 v0 = acc[ai][bj][m][0], v1 = acc[ai][bj][m][1];
                    u32x4 w; w.x = cvtpk(v0[0], v0[1]); w.y = cvtpk(v0[2], v0[3]); w.z = cvtpk(v1[0], v1[1]); w.w = cvtpk(v1[2], v1[3]);
                    if (col < 1024) { *(u32x4*)(Kb + (size_t)row * 1024 + col) = w; }
                    else {
                        const int b = row >> 8, mm = row & 255; bf16_t* p = Vt + ((size_t)(b * 1024 + (col - 1024))) * 256 + mm;
                        p[0 * 256] = (bf16_t)(w.x & 0xffffu); p[1 * 256] = (bf16_t)(w.x >> 16); p[2 * 256] = (bf16_t)(w.y & 0xffffu); p[3 * 256] = (bf16_t)(w.y >> 16);
                        p[4 * 256] = (bf16_t)(w.z & 0xffffu); p[5 * 256] = (bf16_t)(w.z >> 16); p[6 * 256] = (bf16_t)(w.w & 0xffffu); p[7 * 256] = (bf16_t)(w.w >> 16);
                    }
                }
            }
    }
};
}

#define LAS __attribute__((address_space(3)))
typedef pg8::bf16_t bf16_t;
typedef pg8::bf16x8 bf16x8;
typedef pg8::f32x4 f32x4;
typedef pg8::u32x4 u32x4;
typedef unsigned u32x2 __attribute__((ext_vector_type(2)));

constexpr int NTOK = 32768, DM = 1024, SEQ = 8192, NBATCH = 4, NCHUNK = 128, NPROJ = 3328, DFF = 4096, NMEMROWS = 1024;
constexpr int C_GQ = 0, C_GK = 256, C_GV = 512, C_GG = 1024, C_RQ = 1536, C_RK = 1792, C_RV = 2048, C_RG = 2560, C_Z = 3072;
constexpr int NWAVES = 8, NTHREADS = 512;
constexpr int WAVE_LDS = 18432, MISC_OFF = NWAVES * WAVE_LDS, LDS_BYTES = MISC_OFF + 64;
constexpr int VPITCH = 72;
constexpr int APITCH = 528;
constexpr size_t MiB = 1u << 20;
constexpr size_t WS_WIN = 1 * MiB, WS_WOUT = 8 * MiB, WS_WQ = 10 * MiB, WS_WKV = 12 * MiB, WS_WO = 16 * MiB, WS_W1 = 18 * MiB, WS_W2 = 26 * MiB;
constexpr size_t WS_COS = 34 * MiB, WS_SIN = 35 * MiB, WS_MEMN = 36 * MiB, WS_KB = 38 * MiB, WS_VT = 40 * MiB, WS_DEC = 42 * MiB, WS_SSQ1 = 44 * MiB, WS_SSQ2 = 46 * MiB, WS_SSQ3 = 48 * MiB, WS_CTL = 0;
constexpr size_t WS_A1 = 64 * MiB;
constexpr size_t WS_A2 = 128 * MiB;
constexpr size_t WS_BIG = 192 * MiB;
constexpr size_t WS_NEED = 448 * MiB;

struct Params {
    const float *x, *mem, *norm_mix_g, *w_in, *gla_w_gate, *gla_b_gate, *gla_norm_g, *ret_norm_g, *w_out, *norm_x_g, *norm_mem_g, *xa_w_q, *xa_w_kv, *xa_w_o, *norm_ffn_g, *ffn_w1, *ffn_w2, *final_norm_g;
    float* out; unsigned char* ws; int ph_lo, ph_hi;
};

__device__ __forceinline__ float bf2f(unsigned short b) { return __uint_as_float(((unsigned)b) << 16); }
__device__ __forceinline__ unsigned short f2bf(float f) { const unsigned u = __float_as_uint(f); return (unsigned short)((u + 0x7fffu + ((u >> 16) & 1u)) >> 16); }
__device__ __forceinline__ bf16x8 pack8(f32x4 a, f32x4 b) {
    u32x4 w; w.x = cvtpk(a[0], a[1]); w.y = cvtpk(a[2], a[3]); w.z = cvtpk(b[0], b[1]); w.w = cvtpk(b[2], b[3]);
    return __builtin_bit_cast(bf16x8, w);
}
__device__ __forceinline__ void unpack8(bf16x8 v, f32x4& a, f32x4& b) {
    const u32x4 w = __builtin_bit_cast(u32x4, v);
    a[0] = __uint_as_float(w.x << 16); a[1] = __uint_as_float(w.x & 0xffff0000u); a[2] = __uint_as_float(w.y << 16); a[3] = __uint_as_float(w.y & 0xffff0000u);
    b[0] = __uint_as_float(w.z << 16); b[1] = __uint_as_float(w.z & 0xffff0000u); b[2] = __uint_as_float(w.w << 16); b[3] = __uint_as_float(w.w & 0xffff0000u);
}
__device__ __forceinline__ float wave_sum(float v) {
#pragma unroll
    for (int o = 1; o < 64; o <<= 1) v += __shfl_xor(v, o);
    return v;
}
#define MFMA16(a, b, c) __builtin_amdgcn_mfma_f32_16x16x32_bf16((a), (b), (c), 0, 0, 0)
#define LDS_FENCE() asm volatile("s_waitcnt lgkmcnt(0)" ::: "memory")
#define CFENCE() do { asm volatile("" ::: "memory"); __builtin_amdgcn_sched_barrier(0); } while (0)
__device__ __forceinline__ float scan16(float v, int r) {
#pragma unroll
    for (int off = 1; off < 16; off <<= 1) { const float t = __shfl_up(v, off, 16); if (r >= off) v += t; }
    return v;
}

#define XB_TMO      128
#define XB_XCNT(j)  (256  + 64 * (j))
#define XB_XSUB(j)  (1280 + 64 * (j))
#define XB_XGEN(j)  (2304 + 64 * (j))
#define XB_TOP      3328
#define XB_TOPGEN   3392
#define XCD_BAR_WORDS 3456
#define XB_SPIN_CAP (1u << 18)

__device__ __forceinline__ unsigned xb_ld(unsigned* p)              { return __hip_atomic_load(p, __ATOMIC_RELAXED, __HIP_MEMORY_SCOPE_AGENT); }
__device__ __forceinline__ unsigned xb_add(unsigned* p, unsigned v) { return __hip_atomic_fetch_add(p, v, __ATOMIC_RELAXED, __HIP_MEMORY_SCOPE_AGENT); }
__device__ __forceinline__ unsigned xb_xcc_id() { return (unsigned)__builtin_amdgcn_s_getreg((3 << 11) | 20) & 0xFu; }
#define XB_SPIN(cond, bar) do { unsigned _sp = 0; while (cond) { __builtin_amdgcn_s_sleep(1); \
    if ((++_sp & 255u) == 0u) { if (xb_ld(&(bar)[XB_TMO])) break; if (_sp > XB_SPIN_CAP) { atomicAdd(&(bar)[XB_TMO], 1u); break; } } } } while (0)

struct XcdBarrier {
    unsigned* bar; unsigned x;
    volatile LAS unsigned* st;
};

__device__ __forceinline__ XcdBarrier xcd_barrier_post(unsigned* bar, volatile LAS unsigned* st) {
    XcdBarrier b; b.bar = bar; b.x = xb_xcc_id(); b.st = st;
    if (threadIdx.x == 0) (void)xb_add(&bar[XB_XCNT(b.x)], 1u);
    return b;
}
__device__ __forceinline__ void xcd_barrier_complete(unsigned* bar, unsigned x, unsigned& nloc, unsigned& nx) {
    const unsigned G = gridDim.x * gridDim.y * gridDim.z;
    unsigned sum, cnt, mine, sp = 0u;
    for (;;) {
        sum = 0u; cnt = 0u; mine = 0u;
#pragma unroll
        for (unsigned j = 0; j < 16; ++j) { const unsigned c = xb_ld(&bar[XB_XCNT(j)]); sum += c; cnt += (c > 0u) ? 1u : 0u; mine = (j == x) ? c : mine; }
        if (sum == G) break;
        __builtin_amdgcn_s_sleep(1);
        if ((++sp & 255u) == 0u) { if (xb_ld(&bar[XB_TMO])) break; if (sp > XB_SPIN_CAP) { atomicAdd(&bar[XB_TMO], 1u); break; } }
    }
    nloc = mine > 0u ? mine : 1u; nx = cnt > 0u ? cnt : 1u;
}

__device__ __forceinline__ void xcd_barrier(const XcdBarrier& b) {
    asm volatile("s_waitcnt vmcnt(0)" ::: "memory");
    __syncthreads();
    if (threadIdx.x == 0) {
        unsigned* bar = b.bar;
        __builtin_amdgcn_s_waitcnt(0);
        unsigned nloc = b.st[0], nx = b.st[1];
        if (nloc == 0u) { xcd_barrier_complete(bar, b.x, nloc, nx); b.st[0] = nloc; b.st[1] = nx; }
        const unsigned old = xb_add(&bar[XB_XSUB(b.x)], 1u);
        const unsigned gen = old / nloc;
        if (old + 1u == (gen + 1u) * nloc) {
            __builtin_amdgcn_fence(__ATOMIC_RELEASE, "agent");
            asm volatile("s_waitcnt vmcnt(0)" ::: "memory");
            const unsigned og = xb_add(&bar[XB_TOP], 1u);
            const unsigned tg = og / nx;
            if (og + 1u == (tg + 1u) * nx) xb_add(&bar[XB_TOPGEN], 1u);
            else XB_SPIN(xb_ld(&bar[XB_TOPGEN]) == tg, bar);
            __builtin_amdgcn_fence(__ATOMIC_ACQUIRE, "agent");
            xb_add(&bar[XB_XGEN(b.x)], 1u);
            asm volatile("s_waitcnt vmcnt(0)" ::: "memory");
        } else {
            XB_SPIN(xb_ld(&bar[XB_XGEN(b.x)]) == gen, bar);
            __builtin_amdgcn_fence(__ATOMIC_ACQUIRE, "agent");
            asm volatile("s_waitcnt vmcnt(0)" ::: "memory");
        }
    }
    __syncthreads();
}

__device__ __forceinline__ void transpose_item(const float* W, int ldw, int col0, int K, int Nn, const float* g, bf16_t* WT, int row_off, LAS float* scr, int item, int lane) {
    const int nblk = Nn / 32, kb = item / nblk, nb = item % nblk, k0 = 64 * kb, n0 = 32 * nb;
    f32x4 v[8]; const int c4 = (lane & 7) * 4;
#pragma unroll
    for (int i = 0; i < 8; ++i) { const int kk = (lane >> 3) + 8 * i; v[i] = *(const f32x4*)(W + (size_t)(k0 + kk) * ldw + col0 + n0 + c4); }
#pragma unroll
    for (int i = 0; i < 8; ++i) { const int kk = (lane >> 3) + 8 * i; f32x4 w = v[i]; if (g) w *= g[k0 + kk];
        scr[kk * 33 + c4 + 0] = w[0]; scr[kk * 33 + c4 + 1] = w[1]; scr[kk * 33 + c4 + 2] = w[2]; scr[kk * 33 + c4 + 3] = w[3]; }
    LDS_FENCE();
    const int c = lane & 7;
#pragma unroll
    for (int j = 0; j < 4; ++j) { const int n = (lane >> 3) + 8 * j; const LAS float* s = scr + (8 * c) * 33 + n;
        u32x4 o; o.x = cvtpk(s[0 * 33], s[1 * 33]); o.y = cvtpk(s[2 * 33], s[3 * 33]); o.z = cvtpk(s[4 * 33], s[5 * 33]); o.w = cvtpk(s[6 * 33], s[7 * 33]);
        *(u32x4*)(WT + (size_t)(row_off + n0 + n) * K + k0 + 8 * c) = o; }
    LDS_FENCE();
}
template <int NR> __device__ __forceinline__ void rms_rows_to_bf16(const float* x, const float* g, bf16_t* o, int lane) {
    const f32x4* gr = (const f32x4*)g + lane;
    f32x4 v[NR][4]; float rs[NR];
#pragma unroll
    for (int i = 0; i < NR; ++i)
#pragma unroll
        for (int j = 0; j < 4; ++j) v[i][j] = ((const f32x4*)(x + (size_t)i * DM) + lane)[64 * j];
#pragma unroll
    for (int i = 0; i < NR; ++i) {
        float s = 0.f;
#pragma unroll
        for (int j = 0; j < 4; ++j) s += (v[i][j][0] * v[i][j][0] + v[i][j][1] * v[i][j][1]) + (v[i][j][2] * v[i][j][2] + v[i][j][3] * v[i][j][3]);
        rs[i] = 1.0f / sqrtf(wave_sum(s) * (1.0f / 1024.0f) + 1e-6f);
    }
#pragma unroll
    for (int j = 0; j < 4; ++j) { const f32x4 gg = gr[64 * j];
#pragma unroll
        for (int i = 0; i < NR; ++i) { u32x2 w; w.x = cvtpk(v[i][j][0] * rs[i] * gg[0], v[i][j][1] * rs[i] * gg[1]); w.y = cvtpk(v[i][j][2] * rs[i] * gg[2], v[i][j][3] * rs[i] * gg[3]); ((u32x2*)(o + (size_t)i * DM) + lane)[64 * j] = w; } }
}
__device__ __forceinline__ void p0_prologue(const Params& p, LAS unsigned char* lds, int G) {
    const int tid = threadIdx.x, lane = tid & 63, wave = __builtin_amdgcn_readfirstlane(tid >> 6);
    unsigned char* ws = p.ws;
    LAS float* scr = (LAS float*)(lds + wave * WAVE_LDS);
    const int gw = blockIdx.x * NWAVES + wave, NGW = G * NWAVES;
    bf16_t* Win_t = (bf16_t*)(ws + WS_WIN);
    constexpr int I_INA = 16 * 32, I_INB = 16 * 64, I_OUT = 16 * 32, I_Q = 16 * 32, I_KV = 16 * 64, I_O = 16 * 32, I_1 = 16 * 128, I_2 = 64 * 32;
    constexpr int NITEMS = I_INA + I_INB + I_OUT + I_Q + I_KV + I_O + I_1 + I_2;
    for (int it = gw; it < NITEMS; it += NGW) {
        int r = it;
        if (r < I_INA) { transpose_item(p.w_in, 3088, 0, 1024, 1024, nullptr, Win_t, 0, scr, r, lane); continue; } r -= I_INA;
        if (r < I_INB) { transpose_item(p.w_in, 3088, 1040, 1024, 2048, nullptr, Win_t, 1024, scr, r, lane); continue; } r -= I_INB;
        if (r < I_OUT) { transpose_item(p.w_out, 1024, 0, 1024, 1024, nullptr, (bf16_t*)(ws + WS_WOUT), 0, scr, r, lane); continue; } r -= I_OUT;
        if (r < I_Q) { transpose_item(p.xa_w_q, 1024, 0, 1024, 1024, p.norm_x_g, (bf16_t*)(ws + WS_WQ), 0, scr, r, lane); continue; } r -= I_Q;
        if (r < I_KV) { transpose_item(p.xa_w_kv, 2048, 0, 1024, 2048, nullptr, (bf16_t*)(ws + WS_WKV), 0, scr, r, lane); continue; } r -= I_KV;
        if (r < I_O) { transpose_item(p.xa_w_o, 1024, 0, 1024, 1024, nullptr, (bf16_t*)(ws + WS_WO), 0, scr, r, lane); continue; } r -= I_O;
        if (r < I_1) { transpose_item(p.ffn_w1, 4096, 0, 1024, 4096, p.norm_ffn_g, (bf16_t*)(ws + WS_W1), 0, scr, r, lane); continue; } r -= I_1;
        transpose_item(p.ffn_w2, 1024, 0, 4096, 1024, nullptr, (bf16_t*)(ws + WS_W2), 0, scr, r, lane);
    }
    const int gt = blockIdx.x * NTHREADS + tid, NGT = G * NTHREADS;
    for (int o = gt; o < 256 * 1024; o += NGT) {
        const int n = o >> 10, k = o & 1023; const float* wr = p.w_in + (size_t)k * 3088 + 1024; float s = 0.f;
#pragma unroll
        for (int r = 0; r < 16; ++r) s += wr[r] * p.gla_w_gate[r * 256 + n];
        Win_t[(size_t)(3072 + n) * 1024 + k] = f2bf(s);
    }
    float* cosT = (float*)(ws + WS_COS); float* sinT = (float*)(ws + WS_SIN);
    for (int o = gt; o < SEQ * 32; o += NGT) {
        const int pos = o >> 5, i = o & 31; double f = 1.0;
        for (int k = 0; k < i; ++k) f *= 0.7498942093324559;
        const double t = (double)pos * f * 0.15915494309189535;
        const float fr = (float)(t - floor(t));
        cosT[o] = __builtin_amdgcn_cosf(fr); sinT[o] = __builtin_amdgcn_sinf(fr);
    }
    bf16_t* XN = (bf16_t*)(ws + WS_A1); bf16_t* MEMN = (bf16_t*)(ws + WS_MEMN);
    for (int m4 = gw; m4 < (NTOK + NMEMROWS) / 4; m4 += NGW) {
        const int m = 4 * m4;
        if (m < NTOK) rms_rows_to_bf16<4>(p.x + (size_t)m * DM, p.norm_mix_g, XN + (size_t)m * DM, lane);
        else rms_rows_to_bf16<4>(p.mem + (size_t)(m - NTOK) * DM, p.norm_mem_g, MEMN + (size_t)(m - NTOK) * DM, lane);
    }
}

__device__ __forceinline__ void gla_gates(const bf16_t* P, int zcol, const float* bg, int r, int q, float (&bc)[4][2][8], float (&bl)[2][8]) {
    bf16x8 zf[4][2];
#pragma unroll
    for (int mt = 0; mt < 4; ++mt)
#pragma unroll
        for (int ks = 0; ks < 2; ++ks) zf[mt][ks] = *(const bf16x8*)(P + (size_t)(16 * mt + r) * NPROJ + zcol + 32 * ks + 8 * q);
    CFENCE();
#pragma unroll
    for (int ks = 0; ks < 2; ++ks) {
        const f32x4 b0 = *(const f32x4*)(bg + 32 * ks + 8 * q), b1 = *(const f32x4*)(bg + 32 * ks + 8 * q + 4);
#pragma unroll
        for (int mt = 0; mt < 4; ++mt) {
            f32x4 z0, z1; unpack8(zf[mt][ks], z0, z1); z0 += b0; z1 += b1;
#pragma unroll
            for (int e = 0; e < 4; ++e) {
                bc[mt][ks][e] = (fminf(z0[e], 0.f) - __logf(1.0f + __expf(-fabsf(z0[e])))) * (1.0f / 16.0f);
                bc[mt][ks][4 + e] = (fminf(z1[e], 0.f) - __logf(1.0f + __expf(-fabsf(z1[e])))) * (1.0f / 16.0f);
            }
        }
#pragma unroll
        for (int e = 0; e < 8; ++e) {
            float carry = 0.f;
#pragma unroll
            for (int mt = 0; mt < 4; ++mt) { const float v = scan16(bc[mt][ks][e], r); const float tot = __shfl(v, 15, 16); bc[mt][ks][e] = v + carry; carry += tot; }
            bl[ks][e] = carry;
        }
    }
}
__device__ __forceinline__ float ret_log2g(int hr) { return hr == 0 ? -0.04580368961312479f : hr == 1 ? -0.008973692110584325f : hr == 2 ? -0.0017761724589428754f : -0.0003522634716290214f; }
__device__ __forceinline__ void rope_tile(bf16x8 f0, bf16x8 f1, const float* cosT, const float* sinT, int pos, int q, f32x4 (&o)[4]) {
    f32x4 a0, a1, b0, b1; unpack8(f0, a0, a1); unpack8(f1, b0, b1);
    const f32x4 c0 = *(const f32x4*)(cosT + pos * 32 + 8 * q), c1 = *(const f32x4*)(cosT + pos * 32 + 8 * q + 4), s0 = *(const f32x4*)(sinT + pos * 32 + 8 * q), s1 = *(const f32x4*)(sinT + pos * 32 + 8 * q + 4);
    o[0] = a0 * c0 - b0 * s0; o[1] = a1 * c1 - b1 * s1; o[2] = a0 * s0 + b0 * c0; o[3] = a1 * s1 + b1 * c1;
}

__device__ __forceinline__ void chunk_contrib(const Params& p, LAS unsigned char* lds, int G) {
    const int tid = threadIdx.x, lane = tid & 63, wave = __builtin_amdgcn_readfirstlane(tid >> 6);
    unsigned char* ws = p.ws;
    const bf16_t* PROJ = (const bf16_t*)(ws + WS_BIG); bf16_t* CT = (bf16_t*)(ws + WS_A2); float* DEC = (float*)(ws + WS_DEC);
    const float* cosT = (const float*)(ws + WS_COS); const float* sinT = (const float*)(ws + WS_SIN);
    LAS bf16_t* Kdt = (LAS bf16_t*)(lds + wave * WAVE_LDS); LAS bf16_t* Vt = Kdt + 64 * VPITCH;
    for (int u = blockIdx.x * NWAVES + wave; u < NBATCH * NCHUNK * 8; u += G * NWAVES) {
        int h8 = u & 7; asm volatile("" : "+s"(h8));
        const int bn = u >> 3, b = bn >> 7, n = bn & 127;
        const size_t tok0 = (size_t)b * SEQ + (size_t)n * 64;
        const bf16_t* P = PROJ + tok0 * NPROJ;
        const int unit = (b * 8 + h8) * NCHUNK + n;
        int ln = lane; asm volatile("" : "+v"(ln));
        const int r = ln & 15, q = ln >> 4;
        const int vcol = (h8 < 4) ? C_GV + h8 * 128 : C_RV + (h8 - 4) * 128;
        const int kcol = (h8 < 4) ? C_GK + h8 * 64 : C_RK + (h8 - 4) * 64;
        bf16x8 kf[4][2];
#pragma unroll
        for (int mt = 0; mt < 4; ++mt)
#pragma unroll
            for (int ks = 0; ks < 2; ++ks) kf[mt][ks] = *(const bf16x8*)(P + (size_t)(16 * mt + r) * NPROJ + kcol + 32 * ks + 8 * q);
        LDS_FENCE();
        if (h8 < 4) {
            const int h = h8;
            float bc[4][2][8], bl[2][8];
            gla_gates(P, C_Z + h * 64, p.gla_b_gate + h * 64, r, q, bc, bl);
            if (r == 0) {
#pragma unroll
                for (int ks = 0; ks < 2; ++ks) {
                    f32x4 d0, d1;
#pragma unroll
                    for (int e = 0; e < 4; ++e) { d0[e] = __expf(bl[ks][e]); d1[e] = __expf(bl[ks][4 + e]); }
                    *(f32x4*)(DEC + (size_t)unit * 64 + 32 * ks + 8 * q) = d0; *(f32x4*)(DEC + (size_t)unit * 64 + 32 * ks + 8 * q + 4) = d1;
                }
            }
#pragma unroll
            for (int mt = 0; mt < 4; ++mt)
#pragma unroll
                for (int ks = 0; ks < 2; ++ks) {
                    f32x4 k0, k1; unpack8(kf[mt][ks], k0, k1);
#pragma unroll
                    for (int e = 0; e < 4; ++e) {
                        Kdt[(32 * ks + 8 * q + e) * VPITCH + 16 * mt + r] = f2bf(k0[e] * __expf(bl[ks][e] - bc[mt][ks][e]));
                        Kdt[(32 * ks + 8 * q + 4 + e) * VPITCH + 16 * mt + r] = f2bf(k1[e] * __expf(bl[ks][4 + e] - bc[mt][ks][4 + e]));
                    }
                }
        } else {
            const int hr = h8 - 4; const float l2g = ret_log2g(hr);
            if (r == 0) {
                const float d = exp2f(64.0f * l2g); const f32x4 dv = {d, d, d, d};
#pragma unroll
                for (int ks = 0; ks < 2; ++ks) { *(f32x4*)(DEC + (size_t)unit * 64 + 32 * ks + 8 * q) = dv; *(f32x4*)(DEC + (size_t)unit * 64 + 32 * ks + 8 * q + 4) = dv; }
            }
#pragma unroll
            for (int mt = 0; mt < 4; ++mt) {
                CFENCE();
                f32x4 o[4]; rope_tile(kf[mt][0], kf[mt][1], cosT, sinT, n * 64 + 16 * mt + r, q, o);
                const float sc = 0.125f * exp2f((float)(63 - (16 * mt + r)) * l2g);
#pragma unroll
                for (int e = 0; e < 4; ++e) {
                    Kdt[(8 * q + e) * VPITCH + 16 * mt + r] = f2bf(o[0][e] * sc); Kdt[(8 * q + 4 + e) * VPITCH + 16 * mt + r] = f2bf(o[1][e] * sc);
                    Kdt[(32 + 8 * q + e) * VPITCH + 16 * mt + r] = f2bf(o[2][e] * sc); Kdt[(32 + 8 * q + 4 + e) * VPITCH + 16 * mt + r] = f2bf(o[3][e] * sc);
                }
            }
        }
        bf16_t* outp = CT + (size_t)unit * 8192;
#pragma unroll 1
        for (int vh = 0; vh < 2; ++vh) {
            CFENCE();
            bf16x8 xv[8];
#pragma unroll
            for (int i = 0; i < 8; ++i) xv[i] = *(const bf16x8*)(P + (size_t)(i * 8 + (ln >> 3)) * NPROJ + vcol + vh * 64 + (ln & 7) * 8);
            LDS_FENCE();
#pragma unroll
            for (int i = 0; i < 8; ++i) {
                const int token = i * 8 + (ln >> 3), vv = (ln & 7) * 8;
#pragma unroll
                for (int e = 0; e < 8; ++e) Vt[(vv + e) * VPITCH + token] = (bf16_t)xv[i][e];
            }
            LDS_FENCE();
#pragma unroll
            for (int vt = 0; vt < 4; ++vt) {
                CFENCE();
                bf16x8 a[2];
#pragma unroll
                for (int s = 0; s < 2; ++s) a[s] = *(const LAS bf16x8*)(Vt + (16 * vt + r) * VPITCH + 32 * s + 8 * q);
#pragma unroll
                for (int dt = 0; dt < 4; ++dt) {
                    f32x4 acc = {0.f, 0.f, 0.f, 0.f};
#pragma unroll
                    for (int s = 0; s < 2; ++s) { const bf16x8 bb = *(const LAS bf16x8*)(Kdt + (16 * dt + r) * VPITCH + 32 * s + 8 * q); acc = MFMA16(a[s], bb, acc); }
#pragma unroll
                    for (int e = 0; e < 4; ++e) outp[(vh * 64 + 16 * vt + 4 * q + e) * 64 + 16 * dt + r] = f2bf(acc[e]);
                }
            }
        }
    }
}

__device__ __forceinline__ void chunk_scan(const Params& p, int G) {
    unsigned char* ws = p.ws; bf16_t* CT = (bf16_t*)(ws + WS_A2); const float* DEC = (const float*)(ws + WS_DEC);
    const int NGT = G * NTHREADS;
    for (int o = blockIdx.x * NTHREADS + threadIdx.x; o < 32 * 128 * 16; o += NGT) {
        const int d4 = o & 15, v = (o >> 4) & 127, bh = o >> 11;
        bf16_t* base = CT + (size_t)bh * NCHUNK * 8192 + v * 64 + d4 * 4; const float* dbase = DEC + (size_t)bh * NCHUNK * 64 + d4 * 4;
        f32x4 s = {0.f, 0.f, 0.f, 0.f};
#pragma unroll 1
        for (int n0 = 0; n0 < NCHUNK; n0 += 16) {
            u32x2 uu[16]; f32x4 dd[16];
#pragma unroll
            for (int j = 0; j < 16; ++j) { uu[j] = *(const u32x2*)(base + (size_t)(n0 + j) * 8192); dd[j] = *(const f32x4*)(dbase + (size_t)(n0 + j) * 64); }
#pragma unroll
            for (int j = 0; j < 16; ++j) {
                u32x2 w; w.x = cvtpk(s[0], s[1]); w.y = cvtpk(s[2], s[3]);
                *(u32x2*)(base + (size_t)(n0 + j) * 8192) = w;
                f32x4 c; c[0] = __uint_as_float(uu[j].x << 16); c[1] = __uint_as_float(uu[j].x & 0xffff0000u); c[2] = __uint_as_float(uu[j].y << 16); c[3] = __uint_as_float(uu[j].y & 0xffff0000u);
                s = dd[j] * s + c;
            }
        }
    }
}

template <bool GN> __device__ __forceinline__ void norm_gate_store(const f32x4 (&O)[8], const bf16x8 (&gt)[4], const float (&gn)[8], int it, int r, int q, bf16_t* y) {
    f32x4 mean = {0.f, 0.f, 0.f, 0.f};
    if (GN) {
        f32x4 s = {0.f, 0.f, 0.f, 0.f};
#pragma unroll
        for (int vt = 0; vt < 8; ++vt) s += O[vt];
#pragma unroll
        for (int e = 0; e < 4; ++e) { float t = s[e]; t += __shfl_xor(t, 1); t += __shfl_xor(t, 2); t += __shfl_xor(t, 4); t += __shfl_xor(t, 8); mean[e] = t * (1.0f / 128.0f); }
    }
    f32x4 ss = {0.f, 0.f, 0.f, 0.f};
#pragma unroll
    for (int vt = 0; vt < 8; ++vt) { const f32x4 d = O[vt] - mean; ss += d * d; }
    f32x4 rstd;
#pragma unroll
    for (int e = 0; e < 4; ++e) { float t = ss[e]; t += __shfl_xor(t, 1); t += __shfl_xor(t, 2); t += __shfl_xor(t, 4); t += __shfl_xor(t, 8); rstd[e] = __builtin_amdgcn_rsqf(t * (1.0f / 128.0f) + 1e-6f); }
#pragma unroll
    for (int e = 0; e < 4; ++e) {
        const int i = 16 * it + 4 * q + e;
        f32x4 g0, g1; unpack8(gt[e], g0, g1);
        f32x4 o0, o1;
#pragma unroll
        for (int vt = 0; vt < 4; ++vt) {
            const float ga = g0[vt], gb = g1[vt];
            o0[vt] = (O[vt][e] - mean[e]) * rstd[e] * gn[vt] * (ga * __builtin_amdgcn_rcpf(1.0f + __expf(-ga)));
            o1[vt] = (O[4 + vt][e] - mean[e]) * rstd[e] * gn[4 + vt] * (gb * __builtin_amdgcn_rcpf(1.0f + __expf(-gb)));
        }
        *(bf16x8*)(y + (size_t)i * DM + 8 * r) = pack8(o0, o1);
    }
}
__device__ __forceinline__ void out_tile(f32x4 (&O)[8], const bf16x8 (&pf)[2], const bf16x8 (&qi)[2], const LAS bf16_t* Vt, const bf16x8 (&spf)[8][2], int r, int q) {
#pragma unroll
    for (int vt = 0; vt < 8; ++vt) {
        f32x4 acc = {0.f, 0.f, 0.f, 0.f};
#pragma unroll
        for (int s = 0; s < 2; ++s) {
            const u32x2 lo = *(const LAS u32x2*)(Vt + (16 * vt + r) * VPITCH + 32 * s + 4 * q), hi = *(const LAS u32x2*)(Vt + (16 * vt + r) * VPITCH + 32 * s + 16 + 4 * q);
            const u32x4 w = {lo.x, lo.y, hi.x, hi.y};
            acc = MFMA16(pf[s], __builtin_bit_cast(bf16x8, w), acc);
        }
#pragma unroll
        for (int ks = 0; ks < 2; ++ks) acc = MFMA16(qi[ks], spf[vt][ks], acc);
        O[vt] = acc;
    }
}
template <bool GN> __device__ __forceinline__ void out_all(const bf16x8 (&pfa)[4][2], const bf16x8 (&QI)[4][2], const LAS bf16_t* Vt, const bf16_t* SP, const float* gain, const bf16_t* gate, bf16_t* y, int r, int q) {
    bf16x8 spf[8][2]; float gn[8];
    { const f32x4 ga = *(const f32x4*)(gain + 8 * r), gb = *(const f32x4*)(gain + 8 * r + 4);
#pragma unroll
      for (int vt = 0; vt < 4; ++vt) { gn[vt] = ga[vt]; gn[4 + vt] = gb[vt]; } }
#pragma unroll
    for (int vt = 0; vt < 8; ++vt)
#pragma unroll
        for (int ks = 0; ks < 2; ++ks) spf[vt][ks] = *(const bf16x8*)(SP + (8 * r + vt) * 64 + 32 * ks + 8 * q);
#pragma unroll
    for (int it = 0; it < 4; ++it) {
        CFENCE();
        bf16x8 gt[4];
#pragma unroll
        for (int e = 0; e < 4; ++e) gt[e] = *(const bf16x8*)(gate + (size_t)(16 * it + 4 * q + e) * NPROJ + 8 * r);
        CFENCE();
        f32x4 O[8];
        out_tile(O, pfa[it], QI[it], Vt, spf, r, q);
        CFENCE();
        norm_gate_store<GN>(O, gt, gn, it, r, q, y);
    }
}

__device__ __forceinline__ void chunk_output(const Params& p, LAS unsigned char* lds, int G) {
    const int tid = threadIdx.x, lane = tid & 63, wave = __builtin_amdgcn_readfirstlane(tid >> 6);
    unsigned char* ws = p.ws;
    const bf16_t* PROJ = (const bf16_t*)(ws + WS_BIG); const bf16_t* SPB = (const bf16_t*)(ws + WS_A2); bf16_t* Y = (bf16_t*)(ws + WS_A1);
    const float* cosT = (const float*)(ws + WS_COS); const float* sinT = (const float*)(ws + WS_SIN);
    LAS bf16_t* Vt = (LAS bf16_t*)(lds + wave * WAVE_LDS);
    for (int u = blockIdx.x * NWAVES + wave; u < NBATCH * NCHUNK * 8; u += G * NWAVES) {
        int h8 = u & 7; asm volatile("" : "+s"(h8));
        const int bn = u >> 3, b = bn >> 7, n = bn & 127;
        const size_t tok0 = (size_t)b * SEQ + (size_t)n * 64;
        const bf16_t* P = PROJ + tok0 * NPROJ;
        const int unit = (b * 8 + h8) * NCHUNK + n;
        const bf16_t* SP = SPB + (size_t)unit * 8192;
        int ln = lane; asm volatile("" : "+v"(ln));
        const int r = ln & 15, q = ln >> 4;
        const int vcol = (h8 < 4) ? C_GV + h8 * 128 : C_RV + (h8 - 4) * 128;
        LDS_FENCE();
        {
            bf16x8 xv[16];
#pragma unroll
            for (int i = 0; i < 16; ++i) xv[i] = *(const bf16x8*)(P + (size_t)(i * 4 + q) * NPROJ + vcol + r * 8);
            CFENCE();
#pragma unroll
            for (int i = 0; i < 16; ++i) {
                const int token = i * 4 + q;
#pragma unroll
                for (int e = 0; e < 8; ++e) Vt[(16 * e + r) * VPITCH + token] = (bf16_t)xv[i][e];
            }
        }
        LDS_FENCE();
        CFENCE();
#ifdef NO_GLA4
        if (false) {
#else
        if (h8 < 4) {
#endif
            const int h = h8;
            bf16x8 Qe[4][2], Qi[4][2], Ki[4][2], Ke[4][2], pfa[4][2];
            {
                bf16x8 qf[4][2], kf[4][2];
#pragma unroll
                for (int mt = 0; mt < 4; ++mt)
#pragma unroll
                    for (int ks = 0; ks < 2; ++ks) {
                        qf[mt][ks] = *(const bf16x8*)(P + (size_t)(16 * mt + r) * NPROJ + C_GQ + h * 64 + 32 * ks + 8 * q);
                        kf[mt][ks] = *(const bf16x8*)(P + (size_t)(16 * mt + r) * NPROJ + C_GK + h * 64 + 32 * ks + 8 * q);
                    }
                float bc[4][2][8], bl[2][8];
                gla_gates(P, C_Z + h * 64, p.gla_b_gate + h * 64, r, q, bc, bl);
#pragma unroll
                for (int mt = 0; mt < 4; ++mt)
#pragma unroll
                    for (int ks = 0; ks < 2; ++ks) {
                        CFENCE();
                        f32x4 q0, q1, k0, k1; unpack8(qf[mt][ks], q0, q1); unpack8(kf[mt][ks], k0, k1);
                        f32x4 e0, e1, i0, i1;
#pragma unroll
                        for (int e = 0; e < 4; ++e) { e0[e] = __expf(bc[mt][ks][e]); e1[e] = __expf(bc[mt][ks][4 + e]); i0[e] = __expf(-bc[mt][ks][e]); i1[e] = __expf(-bc[mt][ks][4 + e]); }
                        Qe[mt][ks] = pack8(q0 * e0 * 0.125f, q1 * e1 * 0.125f); Qi[mt][ks] = pack8(q0 * i0 * 0.125f, q1 * i1 * 0.125f);
                        Ki[mt][ks] = pack8(k0 * i0, k1 * i1); Ke[mt][ks] = pack8(k0 * e0, k1 * e1);
                    }
            }
#pragma unroll
            for (int it = 0; it < 4; ++it) {
                f32x4 Pt[4];
#pragma unroll
                for (int jt = 0; jt < 4; ++jt) {
                    f32x4 lo = {0.f, 0.f, 0.f, 0.f}, up = {0.f, 0.f, 0.f, 0.f};
                    if (jt <= it) { lo = MFMA16(Ki[jt][0], Qe[it][0], lo); lo = MFMA16(Ki[jt][1], Qe[it][1], lo); }
                    if (jt >= it) { up = MFMA16(Ke[jt][0], Qi[it][0], up); up = MFMA16(Ke[jt][1], Qi[it][1], up); }
                    if (jt < it) Pt[jt] = lo; else if (jt > it) Pt[jt] = up;
                    else {
#pragma unroll
                        for (int e = 0; e < 4; ++e) Pt[jt][e] = (4 * q + e <= r) ? lo[e] : up[e];
                    }
                }
                pfa[it][0] = pack8(Pt[0], Pt[1]); pfa[it][1] = pack8(Pt[2], Pt[3]);
                CFENCE();
            }
            out_all<false>(pfa, Qe, Vt, SP, p.gla_norm_g + h * 128, P + C_GG + h * 128, Y + tok0 * DM + h * 128, r, q);
        }
#ifdef NO_RET4
        else if (false) {
#else
        else {
#endif
            const int hr = h8 - 4; const float l2g = ret_log2g(hr);
            bf16x8 Qr[4][2], Qd[4][2], Kr[4][2], pfa[4][2];
            {
                bf16x8 qf[4][2], kf[4][2];
#pragma unroll
                for (int mt = 0; mt < 4; ++mt)
#pragma unroll
                    for (int ks = 0; ks < 2; ++ks) {
                        qf[mt][ks] = *(const bf16x8*)(P + (size_t)(16 * mt + r) * NPROJ + C_RQ + hr * 64 + 32 * ks + 8 * q);
                        kf[mt][ks] = *(const bf16x8*)(P + (size_t)(16 * mt + r) * NPROJ + C_RK + hr * 64 + 32 * ks + 8 * q);
                    }
#pragma unroll
                for (int mt = 0; mt < 4; ++mt) {
                    const int pos = n * 64 + 16 * mt + r;
                    CFENCE();
                    {
                        f32x4 o[4]; rope_tile(qf[mt][0], qf[mt][1], cosT, sinT, pos, q, o);
                        Qr[mt][0] = pack8(o[0], o[1]); Qr[mt][1] = pack8(o[2], o[3]);
                        const float qd = exp2f((float)(16 * mt + r + 1) * l2g);
                        Qd[mt][0] = pack8(o[0] * qd, o[1] * qd); Qd[mt][1] = pack8(o[2] * qd, o[3] * qd);
                    }
                    CFENCE();
                    {
                        f32x4 o[4]; rope_tile(kf[mt][0], kf[mt][1], cosT, sinT, pos, q, o);
                        Kr[mt][0] = pack8(o[0] * 0.125f, o[1] * 0.125f); Kr[mt][1] = pack8(o[2] * 0.125f, o[3] * 0.125f);
                    }
                }
            }
#pragma unroll
            for (int it = 0; it < 4; ++it) {
                f32x4 Pt[4];
#pragma unroll
                for (int jt = 0; jt < 4; ++jt) {
                    f32x4 st = {0.f, 0.f, 0.f, 0.f};
                    st = MFMA16(Kr[jt][0], Qr[it][0], st); st = MFMA16(Kr[jt][1], Qr[it][1], st);
#pragma unroll
                    for (int e = 0; e < 4; ++e) { const int dj = (16 * it + r) - (16 * jt + 4 * q + e); Pt[jt][e] = st[e] * exp2f((float)(dj < 0 ? -dj : dj) * l2g); }
                }
                pfa[it][0] = pack8(Pt[0], Pt[1]); pfa[it][1] = pack8(Pt[2], Pt[3]);
                CFENCE();
            }
            out_all<true>(pfa, Qd, Vt, SP, p.ret_norm_g + hr * 128, P + C_RG + hr * 128, Y + tok0 * DM + 512 + hr * 128, r, q);
        }
    }
}

__device__ __forceinline__ void stage_image(LAS unsigned char* lds, const bf16_t* src, int tid) {
#pragma unroll
    for (int i = 0; i < 16; ++i) { const int row = (tid >> 5) + 16 * i, c = tid & 31; const u32x4 x = *(const u32x4*)(src + (size_t)row * 256 + c * 8);
        *(LAS u32x4*)(lds + (16 * (tid >> 5) + i) * APITCH + c * 16) = x; }
}
__device__ __forceinline__ void cross_attention(const Params& p, LAS unsigned char* lds, int G) {
    const int tid = threadIdx.x, lane = tid & 63, wave = __builtin_amdgcn_readfirstlane(tid >> 6);
    unsigned char* ws = p.ws;
    const bf16_t* Q = (const bf16_t*)(ws + WS_A1); const bf16_t* Kb = (const bf16_t*)(ws + WS_KB); const bf16_t* Vtg = (const bf16_t*)(ws + WS_VT); bf16_t* OA = (bf16_t*)(ws + WS_BIG);
    for (int u = blockIdx.x; u < 512; u += G) {
        const int bh = u >> 5, b = bh >> 2, h = bh & 3, qb = u & 31;
        int ln = lane; asm volatile("" : "+v"(ln));
        const int r = ln & 15, q = ln >> 4;
        const size_t i0 = (size_t)b * SEQ + qb * 256 + wave * 32;
        __syncthreads();
        {
#pragma unroll
            for (int i = 0; i < 16; ++i) { const int row = (tid >> 5) + 16 * i, c = tid & 31; const u32x4 x = *(const u32x4*)(Kb + (size_t)(b * 256 + row) * 1024 + h * 256 + c * 8); *(LAS u32x4*)(lds + row * APITCH + c * 16) = x; }
        }
        bf16x8 Qf[2][8];
#pragma unroll
        for (int it = 0; it < 2; ++it)
#pragma unroll
            for (int ks = 0; ks < 8; ++ks) Qf[it][ks] = *(const bf16x8*)(Q + (i0 + 16 * it + r) * DM + h * 256 + 32 * ks + 8 * q);
        __syncthreads();
        bf16x8 pf[2][8];
        {
            f32x4 S[2][16];
#pragma unroll
            for (int mt = 0; mt < 16; ++mt) {
                f32x4 a0 = {0.f, 0.f, 0.f, 0.f}, a1 = {0.f, 0.f, 0.f, 0.f};
                CFENCE();
#pragma unroll
                for (int ks = 0; ks < 8; ++ks) { const bf16x8 a = *(const LAS bf16x8*)(lds + (16 * mt + r) * APITCH + (32 * ks + 8 * q) * 2); a0 = MFMA16(a, Qf[0][ks], a0); a1 = MFMA16(a, Qf[1][ks], a1); }
                S[0][mt] = a0; S[1][mt] = a1;
            }
#pragma unroll
            for (int it = 0; it < 2; ++it) {
                CFENCE();
                float mx = -3.0e38f;
#pragma unroll
                for (int mt = 0; mt < 16; ++mt) mx = fmaxf(fmaxf(fmaxf(S[it][mt][0], S[it][mt][1]), fmaxf(S[it][mt][2], S[it][mt][3])), mx);
                mx = fmaxf(mx, __shfl_xor(mx, 16)); mx = fmaxf(mx, __shfl_xor(mx, 32));
                CFENCE();
                float sum = 0.f;
#pragma unroll
                for (int mt = 0; mt < 16; ++mt) {
#pragma unroll
                    for (int e = 0; e < 4; ++e) { S[it][mt][e] = __builtin_amdgcn_exp2f(S[it][mt][e] - mx); sum += S[it][mt][e]; }
                }
                sum += __shfl_xor(sum, 16); sum += __shfl_xor(sum, 32);
                const float inv = 1.0f / sum;
                CFENCE();
#pragma unroll
                for (int s = 0; s < 8; ++s) { pf[it][s] = pack8(S[it][2 * s] * inv, S[it][2 * s + 1] * inv); CFENCE(); }
            }
        }
        __syncthreads();
        stage_image(lds, Vtg + (size_t)(b * 1024 + h * 256) * 256, tid);
        __syncthreads();
        unsigned ob[2][4][8];
#pragma unroll
        for (int np = 0; np < 8; ++np) {
            f32x4 a0[2], a1[2];
#pragma unroll
            for (int h2 = 0; h2 < 2; ++h2) {
                const int nt = 2 * np + h2;
                f32x4 c0 = {0.f, 0.f, 0.f, 0.f}, c1 = {0.f, 0.f, 0.f, 0.f};
                CFENCE();
#pragma unroll
                for (int s = 0; s < 8; ++s) {
                    const u32x2 lo = *(const LAS u32x2*)(lds + (16 * nt + r) * APITCH + (32 * s + 4 * q) * 2), hi = *(const LAS u32x2*)(lds + (16 * nt + r) * APITCH + (32 * s + 16 + 4 * q) * 2);
                    const u32x4 w = {lo.x, lo.y, hi.x, hi.y};
                    c0 = MFMA16(pf[0][s], __builtin_bit_cast(bf16x8, w), c0); c1 = MFMA16(pf[1][s], __builtin_bit_cast(bf16x8, w), c1);
                }
                a0[h2] = c0; a1[h2] = c1;
            }
#pragma unroll
            for (int e = 0; e < 4; ++e) { ob[0][e][np] = cvtpk(a0[0][e], a0[1][e]); ob[1][e][np] = cvtpk(a1[0][e], a1[1][e]); }
        }
#pragma unroll
        for (int it = 0; it < 2; ++it)
#pragma unroll
            for (int e = 0; e < 4; ++e) {
                bf16_t* o = OA + (i0 + 16 * it + 4 * q + e) * DM + h * 256 + 16 * r;
                const u32x4 w0 = {ob[it][e][0], ob[it][e][1], ob[it][e][2], ob[it][e][3]}, w1 = {ob[it][e][4], ob[it][e][5], ob[it][e][6], ob[it][e][7]};
                *(u32x4*)o = w0; *(u32x4*)(o + 8) = w1;
            }
    }
}

__device__ __forceinline__ void final_norm(const Params& p, int G) {
    const int lane = threadIdx.x & 63, wave = __builtin_amdgcn_readfirstlane(threadIdx.x >> 6);
    const bf16_t* H = (const bf16_t*)(p.ws + WS_A2); const float* SSQ = (const float*)(p.ws + WS_SSQ3);
    const f32x4 g0 = *(const f32x4*)(p.final_norm_g + lane * 8), g1 = *(const f32x4*)(p.final_norm_g + lane * 8 + 4), g2 = *(const f32x4*)(p.final_norm_g + 512 + lane * 8), g3 = *(const f32x4*)(p.final_norm_g + 512 + lane * 8 + 4);
    for (int m4 = blockIdx.x * NWAVES + wave; m4 < NTOK / 4; m4 += G * NWAVES) {
        bf16x8 h0[4], h1[4]; f32x4 sp[4];
#pragma unroll
        for (int j = 0; j < 4; ++j) {
            const size_t m = (size_t)m4 * 4 + j;
            h0[j] = *(const bf16x8*)(H + m * DM + lane * 8); h1[j] = *(const bf16x8*)(H + m * DM + 512 + lane * 8);
            sp[j] = *(const f32x4*)(SSQ + m * 16 + 4 * (lane & 3));
        }
#pragma unroll
        for (int j = 0; j < 4; ++j) {
            const size_t m = (size_t)m4 * 4 + j;
            float t = (sp[j][0] + sp[j][1]) + (sp[j][2] + sp[j][3]);
            t += __shfl_xor(t, 1); t += __shfl_xor(t, 2);
            const float rstd = 1.0f / sqrtf(t * (1.0f / 1024.0f) + 1e-6f);
            f32x4 a0, a1, b0, b1; unpack8(h0[j], a0, a1); unpack8(h1[j], b0, b1);
            float* o = p.out + m * DM + lane * 8;
            *(f32x4*)(o) = a0 * rstd * g0; *(f32x4*)(o + 4) = a1 * rstd * g1; *(f32x4*)(o + 512) = b0 * rstd * g2; *(f32x4*)(o + 516) = b1 * rstd * g3;
        }
    }
}

constexpr int NPHASE = 12;
__global__ void __launch_bounds__(NTHREADS, 2) fwd_megakernel(Params p) {
    extern __shared__ __attribute__((aligned(16))) unsigned char lds_raw[];
    LAS unsigned char* lds = (LAS unsigned char*)lds_raw;
    cg::grid_group grid = cg::this_grid();
    const int G = gridDim.x, lo = p.ph_lo, hi = p.ph_hi;
    unsigned char* ws = p.ws;
#define IN(k) (lo <= (k) && (k) < hi)
#ifndef DBG_REP
#define DBG_REP (-1)
#endif
#define REPS(k) ((DBG_REP) == (k) ? 2 : 1)
#define SEAM(k) do { if (IN(k) && IN((k) + 1)) { if ((k) == 0) { asm volatile("s_waitcnt vmcnt(0) lgkmcnt(0)" ::: "memory"); grid.sync(); __builtin_amdgcn_fence(__ATOMIC_ACQUIRE, "agent"); asm volatile("s_waitcnt vmcnt(0)" ::: "memory"); } \
    else xcd_barrier(bar); } } while (0)
    LAS unsigned* misc = (LAS unsigned*)(lds + MISC_OFF);
    if (threadIdx.x < 16) misc[threadIdx.x] = 0u;
    __syncthreads();
    XcdBarrier bar; bar.bar = (unsigned*)(ws + WS_CTL); bar.x = 0; bar.st = nullptr;
    if (hi - lo > 1) bar = xcd_barrier_post((unsigned*)(ws + WS_CTL), (volatile LAS unsigned*)misc);
#ifndef NO_P0
    if (IN(0)) { p0_prologue(p, lds, G); }
#endif
#if defined(DBG_REP) && DBG_REP == 0
    __syncthreads(); if (IN(0)) { p0_prologue(p, lds, G); }
#endif
    SEAM(0);
    if (IN(1)) {
        {
            pg8::Gemm g{(const bf16_t*)(ws + WS_A1), (const bf16_t*)(ws + WS_WIN), NTOK, NPROJ, DM}; pg8::StaticOrder S; S.init(NTOK, NPROJ, G, (int)blockIdx.x);
            pg8::EpiBf16<0> E{(bf16_t*)(ws + WS_BIG), NPROJ, nullptr, 0, 0, 1.f};
            pg8::gemm_phase<pg8::EpiBf16<0>, pg8::StaticOrder, true, true>(lds, g, S, E);
        }
        __syncthreads();
        {
            pg8::Gemm g{(const bf16_t*)(ws + WS_MEMN), (const bf16_t*)(ws + WS_WKV), NMEMROWS, 2048, DM}; pg8::StaticOrder S; S.init(NMEMROWS, 2048, G, (int)((blockIdx.x + G / 2) % G));
            pg8::EpiKV E{(bf16_t*)(ws + WS_KB), (bf16_t*)(ws + WS_VT)};
            pg8::gemm_phase<pg8::EpiKV, pg8::StaticOrder, true, true>(lds, g, S, E);
        }
        __syncthreads();
    } SEAM(1);
    #ifndef NO_P2
    if (IN(2)) { chunk_contrib(p, lds, G); }
#endif
#if defined(DBG_REP) && DBG_REP == 2
    __syncthreads(); if (IN(2)) { chunk_contrib(p, lds, G); }
#endif
    SEAM(2);
    if (IN(3)) { chunk_scan(p, G); } SEAM(3);
    #ifndef NO_P4
    if (IN(4)) { chunk_output(p, lds, G); }
#endif
#if defined(DBG_REP) && DBG_REP == 4
    __syncthreads(); if (IN(4)) { chunk_output(p, lds, G); }
#endif
    SEAM(4);
    if (IN(5)) {
        pg8::Gemm g{(const bf16_t*)(ws + WS_A1), (const bf16_t*)(ws + WS_WOUT), NTOK, DM, DM}; pg8::StaticOrder S; S.init(NTOK, DM, G, (int)blockIdx.x);
        pg8::EpiRes<false> E{p.x, (bf16_t*)(ws + WS_A2), (float*)(ws + WS_SSQ1)};
        pg8::gemm_phase<pg8::EpiRes<false>, pg8::StaticOrder, true, true>(lds, g, S, E);
        __syncthreads();
    } SEAM(5);
#ifdef DBG_XBAR
    if (IN(5) && IN(6)) { for (int i_ = 0; i_ < 10; ++i_) xcd_barrier(bar); }
#endif
    if (IN(6)) {
        pg8::Gemm g{(const bf16_t*)(ws + WS_A2), (const bf16_t*)(ws + WS_WQ), NTOK, DM, DM}; pg8::StaticOrder S; S.init(NTOK, DM, G, (int)blockIdx.x);
        pg8::EpiScale<0> E{(bf16_t*)(ws + WS_A1), DM, (const float*)(ws + WS_SSQ1), 0.0625f * 1.4426950408889634f};
        pg8::gemm_phase<pg8::EpiScale<0>, pg8::StaticOrder, true, true>(lds, g, S, E);
        __syncthreads();
    } SEAM(6);
#ifndef NO_P7
    if (IN(7)) { cross_attention(p, lds, G); __syncthreads(); }
#endif
#if defined(DBG_REP) && DBG_REP == 7
    if (IN(7)) { cross_attention(p, lds, G); __syncthreads(); }
#endif
    SEAM(7);
    if (IN(8)) {
        pg8::Gemm g{(const bf16_t*)(ws + WS_BIG), (const bf16_t*)(ws + WS_WO), NTOK, DM, DM}; pg8::StaticOrder S; S.init(NTOK, DM, G, (int)blockIdx.x);
        pg8::EpiRes<true> E{(const void*)(ws + WS_A2), (bf16_t*)(ws + WS_A1), (float*)(ws + WS_SSQ2)};
        pg8::gemm_phase<pg8::EpiRes<true>, pg8::StaticOrder, true, true>(lds, g, S, E);
        __syncthreads();
    } SEAM(8);
    if (IN(9)) {
        pg8::Gemm g{(const bf16_t*)(ws + WS_A1), (const bf16_t*)(ws + WS_W1), NTOK, DFF, DM}; pg8::StaticOrder S; S.init(NTOK, DFF, G, (int)blockIdx.x);
        pg8::EpiScale<1> E{(bf16_t*)(ws + WS_BIG), DFF, (const float*)(ws + WS_SSQ2), 1.0f};
        pg8::gemm_phase<pg8::EpiScale<1>, pg8::StaticOrder, true, true>(lds, g, S, E);
        __syncthreads();
    } SEAM(9);
    if (IN(10)) {
        pg8::Gemm g{(const bf16_t*)(ws + WS_BIG), (const bf16_t*)(ws + WS_W2), NTOK, DM, DFF}; pg8::StaticOrder S; S.init(NTOK, DM, G, (int)blockIdx.x);
        pg8::EpiRes<true> E{(const void*)(ws + WS_A1), (bf16_t*)(ws + WS_A2), (float*)(ws + WS_SSQ3)};
        pg8::gemm_phase<pg8::EpiRes<true>, pg8::StaticOrder, true, true>(lds, g, S, E);
        __syncthreads();
    } SEAM(10);
    if (IN(11)) { final_norm(p, G); }
#undef IN
#undef SEAM
}

#ifndef MK_PER_PHASE
#define MK_PER_PHASE 0
#endif
#ifdef DBG_DUMP_OFF
__global__ void dump_kernel(const bf16_t* src, size_t n, float* out) {
    for (size_t i = (size_t)blockIdx.x * blockDim.x + threadIdx.x; i < (size_t)NTOK * DM; i += (size_t)gridDim.x * blockDim.x) {
        float s = 0.f; for (size_t j = i; j < n; j += (size_t)NTOK * DM) s += bf2f(src[j]); out[i] = s; }
}
#endif
extern "C" void kernel_launch(void* const* d_in, const int* in_sizes, int n_in, void* d_out, int out_size, void* d_ws, size_t ws_size, hipStream_t stream) {
    static int grid = 0;
    if (grid == 0) {
        if (n_in != 18 || ws_size < WS_NEED) { fprintf(stderr, "kernel_launch: expected 18 inputs and >= %zu bytes of workspace (got %d, %zu)\n", (size_t)WS_NEED, n_in, ws_size); grid = -1; return; }
        int dev = 0, cus = 0, per_cu = 0;
        (void)hipGetDevice(&dev); (void)hipDeviceGetAttribute(&cus, hipDeviceAttributeMultiprocessorCount, dev);
        if (hipFuncSetAttribute((const void*)fwd_megakernel, hipFuncAttributeMaxDynamicSharedMemorySize, LDS_BYTES) != hipSuccess) { fprintf(stderr, "kernel_launch: hipFuncSetAttribute failed\n"); grid = -1; return; }
        if (hipOccupancyMaxActiveBlocksPerMultiprocessor(&per_cu, (const void*)fwd_megakernel, NTHREADS, LDS_BYTES) != hipSuccess || per_cu < 1) { fprintf(stderr, "kernel_launch: occupancy query failed (%d)\n", per_cu); (void)hipGetLastError(); grid = -1; return; }
        grid = cus * per_cu;
    }
    if (grid < 0) return;
    Params p{};
    const float** pp = (const float**)&p;
    for (int i = 0; i < 18; ++i) pp[i] = (const float*)d_in[i];
    p.out = (float*)d_out; p.ws = (unsigned char*)d_ws;
#if MK_PER_PHASE
#ifndef DBG_HI
#define DBG_HI NPHASE
#endif
    for (int k = 0; k < DBG_HI; ++k) { p.ph_lo = k; p.ph_hi = k + 1; hipLaunchKernelGGL(fwd_megakernel, dim3(grid), dim3(NTHREADS), LDS_BYTES, stream, p);
#ifdef DBG_HOSTREP
        if (k == DBG_HOSTREP) hipLaunchKernelGGL(fwd_megakernel, dim3(grid), dim3(NTHREADS), LDS_BYTES, stream, p);
#endif
    }
#ifdef DBG_DUMP_OFF
    hipLaunchKernelGGL(dump_kernel, dim3(2048), dim3(256), 0, stream, (const bf16_t*)((unsigned char*)d_ws + (size_t)(DBG_DUMP_OFF) * MiB), (size_t)(DBG_DUMP_N), (float*)d_out);
#endif
#else
    p.ph_lo = 0; p.ph_hi = NPHASE;
    if (hipMemsetAsync((char*)d_ws + WS_CTL, 0, 16384, stream) != hipSuccess) { fprintf(stderr, "kernel_launch: hipMemsetAsync failed\n"); return; }
    void* args[] = {&p};
    const hipError_t e = hipLaunchCooperativeKernel((const void*)fwd_megakernel, dim3(grid), dim3(NTHREADS), args, LDS_BYTES, stream);
    if (e != hipSuccess) fprintf(stderr, "kernel_launch: cooperative launch failed: %s (grid %d)\n", hipGetErrorString(e), grid);
#endif
}
```

```cpp
#include <hip/hip_runtime.h>
#include <hip/hip_cooperative_groups.h>
#include <cstdio>
#include <cstdint>
namespace cg = cooperative_groups;
namespace pg8 {
#define PG8_LAS __attribute__((address_space(3)))
typedef unsigned short bf16_t;
typedef short bf16x8 __attribute__((ext_vector_type(8)));
typedef float f32x4 __attribute__((ext_vector_type(4)));
typedef unsigned u32x4 __attribute__((ext_vector_type(4)));
constexpr int BM = 256, BK = 64, HALF = 128, HTB = HALF * BK * 2  , STAGE_BYTES = 8 * HTB, NXCD = 8, WGM = 8;

__host__ __device__ __forceinline__ int lds_byte(int r, int c) { const int st = (r >> 4) * 2 + (c >> 5), rr = r & 15, cc = c & 31, ob = rr * 64 + cc * 2; return st * 1024 + (ob ^ (((ob >> 9) & 1) << 5)); }
__host__ __device__ __forceinline__ void stage_rc(int b, int& R, int& C) { const int st = b / 1024, sb = b % 1024, swz = sb ^ (((sb >> 9) & 1) << 5); R = (st >> 1) * 16 + swz / 64; C = (st & 1) * 32 + (swz % 64) / 2; }
__host__ __device__ __forceinline__ int perm32(int rho) { const int n = rho >> 4, i = rho & 15; return 8 * (i >> 2) + 4 * n + (i & 3); }

struct Unit { int pm, pn; };
struct Gemm { const bf16_t* A; const bf16_t* Bt; int M, N, K; };

struct StaticOrder {
    int nM, nN, nwg, G, c;
    __host__ __device__ void init(int M, int N, int G_, int c_) { nM = M / BM; nN = N / BM; nwg = nM * nN; G = G_; c = c_; }
    __host__ __device__ bool next(int i, Unit& u) const {
        const long L = (long)i * G + c; if (L >= nwg) return false;
        int wgid = (int)L; { const int q = nwg / NXCD, r = nwg % NXCD, xcd = wgid % NXCD, off = wgid / NXCD; wgid = (xcd < r ? xcd * (q + 1) : r * (q + 1) + (xcd - r) * q) + off; }
        const int nig = WGM * nN, gid = wgid / nig, fm = gid * WGM, gsz = (nM - fm) < WGM ? (nM - fm) : WGM;
        u.pm = fm + ((wgid % nig) % gsz); u.pn = (wgid % nig) / gsz; return true;
    }
    __device__ __forceinline__ void a_ready(const Unit&) const {}
    __device__ __forceinline__ void done(const Unit&) const {}
};

__device__ __forceinline__ unsigned cvt_pk_bf16(float lo, float hi) { unsigned r; asm volatile("v_cvt_pk_bf16_f32 %0, %1, %2" : "=v"(r) : "v"(lo), "v"(hi)); return r; }
typedef float f32x2 __attribute__((ext_vector_type(2)));
__device__ __forceinline__ f32x2 gelu_pk(f32x2 v) {
    const f32x2 av = __builtin_elementwise_abs(v), d = av * 0.2316418882f + 1.0f;
    f32x2 t; t.x = __builtin_amdgcn_rcpf(d.x); t.y = __builtin_amdgcn_rcpf(d.y);
    f32x2 q = t * 0.5307027145f + (-0.7265760135f); q = q * t + 0.7107068705f; q = q * t + (-0.142248368f); q = q * t + 0.127414796f; q = q * t;
    const f32x2 s = (v * v) * (-0.72134752044f);
    f32x2 e; e.x = __builtin_amdgcn_exp2f(s.x); e.y = __builtin_amdgcn_exp2f(s.y);
    const f32x2 m = v * (q * e), r = v - m;
    f32x2 o; o.x = v.x < 0.f ? m.x : r.x; o.y = v.y < 0.f ? m.y : r.y; return o;
}

template <int ACT  > struct EpiBf16 {
    static constexpr bool PERM = true, AFTER_DRAIN = false; static_assert(ACT == 0 || ACT == 1, "EpiBf16: ACT is 0 (none) or 1 (gelu_pk)");
    bf16_t* O; int ldc; const float* bias; int split_cols; size_t split_stride; float scale0;
    __device__ __forceinline__ void operator()(const f32x4 (&acc)[2][2][4][2], const Unit& u, int wr, int wc, int fr, int fq) const {
        const int row0 = u.pm * BM + wr * 64 + fr; int colt = u.pn * BM; bf16_t* base = O;
        float sc = 1.f; if (split_cols) { const int t = colt / split_cols; base += (size_t)t * split_stride; colt -= t * split_cols; if (t == 0) sc = scale0; }
        const int col0 = colt + wc * 32 + 8 * fq, bcol0 = u.pn * BM + wc * 32 + 8 * fq;
        f32x4 bv[2][2];
#pragma unroll
        for (int bj = 0; bj < 2; ++bj)
#pragma unroll
            for (int n = 0; n < 2; ++n) bv[bj][n] = bias ? *(const f32x4*)(bias + bcol0 + bj * HALF + 4 * n) : (f32x4){0.f, 0.f, 0.f, 0.f};
#pragma unroll
        for (int ai = 0; ai < 2; ++ai)
#pragma unroll
            for (int m = 0; m < 4; ++m) { bf16_t* rowp = base + (size_t)(row0 + ai * HALF + m * 16) * ldc + col0;
#pragma unroll
                for (int bj = 0; bj < 2; ++bj) { f32x4 v0 = acc[ai][bj][m][0] + bv[bj][0], v1 = acc[ai][bj][m][1] + bv[bj][1];
                    if (ACT == 1) { f32x2 a = gelu_pk((f32x2){v0[0], v0[1]}), b = gelu_pk((f32x2){v0[2], v0[3]}), c = gelu_pk((f32x2){v1[0], v1[1]}), d = gelu_pk((f32x2){v1[2], v1[3]});
                        v0 = (f32x4){a.x, a.y, b.x, b.y}; v1 = (f32x4){c.x, c.y, d.x, d.y}; }
                    v0 = v0 * sc; v1 = v1 * sc; u32x4 w; w.x = cvt_pk_bf16(v0[0], v0[1]); w.y = cvt_pk_bf16(v0[2], v0[3]); w.z = cvt_pk_bf16(v1[0], v1[1]); w.w = cvt_pk_bf16(v1[2], v1[3]);
                    *(u32x4*)(rowp + bj * HALF) = w; } }
    }
};

struct PanelStats {
    unsigned* xbuf;
    unsigned* cnt;
    unsigned* tmo;
    int ntn; float eps;
    unsigned code;
    __device__ __forceinline__ bool run(const f32x4 (&v)[2][2][4][2], const Unit& u, int wr, int wc, int fr, int fq, PG8_LAS unsigned char* lds, int wid, int lane) const {
        typedef float f32x2v __attribute__((ext_vector_type(2)));
        PG8_LAS f32x2v* P = (PG8_LAS f32x2v*)lds;
        PG8_LAS f32x2v* S = (PG8_LAS f32x2v*)(lds + 8192);
        PG8_LAS unsigned* flag = (PG8_LAS unsigned*)(lds + 8192 + 2048);
#pragma unroll
        for (int ai = 0; ai < 2; ++ai)
#pragma unroll
            for (int m = 0; m < 4; ++m) {
                float s = 0.f;
#pragma unroll
                for (int bj = 0; bj < 2; ++bj)
#pragma unroll
                    for (int n = 0; n < 2; ++n) { const f32x4 x = v[ai][bj][m][n]; s += (x[0] + x[1]) + (x[2] + x[3]); }
                s += __shfl_xor(s, 16); s += __shfl_xor(s, 32);
                const float mw = s * (1.0f / 64.0f); float q = 0.f;
#pragma unroll
                for (int bj = 0; bj < 2; ++bj)
#pragma unroll
                    for (int n = 0; n < 2; ++n) { const f32x4 d = v[ai][bj][m][n] - mw; q += (d[0] * d[0] + d[1] * d[1]) + (d[2] * d[2] + d[3] * d[3]); }
                q += __shfl_xor(q, 16); q += __shfl_xor(q, 32);
                if (fq == 0) P[(ai * HALF + wr * 64 + m * 16 + fr) * 4 + wc] = (f32x2v){mw, q};
            }
        asm volatile("s_waitcnt lgkmcnt(0)" ::: "memory"); __builtin_amdgcn_s_barrier(); asm volatile("" ::: "memory");
#if defined(BROKEN_EXCHANGE_NO_WAIT)
#warning BROKEN CONTROL BUILD: the row-statistics exchange does not wait; results are wrong by design
        if (blockIdx.x >= 64) { const long long t0_ = clock64(); while (clock64() - t0_ < 60000) __builtin_amdgcn_s_sleep(8); }
#endif
        const int row = wid * 32 + (lane & 31);
        if (lane < 32) {
            const f32x2v a = P[row * 4 + 0], b = P[row * 4 + 1], c = P[row * 4 + 2], d = P[row * 4 + 3];
            const float mt = (a.x + b.x + c.x + d.x) * 0.25f;
            const float da = a.x - mt, db = b.x - mt, dc = c.x - mt, dd = d.x - mt;
            const float m2 = (a.y + b.y) + (c.y + d.y) + 64.0f * ((da * da + db * db) + (dc * dc + dd * dd));
            unsigned long long* slot = (unsigned long long*)xbuf + ((size_t)(u.pm * BM + row) * 4 + u.pn);
            __hip_atomic_store(slot, ((unsigned long long)__float_as_uint(m2) << 32) | __float_as_uint(mt), __ATOMIC_RELAXED, __HIP_MEMORY_SCOPE_AGENT);
        }
        asm volatile("s_waitcnt vmcnt(0)" ::: "memory");
        if (lane == 0) __hip_atomic_fetch_add(cnt + 64 * u.pm, 1u, __ATOMIC_RELAXED, __HIP_MEMORY_SCOPE_AGENT);
        if (wid == 0) {
            bool dead = false; const unsigned long long t0 = __builtin_amdgcn_s_memrealtime(); const unsigned want = 8u * (unsigned)ntn;
            for (;;) {
#if defined(BROKEN_EXCHANGE_NO_WAIT)
                break;
#endif
                if ((unsigned)__builtin_amdgcn_readfirstlane(__hip_atomic_load(cnt + 64 * u.pm, __ATOMIC_RELAXED, __HIP_MEMORY_SCOPE_AGENT)) >= want) break;
                if (__builtin_amdgcn_s_memrealtime() - t0 > 2000000ull) {
                    if (lane == 0) { unsigned expect = 0u; __hip_atomic_compare_exchange_strong(tmo + 1, &expect, code | (unsigned)(u.pm & 0xff), __ATOMIC_RELAXED, __ATOMIC_RELAXED, __HIP_MEMORY_SCOPE_AGENT);
                                     __hip_atomic_store(tmo, 1u, __ATOMIC_RELAXED, __HIP_MEMORY_SCOPE_AGENT); }
                    dead = true; break; }
                __builtin_amdgcn_s_sleep(2);
            }
            __builtin_amdgcn_fence(__ATOMIC_ACQUIRE, "agent");
            if (lane == 0) flag[0] = dead ? 1u : 0u;
        }
        asm volatile("s_waitcnt vmcnt(0) lgkmcnt(0)" ::: "memory"); __builtin_amdgcn_s_barrier(); asm volatile("" ::: "memory");
        const bool bad = flag[0] != 0u;
        if (lane < 32) {
            const unsigned long long* slot = (const unsigned long long*)xbuf + (size_t)(u.pm * BM + row) * 4; float mt[4], m2[4]; float ms = 0.f;
#pragma unroll
            for (int t = 0; t < 4; ++t) { if (t < ntn) { const unsigned long long w = __hip_atomic_load(slot + t, __ATOMIC_RELAXED, __HIP_MEMORY_SCOPE_AGENT); mt[t] = __uint_as_float((unsigned)w); m2[t] = __uint_as_float((unsigned)(w >> 32)); } else { mt[t] = 0.f; m2[t] = 0.f; } ms += mt[t]; }
            const float mean = ms / (float)ntn; float q = 0.f;
#pragma unroll
            for (int t = 0; t < 4; ++t) if (t < ntn) { const float dm = mt[t] - mean; q += m2[t] + 256.0f * dm * dm; }
            S[row] = (f32x2v){mean, 1.0f / sqrtf(q / (256.0f * (float)ntn) + eps)};
        }
        asm volatile("s_waitcnt lgkmcnt(0)" ::: "memory"); __builtin_amdgcn_s_barrier(); asm volatile("" ::: "memory");
        return bad;
    }
};
struct EpiLnRes {
    static constexpr bool PERM = false, AFTER_DRAIN = true;
    const float* base; float* out; int ldc; const float* bias; PanelStats st; unsigned poison;
    __device__ __forceinline__ void fused(f32x4 (&acc)[2][2][4][2], const Unit& u, int wr, int wc, int fr, int fq, PG8_LAS unsigned char* lds, int wid, int lane) const {
        typedef float f32x2v __attribute__((ext_vector_type(2)));
        const PG8_LAS f32x2v* S = (const PG8_LAS f32x2v*)(lds + 8192);
        const int col0 = u.pn * BM + wc * 32 + 4 * fq;
#pragma unroll
        for (int bj = 0; bj < 2; ++bj)
#pragma unroll
            for (int n = 0; n < 2; ++n) { const f32x4 bv = bias ? *(const f32x4*)(bias + col0 + bj * HALF + n * 16) : (f32x4){0.f, 0.f, 0.f, 0.f};
#pragma unroll
                for (int ai = 0; ai < 2; ++ai)
#pragma unroll
                    for (int m = 0; m < 4; ++m) acc[ai][bj][m][n] += bv; }
        f32x4 pre[4][2][2];
#pragma unroll
        for (int m = 0; m < 4; ++m) { const size_t off = (size_t)(u.pm * BM + wr * 64 + m * 16 + fr) * ldc + col0;
#pragma unroll
            for (int bj = 0; bj < 2; ++bj)
#pragma unroll
                for (int n = 0; n < 2; ++n) pre[m][bj][n] = *(const f32x4*)(base + off + bj * HALF + n * 16); }
        const bool bad = st.run(acc, u, wr, wc, fr, fq, lds, wid, lane) || poison != 0u;
        const float qnan = __builtin_nanf("");
#pragma unroll
        for (int ai = 0; ai < 2; ++ai)
#pragma unroll
            for (int m = 0; m < 4; ++m) { const int r = ai * HALF + wr * 64 + m * 16 + fr; const f32x2v sr = S[r]; const size_t off = (size_t)(u.pm * BM + r) * ldc + col0;
#pragma unroll
                for (int bj = 0; bj < 2; ++bj)
#pragma unroll
                    for (int n = 0; n < 2; ++n) { const f32x4 bs = ai == 0 ? pre[m][bj][n] : *(const f32x4*)(base + off + bj * HALF + n * 16); f32x4 o = bs + (acc[ai][bj][m][n] - sr.x) * sr.y;
                        if (bad) o = (f32x4){qnan, qnan, qnan, qnan}; *(f32x4*)(out + off + bj * HALF + n * 16) = o; }
                if (m & 1) asm volatile("" ::: "memory"); }
    }
};
struct EpiLnResLn {
    static constexpr bool PERM = false, AFTER_DRAIN = true;
    const float* base; float* out; bf16_t* xn; int ldc; const float* bias; PanelStats st1, st2; unsigned poison;
    __device__ __forceinline__ void fused(f32x4 (&acc)[2][2][4][2], const Unit& u, int wr, int wc, int fr, int fq, PG8_LAS unsigned char* lds, int wid, int lane) const {
        typedef float f32x2v __attribute__((ext_vector_type(2))); typedef unsigned u32x2v __attribute__((ext_vector_type(2)));
        const PG8_LAS f32x2v* S = (const PG8_LAS f32x2v*)(lds + 8192);
        const int col0 = u.pn * BM + wc * 32 + 4 * fq;
#pragma unroll
        for (int bj = 0; bj < 2; ++bj)
#pragma unroll
            for (int n = 0; n < 2; ++n) { const f32x4 bv = bias ? *(const f32x4*)(bias + col0 + bj * HALF + n * 16) : (f32x4){0.f, 0.f, 0.f, 0.f};
#pragma unroll
                for (int ai = 0; ai < 2; ++ai)
#pragma unroll
                    for (int m = 0; m < 4; ++m) acc[ai][bj][m][n] += bv; }
        bool bad = st1.run(acc, u, wr, wc, fr, fq, lds, wid, lane) || poison != 0u;
        const float qnan = __builtin_nanf("");
#pragma unroll
        for (int ai = 0; ai < 2; ++ai)
#pragma unroll
            for (int m = 0; m < 4; ++m) { const int r = ai * HALF + wr * 64 + m * 16 + fr; const f32x2v sr = S[r]; const size_t off = (size_t)(u.pm * BM + r) * ldc + col0;
#pragma unroll
                for (int bj = 0; bj < 2; ++bj)
#pragma unroll
                    for (int n = 0; n < 2; ++n) { const f32x4 bs = *(const f32x4*)(base + off + bj * HALF + n * 16); acc[ai][bj][m][n] = bs + (acc[ai][bj][m][n] - sr.x) * sr.y; }
                asm volatile("" : "+v"(acc[ai][0][m][0]), "+v"(acc[ai][0][m][1]), "+v"(acc[ai][1][m][0]), "+v"(acc[ai][1][m][1]));
                if (m & 1) asm volatile("" ::: "memory"); }
        const bool bad1 = bad;
        bad = st2.run(acc, u, wr, wc, fr, fq, lds, wid, lane) || bad;
#pragma unroll
        for (int ai = 0; ai < 2; ++ai)
#pragma unroll
            for (int m = 0; m < 4; ++m) { const int r = ai * HALF + wr * 64 + m * 16 + fr; const f32x2v sr = S[r]; const size_t off = (size_t)(u.pm * BM + r) * ldc + col0;
#pragma unroll
                for (int bj = 0; bj < 2; ++bj)
#pragma unroll
                    for (int n = 0; n < 2; ++n) { const f32x4 x1 = acc[ai][bj][m][n]; *(f32x4*)(out + off + bj * HALF + n * 16) = bad1 ? (f32x4){qnan, qnan, qnan, qnan} : x1;
                        const f32x4 o = (x1 - sr.x) * sr.y; u32x2v w; w.x = cvt_pk_bf16(o[0], o[1]); w.y = cvt_pk_bf16(o[2], o[3]);
                        if (bad) { w.x = 0x7fc07fc0u; w.y = 0x7fc07fc0u; } *(u32x2v*)(xn + off + bj * HALF + n * 16) = w; }
                asm volatile("" ::: "memory"); }
    }
};

template <class Epi, class Sched, bool ALIGN_EPI = false, bool SP2 = false>
__device__ __forceinline__ void gemm_phase(PG8_LAS unsigned char* lds, const Gemm g, const Sched& S, const Epi& E) {
    const int tid = threadIdx.x, wid = __builtin_amdgcn_readfirstlane(tid >> 6), lane = tid & 63, wr = wid >> 2, wc = wid & 3, fr = lane & 15, fq = lane >> 4;
    const int K = g.K, nt = K / BK;
    unsigned voffA[2], voffB[2];
#pragma unroll
    for (int i = 0; i < 2; ++i) { int R, C; stage_rc(tid * 16 + i * 8192, R, C); const int Rb = Epi::PERM ? ((R & ~31) + perm32(R & 31)) : R;
        voffA[i] = (unsigned)(R * K + C) * 2u; voffB[i] = (unsigned)(Rb * K + C) * 2u; }
    const size_t kstep = (size_t)(BK * 2);
    const size_t hstep = (size_t)HALF * K * 2;
    const size_t tstep = 2 * hstep;
    const unsigned ldsw = (unsigned)wid * 1024u;
    const int aoff = lds_byte(wr * 64 + fr, fq * 8), boff = lds_byte(wc * 32 + fr, fq * 8);
#define PG8_SA(b, h) (((b) * 2 + (h)) * HTB)
#define PG8_SB(b, h) ((4 + (b) * 2 + (h)) * HTB)
#define PG8_STAGE(bufoff, gbase, voff) do { _Pragma("unroll") for (int _i = 0; _i < 2; ++_i) \
        __builtin_amdgcn_global_load_lds((const unsigned*)((const char*)(gbase) + (voff)[_i]), (PG8_LAS unsigned*)(lds + (bufoff) + ldsw + _i * 8192), 16, 0, 0); } while (0)
#define PG8_LDA(dst, b, h) do { _Pragma("unroll") for (int m = 0; m < 4; ++m) _Pragma("unroll") for (int k = 0; k < 2; ++k) dst[m][k] = *(const PG8_LAS bf16x8*)(lds + PG8_SA(b, h) + aoff + m * 2048 + k * 1024); } while (0)
#define PG8_LDB(dst, b, h) do { _Pragma("unroll") for (int n = 0; n < 2; ++n) _Pragma("unroll") for (int k = 0; k < 2; ++k) dst[n][k] = *(const PG8_LAS bf16x8*)(lds + PG8_SB(b, h) + boff + n * 2048 + k * 1024); } while (0)
#define PG8_MMA(ai, bj, At, Bt) do { __builtin_amdgcn_s_setprio(1); _Pragma("unroll") for (int m = 0; m < 4; ++m) _Pragma("unroll") for (int n = 0; n < 2; ++n) _Pragma("unroll") for (int k = 0; k < 2; ++k) \
        acc[ai][bj][m][n] = __builtin_amdgcn_mfma_f32_16x16x32_bf16(Bt[n][k], At[m][k], acc[ai][bj][m][n], 0, 0, 0); __builtin_amdgcn_s_setprio(0); } while (0)
#define PG8_WAIT_V(n) asm volatile("s_waitcnt vmcnt(" #n ")" ::: "memory")
#define PG8_WAIT_L(n) asm volatile("s_waitcnt lgkmcnt(" #n ")" ::: "memory")
#define PG8_BAR __builtin_amdgcn_s_barrier()
#define PG8_SCHED __builtin_amdgcn_sched_barrier(0)
    Unit cur, nxt; int ui = 0;
    if (!S.next(0, cur)) return;
    f32x4 acc[2][2][4][2];
#pragma unroll
    for (int a = 0; a < 2; ++a)
#pragma unroll
        for (int b = 0; b < 2; ++b)
#pragma unroll
            for (int m = 0; m < 4; ++m)
#pragma unroll
                for (int n = 0; n < 2; ++n) acc[a][b][m][n] = (f32x4){0.f, 0.f, 0.f, 0.f};
    bf16x8 At[4][2], B0[2][2], B1[2][2];
    const char* cA = (const char*)g.A + (size_t)cur.pm * tstep; const char* cB = (const char*)g.Bt + (size_t)cur.pn * tstep;
    S.a_ready(cur);
    if constexpr (SP2) {
        PG8_STAGE(PG8_SB(0, 0), cB, voffB); PG8_STAGE(PG8_SB(0, 1), cB + hstep, voffB); PG8_STAGE(PG8_SA(0, 0), cA, voffA); PG8_STAGE(PG8_SA(0, 1), cA + hstep, voffA);
        if (wr == 1) PG8_BAR;
        PG8_WAIT_V(2); PG8_BAR;
        PG8_STAGE(PG8_SB(1, 0), cB + kstep, voffB); PG8_STAGE(PG8_SA(1, 0), cA + kstep, voffA); PG8_STAGE(PG8_SB(1, 1), cB + hstep + kstep, voffB);
        PG8_WAIT_V(6); PG8_BAR;
    } else {
        PG8_STAGE(PG8_SB(0, 0), cB, voffB); PG8_STAGE(PG8_SA(0, 0), cA, voffA); PG8_STAGE(PG8_SB(0, 1), cB + hstep, voffB); PG8_STAGE(PG8_SA(0, 1), cA + hstep, voffA);
        if (wr == 1) PG8_BAR;
        PG8_WAIT_V(4); PG8_BAR;
        PG8_STAGE(PG8_SB(1, 0), cB + kstep, voffB); PG8_STAGE(PG8_SA(1, 0), cA + kstep, voffA); PG8_STAGE(PG8_SB(1, 1), cB + hstep + kstep, voffB);
        PG8_WAIT_V(6); PG8_BAR;
    }
    for (;;) {
        const bool has_next = S.next(ui + 1, nxt);
        const char* nA = has_next ? (const char*)g.A + (size_t)nxt.pm * tstep : cA; const char* nB = has_next ? (const char*)g.Bt + (size_t)nxt.pn * tstep : cB;
        for (int t = 0; t < nt; t += 2) {
            const bool last = (t == nt - 2);
            const char* a1 = cA + (size_t)(t + 1) * kstep;
            const char* a2 = last ? nA : cA + (size_t)(t + 2) * kstep; const char* b2 = last ? nB : cB + (size_t)(t + 2) * kstep;
            const char* a3 = a2 + kstep; const char* b3 = b2 + kstep;
            if (last && has_next) S.a_ready(nxt);
            if constexpr (SP2) {
            PG8_LDB(B0, 0, 0); PG8_LDB(B1, 0, 1); PG8_SCHED; PG8_LDA(At, 0, 0); PG8_STAGE(PG8_SA(1, 1), a1 + hstep, voffA);
            PG8_WAIT_V(8); PG8_WAIT_L(0); PG8_BAR; PG8_MMA(0, 0, At, B0); PG8_MMA(0, 1, At, B1); PG8_BAR; PG8_SCHED;
            PG8_LDA(At, 0, 1); PG8_STAGE(PG8_SB(0, 0), b2, voffB); PG8_STAGE(PG8_SB(0, 1), b2 + hstep, voffB); PG8_STAGE(PG8_SA(0, 0), a2, voffA);
            PG8_WAIT_V(8); PG8_WAIT_L(0); PG8_BAR; PG8_MMA(1, 0, At, B0); PG8_MMA(1, 1, At, B1); PG8_BAR; PG8_SCHED;
            PG8_LDB(B0, 1, 0); PG8_LDB(B1, 1, 1); PG8_SCHED; PG8_LDA(At, 1, 0); PG8_STAGE(PG8_SA(0, 1), a2 + hstep, voffA);
            PG8_WAIT_V(8); PG8_WAIT_L(0); PG8_BAR; PG8_MMA(0, 0, At, B0); PG8_MMA(0, 1, At, B1); PG8_BAR; PG8_SCHED;
            PG8_LDA(At, 1, 1); PG8_STAGE(PG8_SB(1, 0), b3, voffB); PG8_STAGE(PG8_SB(1, 1), b3 + hstep, voffB); PG8_STAGE(PG8_SA(1, 0), a3, voffA);
            PG8_WAIT_V(8); PG8_WAIT_L(0); PG8_BAR; PG8_MMA(1, 0, At, B0); PG8_MMA(1, 1, At, B1); PG8_BAR; PG8_SCHED;
            } else {
            PG8_LDB(B0, 0, 0); PG8_SCHED; PG8_LDA(At, 0, 0); PG8_STAGE(PG8_SA(1, 1), a1 + hstep, voffA);
            PG8_WAIT_L(8); PG8_BAR; PG8_WAIT_L(0); PG8_MMA(0, 0, At, B0); PG8_BAR; PG8_SCHED;
            PG8_LDB(B1, 0, 1); PG8_STAGE(PG8_SB(0, 0), b2, voffB);
            PG8_BAR; PG8_WAIT_L(0); PG8_MMA(0, 1, At, B1); PG8_BAR;
            PG8_LDA(At, 0, 1); PG8_STAGE(PG8_SA(0, 0), a2, voffA);
            PG8_BAR; PG8_WAIT_L(0); PG8_MMA(1, 0, At, B0); PG8_BAR; PG8_SCHED;
            PG8_STAGE(PG8_SB(0, 1), b2 + hstep, voffB);
            PG8_WAIT_V(6); PG8_BAR; PG8_MMA(1, 1, At, B1); PG8_BAR;
            PG8_LDB(B0, 1, 0); PG8_SCHED; PG8_LDA(At, 1, 0); PG8_STAGE(PG8_SA(0, 1), a2 + hstep, voffA);
            PG8_WAIT_L(8); PG8_BAR; PG8_WAIT_L(0); PG8_MMA(0, 0, At, B0); PG8_BAR; PG8_SCHED;
            PG8_LDB(B1, 1, 1); PG8_STAGE(PG8_SB(1, 0), b3, voffB);
            PG8_BAR; PG8_WAIT_L(0); PG8_MMA(0, 1, At, B1); PG8_BAR;
            PG8_LDA(At, 1, 1); PG8_STAGE(PG8_SA(1, 0), a3, voffA);
            PG8_BAR; PG8_WAIT_L(0); PG8_MMA(1, 0, At, B0); PG8_BAR; PG8_SCHED;
            PG8_STAGE(PG8_SB(1, 1), b3 + hstep, voffB);
            PG8_WAIT_V(6); PG8_BAR; PG8_MMA(1, 1, At, B1); PG8_BAR;
            }
        }
        if constexpr (ALIGN_EPI) { if (wr == 0) PG8_BAR; }
        if constexpr (!Epi::AFTER_DRAIN) { E(acc, cur, wr, wc, fr, fq); S.done(cur); }
        if (!has_next) break;
#pragma unroll
        for (int a = 0; a < 2; ++a)
#pragma unroll
            for (int b = 0; b < 2; ++b)
#pragma unroll
                for (int m = 0; m < 4; ++m)
#pragma unroll
                    for (int n = 0; n < 2; ++n) acc[a][b][m][n] = (f32x4){0.f, 0.f, 0.f, 0.f};
        cur = nxt; cA = nA; cB = nB; ++ui;
        if constexpr (ALIGN_EPI) { if (wr == 1) PG8_BAR; }
    }
    PG8_WAIT_V(0);
    if constexpr (!ALIGN_EPI) { if (wr == 0) PG8_BAR; }
    PG8_BAR;
    if constexpr (Epi::AFTER_DRAIN) { E.fused(acc, cur, wr, wc, fr, fq, lds, wid, lane); S.done(cur); }
#undef PG8_SA
#undef PG8_SB
#undef PG8_STAGE
#undef PG8_LDA
#undef PG8_LDB
#undef PG8_MMA
#undef PG8_WAIT_V
#undef PG8_WAIT_L
#undef PG8_BAR
#undef PG8_SCHED
}
}

typedef float f32x2_t __attribute__((ext_vector_type(2))); typedef __bf16 bf16x2_t __attribute__((ext_vector_type(2)));
__device__ __forceinline__ unsigned cvtpk(float lo, float hi) { f32x2_t v = {lo, hi}; bf16x2_t b = __builtin_convertvector(v, bf16x2_t); return __builtin_bit_cast(unsigned, b); }

namespace pg8 {
template <bool BASE_BF16> struct EpiRes {
    static constexpr bool PERM = true, AFTER_DRAIN = false;
    const void* base; bf16_t* hb; float* ssq;
    __device__ __forceinline__ void operator()(const f32x4 (&acc)[2][2][4][2], const Unit& u, int wr, int wc, int fr, int fq) const {
        const int row0 = u.pm * BM + wr * 64 + fr, col0 = u.pn * BM + wc * 32 + 8 * fq;
#pragma unroll
        for (int ai = 0; ai < 2; ++ai) {
            f32x4 b0[4][2], b1[4][2];
#pragma unroll
            for (int m = 0; m < 4; ++m)
#pragma unroll
                for (int bj = 0; bj < 2; ++bj) {
                    const size_t off = (size_t)(row0 + ai * HALF + m * 16) * 1024 + col0 + bj * HALF;
                    if (BASE_BF16) {
                        const u32x4 w = *(const u32x4*)((const bf16_t*)base + off);
                        b0[m][bj][0] = __uint_as_float(w.x << 16); b0[m][bj][1] = __uint_as_float(w.x & 0xffff0000u); b0[m][bj][2] = __uint_as_float(w.y << 16); b0[m][bj][3] = __uint_as_float(w.y & 0xffff0000u);
                        b1[m][bj][0] = __uint_as_float(w.z << 16); b1[m][bj][1] = __uint_as_float(w.z & 0xffff0000u); b1[m][bj][2] = __uint_as_float(w.w << 16); b1[m][bj][3] = __uint_as_float(w.w & 0xffff0000u);
                    } else { b0[m][bj] = *(const f32x4*)((const float*)base + off); b1[m][bj] = *(const f32x4*)((const float*)base + off + 4); }
                }
#pragma unroll
            for (int m = 0; m < 4; ++m) {
                const size_t row = (size_t)(row0 + ai * HALF + m * 16); float s = 0.f;
#pragma unroll
                for (int bj = 0; bj < 2; ++bj) {
                    const size_t off = row * 1024 + col0 + bj * HALF;
                    const f32x4 v0 = acc[ai][bj][m][0] + b0[m][bj], v1 = acc[ai][bj][m][1] + b1[m][bj];
                    s += (v0[0] * v0[0] + v0[1] * v0[1]) + (v0[2] * v0[2] + v0[3] * v0[3]) + (v1[0] * v1[0] + v1[1] * v1[1]) + (v1[2] * v1[2] + v1[3] * v1[3]);
                    u32x4 w; w.x = cvtpk(v0[0], v0[1]); w.y = cvtpk(v0[2], v0[3]); w.z = cvtpk(v1[0], v1[1]); w.w = cvtpk(v1[2], v1[3]); *(u32x4*)(hb + off) = w;
                }
                s += __shfl_xor(s, 16); s += __shfl_xor(s, 32); if (fq == 0) ssq[row * 16 + u.pn * 4 + wc] = s;
            }
        }
    }
};
template <int MODE> struct EpiScale {
    static constexpr bool PERM = true, AFTER_DRAIN = false;
    bf16_t* O; int ldc; const float* ssq; float scale;
    __device__ __forceinline__ void operator()(const f32x4 (&acc)[2][2][4][2], const Unit& u, int wr, int wc, int fr, int fq) const {
        const int row0 = u.pm * BM + wr * 64 + fr, col0 = u.pn * BM + wc * 32 + 8 * fq;
        f32x4 sp[2][4];
#pragma unroll
        for (int ai = 0; ai < 2; ++ai)
#pragma unroll
            for (int m = 0; m < 4; ++m) sp[ai][m] = *(const f32x4*)(ssq + (size_t)(row0 + ai * HALF + m * 16) * 16 + 4 * fq);
#pragma unroll
        for (int ai = 0; ai < 2; ++ai)
#pragma unroll
            for (int m = 0; m < 4; ++m) {
                const size_t row = (size_t)(row0 + ai * HALF + m * 16);
                float t = (sp[ai][m][0] + sp[ai][m][1]) + (sp[ai][m][2] + sp[ai][m][3]);
                t += __shfl_xor(t, 16); t += __shfl_xor(t, 32);
                const float rs = __builtin_amdgcn_rsqf(t * (1.0f / 1024.0f) + 1e-6f) * scale;
#pragma unroll
                for (int bj = 0; bj < 2; ++bj) {
                    f32x4 v0 = acc[ai][bj][m][0] * rs, v1 = acc[ai][bj][m][1] * rs;
                    if (MODE == 1) {
#pragma unroll
                        for (int e = 0; e < 4; ++e) { const float a = fmaxf(v0[e], 0.f), b = fmaxf(v1[e], 0.f); v0[e] = a * a; v1[e] = b * b; }
                    }
                    u32x4 w; w.x = cvtpk(v0[0], v0[1]); w.y = cvtpk(v0[2], v0[3]); w.z = cvtpk(v1[0], v1[1]); w.w = cvtpk(v1[2], v1[3]);
                    *(u32x4*)(O + row * ldc + col0 + bj * HALF) = w;
                }
            }
    }
};
struct EpiKV {
    static constexpr bool PERM = true, AFTER_DRAIN = false;
    bf16_t* Kb; bf16_t* Vt;
    __device__ __forceinline__ void operator()(const f32x4 (&acc)[2][2][4][2], const Unit& u, int wr, int wc, int fr, int fq) const {
        const int row0 = u.pm * BM + wr * 64 + fr, col0 = u.pn * BM + wc * 32 + 8 * fq;
#pragma unroll
        for (int ai = 0; ai < 2; ++ai)
#pragma unroll
            for (int m = 0; m < 4; ++m) {
                const int row = row0 + ai * HALF + m * 16;
#pragma unroll
                for (int bj = 0; bj < 2; ++bj) {
                    const int col = col0 + bj * HALF; const f32x4 v0 = acc[ai][bj][m][0], v1 = acc[ai][bj][m][1];
                    u32x4 w; w.x = cvtpk(v0[0], v0[1]); w.y = cvtpk(v0[2], v0[3]); w.z = cvtpk(v1[0], v1[1]); w.w = cvtpk(v1[2], v1[3]);
                    if (col < 1024) { *(u32x4*)(Kb + (size_t)row * 1024 + col) = w; }
                    else {
                        const int b = row >> 8, mm = row & 255; bf16_t* p = Vt + ((size_t)(b * 1024 + (col - 1024))) * 256 + mm;
                        p[0 * 256] = (bf16_t)(w.x & 0xffffu); p[1 * 256] = (bf16_t)(w.x >> 16); p[2 * 256] = (bf16_t)(w.y & 0xffffu); p[3 * 256] = (bf16_t)(w.y >> 16);
                        p[4 * 256] = (bf16_t)(w.z & 0xffffu); p[5 * 256] = (bf16_t)(w.z >> 16); p[6 * 256] = (bf16_t)(w.w & 0xffffu); p[7 * 256] = (bf16_t)(w.w >> 16);
                    }
                }
            }
    }
};
}

#define LAS __attribute__((address_space(3)))
typedef pg8::bf16_t bf16_t;
typedef pg8::bf16x8 bf16x8;
typedef pg8::f32x4 f32x4;
typedef pg8::u32x4 u32x4;
typedef unsigned u32x2 __attribute__((ext_vector_type(2)));

constexpr int NTOK = 32768, DM = 1024, SEQ = 8192, NBATCH = 4, NCHUNK = 128, NPROJ = 3328, DFF = 4096, NMEMROWS = 1024;
constexpr int C_GQ = 0, C_GK = 256, C_GV = 512, C_GG = 1024, C_RQ = 1536, C_RK = 1792, C_RV = 2048, C_RG = 2560, C_Z = 3072;
constexpr int NWAVES = 8, NTHREADS = 512;
constexpr int WAVE_LDS = 18432, MISC_OFF = NWAVES * WAVE_LDS, LDS_BYTES = MISC_OFF + 64;
constexpr int VPITCH = 72;
constexpr int APITCH = 528;
constexpr size_t MiB = 1u << 20;
constexpr size_t WS_WIN = 1 * MiB, WS_WOUT = 8 * MiB, WS_WQ = 10 * MiB, WS_WKV = 12 * MiB, WS_WO = 16 * MiB, WS_W1 = 18 * MiB, WS_W2 = 26 * MiB;
constexpr size_t WS_COS = 34 * MiB, WS_SIN = 35 * MiB, WS_MEMN = 36 * MiB, WS_KB = 38 * MiB, WS_VT = 40 * MiB, WS_DEC = 42 * MiB, WS_SSQ1 = 44 * MiB, WS_SSQ2 = 46 * MiB, WS_SSQ3 = 48 * MiB, WS_CTL = 0;
constexpr size_t WS_A1 = 64 * MiB;
constexpr size_t WS_A2 = 128 * MiB;
constexpr size_t WS_BIG = 192 * MiB;
constexpr size_t WS_NEED = 448 * MiB;

struct Params {
    const float *x, *mem, *norm_mix_g, *w_in, *gla_w_gate, *gla_b_gate, *gla_norm_g, *ret_norm_g, *w_out, *norm_x_g, *norm_mem_g, *xa_w_q, *xa_w_kv, *xa_w_o, *norm_ffn_g, *ffn_w1, *ffn_w2, *final_norm_g;
    float* out; unsigned char* ws; int ph_lo, ph_hi;
};

__device__ __forceinline__ float bf2f(unsigned short b) { return __uint_as_float(((unsigned)b) << 16); }
__device__ __forceinline__ unsigned short f2bf(float f) { const unsigned u = __float_as_uint(f); return (unsigned short)((u + 0x7fffu + ((u >> 16) & 1u)) >> 16); }
__device__ __forceinline__ bf16x8 pack8(f32x4 a, f32x4 b) {
    u32x4 w; w.x = cvtpk(a[0], a[1]); w.y = cvtpk(a[2], a[3]); w.z = cvtpk(b[0], b[1]); w.w = cvtpk(b[2], b[3]);
    return __builtin_bit_cast(bf16x8, w);
}
__device__ __forceinline__ void unpack8(bf16x8 v, f32x4& a, f32x4& b) {
    const u32x4 w = __builtin_bit_cast(u32x4, v);
    a[0] = __uint_as_float(w.x << 16); a[1] = __uint_as_float(w.x & 0xffff0000u); a[2] = __uint_as_float(w.y << 16); a[3] = __uint_as_float(w.y & 0xffff0000u);
    b[0] = __uint_as_float(w.z << 16); b[1] = __uint_as_float(w.z & 0xffff0000u); b[2] = __uint_as_float(w.w << 16); b[3] = __uint_as_float(w.w & 0xffff0000u);
}
__device__ __forceinline__ float wave_sum(float v) {
#pragma unroll
    for (int o = 1; o < 64; o <<= 1) v += __shfl_xor(v, o);
    return v;
}
#define MFMA16(a, b, c) __builtin_amdgcn_mfma_f32_16x16x32_bf16((a), (b), (c), 0, 0, 0)
#define LDS_FENCE() asm volatile("s_waitcnt lgkmcnt(0)" ::: "memory")
#define CFENCE() do { asm volatile("" ::: "memory"); __builtin_amdgcn_sched_barrier(0); } while (0)
__device__ __forceinline__ float scan16(float v, int r) {
#pragma unroll
    for (int off = 1; off < 16; off <<= 1) { const float t = __shfl_up(v, off, 16); if (r >= off) v += t; }
    return v;
}

#define XB_TMO      128
#define XB_XCNT(j)  (256  + 64 * (j))
#define XB_XSUB(j)  (1280 + 64 * (j))
#define XB_XGEN(j)  (2304 + 64 * (j))
#define XB_TOP      3328
#define XB_TOPGEN   3392
#define XCD_BAR_WORDS 3456
#define XB_SPIN_CAP (1u << 18)

__device__ __forceinline__ unsigned xb_ld(unsigned* p)              { return __hip_atomic_load(p, __ATOMIC_RELAXED, __HIP_MEMORY_SCOPE_AGENT); }
__device__ __forceinline__ unsigned xb_add(unsigned* p, unsigned v) { return __hip_atomic_fetch_add(p, v, __ATOMIC_RELAXED, __HIP_MEMORY_SCOPE_AGENT); }
__device__ __forceinline__ unsigned xb_xcc_id() { return (unsigned)__builtin_amdgcn_s_getreg((3 << 11) | 20) & 0xFu; }
#define XB_SPIN(cond, bar) do { unsigned _sp = 0; while (cond) { __builtin_amdgcn_s_sleep(1); \
    if ((++_sp & 255u) == 0u) { if (xb_ld(&(bar)[XB_TMO])) break; if (_sp > XB_SPIN_CAP) { atomicAdd(&(bar)[XB_TMO], 1u); break; } } } } while (0)

struct XcdBarrier {
    unsigned* bar; unsigned x;
    volatile LAS unsigned* st;
};

__device__ __forceinline__ XcdBarrier xcd_barrier_post(unsigned* bar, volatile LAS unsigned* st) {
    XcdBarrier b; b.bar = bar; b.x = xb_xcc_id(); b.st = st;
    if (threadIdx.x == 0) (void)xb_add(&bar[XB_XCNT(b.x)], 1u);
    return b;
}
__device__ __forceinline__ void xcd_barrier_complete(unsigned* bar, unsigned x, unsigned& nloc, unsigned& nx) {
    const unsigned G = gridDim.x * gridDim.y * gridDim.z;
    unsigned sum, cnt, mine, sp = 0u;
    for (;;) {
        sum = 0u; cnt = 0u; mine = 0u;
#pragma unroll
        for (unsigned j = 0; j < 16; ++j) { const unsigned c = xb_ld(&bar[XB_XCNT(j)]); sum += c; cnt += (c > 0u) ? 1u : 0u; mine = (j == x) ? c : mine; }
        if (sum == G) break;
        __builtin_amdgcn_s_sleep(1);
        if ((++sp & 255u) == 0u) { if (xb_ld(&bar[XB_TMO])) break; if (sp > XB_SPIN_CAP) { atomicAdd(&bar[XB_TMO], 1u); break; } }
    }
    nloc = mine > 0u ? mine : 1u; nx = cnt > 0u ? cnt : 1u;
}

__device__ __forceinline__ void xcd_barrier(const XcdBarrier& b) {
    asm volatile("s_waitcnt vmcnt(0)" ::: "memory");
    __syncthreads();
    if (threadIdx.x == 0) {
        unsigned* bar = b.bar;
        __builtin_amdgcn_s_waitcnt(0);
        unsigned nloc = b.st[0], nx = b.st[1];
        if (nloc == 0u) { xcd_barrier_complete(bar, b.x, nloc, nx); b.st[0] = nloc; b.st[1] = nx; }
        const unsigned old = xb_add(&bar[XB_XSUB(b.x)], 1u);
        const unsigned gen = old / nloc;
        if (old + 1u == (gen + 1u) * nloc) {
            __builtin_amdgcn_fence(__ATOMIC_RELEASE, "agent");
            asm volatile("s_waitcnt vmcnt(0)" ::: "memory");
            const unsigned og = xb_add(&bar[XB_TOP], 1u);
            const unsigned tg = og / nx;
            if (og + 1u == (tg + 1u) * nx) xb_add(&bar[XB_TOPGEN], 1u);
            else XB_SPIN(xb_ld(&bar[XB_TOPGEN]) == tg, bar);
            __builtin_amdgcn_fence(__ATOMIC_ACQUIRE, "agent");
            xb_add(&bar[XB_XGEN(b.x)], 1u);
            asm volatile("s_waitcnt vmcnt(0)" ::: "memory");
        } else {
            XB_SPIN(xb_ld(&bar[XB_XGEN(b.x)]) == gen, bar);
            __builtin_amdgcn_fence(__ATOMIC_ACQUIRE, "agent");
            asm volatile("s_waitcnt vmcnt(0)" ::: "memory");
        }
    }
    __syncthreads();
}

__device__ __forceinline__ void transpose_item(const float* W, int ldw, int col0, int K, int Nn, const float* g, bf16_t* WT, int row_off, LAS float* scr, int item, int lane) {
    const int nblk = Nn / 32, kb = item / nblk, nb = item % nblk, k0 = 64 * kb, n0 = 32 * nb;
    f32x4 v[8]; const int c4 = (lane & 7) * 4;
#pragma unroll
    for (int i = 0; i < 8; ++i) { const int kk = (lane >> 3) + 8 * i; v[i] = *(const f32x4*)(W + (size_t)(k0 + kk) * ldw + col0 + n0 + c4); }
#pragma unroll
    for (int i = 0; i < 8; ++i) { const int kk = (lane >> 3) + 8 * i; f32x4 w = v[i]; if (g) w *= g[k0 + kk];
        scr[kk * 33 + c4 + 0] = w[0]; scr[kk * 33 + c4 + 1] = w[1]; scr[kk * 33 + c4 + 2] = w[2]; scr[kk * 33 + c4 + 3] = w[3]; }
    LDS_FENCE();
    const int c = lane & 7;
#pragma unroll
    for (int j = 0; j < 4; ++j) { const int n = (lane >> 3) + 8 * j; const LAS float* s = scr + (8 * c) * 33 + n;
        u32x4 o; o.x = cvtpk(s[0 * 33], s[1 * 33]); o.y = cvtpk(s[2 * 33], s[3 * 33]); o.z = cvtpk(s[4 * 33], s[5 * 33]); o.w = cvtpk(s[6 * 33], s[7 * 33]);
        *(u32x4*)(WT + (size_t)(row_off + n0 + n) * K + k0 + 8 * c) = o; }
    LDS_FENCE();
}
template <int NR> __device__ __forceinline__ void rms_rows_to_bf16(const float* x, const float* g, bf16_t* o, int lane) {
    const f32x4* gr = (const f32x4*)g + lane;
    f32x4 v[NR][4]; float rs[NR];
#pragma unroll
    for (int i = 0; i < NR; ++i)
#pragma unroll
        for (int j = 0; j < 4; ++j) v[i][j] = ((const f32x4*)(x + (size_t)i * DM) + lane)[64 * j];
#pragma unroll
    for (int i = 0; i < NR; ++i) {
        float s = 0.f;
#pragma unroll
        for (int j = 0; j < 4; ++j) s += (v[i][j][0] * v[i][j][0] + v[i][j][1] * v[i][j][1]) + (v[i][j][2] * v[i][j][2] + v[i][j][3] * v[i][j][3]);
        rs[i] = 1.0f / sqrtf(wave_sum(s) * (1.0f / 1024.0f) + 1e-6f);
    }
#pragma unroll
    for (int j = 0; j < 4; ++j) { const f32x4 gg = gr[64 * j];
#pragma unroll
        for (int i = 0; i < NR; ++i) { u32x2 w; w.x = cvtpk(v[i][j][0] * rs[i] * gg[0], v[i][j][1] * rs[i] * gg[1]); w.y = cvtpk(v[i][j][2] * rs[i] * gg[2], v[i][j][3] * rs[i] * gg[3]); ((u32x2*)(o + (size_t)i * DM) + lane)[64 * j] = w; } }
}
__device__ __forceinline__ void p0_prologue(const Params& p, LAS unsigned char* lds, int G) {
    const int tid = threadIdx.x, lane = tid & 63, wave = __builtin_amdgcn_readfirstlane(tid >> 6);
    unsigned char* ws = p.ws;
    LAS float* scr = (LAS float*)(lds + wave * WAVE_LDS);
    const int gw = blockIdx.x * NWAVES + wave, NGW = G * NWAVES;
    bf16_t* Win_t = (bf16_t*)(ws + WS_WIN);
    constexpr int I_INA = 16 * 32, I_INB = 16 * 64, I_OUT = 16 * 32, I_Q = 16 * 32, I_KV = 16 * 64, I_O = 16 * 32, I_1 = 16 * 128, I_2 = 64 * 32;
    constexpr int NITEMS = I_INA + I_INB + I_OUT + I_Q + I_KV + I_O + I_1 + I_2;
    for (int it = gw; it < NITEMS; it += NGW) {
        int r = it;
        if (r < I_INA) { transpose_item(p.w_in, 3088, 0, 1024, 1024, nullptr, Win_t, 0, scr, r, lane); continue; } r -= I_INA;
        if (r < I_INB) { transpose_item(p.w_in, 3088, 1040, 1024, 2048, nullptr, Win_t, 1024, scr, r, lane); continue; } r -= I_INB;
        if (r < I_OUT) { transpose_item(p.w_out, 1024, 0, 1024, 1024, nullptr, (bf16_t*)(ws + WS_WOUT), 0, scr, r, lane); continue; } r -= I_OUT;
        if (r < I_Q) { transpose_item(p.xa_w_q, 1024, 0, 1024, 1024, p.norm_x_g, (bf16_t*)(ws + WS_WQ), 0, scr, r, lane); continue; } r -= I_Q;
        if (r < I_KV) { transpose_item(p.xa_w_kv, 2048, 0, 1024, 2048, nullptr, (bf16_t*)(ws + WS_WKV), 0, scr, r, lane); continue; } r -= I_KV;
        if (r < I_O) { transpose_item(p.xa_w_o, 1024, 0, 1024, 1024, nullptr, (bf16_t*)(ws + WS_WO), 0, scr, r, lane); continue; } r -= I_O;
        if (r < I_1) { transpose_item(p.ffn_w1, 4096, 0, 1024, 4096, p.norm_ffn_g, (bf16_t*)(ws + WS_W1), 0, scr, r, lane); continue; } r -= I_1;
        transpose_item(p.ffn_w2, 1024, 0, 4096, 1024, nullptr, (bf16_t*)(ws + WS_W2), 0, scr, r, lane);
    }
    const int gt = blockIdx.x * NTHREADS + tid, NGT = G * NTHREADS;
    for (int o = gt; o < 256 * 1024; o += NGT) {
        const int n = o >> 10, k = o & 1023; const float* wr = p.w_in + (size_t)k * 3088 + 1024; float s = 0.f;
#pragma unroll
        for (int r = 0; r < 16; ++r) s += wr[r] * p.gla_w_gate[r * 256 + n];
        Win_t[(size_t)(3072 + n) * 1024 + k] = f2bf(s);
    }
    float* cosT = (float*)(ws + WS_COS); float* sinT = (float*)(ws + WS_SIN);
    for (int o = gt; o < SEQ * 32; o += NGT) {
        const int pos = o >> 5, i = o & 31; double f = 1.0;
        for (int k = 0; k < i; ++k) f *= 0.7498942093324559;
        const double t = (double)pos * f * 0.15915494309189535;
        const float fr = (float)(t - floor(t));
        cosT[o] = __builtin_amdgcn_cosf(fr); sinT[o] = __builtin_amdgcn_sinf(fr);
    }
    bf16_t* XN = (bf16_t*)(ws + WS_A1); bf16_t* MEMN = (bf16_t*)(ws + WS_MEMN);
    for (int m4 = gw; m4 < (NTOK + NMEMROWS) / 4; m4 += NGW) {
        const int m = 4 * m4;
        if (m < NTOK) rms_rows_to_bf16<4>(p.x + (size_t)m * DM, p.norm_mix_g, XN + (size_t)m * DM, lane);
        else rms_rows_to_bf16<4>(p.mem + (size_t)(m - NTOK) * DM, p.norm_mem_g, MEMN + (size_t)(m - NTOK) * DM, lane);
    }
}

__device__ __forceinline__ void gla_gates(const bf16_t* P, int zcol, const float* bg, int r, int q, float (&bc)[4][2][8], float (&bl)[2][8]) {
    bf16x8 zf[4][2];
#pragma unroll
    for (int mt = 0; mt < 4; ++mt)
#pragma unroll
        for (int ks = 0; ks < 2; ++ks) zf[mt][ks] = *(const bf16x8*)(P + (size_t)(16 * mt + r) * NPROJ + zcol + 32 * ks + 8 * q);
    CFENCE();
#pragma unroll
    for (int ks = 0; ks < 2; ++ks) {
        const f32x4 b0 = *(const f32x4*)(bg + 32 * ks + 8 * q), b1 = *(const f32x4*)(bg + 32 * ks + 8 * q + 4);
#pragma unroll
        for (int mt = 0; mt < 4; ++mt) {
            f32x4 z0, z1; unpack8(zf[mt][ks], z0, z1); z0 += b0; z1 += b1;
#pragma unroll
            for (int e = 0; e < 4; ++e) {
                bc[mt][ks][e] = (fminf(z0[e], 0.f) - __logf(1.0f + __expf(-fabsf(z0[e])))) * (1.0f / 16.0f);
                bc[mt][ks][4 + e] = (fminf(z1[e], 0.f) - __logf(1.0f + __expf(-fabsf(z1[e])))) * (1.0f / 16.0f);
            }
        }
#pragma unroll
        for (int e = 0; e < 8; ++e) {
            float carry = 0.f;
#pragma unroll
            for (int mt = 0; mt < 4; ++mt) { const float v = scan16(bc[mt][ks][e], r); const float tot = __shfl(v, 15, 16); bc[mt][ks][e] = v + carry; carry += tot; }
            bl[ks][e] = carry;
        }
    }
}
__device__ __forceinline__ float ret_log2g(int hr) { return hr == 0 ? -0.04580368961312479f : hr == 1 ? -0.008973692110584325f : hr == 2 ? -0.0017761724589428754f : -0.0003522634716290214f; }
__device__ __forceinline__ void rope_tile(bf16x8 f0, bf16x8 f1, const float* cosT, const float* sinT, int pos, int q, f32x4 (&o)[4]) {
    f32x4 a0, a1, b0, b1; unpack8(f0, a0, a1); unpack8(f1, b0, b1);
    const f32x4 c0 = *(const f32x4*)(cosT + pos * 32 + 8 * q), c1 = *(const f32x4*)(cosT + pos * 32 + 8 * q + 4), s0 = *(const f32x4*)(sinT + pos * 32 + 8 * q), s1 = *(const f32x4*)(sinT + pos * 32 + 8 * q + 4);
    o[0] = a0 * c0 - b0 * s0; o[1] = a1 * c1 - b1 * s1; o[2] = a0 * s0 + b0 * c0; o[3] = a1 * s1 + b1 * c1;
}

__device__ __forceinline__ void chunk_contrib(const Params& p, LAS unsigned char* lds, int G) {
    const int tid = threadIdx.x, lane = tid & 63, wave = __builtin_amdgcn_readfirstlane(tid >> 6);
    unsigned char* ws = p.ws;
    const bf16_t* PROJ = (const bf16_t*)(ws + WS_BIG); bf16_t* CT = (bf16_t*)(ws + WS_A2); float* DEC = (float*)(ws + WS_DEC);
    const float* cosT = (const float*)(ws + WS_COS); const float* sinT = (const float*)(ws + WS_SIN);
    LAS bf16_t* Kdt = (LAS bf16_t*)(lds + wave * WAVE_LDS); LAS bf16_t* Vt = Kdt + 64 * VPITCH;
    for (int u = blockIdx.x * NWAVES + wave; u < NBATCH * NCHUNK * 8; u += G * NWAVES) {
        int h8 = u & 7; asm volatile("" : "+s"(h8));
        const int bn = u >> 3, b = bn >> 7, n = bn & 127;
        const size_t tok0 = (size_t)b * SEQ + (size_t)n * 64;
        const bf16_t* P = PROJ + tok0 * NPROJ;
        const int unit = (b * 8 + h8) * NCHUNK + n;
        int ln = lane; asm volatile("" : "+v"(ln));
        const int r = ln & 15, q = ln >> 4;
        const int vcol = (h8 < 4) ? C_GV + h8 * 128 : C_RV + (h8 - 4) * 128;
        const int kcol = (h8 < 4) ? C_GK + h8 * 64 : C_RK + (h8 - 4) * 64;
        bf16x8 kf[4][2];
#pragma unroll
        for (int mt = 0; mt < 4; ++mt)
#pragma unroll
            for (int ks = 0; ks < 2; ++ks) kf[mt][ks] = *(const bf16x8*)(P + (size_t)(16 * mt + r) * NPROJ + kcol + 32 * ks + 8 * q);
        LDS_FENCE();
        if (h8 < 4) {
            const int h = h8;
            float bc[4][2][8], bl[2][8];
            gla_gates(P, C_Z + h * 64, p.gla_b_gate + h * 64, r, q, bc, bl);
            if (r == 0) {
#pragma unroll
                for (int ks = 0; ks < 2; ++ks) {
                    f32x4 d0, d1;
#pragma unroll
                    for (int e = 0; e < 4; ++e) { d0[e] = __expf(bl[ks][e]); d1[e] = __expf(bl[ks][4 + e]); }
                    *(f32x4*)(DEC + (size_t)unit * 64 + 32 * ks + 8 * q) = d0; *(f32x4*)(DEC + (size_t)unit * 64 + 32 * ks + 8 * q + 4) = d1;
                }
            }
#pragma unroll
            for (int mt = 0; mt < 4; ++mt)
#pragma unroll
                for (int ks = 0; ks < 2; ++ks) {
                    f32x4 k0, k1; unpack8(kf[mt][ks], k0, k1);
#pragma unroll
                    for (int e = 0; e < 4; ++e) {
                        Kdt[(32 * ks + 8 * q + e) * VPITCH + 16 * mt + r] = f2bf(k0[e] * __expf(bl[ks][e] - bc[mt][ks][e]));
                        Kdt[(32 * ks + 8 * q + 4 + e) * VPITCH + 16 * mt + r] = f2bf(k1[e] * __expf(bl[ks][4 + e] - bc[mt][ks][4 + e]));
                    }
                }
        } else {
            const int hr = h8 - 4; const float l2g = ret_log2g(hr);
            if (r == 0) {
                const float d = exp2f(64.0f * l2g); const f32x4 dv = {d, d, d, d};
#pragma unroll
                for (int ks = 0; ks < 2; ++ks) { *(f32x4*)(DEC + (size_t)unit * 64 + 32 * ks + 8 * q) = dv; *(f32x4*)(DEC + (size_t)unit * 64 + 32 * ks + 8 * q + 4) = dv; }
            }
#pragma unroll
            for (int mt = 0; mt < 4; ++mt) {
                CFENCE();
                f32x4 o[4]; rope_tile(kf[mt][0], kf[mt][1], cosT, sinT, n * 64 + 16 * mt + r, q, o);
                const float sc = 0.125f * exp2f((float)(63 - (16 * mt + r)) * l2g);
#pragma unroll
                for (int e = 0; e < 4; ++e) {
                    Kdt[(8 * q + e) * VPITCH + 16 * mt + r] = f2bf(o[0][e] * sc); Kdt[(8 * q + 4 + e) * VPITCH + 16 * mt + r] = f2bf(o[1][e] * sc);
                    Kdt[(32 + 8 * q + e) * VPITCH + 16 * mt + r] = f2bf(o[2][e] * sc); Kdt[(32 + 8 * q + 4 + e) * VPITCH + 16 * mt + r] = f2bf(o[3][e] * sc);
                }
            }
        }
        bf16_t* outp = CT + (size_t)unit * 8192;
#pragma unroll 1
        for (int vh = 0; vh < 2; ++vh) {
            CFENCE();
            bf16x8 xv[8];
#pragma unroll
            for (int i = 0; i < 8; ++i) xv[i] = *(const bf16x8*)(P + (size_t)(i * 8 + (ln >> 3)) * NPROJ + vcol + vh * 64 + (ln & 7) * 8);
            LDS_FENCE();
#pragma unroll
            for (int i = 0; i < 8; ++i) {
                const int token = i * 8 + (ln >> 3), vv = (ln & 7) * 8;
#pragma unroll
                for (int e = 0; e < 8; ++e) Vt[(vv + e) * VPITCH + token] = (bf16_t)xv[i][e];
            }
            LDS_FENCE();
#pragma unroll
            for (int vt = 0; vt < 4; ++vt) {
                CFENCE();
                bf16x8 a[2];
#pragma unroll
                for (int s = 0; s < 2; ++s) a[s] = *(const LAS bf16x8*)(Vt + (16 * vt + r) * VPITCH + 32 * s + 8 * q);
#pragma unroll
                for (int dt = 0; dt < 4; ++dt) {
                    f32x4 acc = {0.f, 0.f, 0.f, 0.f};
#pragma unroll
                    for (int s = 0; s < 2; ++s) { const bf16x8 bb = *(const LAS bf16x8*)(Kdt + (16 * dt + r) * VPITCH + 32 * s + 8 * q); acc = MFMA16(a[s], bb, acc); }
#pragma unroll
                    for (int e = 0; e < 4; ++e) outp[(vh * 64 + 16 * vt + 4 * q + e) * 64 + 16 * dt + r] = f2bf(acc[e]);
                }
            }
        }
    }
}

__device__ __forceinline__ void chunk_scan(const Params& p, int G) {
    unsigned char* ws = p.ws; bf16_t* CT = (bf16_t*)(ws + WS_A2); const float* DEC = (const float*)(ws + WS_DEC);
    typedef float f32x2v __attribute__((ext_vector_type(2)));
    const int NGT = G * NTHREADS;
    for (int o = blockIdx.x * NTHREADS + threadIdx.x; o < 32 * 128 * 32; o += NGT) {
        const int d2 = o & 31, v = (o >> 5) & 127, bh = o >> 12;
        bf16_t* base = CT + (size_t)bh * NCHUNK * 8192 + v * 64 + d2 * 2; const float* dbase = DEC + (size_t)bh * NCHUNK * 64 + d2 * 2;
        float s0 = 0.f, s1 = 0.f;
#pragma unroll 1
        for (int n0 = 0; n0 < NCHUNK; n0 += 32) {
            unsigned uu[32]; f32x2v dd[32];
#pragma unroll
            for (int j = 0; j < 32; ++j) { uu[j] = *(const unsigned*)(base + (size_t)(n0 + j) * 8192); dd[j] = *(const f32x2v*)(dbase + (size_t)(n0 + j) * 64); }
#pragma unroll
            for (int j = 0; j < 32; ++j) {
                *(unsigned*)(base + (size_t)(n0 + j) * 8192) = cvtpk(s0, s1);
                s0 = dd[j][0] * s0 + __uint_as_float(uu[j] << 16); s1 = dd[j][1] * s1 + __uint_as_float(uu[j] & 0xffff0000u);
            }
        }
    }
}

template <bool GN> __device__ __forceinline__ void norm_gate_store(const f32x4 (&O)[8], const bf16x8 (&gt)[4], const float (&gn)[8], int it, int r, int q, bf16_t* y) {
    f32x4 mean = {0.f, 0.f, 0.f, 0.f};
    if (GN) {
        f32x4 s = {0.f, 0.f, 0.f, 0.f};
#pragma unroll
        for (int vt = 0; vt < 8; ++vt) s += O[vt];
#pragma unroll
        for (int e = 0; e < 4; ++e) { float t = s[e]; t += __shfl_xor(t, 1); t += __shfl_xor(t, 2); t += __shfl_xor(t, 4); t += __shfl_xor(t, 8); mean[e] = t * (1.0f / 128.0f); }
    }
    f32x4 ss = {0.f, 0.f, 0.f, 0.f};
#pragma unroll
    for (int vt = 0; vt < 8; ++vt) { const f32x4 d = O[vt] - mean; ss += d * d; }
    f32x4 rstd;
#pragma unroll
    for (int e = 0; e < 4; ++e) { float t = ss[e]; t += __shfl_xor(t, 1); t += __shfl_xor(t, 2); t += __shfl_xor(t, 4); t += __shfl_xor(t, 8); rstd[e] = __builtin_amdgcn_rsqf(t * (1.0f / 128.0f) + 1e-6f); }
#pragma unroll
    for (int e = 0; e < 4; ++e) {
        const int i = 16 * it + 4 * q + e;
        f32x4 g0, g1; unpack8(gt[e], g0, g1);
        f32x4 o0, o1;
#pragma unroll
        for (int vt = 0; vt < 4; ++vt) {
            const float ga = g0[vt], gb = g1[vt];
            o0[vt] = (O[vt][e] - mean[e]) * rstd[e] * gn[vt] * (ga * __builtin_amdgcn_rcpf(1.0f + __expf(-ga)));
            o1[vt] = (O[4 + vt][e] - mean[e]) * rstd[e] * gn[4 + vt] * (gb * __builtin_amdgcn_rcpf(1.0f + __expf(-gb)));
        }
        *(bf16x8*)(y + (size_t)i * DM + 8 * r) = pack8(o0, o1);
    }
}
__device__ __forceinline__ void out_tile(f32x4 (&O)[8], const bf16x8 (&pf)[2], const bf16x8 (&qi)[2], const LAS bf16_t* Vt, const bf16x8 (&spf)[8][2], int r, int q) {
#pragma unroll
    for (int vt = 0; vt < 8; ++vt) {
        f32x4 acc = {0.f, 0.f, 0.f, 0.f};
#pragma unroll
        for (int s = 0; s < 2; ++s) {
            const u32x2 lo = *(const LAS u32x2*)(Vt + (16 * vt + r) * VPITCH + 32 * s + 4 * q), hi = *(const LAS u32x2*)(Vt + (16 * vt + r) * VPITCH + 32 * s + 16 + 4 * q);
            const u32x4 w = {lo.x, lo.y, hi.x, hi.y};
            acc = MFMA16(pf[s], __builtin_bit_cast(bf16x8, w), acc);
        }
#pragma unroll
        for (int ks = 0; ks < 2; ++ks) acc = MFMA16(qi[ks], spf[vt][ks], acc);
        O[vt] = acc;
    }
}
template <bool GN> __device__ __forceinline__ void out_all(const bf16x8 (&pfa)[4][2], const bf16x8 (&QI)[4][2], const LAS bf16_t* Vt, const bf16_t* SP, const float* gain, const bf16_t* gate, bf16_t* y, int r, int q) {
    bf16x8 spf[8][2]; float gn[8];
    { const f32x4 ga = *(const f32x4*)(gain + 8 * r), gb = *(const f32x4*)(gain + 8 * r + 4);
#pragma unroll
      for (int vt = 0; vt < 4; ++vt) { gn[vt] = ga[vt]; gn[4 + vt] = gb[vt]; } }
#pragma unroll
    for (int vt = 0; vt < 8; ++vt)
#pragma unroll
        for (int ks = 0; ks < 2; ++ks) spf[vt][ks] = *(const bf16x8*)(SP + (8 * r + vt) * 64 + 32 * ks + 8 * q);
#pragma unroll
    for (int it = 0; it < 4; ++it) {
        CFENCE();
        bf16x8 gt[4];
#pragma unroll
        for (int e = 0; e < 4; ++e) gt[e] = *(const bf16x8*)(gate + (size_t)(16 * it + 4 * q + e) * NPROJ + 8 * r);
        CFENCE();
        f32x4 O[8];
        out_tile(O, pfa[it], QI[it], Vt, spf, r, q);
        CFENCE();
        norm_gate_store<GN>(O, gt, gn, it, r, q, y);
    }
}

__device__ __forceinline__ void chunk_output(const Params& p, LAS unsigned char* lds, int G) {
    const int tid = threadIdx.x, lane = tid & 63, wave = __builtin_amdgcn_readfirstlane(tid >> 6);
    unsigned char* ws = p.ws;
    const bf16_t* PROJ = (const bf16_t*)(ws + WS_BIG); const bf16_t* SPB = (const bf16_t*)(ws + WS_A2); bf16_t* Y = (bf16_t*)(ws + WS_A1);
    const float* cosT = (const float*)(ws + WS_COS); const float* sinT = (const float*)(ws + WS_SIN);
    LAS bf16_t* Vt = (LAS bf16_t*)(lds + wave * WAVE_LDS);
    for (int u = blockIdx.x * NWAVES + wave; u < NBATCH * NCHUNK * 8; u += G * NWAVES) {
        int h8 = u & 7; asm volatile("" : "+s"(h8));
        const int bn = u >> 3, b = bn >> 7, n = bn & 127;
        const size_t tok0 = (size_t)b * SEQ + (size_t)n * 64;
        const bf16_t* P = PROJ + tok0 * NPROJ;
        const int unit = (b * 8 + h8) * NCHUNK + n;
        const bf16_t* SP = SPB + (size_t)unit * 8192;
        int ln = lane; asm volatile("" : "+v"(ln));
        const int r = ln & 15, q = ln >> 4;
        const int vcol = (h8 < 4) ? C_GV + h8 * 128 : C_RV + (h8 - 4) * 128;
        LDS_FENCE();
        {
            bf16x8 xv[16];
#pragma unroll
            for (int i = 0; i < 16; ++i) xv[i] = *(const bf16x8*)(P + (size_t)(i * 4 + q) * NPROJ + vcol + r * 8);
            CFENCE();
#pragma unroll
            for (int i = 0; i < 16; ++i) {
                const int token = i * 4 + q;
#pragma unroll
                for (int e = 0; e < 8; ++e) Vt[(16 * e + r) * VPITCH + token] = (bf16_t)xv[i][e];
            }
        }
        LDS_FENCE();
        CFENCE();
#ifdef NO_GLA4
        if (false) {
#else
        if (h8 < 4) {
#endif
            const int h = h8;
            bf16x8 Qe[4][2], Qi[4][2], Ki[4][2], Ke[4][2], pfa[4][2];
            {
                bf16x8 qf[4][2], kf[4][2];
#pragma unroll
                for (int mt = 0; mt < 4; ++mt)
#pragma unroll
                    for (int ks = 0; ks < 2; ++ks) {
                        qf[mt][ks] = *(const bf16x8*)(P + (size_t)(16 * mt + r) * NPROJ + C_GQ + h * 64 + 32 * ks + 8 * q);
                        kf[mt][ks] = *(const bf16x8*)(P + (size_t)(16 * mt + r) * NPROJ + C_GK + h * 64 + 32 * ks + 8 * q);
                    }
                float bc[4][2][8], bl[2][8];
                gla_gates(P, C_Z + h * 64, p.gla_b_gate + h * 64, r, q, bc, bl);
#pragma unroll
                for (int mt = 0; mt < 4; ++mt)
#pragma unroll
                    for (int ks = 0; ks < 2; ++ks) {
                        CFENCE();
                        f32x4 q0, q1, k0, k1; unpack8(qf[mt][ks], q0, q1); unpack8(kf[mt][ks], k0, k1);
                        f32x4 e0, e1, i0, i1;
#pragma unroll
                        for (int e = 0; e < 4; ++e) { e0[e] = __expf(bc[mt][ks][e]); e1[e] = __expf(bc[mt][ks][4 + e]); i0[e] = __expf(-bc[mt][ks][e]); i1[e] = __expf(-bc[mt][ks][4 + e]); }
                        Qe[mt][ks] = pack8(q0 * e0 * 0.125f, q1 * e1 * 0.125f); Qi[mt][ks] = pack8(q0 * i0 * 0.125f, q1 * i1 * 0.125f);
                        Ki[mt][ks] = pack8(k0 * i0, k1 * i1); Ke[mt][ks] = pack8(k0 * e0, k1 * e1);
                    }
            }
#pragma unroll
            for (int it = 0; it < 4; ++it) {
                f32x4 Pt[4];
#pragma unroll
                for (int jt = 0; jt < 4; ++jt) {
                    f32x4 lo = {0.f, 0.f, 0.f, 0.f}, up = {0.f, 0.f, 0.f, 0.f};
                    if (jt <= it) { lo = MFMA16(Ki[jt][0], Qe[it][0], lo); lo = MFMA16(Ki[jt][1], Qe[it][1], lo); }
                    if (jt >= it) { up = MFMA16(Ke[jt][0], Qi[it][0], up); up = MFMA16(Ke[jt][1], Qi[it][1], up); }
                    if (jt < it) Pt[jt] = lo; else if (jt > it) Pt[jt] = up;
                    else {
#pragma unroll
                        for (int e = 0; e < 4; ++e) Pt[jt][e] = (4 * q + e <= r) ? lo[e] : up[e];
                    }
                }
                pfa[it][0] = pack8(Pt[0], Pt[1]); pfa[it][1] = pack8(Pt[2], Pt[3]);
                CFENCE();
            }
            out_all<false>(pfa, Qe, Vt, SP, p.gla_norm_g + h * 128, P + C_GG + h * 128, Y + tok0 * DM + h * 128, r, q);
        }
#ifdef NO_RET4
        else if (false) {
#else
        else {
#endif
            const int hr = h8 - 4; const float l2g = ret_log2g(hr);
            bf16x8 Qr[4][2], Qd[4][2], Kr[4][2], pfa[4][2];
            {
                bf16x8 qf[4][2], kf[4][2];
#pragma unroll
                for (int mt = 0; mt < 4; ++mt)
#pragma unroll
                    for (int ks = 0; ks < 2; ++ks) {
                        qf[mt][ks] = *(const bf16x8*)(P + (size_t)(16 * mt + r) * NPROJ + C_RQ + hr * 64 + 32 * ks + 8 * q);
                        kf[mt][ks] = *(const bf16x8*)(P + (size_t)(16 * mt + r) * NPROJ + C_RK + hr * 64 + 32 * ks + 8 * q);
                    }
#pragma unroll
                for (int mt = 0; mt < 4; ++mt) {
                    const int pos = n * 64 + 16 * mt + r;
                    CFENCE();
                    {
                        f32x4 o[4]; rope_tile(qf[mt][0], qf[mt][1], cosT, sinT, pos, q, o);
                        Qr[mt][0] = pack8(o[0], o[1]); Qr[mt][1] = pack8(o[2], o[3]);
                        const float qd = exp2f((float)(16 * mt + r + 1) * l2g);
                        Qd[mt][0] = pack8(o[0] * qd, o[1] * qd); Qd[mt][1] = pack8(o[2] * qd, o[3] * qd);
                    }
                    CFENCE();
                    {
                        f32x4 o[4]; rope_tile(kf[mt][0], kf[mt][1], cosT, sinT, pos, q, o);
                        Kr[mt][0] = pack8(o[0] * 0.125f, o[1] * 0.125f); Kr[mt][1] = pack8(o[2] * 0.125f, o[3] * 0.125f);
                    }
                }
            }
#pragma unroll
            for (int it = 0; it < 4; ++it) {
                f32x4 Pt[4];
#pragma unroll
                for (int jt = 0; jt < 4; ++jt) {
                    f32x4 st = {0.f, 0.f, 0.f, 0.f};
                    st = MFMA16(Kr[jt][0], Qr[it][0], st); st = MFMA16(Kr[jt][1], Qr[it][1], st);
#pragma unroll
                    for (int e = 0; e < 4; ++e) { const int dj = (16 * it + r) - (16 * jt + 4 * q + e); Pt[jt][e] = st[e] * exp2f((float)(dj < 0 ? -dj : dj) * l2g); }
                }
                pfa[it][0] = pack8(Pt[0], Pt[1]); pfa[it][1] = pack8(Pt[2], Pt[3]);
                CFENCE();
            }
            out_all<true>(pfa, Qd, Vt, SP, p.ret_norm_g + hr * 128, P + C_RG + hr * 128, Y + tok0 * DM + 512 + hr * 128, r, q);
        }
    }
}

__device__ __forceinline__ void stage_image(LAS unsigned char* lds, const bf16_t* src, int tid) {
#pragma unroll
    for (int i = 0; i < 16; ++i) { const int row = (tid >> 5) + 16 * i, c = tid & 31; const u32x4 x = *(const u32x4*)(src + (size_t)row * 256 + c * 8);
        *(LAS u32x4*)(lds + (16 * (tid >> 5) + i) * APITCH + c * 16) = x; }
}
__device__ __forceinline__ void cross_attention(const Params& p, LAS unsigned char* lds, int G) {
    const int tid = threadIdx.x, lane = tid & 63, wave = __builtin_amdgcn_readfirstlane(tid >> 6);
    unsigned char* ws = p.ws;
    const bf16_t* Q = (const bf16_t*)(ws + WS_A1); const bf16_t* Kb = (const bf16_t*)(ws + WS_KB); const bf16_t* Vtg = (const bf16_t*)(ws + WS_VT); bf16_t* OA = (bf16_t*)(ws + WS_BIG);
    for (int u = blockIdx.x; u < 512; u += G) {
        const int bh = u >> 5, b = bh >> 2, h = bh & 3, qb = u & 31;
        int ln = lane; asm volatile("" : "+v"(ln));
        const int r = ln & 15, q = ln >> 4;
        const size_t i0 = (size_t)b * SEQ + qb * 256 + wave * 32;
        __syncthreads();
        {
#pragma unroll
            for (int i = 0; i < 16; ++i) { const int row = (tid >> 5) + 16 * i, c = tid & 31; const u32x4 x = *(const u32x4*)(Kb + (size_t)(b * 256 + row) * 1024 + h * 256 + c * 8); *(LAS u32x4*)(lds + row * APITCH + c * 16) = x; }
        }
        bf16x8 Qf[2][8];
#pragma unroll
        for (int it = 0; it < 2; ++it)
#pragma unroll
            for (int ks = 0; ks < 8; ++ks) Qf[it][ks] = *(const bf16x8*)(Q + (i0 + 16 * it + r) * DM + h * 256 + 32 * ks + 8 * q);
        __syncthreads();
        bf16x8 pf[2][8];
        {
            f32x4 S[2][16];
#pragma unroll
            for (int mt = 0; mt < 16; ++mt) {
                f32x4 a0 = {0.f, 0.f, 0.f, 0.f}, a1 = {0.f, 0.f, 0.f, 0.f};
                CFENCE();
#pragma unroll
                for (int ks = 0; ks < 8; ++ks) { const bf16x8 a = *(const LAS bf16x8*)(lds + (16 * mt + r) * APITCH + (32 * ks + 8 * q) * 2); a0 = MFMA16(a, Qf[0][ks], a0); a1 = MFMA16(a, Qf[1][ks], a1); }
                S[0][mt] = a0; S[1][mt] = a1;
            }
#pragma unroll
            for (int it = 0; it < 2; ++it) {
                CFENCE();
                float mx = -3.0e38f;
#pragma unroll
                for (int mt = 0; mt < 16; ++mt) mx = fmaxf(fmaxf(fmaxf(S[it][mt][0], S[it][mt][1]), fmaxf(S[it][mt][2], S[it][mt][3])), mx);
                mx = fmaxf(mx, __shfl_xor(mx, 16)); mx = fmaxf(mx, __shfl_xor(mx, 32));
                CFENCE();
                float sum = 0.f;
#pragma unroll
                for (int mt = 0; mt < 16; ++mt) {
#pragma unroll
                    for (int e = 0; e < 4; ++e) { S[it][mt][e] = __builtin_amdgcn_exp2f(S[it][mt][e] - mx); sum += S[it][mt][e]; }
                }
                sum += __shfl_xor(sum, 16); sum += __shfl_xor(sum, 32);
                const float inv = 1.0f / sum;
                CFENCE();
#pragma unroll
                for (int s = 0; s < 8; ++s) { pf[it][s] = pack8(S[it][2 * s] * inv, S[it][2 * s + 1] * inv); CFENCE(); }
            }
        }
        __syncthreads();
        stage_image(lds, Vtg + (size_t)(b * 1024 + h * 256) * 256, tid);
        __syncthreads();
        unsigned ob[2][4][8];
#pragma unroll
        for (int np = 0; np < 8; ++np) {
            f32x4 a0[2], a1[2];
#pragma unroll
            for (int h2 = 0; h2 < 2; ++h2) {
                const int nt = 2 * np + h2;
                f32x4 c0 = {0.f, 0.f, 0.f, 0.f}, c1 = {0.f, 0.f, 0.f, 0.f};
                CFENCE();
#pragma unroll
                for (int s = 0; s < 8; ++s) {
                    const u32x2 lo = *(const LAS u32x2*)(lds + (16 * nt + r) * APITCH + (32 * s + 4 * q) * 2), hi = *(const LAS u32x2*)(lds + (16 * nt + r) * APITCH + (32 * s + 16 + 4 * q) * 2);
                    const u32x4 w = {lo.x, lo.y, hi.x, hi.y};
                    c0 = MFMA16(pf[0][s], __builtin_bit_cast(bf16x8, w), c0); c1 = MFMA16(pf[1][s], __builtin_bit_cast(bf16x8, w), c1);
                }
                a0[h2] = c0; a1[h2] = c1;
            }
#pragma unroll
            for (int e = 0; e < 4; ++e) { ob[0][e][np] = cvtpk(a0[0][e], a0[1][e]); ob[1][e][np] = cvtpk(a1[0][e], a1[1][e]); }
        }
#pragma unroll
        for (int it = 0; it < 2; ++it)
#pragma unroll
            for (int e = 0; e < 4; ++e) {
                bf16_t* o = OA + (i0 + 16 * it + 4 * q + e) * DM + h * 256 + 16 * r;
                const u32x4 w0 = {ob[it][e][0], ob[it][e][1], ob[it][e][2], ob[it][e][3]}, w1 = {ob[it][e][4], ob[it][e][5], ob[it][e][6], ob[it][e][7]};
                *(u32x4*)o = w0; *(u32x4*)(o + 8) = w1;
            }
    }
}

__device__ __forceinline__ void final_norm(const Params& p, int G) {
    const int lane = threadIdx.x & 63, wave = __builtin_amdgcn_readfirstlane(threadIdx.x >> 6);
    const bf16_t* H = (const bf16_t*)(p.ws + WS_A2); const float* SSQ = (const float*)(p.ws + WS_SSQ3);
    const f32x4 g0 = *(const f32x4*)(p.final_norm_g + lane * 8), g1 = *(const f32x4*)(p.final_norm_g + lane * 8 + 4), g2 = *(const f32x4*)(p.final_norm_g + 512 + lane * 8), g3 = *(const f32x4*)(p.final_norm_g + 512 + lane * 8 + 4);
    for (int m4 = blockIdx.x * NWAVES + wave; m4 < NTOK / 4; m4 += G * NWAVES) {
        bf16x8 h0[4], h1[4]; f32x4 sp[4];
#pragma unroll
        for (int j = 0; j < 4; ++j) {
            const size_t m = (size_t)m4 * 4 + j;
            h0[j] = *(const bf16x8*)(H + m * DM + lane * 8); h1[j] = *(const bf16x8*)(H + m * DM + 512 + lane * 8);
            sp[j] = *(const f32x4*)(SSQ + m * 16 + 4 * (lane & 3));
        }
#pragma unroll
        for (int j = 0; j < 4; ++j) {
            const size_t m = (size_t)m4 * 4 + j;
            float t = (sp[j][0] + sp[j][1]) + (sp[j][2] + sp[j][3]);
            t += __shfl_xor(t, 1); t += __shfl_xor(t, 2);
            const float rstd = 1.0f / sqrtf(t * (1.0f / 1024.0f) + 1e-6f);
            f32x4 a0, a1, b0, b1; unpack8(h0[j], a0, a1); unpack8(h1[j], b0, b1);
            float* o = p.out + m * DM + lane * 8;
            *(f32x4*)(o) = a0 * rstd * g0; *(f32x4*)(o + 4) = a1 * rstd * g1; *(f32x4*)(o + 512) = b0 * rstd * g2; *(f32x4*)(o + 516) = b1 * rstd * g3;
        }
    }
}

constexpr int NPHASE = 12;
__global__ void __launch_bounds__(NTHREADS, 2) fwd_megakernel(Params p) {
    extern __shared__ __attribute__((aligned(16))) unsigned char lds_raw[];
    LAS unsigned char* lds = (LAS unsigned char*)lds_raw;
    cg::grid_group grid = cg::this_grid();
    const int G = gridDim.x, lo = p.ph_lo, hi = p.ph_hi;
    unsigned char* ws = p.ws;
#define IN(k) (lo <= (k) && (k) < hi)
#ifndef DBG_REP
#define DBG_REP (-1)
#endif
#define REPS(k) ((DBG_REP) == (k) ? 2 : 1)
#define SEAM(k) do { if (IN(k) && IN((k) + 1)) { if ((k) == 0) { asm volatile("s_waitcnt vmcnt(0) lgkmcnt(0)" ::: "memory"); grid.sync(); __builtin_amdgcn_fence(__ATOMIC_ACQUIRE, "agent"); asm volatile("s_waitcnt vmcnt(0)" ::: "memory"); } \
    else xcd_barrier(bar); } } while (0)
    LAS unsigned* misc = (LAS unsigned*)(lds + MISC_OFF);
    if (threadIdx.x < 16) misc[threadIdx.x] = 0u;
    __syncthreads();
    XcdBarrier bar; bar.bar = (unsigned*)(ws + WS_CTL); bar.x = 0; bar.st = nullptr;
    if (hi - lo > 1) bar = xcd_barrier_post((unsigned*)(ws + WS_CTL), (volatile LAS unsigned*)misc);
#ifndef NO_P0
    if (IN(0)) { p0_prologue(p, lds, G); }
#endif
#if defined(DBG_REP) && DBG_REP == 0
    __syncthreads(); if (IN(0)) { p0_prologue(p, lds, G); }
#endif
    SEAM(0);
    if (IN(1)) {
        {
            pg8::Gemm g{(const bf16_t*)(ws + WS_A1), (const bf16_t*)(ws + WS_WIN), NTOK, NPROJ, DM}; pg8::StaticOrder S; S.init(NTOK, NPROJ, G, (int)blockIdx.x);
            pg8::EpiBf16<0> E{(bf16_t*)(ws + WS_BIG), NPROJ, nullptr, 0, 0, 1.f};
            pg8::gemm_phase<pg8::EpiBf16<0>, pg8::StaticOrder, true, true>(lds, g, S, E);
        }
        __syncthreads();
        {
            pg8::Gemm g{(const bf16_t*)(ws + WS_MEMN), (const bf16_t*)(ws + WS_WKV), NMEMROWS, 2048, DM}; pg8::StaticOrder S; S.init(NMEMROWS, 2048, G, (int)((blockIdx.x + G / 2) % G));
            pg8::EpiKV E{(bf16_t*)(ws + WS_KB), (bf16_t*)(ws + WS_VT)};
            pg8::gemm_phase<pg8::EpiKV, pg8::StaticOrder, true, true>(lds, g, S, E);
        }
        __syncthreads();
    } SEAM(1);
    #ifndef NO_P2
    if (IN(2)) { chunk_contrib(p, lds, G); }
#endif
#if defined(DBG_REP) && DBG_REP == 2
    __syncthreads(); if (IN(2)) { chunk_contrib(p, lds, G); }
#endif
    SEAM(2);
    if (IN(3)) { chunk_scan(p, G); } SEAM(3);
    #ifndef NO_P4
    if (IN(4)) { chunk_output(p, lds, G); }
#endif
#if defined(DBG_REP) && DBG_REP == 4
    __syncthreads(); if (IN(4)) { chunk_output(p, lds, G); }
#endif
    SEAM(4);
    if (IN(5)) {
        pg8::Gemm g{(const bf16_t*)(ws + WS_A1), (const bf16_t*)(ws + WS_WOUT), NTOK, DM, DM}; pg8::StaticOrder S; S.init(NTOK, DM, G, (int)blockIdx.x);
        pg8::EpiRes<false> E{p.x, (bf16_t*)(ws + WS_A2), (float*)(ws + WS_SSQ1)};
        pg8::gemm_phase<pg8::EpiRes<false>, pg8::StaticOrder, true, true>(lds, g, S, E);
        __syncthreads();
    } SEAM(5);
#ifdef DBG_XBAR
    if (IN(5) && IN(6)) { for (int i_ = 0; i_ < 10; ++i_) xcd_barrier(bar); }
#endif
    if (IN(6)) {
        pg8::Gemm g{(const bf16_t*)(ws + WS_A2), (const bf16_t*)(ws + WS_WQ), NTOK, DM, DM}; pg8::StaticOrder S; S.init(NTOK, DM, G, (int)blockIdx.x);
        pg8::EpiScale<0> E{(bf16_t*)(ws + WS_A1), DM, (const float*)(ws + WS_SSQ1), 0.0625f * 1.4426950408889634f};
        pg8::gemm_phase<pg8::EpiScale<0>, pg8::StaticOrder, true, true>(lds, g, S, E);
        __syncthreads();
    } SEAM(6);
#ifndef NO_P7
    if (IN(7)) { cross_attention(p, lds, G); __syncthreads(); }
#endif
#if defined(DBG_REP) && DBG_REP == 7
    if (IN(7)) { cross_attention(p, lds, G); __syncthreads(); }
#endif
    SEAM(7);
    if (IN(8)) {
        pg8::Gemm g{(const bf16_t*)(ws + WS_BIG), (const bf16_t*)(ws + WS_WO), NTOK, DM, DM}; pg8::StaticOrder S; S.init(NTOK, DM, G, (int)blockIdx.x);
        pg8::EpiRes<true> E{(const void*)(ws + WS_A2), (bf16_t*)(ws + WS_A1), (float*)(ws + WS_SSQ2)};
        pg8::gemm_phase<pg8::EpiRes<true>, pg8::StaticOrder, true, true>(lds, g, S, E);
        __syncthreads();
    } SEAM(8);
    if (IN(9)) {
        pg8::Gemm g{(const bf16_t*)(ws + WS_A1), (const bf16_t*)(ws + WS_W1), NTOK, DFF, DM}; pg8::StaticOrder S; S.init(NTOK, DFF, G, (int)blockIdx.x);
        pg8::EpiScale<1> E{(bf16_t*)(ws + WS_BIG), DFF, (const float*)(ws + WS_SSQ2), 1.0f};
        pg8::gemm_phase<pg8::EpiScale<1>, pg8::StaticOrder, true, true>(lds, g, S, E);
        __syncthreads();
    } SEAM(9);
    if (IN(10)) {
        pg8::Gemm g{(const bf16_t*)(ws + WS_BIG), (const bf16_t*)(ws + WS_W2), NTOK, DM, DFF}; pg8::StaticOrder S; S.init(NTOK, DM, G, (int)blockIdx.x);
        pg8::EpiRes<true> E{(const void*)(ws + WS_A1), (bf16_t*)(ws + WS_A2), (float*)(ws + WS_SSQ3)};
        pg8::gemm_phase<pg8::EpiRes<true>, pg8::StaticOrder, true, true>(lds, g, S, E);
        __syncthreads();
    } SEAM(10);
    if (IN(11)) { final_norm(p, G); }
#undef IN
#undef SEAM
}

#ifndef MK_PER_PHASE
#define MK_PER_PHASE 0
#endif
#ifdef DBG_DUMP_OFF
__global__ void dump_kernel(const bf16_t* src, size_t n, float* out) {
    for (size_t i = (size_t)blockIdx.x * blockDim.x + threadIdx.x; i < (size_t)NTOK * DM; i += (size_t)gridDim.x * blockDim.x) {
        float s = 0.f; for (size_t j = i; j < n; j += (size_t)NTOK * DM) s += bf2f(src[j]); out[i] = s; }
}
#endif
extern "C" void kernel_launch(void* const* d_in, const int* in_sizes, int n_in, void* d_out, int out_size, void* d_ws, size_t ws_size, hipStream_t stream) {
    static int grid = 0;
    if (grid == 0) {
        if (n_in != 18 || ws_size < WS_NEED) { fprintf(stderr, "kernel_launch: expected 18 inputs and >= %zu bytes of workspace (got %d, %zu)\n", (size_t)WS_NEED, n_in, ws_size); grid = -1; return; }
        int dev = 0, cus = 0, per_cu = 0;
        (void)hipGetDevice(&dev); (void)hipDeviceGetAttribute(&cus, hipDeviceAttributeMultiprocessorCount, dev);
        if (hipFuncSetAttribute((const void*)fwd_megakernel, hipFuncAttributeMaxDynamicSharedMemorySize, LDS_BYTES) != hipSuccess) { fprintf(stderr, "kernel_launch: hipFuncSetAttribute failed\n"); grid = -1; return; }
        if (hipOccupancyMaxActiveBlocksPerMultiprocessor(&per_cu, (const void*)fwd_megakernel, NTHREADS, LDS_BYTES) != hipSuccess || per_cu < 1) { fprintf(stderr, "kernel_launch: occupancy query failed (%d)\n", per_cu); (void)hipGetLastError(); grid = -1; return; }
        grid = cus * per_cu;
    }
    if (grid < 0) return;
    Params p{};
    const float** pp = (const float**)&p;
    for (int i = 0; i < 18; ++i) pp[i] = (const float*)d_in[i];
    p.out = (float*)d_out; p.ws = (unsigned char*)d_ws;
#if MK_PER_PHASE
#ifndef DBG_HI
#define DBG_HI NPHASE
#endif
    for (int k = 0; k < DBG_HI; ++k) { p.ph_lo = k; p.ph_hi = k + 1; hipLaunchKernelGGL(fwd_megakernel, dim3(grid), dim3(NTHREADS), LDS_BYTES, stream, p);
#ifdef DBG_HOSTREP
        if (k == DBG_HOSTREP) hipLaunchKernelGGL(fwd_megakernel, dim3(grid), dim3(NTHREADS), LDS_BYTES, stream, p);
#endif
    }
#ifdef DBG_DUMP_OFF
    hipLaunchKernelGGL(dump_kernel, dim3(2048), dim3(256), 0, stream, (const bf16_t*)((unsigned char*)d_ws + (size_t)(DBG_DUMP_OFF) * MiB), (size_t)(DBG_DUMP_N), (float*)d_out);
#endif
#else
    p.ph_lo = 0; p.ph_hi = NPHASE;
    if (hipMemsetAsync((char*)d_ws + WS_CTL, 0, 16384, stream) != hipSuccess) { fprintf(stderr, "kernel_launch: hipMemsetAsync failed\n"); return; }
    void* args[] = {&p};
    const hipError_t e = hipLaunchCooperativeKernel((const void*)fwd_megakernel, dim3(grid), dim3(NTHREADS), args, LDS_BYTES, stream);
    if (e != hipSuccess) fprintf(stderr, "kernel_launch: cooperative launch failed: %s (grid %d)\n", hipGetErrorString(e), grid);
#endif
}
```

```cpp
#include <hip/hip_runtime.h>
#include <hip/hip_cooperative_groups.h>
#include <cstdio>
#include <cstdint>
namespace cg = cooperative_groups;
namespace pg8 {
#define PG8_LAS __attribute__((address_space(3)))
typedef unsigned short bf16_t;
typedef short bf16x8 __attribute__((ext_vector_type(8)));
typedef float f32x4 __attribute__((ext_vector_type(4)));
typedef unsigned u32x4 __attribute__((ext_vector_type(4)));
constexpr int BM = 256, BK = 64, HALF = 128, HTB = HALF * BK * 2  , STAGE_BYTES = 8 * HTB, NXCD = 8, WGM = 8;

__host__ __device__ __forceinline__ int lds_byte(int r, int c) { const int st = (r >> 4) * 2 + (c >> 5), rr = r & 15, cc = c & 31, ob = rr * 64 + cc * 2; return st * 1024 + (ob ^ (((ob >> 9) & 1) << 5)); }
__host__ __device__ __forceinline__ void stage_rc(int b, int& R, int& C) { const int st = b / 1024, sb = b % 1024, swz = sb ^ (((sb >> 9) & 1) << 5); R = (st >> 1) * 16 + swz / 64; C = (st & 1) * 32 + (swz % 64) / 2; }
__host__ __device__ __forceinline__ int perm32(int rho) { const int n = rho >> 4, i = rho & 15; return 8 * (i >> 2) + 4 * n + (i & 3); }

struct Unit { int pm, pn; };
struct Gemm { const bf16_t* A; const bf16_t* Bt; int M, N, K; };

struct StaticOrder {
    int nM, nN, nwg, G, c;
    __host__ __device__ void init(int M, int N, int G_, int c_) { nM = M / BM; nN = N / BM; nwg = nM * nN; G = G_; c = c_; }
    __host__ __device__ bool next(int i, Unit& u) const {
        const long L = (long)i * G + c; if (L >= nwg) return false;
        int wgid = (int)L; { const int q = nwg / NXCD, r = nwg % NXCD, xcd = wgid % NXCD, off = wgid / NXCD; wgid = (xcd < r ? xcd * (q + 1) : r * (q + 1) + (xcd - r) * q) + off; }
        const int nig = WGM * nN, gid = wgid / nig, fm = gid * WGM, gsz = (nM - fm) < WGM ? (nM - fm) : WGM;
        u.pm = fm + ((wgid % nig) % gsz); u.pn = (wgid % nig) / gsz; return true;
    }
    __device__ __forceinline__ void a_ready(const Unit&) const {}
    __device__ __forceinline__ void done(const Unit&) const {}
};

__device__ __forceinline__ unsigned cvt_pk_bf16(float lo, float hi) { unsigned r; asm volatile("v_cvt_pk_bf16_f32 %0, %1, %2" : "=v"(r) : "v"(lo), "v"(hi)); return r; }
typedef float f32x2 __attribute__((ext_vector_type(2)));
__device__ __forceinline__ f32x2 gelu_pk(f32x2 v) {
    const f32x2 av = __builtin_elementwise_abs(v), d = av * 0.2316418882f + 1.0f;
    f32x2 t; t.x = __builtin_amdgcn_rcpf(d.x); t.y = __builtin_amdgcn_rcpf(d.y);
    f32x2 q = t * 0.5307027145f + (-0.7265760135f); q = q * t + 0.7107068705f; q = q * t + (-0.142248368f); q = q * t + 0.127414796f; q = q * t;
    const f32x2 s = (v * v) * (-0.72134752044f);
    f32x2 e; e.x = __builtin_amdgcn_exp2f(s.x); e.y = __builtin_amdgcn_exp2f(s.y);
    const f32x2 m = v * (q * e), r = v - m;
    f32x2 o; o.x = v.x < 0.f ? m.x : r.x; o.y = v.y < 0.f ? m.y : r.y; return o;
}

template <int ACT  > struct EpiBf16 {
    static constexpr bool PERM = true, AFTER_DRAIN = false; static_assert(ACT == 0 || ACT == 1, "EpiBf16: ACT is 0 (none) or 1 (gelu_pk)");
    bf16_t* O; int ldc; const float* bias; int split_cols; size_t split_stride; float scale0;
    __device__ __forceinline__ void operator()(const f32x4 (&acc)[2][2][4][2], const Unit& u, int wr, int wc, int fr, int fq) const {
        const int row0 = u.pm * BM + wr * 64 + fr; int colt = u.pn * BM; bf16_t* base = O;
        float sc = 1.f; if (split_cols) { const int t = colt / split_cols; base += (size_t)t * split_stride; colt -= t * split_cols; if (t == 0) sc = scale0; }
        const int col0 = colt + wc * 32 + 8 * fq, bcol0 = u.pn * BM + wc * 32 + 8 * fq;
        f32x4 bv[2][2];
#pragma unroll
        for (int bj = 0; bj < 2; ++bj)
#pragma unroll
            for (int n = 0; n < 2; ++n) bv[bj][n] = bias ? *(const f32x4*)(bias + bcol0 + bj * HALF + 4 * n) : (f32x4){0.f, 0.f, 0.f, 0.f};
#pragma unroll
        for (int ai = 0; ai < 2; ++ai)
#pragma unroll
            for (int m = 0; m < 4; ++m) { bf16_t* rowp = base + (size_t)(row0 + ai * HALF + m * 16) * ldc + col0;
#pragma unroll
                for (int bj = 0; bj < 2; ++bj) { f32x4 v0 = acc[ai][bj][m][0] + bv[bj][0], v1 = acc[ai][bj][m][1] + bv[bj][1];
                    if (ACT == 1) { f32x2 a = gelu_pk((f32x2){v0[0], v0[1]}), b = gelu_pk((f32x2){v0[2], v0[3]}), c = gelu_pk((f32x2){v1[0], v1[1]}), d = gelu_pk((f32x2){v1[2], v1[3]});
                        v0 = (f32x4){a.x, a.y, b.x, b.y}; v1 = (f32x4){c.x, c.y, d.x, d.y}; }
                    v0 = v0 * sc; v1 = v1 * sc; u32x4 w; w.x = cvt_pk_bf16(v0[0], v0[1]); w.y = cvt_pk_bf16(v0[2], v0[3]); w.z = cvt_pk_bf16(v1[0], v1[1]); w.w = cvt_pk_bf16(v1[2], v1[3]);
                    *(u32x4*)(rowp + bj * HALF) = w; } }
    }
};

struct PanelStats {
    unsigned* xbuf;
    unsigned* cnt;
    unsigned* tmo;
    int ntn; float eps;
    unsigned code;
    __device__ __forceinline__ bool run(const f32x4 (&v)[2][2][4][2], const Unit& u, int wr, int wc, int fr, int fq, PG8_LAS unsigned char* lds, int wid, int lane) const {
        typedef float f32x2v __attribute__((ext_vector_type(2)));
        PG8_LAS f32x2v* P = (PG8_LAS f32x2v*)lds;
        PG8_LAS f32x2v* S = (PG8_LAS f32x2v*)(lds + 8192);
        PG8_LAS unsigned* flag = (PG8_LAS unsigned*)(lds + 8192 + 2048);
#pragma unroll
        for (int ai = 0; ai < 2; ++ai)
#pragma unroll
            for (int m = 0; m < 4; ++m) {
                float s = 0.f;
#pragma unroll
                for (int bj = 0; bj < 2; ++bj)
#pragma unroll
                    for (int n = 0; n < 2; ++n) { const f32x4 x = v[ai][bj][m][n]; s += (x[0] + x[1]) + (x[2] + x[3]); }
                s += __shfl_xor(s, 16); s += __shfl_xor(s, 32);
                const float mw = s * (1.0f / 64.0f); float q = 0.f;
#pragma unroll
                for (int bj = 0; bj < 2; ++bj)
#pragma unroll
                    for (int n = 0; n < 2; ++n) { const f32x4 d = v[ai][bj][m][n] - mw; q += (d[0] * d[0] + d[1] * d[1]) + (d[2] * d[2] + d[3] * d[3]); }
                q += __shfl_xor(q, 16); q += __shfl_xor(q, 32);
                if (fq == 0) P[(ai * HALF + wr * 64 + m * 16 + fr) * 4 + wc] = (f32x2v){mw, q};
            }
        asm volatile("s_waitcnt lgkmcnt(0)" ::: "memory"); __builtin_amdgcn_s_barrier(); asm volatile("" ::: "memory");
#if defined(BROKEN_EXCHANGE_NO_WAIT)
#warning BROKEN CONTROL BUILD: the row-statistics exchange does not wait; results are wrong by design
        if (blockIdx.x >= 64) { const long long t0_ = clock64(); while (clock64() - t0_ < 60000) __builtin_amdgcn_s_sleep(8); }
#endif
        const int row = wid * 32 + (lane & 31);
        if (lane < 32) {
            const f32x2v a = P[row * 4 + 0], b = P[row * 4 + 1], c = P[row * 4 + 2], d = P[row * 4 + 3];
            const float mt = (a.x + b.x + c.x + d.x) * 0.25f;
            const float da = a.x - mt, db = b.x - mt, dc = c.x - mt, dd = d.x - mt;
            const float m2 = (a.y + b.y) + (c.y + d.y) + 64.0f * ((da * da + db * db) + (dc * dc + dd * dd));
            unsigned long long* slot = (unsigned long long*)xbuf + ((size_t)(u.pm * BM + row) * 4 + u.pn);
            __hip_atomic_store(slot, ((unsigned long long)__float_as_uint(m2) << 32) | __float_as_uint(mt), __ATOMIC_RELAXED, __HIP_MEMORY_SCOPE_AGENT);
        }
        asm volatile("s_waitcnt vmcnt(0)" ::: "memory");
        if (lane == 0) __hip_atomic_fetch_add(cnt + 64 * u.pm, 1u, __ATOMIC_RELAXED, __HIP_MEMORY_SCOPE_AGENT);
        if (wid == 0) {
            bool dead = false; const unsigned long long t0 = __builtin_amdgcn_s_memrealtime(); const unsigned want = 8u * (unsigned)ntn;
            for (;;) {
#if defined(BROKEN_EXCHANGE_NO_WAIT)
                break;
#endif
                if ((unsigned)__builtin_amdgcn_readfirstlane(__hip_atomic_load(cnt + 64 * u.pm, __ATOMIC_RELAXED, __HIP_MEMORY_SCOPE_AGENT)) >= want) break;
                if (__builtin_amdgcn_s_memrealtime() - t0 > 2000000ull) {
                    if (lane == 0) { unsigned expect = 0u; __hip_atomic_compare_exchange_strong(tmo + 1, &expect, code | (unsigned)(u.pm & 0xff), __ATOMIC_RELAXED, __ATOMIC_RELAXED, __HIP_MEMORY_SCOPE_AGENT);
                                     __hip_atomic_store(tmo, 1u, __ATOMIC_RELAXED, __HIP_MEMORY_SCOPE_AGENT); }
                    dead = true; break; }
                __builtin_amdgcn_s_sleep(2);
            }
            __builtin_amdgcn_fence(__ATOMIC_ACQUIRE, "agent");
            if (lane == 0) flag[0] = dead ? 1u : 0u;
        }
        asm volatile("s_waitcnt vmcnt(0) lgkmcnt(0)" ::: "memory"); __builtin_amdgcn_s_barrier(); asm volatile("" ::: "memory");
        const bool bad = flag[0] != 0u;
        if (lane < 32) {
            const unsigned long long* slot = (const unsigned long long*)xbuf + (size_t)(u.pm * BM + row) * 4; float mt[4], m2[4]; float ms = 0.f;
#pragma unroll
            for (int t = 0; t < 4; ++t) { if (t < ntn) { const unsigned long long w = __hip_atomic_load(slot + t, __ATOMIC_RELAXED, __HIP_MEMORY_SCOPE_AGENT); mt[t] = __uint_as_float((unsigned)w); m2[t] = __uint_as_float((unsigned)(w >> 32)); } else { mt[t] = 0.f; m2[t] = 0.f; } ms += mt[t]; }
            const float mean = ms / (float)ntn; float q = 0.f;
#pragma unroll
            for (int t = 0; t < 4; ++t) if (t < ntn) { const float dm = mt[t] - mean; q += m2[t] + 256.0f * dm * dm; }
            S[row] = (f32x2v){mean, 1.0f / sqrtf(q / (256.0f * (float)ntn) + eps)};
        }
        asm volatile("s_waitcnt lgkmcnt(0)" ::: "memory"); __builtin_amdgcn_s_barrier(); asm volatile("" ::: "memory");
        return bad;
    }
};
struct EpiLnRes {
    static constexpr bool PERM = false, AFTER_DRAIN = true;
    const float* base; float* out; int ldc; const float* bias; PanelStats st; unsigned poison;
    __device__ __forceinline__ void fused(f32x4 (&acc)[2][2][4][2], const Unit& u, int wr, int wc, int fr, int fq, PG8_LAS unsigned char* lds, int wid, int lane) const {
        typedef float f32x2v __attribute__((ext_vector_type(2)));
        const PG8_LAS f32x2v* S = (const PG8_LAS f32x2v*)(lds + 8192);
        const int col0 = u.pn * BM + wc * 32 + 4 * fq;
#pragma unroll
        for (int bj = 0; bj < 2; ++bj)
#pragma unroll
            for (int n = 0; n < 2; ++n) { const f32x4 bv = bias ? *(const f32x4*)(bias + col0 + bj * HALF + n * 16) : (f32x4){0.f, 0.f, 0.f, 0.f};
#pragma unroll
                for (int ai = 0; ai < 2; ++ai)
#pragma unroll
                    for (int m = 0; m < 4; ++m) acc[ai][bj][m][n] += bv; }
        f32x4 pre[4][2][2];
#pragma unroll
        for (int m = 0; m < 4; ++m) { const size_t off = (size_t)(u.pm * BM + wr * 64 + m * 16 + fr) * ldc + col0;
#pragma unroll
            for (int bj = 0; bj < 2; ++bj)
#pragma unroll
                for (int n = 0; n < 2; ++n) pre[m][bj][n] = *(const f32x4*)(base + off + bj * HALF + n * 16); }
        const bool bad = st.run(acc, u, wr, wc, fr, fq, lds, wid, lane) || poison != 0u;
        const float qnan = __builtin_nanf("");
#pragma unroll
        for (int ai = 0; ai < 2; ++ai)
#pragma unroll
            for (int m = 0; m < 4; ++m) { const int r = ai * HALF + wr * 64 + m * 16 + fr; const f32x2v sr = S[r]; const size_t off = (size_t)(u.pm * BM + r) * ldc + col0;
#pragma unroll
                for (int bj = 0; bj < 2; ++bj)
#pragma unroll
                    for (int n = 0; n < 2; ++n) { const f32x4 bs = ai == 0 ? pre[m][bj][n] : *(const f32x4*)(base + off + bj * HALF + n * 16); f32x4 o = bs + (acc[ai][bj][m][n] - sr.x) * sr.y;
                        if (bad) o = (f32x4){qnan, qnan, qnan, qnan}; *(f32x4*)(out + off + bj * HALF + n * 16) = o; }
                if (m & 1) asm volatile("" ::: "memory"); }
    }
};
struct EpiLnResLn {
    static constexpr bool PERM = false, AFTER_DRAIN = true;
    const float* base; float* out; bf16_t* xn; int ldc; const float* bias; PanelStats st1, st2; unsigned poison;
    __device__ __forceinline__ void fused(f32x4 (&acc)[2][2][4][2], const Unit& u, int wr, int wc, int fr, int fq, PG8_LAS unsigned char* lds, int wid, int lane) const {
        typedef float f32x2v __attribute__((ext_vector_type(2))); typedef unsigned u32x2v __attribute__((ext_vector_type(2)));
        const PG8_LAS f32x2v* S = (const PG8_LAS f32x2v*)(lds + 8192);
        const int col0 = u.pn * BM + wc * 32 + 4 * fq;
#pragma unroll
        for (int bj = 0; bj < 2; ++bj)
#pragma unroll
            for (int n = 0; n < 2; ++n) { const f32x4 bv = bias ? *(const f32x4*)(bias + col0 + bj * HALF + n * 16) : (f32x4){0.f, 0.f, 0.f, 0.f};
#pragma unroll
                for (int ai = 0; ai < 2; ++ai)
#pragma unroll
                    for (int m = 0; m < 4; ++m) acc[ai][bj][m][n] += bv; }
        bool bad = st1.run(acc, u, wr, wc, fr, fq, lds, wid, lane) || poison != 0u;
        const float qnan = __builtin_nanf("");
#pragma unroll
        for (int ai = 0; ai < 2; ++ai)
#pragma unroll
            for (int m = 0; m < 4; ++m) { const int r = ai * HALF + wr * 64 + m * 16 + fr; const f32x2v sr = S[r]; const size_t off = (size_t)(u.pm * BM + r) * ldc + col0;
#pragma unroll
                for (int bj = 0; bj < 2; ++bj)
#pragma unroll
                    for (int n = 0; n < 2; ++n) { const f32x4 bs = *(const f32x4*)(base + off + bj * HALF + n * 16); acc[ai][bj][m][n] = bs + (acc[ai][bj][m][n] - sr.x) * sr.y; }
                asm volatile("" : "+v"(acc[ai][0][m][0]), "+v"(acc[ai][0][m][1]), "+v"(acc[ai][1][m][0]), "+v"(acc[ai][1][m][1]));
                if (m & 1) asm volatile("" ::: "memory"); }
        const bool bad1 = bad;
        bad = st2.run(acc, u, wr, wc, fr, fq, lds, wid, lane) || bad;
#pragma unroll
        for (int ai = 0; ai < 2; ++ai)
#pragma unroll
            for (int m = 0; m < 4; ++m) { const int r = ai * HALF + wr * 64 + m * 16 + fr; const f32x2v sr = S[r]; const size_t off = (size_t)(u.pm * BM + r) * ldc + col0;
#pragma unroll
                for (int bj = 0; bj < 2; ++bj)
#pragma unroll
                    for (int n = 0; n < 2; ++n) { const f32x4 x1 = acc[ai][bj][m][n]; *(f32x4*)(out + off + bj * HALF + n * 16) = bad1 ? (f32x4){qnan, qnan, qnan, qnan} : x1;
                        const f32x4 o = (x1 - sr.x) * sr.y; u32x2v w; w.x = cvt_pk_bf16(o[0], o[1]); w.y = cvt_pk_bf16(o[2], o[3]);
                        if (bad) { w.x = 0x7fc07fc0u; w.y = 0x7fc07fc0u; } *(u32x2v*)(xn + off + bj * HALF + n * 16) = w; }
                asm volatile("" ::: "memory"); }
    }
};

template <class Epi, class Sched, bool ALIGN_EPI = false, bool SP2 = false>
__device__ __forceinline__ void gemm_phase(PG8_LAS unsigned char* lds, const Gemm g, const Sched& S, const Epi& E) {
    const int tid = threadIdx.x, wid = __builtin_amdgcn_readfirstlane(tid >> 6), lane = tid & 63, wr = wid >> 2, wc = wid & 3, fr = lane & 15, fq = lane >> 4;
    const int K = g.K, nt = K / BK;
    unsigned voffA[2], voffB[2];
#pragma unroll
    for (int i = 0; i < 2; ++i) { int R, C; stage_rc(tid * 16 + i * 8192, R, C); const int Rb = Epi::PERM ? ((R & ~31) + perm32(R & 31)) : R;
        voffA[i] = (unsigned)(R * K + C) * 2u; voffB[i] = (unsigned)(Rb * K + C) * 2u; }
    const size_t kstep = (size_t)(BK * 2);
    const size_t hstep = (size_t)HALF * K * 2;
    const size_t tstep = 2 * hstep;
    const unsigned ldsw = (unsigned)wid * 1024u;
    const int aoff = lds_byte(wr * 64 + fr, fq * 8), boff = lds_byte(wc * 32 + fr, fq * 8);
#define PG8_SA(b, h) (((b) * 2 + (h)) * HTB)
#define PG8_SB(b, h) ((4 + (b) * 2 + (h)) * HTB)
#define PG8_STAGE(bufoff, gbase, voff) do { _Pragma("unroll") for (int _i = 0; _i < 2; ++_i) \
        __builtin_amdgcn_global_load_lds((const unsigned*)((const char*)(gbase) + (voff)[_i]), (PG8_LAS unsigned*)(lds + (bufoff) + ldsw + _i * 8192), 16, 0, 0); } while (0)
#define PG8_LDA(dst, b, h) do { _Pragma("unroll") for (int m = 0; m < 4; ++m) _Pragma("unroll") for (int k = 0; k < 2; ++k) dst[m][k] = *(const PG8_LAS bf16x8*)(lds + PG8_SA(b, h) + aoff + m * 2048 + k * 1024); } while (0)
#define PG8_LDB(dst, b, h) do { _Pragma("unroll") for (int n = 0; n < 2; ++n) _Pragma("unroll") for (int k = 0; k < 2; ++k) dst[n][k] = *(const PG8_LAS bf16x8*)(lds + PG8_SB(b, h) + boff + n * 2048 + k * 1024); } while (0)
#define PG8_MMA(ai, bj, At, Bt) do { __builtin_amdgcn_s_setprio(1); _Pragma("unroll") for (int m = 0; m < 4; ++m) _Pragma("unroll") for (int n = 0; n < 2; ++n) _Pragma("unroll") for (int k = 0; k < 2; ++k) \
        acc[ai][bj][m][n] = __builtin_amdgcn_mfma_f32_16x16x32_bf16(Bt[n][k], At[m][k], acc[ai][bj][m][n], 0, 0, 0); __builtin_amdgcn_s_setprio(0); } while (0)
#define PG8_WAIT_V(n) asm volatile("s_waitcnt vmcnt(" #n ")" ::: "memory")
#define PG8_WAIT_L(n) asm volatile("s_waitcnt lgkmcnt(" #n ")" ::: "memory")
#define PG8_BAR __builtin_amdgcn_s_barrier()
#define PG8_SCHED __builtin_amdgcn_sched_barrier(0)
    Unit cur, nxt; int ui = 0;
    if (!S.next(0, cur)) return;
    f32x4 acc[2][2][4][2];
#pragma unroll
    for (int a = 0; a < 2; ++a)
#pragma unroll
        for (int b = 0; b < 2; ++b)
#pragma unroll
            for (int m = 0; m < 4; ++m)
#pragma unroll
                for (int n = 0; n < 2; ++n) acc[a][b][m][n] = (f32x4){0.f, 0.f, 0.f, 0.f};
    bf16x8 At[4][2], B0[2][2], B1[2][2];
    const char* cA = (const char*)g.A + (size_t)cur.pm * tstep; const char* cB = (const char*)g.Bt + (size_t)cur.pn * tstep;
    S.a_ready(cur);
    if constexpr (SP2) {
        PG8_STAGE(PG8_SB(0, 0), cB, voffB); PG8_STAGE(PG8_SB(0, 1), cB + hstep, voffB); PG8_STAGE(PG8_SA(0, 0), cA, voffA); PG8_STAGE(PG8_SA(0, 1), cA + hstep, voffA);
        if (wr == 1) PG8_BAR;
        PG8_WAIT_V(2); PG8_BAR;
        PG8_STAGE(PG8_SB(1, 0), cB + kstep, voffB); PG8_STAGE(PG8_SA(1, 0), cA + kstep, voffA); PG8_STAGE(PG8_SB(1, 1), cB + hstep + kstep, voffB);
        PG8_WAIT_V(6); PG8_BAR;
    } else {
        PG8_STAGE(PG8_SB(0, 0), cB, voffB); PG8_STAGE(PG8_SA(0, 0), cA, voffA); PG8_STAGE(PG8_SB(0, 1), cB + hstep, voffB); PG8_STAGE(PG8_SA(0, 1), cA + hstep, voffA);
        if (wr == 1) PG8_BAR;
        PG8_WAIT_V(4); PG8_BAR;
        PG8_STAGE(PG8_SB(1, 0), cB + kstep, voffB); PG8_STAGE(PG8_SA(1, 0), cA + kstep, voffA); PG8_STAGE(PG8_SB(1, 1), cB + hstep + kstep, voffB);
        PG8_WAIT_V(6); PG8_BAR;
    }
    for (;;) {
        const bool has_next = S.next(ui + 1, nxt);
        const char* nA = has_next ? (const char*)g.A + (size_t)nxt.pm * tstep : cA; const char* nB = has_next ? (const char*)g.Bt + (size_t)nxt.pn * tstep : cB;
        for (int t = 0; t < nt; t += 2) {
            const bool last = (t == nt - 2);
            const char* a1 = cA + (size_t)(t + 1) * kstep;
            const char* a2 = last ? nA : cA + (size_t)(t + 2) * kstep; const char* b2 = last ? nB : cB + (size_t)(t + 2) * kstep;
            const char* a3 = a2 + kstep; const char* b3 = b2 + kstep;
            if (last && has_next) S.a_ready(nxt);
            if constexpr (SP2) {
            PG8_LDB(B0, 0, 0); PG8_LDB(B1, 0, 1); PG8_SCHED; PG8_LDA(At, 0, 0); PG8_STAGE(PG8_SA(1, 1), a1 + hstep, voffA);
            PG8_WAIT_V(8); PG8_WAIT_L(0); PG8_BAR; PG8_MMA(0, 0, At, B0); PG8_MMA(0, 1, At, B1); PG8_BAR; PG8_SCHED;
            PG8_LDA(At, 0, 1); PG8_STAGE(PG8_SB(0, 0), b2, voffB); PG8_STAGE(PG8_SB(0, 1), b2 + hstep, voffB); PG8_STAGE(PG8_SA(0, 0), a2, voffA);
            PG8_WAIT_V(8); PG8_WAIT_L(0); PG8_BAR; PG8_MMA(1, 0, At, B0); PG8_MMA(1, 1, At, B1); PG8_BAR; PG8_SCHED;
            PG8_LDB(B0, 1, 0); PG8_LDB(B1, 1, 1); PG8_SCHED; PG8_LDA(At, 1, 0); PG8_STAGE(PG8_SA(0, 1), a2 + hstep, voffA);
            PG8_WAIT_V(8); PG8_WAIT_L(0); PG8_BAR; PG8_MMA(0, 0, At, B0); PG8_MMA(0, 1, At, B1); PG8_BAR; PG8_SCHED;
            PG8_LDA(At, 1, 1); PG8_STAGE(PG8_SB(1, 0), b3, voffB); PG8_STAGE(PG8_SB(1, 1), b3 + hstep, voffB); PG8_STAGE(PG8_SA(1, 0), a3, voffA);
            PG8_WAIT_V(8); PG8_WAIT_L(0); PG8_BAR; PG8_MMA(1, 0, At, B0); PG8_MMA(1, 1, At, B1); PG8_BAR; PG8_SCHED;
            } else {
            PG8_LDB(B0, 0, 0); PG8_SCHED; PG8_LDA(At, 0, 0); PG8_STAGE(PG8_SA(1, 1), a1 + hstep, voffA);
            PG8_WAIT_L(8); PG8_BAR; PG8_WAIT_L(0); PG8_MMA(0, 0, At, B0); PG8_BAR; PG8_SCHED;
            PG8_LDB(B1, 0, 1); PG8_STAGE(PG8_SB(0, 0), b2, voffB);
            PG8_BAR; PG8_WAIT_L(0); PG8_MMA(0, 1, At, B1); PG8_BAR;
            PG8_LDA(At, 0, 1); PG8_STAGE(PG8_SA(0, 0), a2, voffA);
            PG8_BAR; PG8_WAIT_L(0); PG8_MMA(1, 0, At, B0); PG8_BAR; PG8_SCHED;
            PG8_STAGE(PG8_SB(0, 1), b2 + hstep, voffB);
            PG8_WAIT_V(6); PG8_BAR; PG8_MMA(1, 1, At, B1); PG8_BAR;
            PG8_LDB(B0, 1, 0); PG8_SCHED; PG8_LDA(At, 1, 0); PG8_STAGE(PG8_SA(0, 1), a2 + hstep, voffA);
            PG8_WAIT_L(8); PG8_BAR; PG8_WAIT_L(0); PG8_MMA(0, 0, At, B0); PG8_BAR; PG8_SCHED;
            PG8_LDB(B1, 1, 1); PG8_STAGE(PG8_SB(1, 0), b3, voffB);
            PG8_BAR; PG8_WAIT_L(0); PG8_MMA(0, 1, At, B1); PG8_BAR;
            PG8_LDA(At, 1, 1); PG8_STAGE(PG8_SA(1, 0), a3, voffA);
            PG8_BAR; PG8_WAIT_L(0); PG8_MMA(1, 0, At, B0); PG8_BAR; PG8_SCHED;
            PG8_STAGE(PG8_SB(1, 1), b3 + hstep, voffB);
            PG8_WAIT_V(6); PG8_BAR; PG8_MMA(1, 1, At, B1); PG8_BAR;
            }
        }
        if constexpr (ALIGN_EPI) { if (wr == 0) PG8_BAR; }
        if constexpr (!Epi::AFTER_DRAIN) { E(acc, cur, wr, wc, fr, fq); S.done(cur); }
        if (!has_next) break;
#pragma unroll
        for (int a = 0; a < 2; ++a)
#pragma unroll
            for (int b = 0; b < 2; ++b)
#pragma unroll
                for (int m = 0; m < 4; ++m)
#pragma unroll
                    for (int n = 0; n < 2; ++n) acc[a][b][m][n] = (f32x4){0.f, 0.f, 0.f, 0.f};
        cur = nxt; cA = nA; cB = nB; ++ui;
        if constexpr (ALIGN_EPI) { if (wr == 1) PG8_BAR; }
    }
    PG8_WAIT_V(0);
    if constexpr (!ALIGN_EPI) { if (wr == 0) PG8_BAR; }
    PG8_BAR;
    if constexpr (Epi::AFTER_DRAIN) { E.fused(acc, cur, wr, wc, fr, fq, lds, wid, lane); S.done(cur); }
#undef PG8_SA
#undef PG8_SB
#undef PG8_STAGE
#undef PG8_LDA
#undef PG8_LDB
#undef PG8_MMA
#undef PG8_WAIT_V
#undef PG8_WAIT_L
#undef PG8_BAR
#undef PG8_SCHED
}
}

typedef float f32x2_t __attribute__((ext_vector_type(2))); typedef __bf16 bf16x2_t __attribute__((ext_vector_type(2)));
__device__ __forceinline__ unsigned cvtpk(float lo, float hi) { f32x2_t v = {lo, hi}; bf16x2_t b = __builtin_convertvector(v, bf16x2_t); return __builtin_bit_cast(unsigned, b); }

namespace pg8 {
template <bool BASE_BF16> struct EpiRes {
    static constexpr bool PERM = true, AFTER_DRAIN = false;
    const void* base; bf16_t* hb; float* ssq;
    __device__ __forceinline__ void operator()(const f32x4 (&acc)[2][2][4][2], const Unit& u, int wr, int wc, int fr, int fq) const {
        const int row0 = u.pm * BM + wr * 64 + fr, col0 = u.pn * BM + wc * 32 + 8 * fq;
#pragma unroll
        for (int ai = 0; ai < 2; ++ai) {
            f32x4 b0[4][2], b1[4][2];
#pragma unroll
            for (int m = 0; m < 4; ++m)
#pragma unroll
                for (int bj = 0; bj < 2; ++bj) {
                    const size_t off = (size_t)(row0 + ai * HALF + m * 16) * 1024 + col0 + bj * HALF;
                    if (BASE_BF16) {
                        const u32x4 w = *(const u32x4*)((const bf16_t*)base + off);
                        b0[m][bj][0] = __uint_as_float(w.x << 16); b0[m][bj][1] = __uint_as_float(w.x & 0xffff0000u); b0[m][bj][2] = __uint_as_float(w.y << 16); b0[m][bj][3] = __uint_as_float(w.y & 0xffff0000u);
                        b1[m][bj][0] = __uint_as_float(w.z << 16); b1[m][bj][1] = __uint_as_float(w.z & 0xffff0000u); b1[m][bj][2] = __uint_as_float(w.w << 16); b1[m][bj][3] = __uint_as_float(w.w & 0xffff0000u);
                    } else { b0[m][bj] = *(const f32x4*)((const float*)base + off); b1[m][bj] = *(const f32x4*)((const float*)base + off + 4); }
                }
#pragma unroll
            for (int m = 0; m < 4; ++m) {
                const size_t row = (size_t)(row0 + ai * HALF + m * 16); float s = 0.f;
#pragma unroll
                for (int bj = 0; bj < 2; ++bj) {
                    const size_t off = row * 1024 + col0 + bj * HALF;
                    const f32x4 v0 = acc[ai][bj][m][0] + b0[m][bj], v1 = acc[ai][bj][m][1] + b1[m][bj];
                    s += (v0[0] * v0[0] + v0[1] * v0[1]) + (v0[2] * v0[2] + v0[3] * v0[3]) + (v1[0] * v1[0] + v1[1] * v1[1]) + (v1[2] * v1[2] + v1[3] * v1[3]);
                    u32x4 w; w.x = cvtpk(v0[0], v0[1]); w.y = cvtpk(v0[2], v0[3]); w.z = cvtpk(v1[0], v1[1]); w.w = cvtpk(v1[2], v1[3]); *(u32x4*)(hb + off) = w;
                }
                s += __shfl_xor(s, 16); s += __shfl_xor(s, 32); if (fq == 0) ssq[row * 16 + u.pn * 4 + wc] = s;
            }
        }
    }
};
template <int MODE> struct EpiScale {
    static constexpr bool PERM = true, AFTER_DRAIN = false;
    bf16_t* O; int ldc; const float* ssq; float scale;
    __device__ __forceinline__ void operator()(const f32x4 (&acc)[2][2][4][2], const Unit& u, int wr, int wc, int fr, int fq) const {
        const int row0 = u.pm * BM + wr * 64 + fr, col0 = u.pn * BM + wc * 32 + 8 * fq;
        f32x4 sp[2][4];
#pragma unroll
        for (int ai = 0; ai < 2; ++ai)
#pragma unroll
            for (int m = 0; m < 4; ++m) sp[ai][m] = *(const f32x4*)(ssq + (size_t)(row0 + ai * HALF + m * 16) * 16 + 4 * fq);
#pragma unroll
        for (int ai = 0; ai < 2; ++ai)
#pragma unroll
            for (int m = 0; m < 4; ++m) {
                const size_t row = (size_t)(row0 + ai * HALF + m * 16);
                float t = (sp[ai][m][0] + sp[ai][m][1]) + (sp[ai][m][2] + sp[ai][m][3]);
                t += __shfl_xor(t, 16); t += __shfl_xor(t, 32);
                const float rs = __builtin_amdgcn_rsqf(t * (1.0f / 1024.0f) + 1e-6f) * scale;
#pragma unroll
                for (int bj = 0; bj < 2; ++bj) {
                    f32x4 v0 = acc[ai][bj][m][0] * rs, v1 = acc[ai][bj][m][1] * rs;
                    if (MODE == 1) {
#pragma unroll
                        for (int e = 0; e < 4; ++e) { const float a = fmaxf(v0[e], 0.f), b = fmaxf(v1[e], 0.f); v0[e] = a * a; v1[e] = b * b; }
                    }
                    u32x4 w; w.x = cvtpk(v0[0], v0[1]); w.y = cvtpk(v0[2], v0[3]); w.z = cvtpk(v1[0], v1[1]); w.w = cvtpk(v1[2], v1[3]);
                    *(u32x4*)(O + row * ldc + col0 + bj * HALF) = w;
                }
            }
    }
};
struct EpiKV {
    static constexpr bool PERM = true, AFTER_DRAIN = false;
    bf16_t* Kb; bf16_t* Vt;
    __device__ __forceinline__ void operator()(const f32x4 (&acc)[2][2][4][2], const Unit& u, int wr, int wc, int fr, int fq) const {
        const int row0 = u.pm * BM + wr * 64 + fr, col0 = u.pn * BM + wc * 32 + 8 * fq;
#pragma unroll
        for (int ai = 0; ai < 2; ++ai)
#pragma unroll
            for (int m = 0; m < 4; ++m) {
                const int row = row0 + ai * HALF + m * 16;
#pragma unroll
                for (int bj = 0; bj < 2; ++bj) {
                    const int col = col0 + bj * HALF; const f32x4 v0 = acc[ai][bj][m][0], v1 = acc[ai][bj][m][1];
                    u32x4 w; w.x = cvtpk(v0[0], v0[1]); w.y = cvtpk(v0[2], v0[3]); w.z = cvtpk(v1[0], v1[1]); w.w = cvtpk(v1[2], v1[3]);
                    if (col < 1024) { *(u32x4*)(Kb + (size_t)row * 1024 + col) = w; }
                    else {
                        const int b = row >> 8, mm = row & 255; bf16_t* p = Vt + ((size_t)(b * 1024 + (col - 1024))) * 256 + mm;
                        p[0 * 256] = (bf16_t)(w.x & 0xffffu); p[1 * 256] = (bf16_t)(w.x >> 16); p[2 * 256] = (bf16_t)(w.y & 0xffffu); p[3 * 256] = (bf16_t)(w.y >> 16);
                        p[4 * 256] = (bf16_t)(w.z & 0xffffu); p[5 * 256] = (bf16_t)(w.z >> 16); p[6 * 256] = (bf16_t)(w.w & 0xffffu); p[7 * 256] = (bf16_t)(w.w >> 16);
                    }
                }
            }
    }
};
}

#define LAS __attribute__((address_space(3)))
typedef pg8::bf16_t bf16_t;
typedef pg8::bf16x8 bf16x8;
typedef pg8::f32x4 f32x4;
typedef pg8::u32x4 u32x4;
typedef unsigned u32x2 __attribute__((ext_vector_type(2)));

constexpr int NTOK = 32768, DM = 1024, SEQ = 8192, NBATCH = 4, NCHUNK = 128, NPROJ = 3328, DFF = 4096, NMEMROWS = 1024;
constexpr int C_GQ = 0, C_GK = 256, C_GV = 512, C_GG = 1024, C_RQ = 1536, C_RK = 1792, C_RV = 2048, C_RG = 2560, C_Z = 3072;
constexpr int NWAVES = 8, NTHREADS = 512;
constexpr int WAVE_LDS = 18432, MISC_OFF = NWAVES * WAVE_LDS, LDS_BYTES = MISC_OFF + 64;
constexpr int VPITCH = 72;
constexpr int APITCH = 528;
constexpr size_t MiB = 1u << 20;
constexpr size_t WS_WIN = 1 * MiB, WS_WOUT = 8 * MiB, WS_WQ = 10 * MiB, WS_WKV = 12 * MiB, WS_WO = 16 * MiB, WS_W1 = 18 * MiB, WS_W2 = 26 * MiB;
constexpr size_t WS_COS = 34 * MiB, WS_SIN = 35 * MiB, WS_MEMN = 36 * MiB, WS_KB = 38 * MiB, WS_VT = 40 * MiB, WS_DEC = 42 * MiB, WS_SSQ1 = 44 * MiB, WS_SSQ2 = 46 * MiB, WS_SSQ3 = 48 * MiB, WS_CTL = 0;
constexpr size_t WS_A1 = 64 * MiB;
constexpr size_t WS_A2 = 128 * MiB;
constexpr size_t WS_BIG = 192 * MiB;
constexpr size_t WS_NEED = 448 * MiB;

struct Params {
    const float *x, *mem, *norm_mix_g, *w_in, *gla_w_gate, *gla_b_gate, *gla_norm_g, *ret_norm_g, *w_out, *norm_x_g, *norm_mem_g, *xa_w_q, *xa_w_kv, *xa_w_o, *norm_ffn_g, *ffn_w1, *ffn_w2, *final_norm_g;
    float* out; unsigned char* ws; int ph_lo, ph_hi;
};

__device__ __forceinline__ float bf2f(unsigned short b) { return __uint_as_float(((unsigned)b) << 16); }
__device__ __forceinline__ unsigned short f2bf(float f) { const unsigned u = __float_as_uint(f); return (unsigned short)((u + 0x7fffu + ((u >> 16) & 1u)) >> 16); }
__device__ __forceinline__ bf16x8 pack8(f32x4 a, f32x4 b) {
    u32x4 w; w.x = cvtpk(a[0], a[1]); w.y = cvtpk(a[2], a[3]); w.z = cvtpk(b[0], b[1]); w.w = cvtpk(b[2], b[3]);
    return __builtin_bit_cast(bf16x8, w);
}
__device__ __forceinline__ void unpack8(bf16x8 v, f32x4& a, f32x4& b) {
    const u32x4 w = __builtin_bit_cast(u32x4, v);
    a[0] = __uint_as_float(w.x << 16); a[1] = __uint_as_float(w.x & 0xffff0000u); a[2] = __uint_as_float(w.y << 16); a[3] = __uint_as_float(w.y & 0xffff0000u);
    b[0] = __uint_as_float(w.z << 16); b[1] = __uint_as_float(w.z & 0xffff0000u); b[2] = __uint_as_float(w.w << 16); b[3] = __uint_as_float(w.w & 0xffff0000u);
}
__device__ __forceinline__ float wave_sum(float v) {
#pragma unroll
    for (int o = 1; o < 64; o <<= 1) v += __shfl_xor(v, o);
    return v;
}
#define MFMA16(a, b, c) __builtin_amdgcn_mfma_f32_16x16x32_bf16((a), (b), (c), 0, 0, 0)
#define LDS_FENCE() asm volatile("s_waitcnt lgkmcnt(0)" ::: "memory")
#define CFENCE() do { asm volatile("" ::: "memory"); __builtin_amdgcn_sched_barrier(0); } while (0)
__device__ __forceinline__ float scan16(float v, int r) {
#pragma unroll
    for (int off = 1; off < 16; off <<= 1) { const float t = __shfl_up(v, off, 16); if (r >= off) v += t; }
    return v;
}

#define XB_TMO      128
#define XB_XCNT(j)  (256  + 64 * (j))
#define XB_XSUB(j)  (1280 + 64 * (j))
#define XB_XGEN(j)  (2304 + 64 * (j))
#define XB_TOP      3328
#define XB_TOPGEN   3392
#define XCD_BAR_WORDS 3456
#define XB_SPIN_CAP (1u << 18)

__device__ __forceinline__ unsigned xb_ld(unsigned* p)              { return __hip_atomic_load(p, __ATOMIC_RELAXED, __HIP_MEMORY_SCOPE_AGENT); }
__device__ __forceinline__ unsigned xb_add(unsigned* p, unsigned v) { return __hip_atomic_fetch_add(p, v, __ATOMIC_RELAXED, __HIP_MEMORY_SCOPE_AGENT); }
__device__ __forceinline__ unsigned xb_xcc_id() { return (unsigned)__builtin_amdgcn_s_getreg((3 << 11) | 20) & 0xFu; }
#define XB_SPIN(cond, bar) do { unsigned _sp = 0; while (cond) { __builtin_amdgcn_s_sleep(1); \
    if ((++_sp & 255u) == 0u) { if (xb_ld(&(bar)[XB_TMO])) break; if (_sp > XB_SPIN_CAP) { atomicAdd(&(bar)[XB_TMO], 1u); break; } } } } while (0)

struct XcdBarrier {
    unsigned* bar; unsigned x;
    volatile LAS unsigned* st;
};

__device__ __forceinline__ XcdBarrier xcd_barrier_post(unsigned* bar, volatile LAS unsigned* st) {
    XcdBarrier b; b.bar = bar; b.x = xb_xcc_id(); b.st = st;
    if (threadIdx.x == 0) (void)xb_add(&bar[XB_XCNT(b.x)], 1u);
    return b;
}
__device__ __forceinline__ void xcd_barrier_complete(unsigned* bar, unsigned x, unsigned& nloc, unsigned& nx) {
    const unsigned G = gridDim.x * gridDim.y * gridDim.z;
    unsigned sum, cnt, mine, sp = 0u;
    for (;;) {
        sum = 0u; cnt = 0u; mine = 0u;
#pragma unroll
        for (unsigned j = 0; j < 16; ++j) { const unsigned c = xb_ld(&bar[XB_XCNT(j)]); sum += c; cnt += (c > 0u) ? 1u : 0u; mine = (j == x) ? c : mine; }
        if (sum == G) break;
        __builtin_amdgcn_s_sleep(1);
        if ((++sp & 255u) == 0u) { if (xb_ld(&bar[XB_TMO])) break; if (sp > XB_SPIN_CAP) { atomicAdd(&bar[XB_TMO], 1u); break; } }
    }
    nloc = mine > 0u ? mine : 1u; nx = cnt > 0u ? cnt : 1u;
}

__device__ __forceinline__ void xcd_barrier(const XcdBarrier& b) {
    asm volatile("s_waitcnt vmcnt(0)" ::: "memory");
    __syncthreads();
    if (threadIdx.x == 0) {
        unsigned* bar = b.bar;
        __builtin_amdgcn_s_waitcnt(0);
        unsigned nloc = b.st[0], nx = b.st[1];
        if (nloc == 0u) { xcd_barrier_complete(bar, b.x, nloc, nx); b.st[0] = nloc; b.st[1] = nx; }
        const unsigned old = xb_add(&bar[XB_XSUB(b.x)], 1u);
        const unsigned gen = old / nloc;
        if (old + 1u == (gen + 1u) * nloc) {
            __builtin_amdgcn_fence(__ATOMIC_RELEASE, "agent");
            asm volatile("s_waitcnt vmcnt(0)" ::: "memory");
            const unsigned og = xb_add(&bar[XB_TOP], 1u);
            const unsigned tg = og / nx;
            if (og + 1u == (tg + 1u) * nx) xb_add(&bar[XB_TOPGEN], 1u);
            else XB_SPIN(xb_ld(&bar[XB_TOPGEN]) == tg, bar);
            __builtin_amdgcn_fence(__ATOMIC_ACQUIRE, "agent");
            xb_add(&bar[XB_XGEN(b.x)], 1u);
            asm volatile("s_waitcnt vmcnt(0)" ::: "memory");
        } else {
            XB_SPIN(xb_ld(&bar[XB_XGEN(b.x)]) == gen, bar);
            __builtin_amdgcn_fence(__ATOMIC_ACQUIRE, "agent");
            asm volatile("s_waitcnt vmcnt(0)" ::: "memory");
        }
    }
    __syncthreads();
}

__device__ __forceinline__ void transpose_item(const float* W, int ldw, int col0, int K, int Nn, const float* g, bf16_t* WT, int row_off, LAS float* scr, int item, int lane) {
    const int nblk = Nn / 32, kb = item / nblk, nb = item % nblk, k0 = 64 * kb, n0 = 32 * nb;
    f32x4 v[8]; const int c4 = (lane & 7) * 4;
#pragma unroll
    for (int i = 0; i < 8; ++i) { const int kk = (lane >> 3) + 8 * i; v[i] = *(const f32x4*)(W + (size_t)(k0 + kk) * ldw + col0 + n0 + c4); }
#pragma unroll
    for (int i = 0; i < 8; ++i) { const int kk = (lane >> 3) + 8 * i; f32x4 w = v[i]; if (g) w *= g[k0 + kk];
        scr[kk * 33 + c4 + 0] = w[0]; scr[kk * 33 + c4 + 1] = w[1]; scr[kk * 33 + c4 + 2] = w[2]; scr[kk * 33 + c4 + 3] = w[3]; }
    LDS_FENCE();
    const int c = lane & 7;
#pragma unroll
    for (int j = 0; j < 4; ++j) { const int n = (lane >> 3) + 8 * j; const LAS float* s = scr + (8 * c) * 33 + n;
        u32x4 o; o.x = cvtpk(s[0 * 33], s[1 * 33]); o.y = cvtpk(s[2 * 33], s[3 * 33]); o.z = cvtpk(s[4 * 33], s[5 * 33]); o.w = cvtpk(s[6 * 33], s[7 * 33]);
        *(u32x4*)(WT + (size_t)(row_off + n0 + n) * K + k0 + 8 * c) = o; }
    LDS_FENCE();
}
template <int NR> __device__ __forceinline__ void rms_rows_to_bf16(const float* x, const float* g, bf16_t* o, int lane) {
    const f32x4* gr = (const f32x4*)g + lane;
    f32x4 v[NR][4]; float rs[NR];
#pragma unroll
    for (int i = 0; i < NR; ++i)
#pragma unroll
        for (int j = 0; j < 4; ++j) v[i][j] = ((const f32x4*)(x + (size_t)i * DM) + lane)[64 * j];
#pragma unroll
    for (int i = 0; i < NR; ++i) {
        float s = 0.f;
#pragma unroll
        for (int j = 0; j < 4; ++j) s += (v[i][j][0] * v[i][j][0] + v[i][j][1] * v[i][j][1]) + (v[i][j][2] * v[i][j][2] + v[i][j][3] * v[i][j][3]);
        rs[i] = 1.0f / sqrtf(wave_sum(s) * (1.0f / 1024.0f) + 1e-6f);
    }
#pragma unroll
    for (int j = 0; j < 4; ++j) { const f32x4 gg = gr[64 * j];
#pragma unroll
        for (int i = 0; i < NR; ++i) { u32x2 w; w.x = cvtpk(v[i][j][0] * rs[i] * gg[0], v[i][j][1] * rs[i] * gg[1]); w.y = cvtpk(v[i][j][2] * rs[i] * gg[2], v[i][j][3] * rs[i] * gg[3]); ((u32x2*)(o + (size_t)i * DM) + lane)[64 * j] = w; } }
}
__device__ __forceinline__ void p0_prologue(const Params& p, LAS unsigned char* lds, int G) {
    const int tid = threadIdx.x, lane = tid & 63, wave = __builtin_amdgcn_readfirstlane(tid >> 6);
    unsigned char* ws = p.ws;
    LAS float* scr = (LAS float*)(lds + wave * WAVE_LDS);
    const int gw = blockIdx.x * NWAVES + wave, NGW = G * NWAVES;
    bf16_t* Win_t = (bf16_t*)(ws + WS_WIN);
    constexpr int I_INA = 16 * 32, I_INB = 16 * 64, I_OUT = 16 * 32, I_Q = 16 * 32, I_KV = 16 * 64, I_O = 16 * 32, I_1 = 16 * 128, I_2 = 64 * 32;
    constexpr int NITEMS = I_INA + I_INB + I_OUT + I_Q + I_KV + I_O + I_1 + I_2;
    for (int it = gw; it < NITEMS; it += NGW) {
        int r = it;
        if (r < I_INA) { transpose_item(p.w_in, 3088, 0, 1024, 1024, nullptr, Win_t, 0, scr, r, lane); continue; } r -= I_INA;
        if (r < I_INB) { transpose_item(p.w_in, 3088, 1040, 1024, 2048, nullptr, Win_t, 1024, scr, r, lane); continue; } r -= I_INB;
        if (r < I_OUT) { transpose_item(p.w_out, 1024, 0, 1024, 1024, nullptr, (bf16_t*)(ws + WS_WOUT), 0, scr, r, lane); continue; } r -= I_OUT;
        if (r < I_Q) { transpose_item(p.xa_w_q, 1024, 0, 1024, 1024, p.norm_x_g, (bf16_t*)(ws + WS_WQ), 0, scr, r, lane); continue; } r -= I_Q;
        if (r < I_KV) { transpose_item(p.xa_w_kv, 2048, 0, 1024, 2048, nullptr, (bf16_t*)(ws + WS_WKV), 0, scr, r, lane); continue; } r -= I_KV;
        if (r < I_O) { transpose_item(p.xa_w_o, 1024, 0, 1024, 1024, nullptr, (bf16_t*)(ws + WS_WO), 0, scr, r, lane); continue; } r -= I_O;
        if (r < I_1) { transpose_item(p.ffn_w1, 4096, 0, 1024, 4096, p.norm_ffn_g, (bf16_t*)(ws + WS_W1), 0, scr, r, lane); continue; } r -= I_1;
        transpose_item(p.ffn_w2, 1024, 0, 4096, 1024, nullptr, (bf16_t*)(ws + WS_W2), 0, scr, r, lane);
    }
    const int gt = blockIdx.x * NTHREADS + tid, NGT = G * NTHREADS;
    for (int o = gt; o < 256 * 1024; o += NGT) {
        const int n = o >> 10, k = o & 1023; const float* wr = p.w_in + (size_t)k * 3088 + 1024; float s = 0.f;
#pragma unroll
        for (int r = 0; r < 16; ++r) s += wr[r] * p.gla_w_gate[r * 256 + n];
        Win_t[(size_t)(3072 + n) * 1024 + k] = f2bf(s);
    }
    float* cosT = (float*)(ws + WS_COS); float* sinT = (float*)(ws + WS_SIN);
    for (int o = gt; o < SEQ * 32; o += NGT) {
        const int pos = o >> 5, i = o & 31; double f = 1.0;
        for (int k = 0; k < i; ++k) f *= 0.7498942093324559;
        const double t = (double)pos * f * 0.15915494309189535;
        const float fr = (float)(t - floor(t));
        cosT[o] = __builtin_amdgcn_cosf(fr); sinT[o] = __builtin_amdgcn_sinf(fr);
    }
    bf16_t* XN = (bf16_t*)(ws + WS_A1); bf16_t* MEMN = (bf16_t*)(ws + WS_MEMN);
    for (int m4 = gw; m4 < (NTOK + NMEMROWS) / 4; m4 += NGW) {
        const int m = 4 * m4;
        if (m < NTOK) rms_rows_to_bf16<4>(p.x + (size_t)m * DM, p.norm_mix_g, XN + (size_t)m * DM, lane);
        else rms_rows_to_bf16<4>(p.mem + (size_t)(m - NTOK) * DM, p.norm_mem_g, MEMN + (size_t)(m - NTOK) * DM, lane);
    }
}

__device__ __forceinline__ void gla_gates(const bf16_t* P, int zcol, const float* bg, int r, int q, float (&bc)[4][2][8], float (&bl)[2][8]) {
    bf16x8 zf[4][2];
#pragma unroll
    for (int mt = 0; mt < 4; ++mt)
#pragma unroll
        for (int ks = 0; ks < 2; ++ks) zf[mt][ks] = *(const bf16x8*)(P + (size_t)(16 * mt + r) * NPROJ + zcol + 32 * ks + 8 * q);
    CFENCE();
#pragma unroll
    for (int ks = 0; ks < 2; ++ks) {
        const f32x4 b0 = *(const f32x4*)(bg + 32 * ks + 8 * q), b1 = *(const f32x4*)(bg + 32 * ks + 8 * q + 4);
#pragma unroll
        for (int mt = 0; mt < 4; ++mt) {
            f32x4 z0, z1; unpack8(zf[mt][ks], z0, z1); z0 += b0; z1 += b1;
#pragma unroll
            for (int e = 0; e < 4; ++e) {
                bc[mt][ks][e] = (fminf(z0[e], 0.f) - __logf(1.0f + __expf(-fabsf(z0[e])))) * (1.0f / 16.0f);
                bc[mt][ks][4 + e] = (fminf(z1[e], 0.f) - __logf(1.0f + __expf(-fabsf(z1[e])))) * (1.0f / 16.0f);
            }
        }
#pragma unroll
        for (int e = 0; e < 8; ++e) {
            float carry = 0.f;
#pragma unroll
            for (int mt = 0; mt < 4; ++mt) { const float v = scan16(bc[mt][ks][e], r); const float tot = __shfl(v, 15, 16); bc[mt][ks][e] = v + carry; carry += tot; }
            bl[ks][e] = carry;
        }
    }
}
__device__ __forceinline__ float ret_log2g(int hr) { return hr == 0 ? -0.04580368961312479f : hr == 1 ? -0.008973692110584325f : hr == 2 ? -0.0017761724589428754f : -0.0003522634716290214f; }
__device__ __forceinline__ void rope_tile(bf16x8 f0, bf16x8 f1, const float* cosT, const float* sinT, int pos, int q, f32x4 (&o)[4]) {
    f32x4 a0, a1, b0, b1; unpack8(f0, a0, a1); unpack8(f1, b0, b1);
    const f32x4 c0 = *(const f32x4*)(cosT + pos * 32 + 8 * q), c1 = *(const f32x4*)(cosT + pos * 32 + 8 * q + 4), s0 = *(const f32x4*)(sinT + pos * 32 + 8 * q), s1 = *(const f32x4*)(sinT + pos * 32 + 8 * q + 4);
    o[0] = a0 * c0 - b0 * s0; o[1] = a1 * c1 - b1 * s1; o[2] = a0 * s0 + b0 * c0; o[3] = a1 * s1 + b1 * c1;
}

__device__ __forceinline__ void chunk_contrib(const Params& p, LAS unsigned char* lds, int G) {
    const int tid = threadIdx.x, lane = tid & 63, wave = __builtin_amdgcn_readfirstlane(tid >> 6);
    unsigned char* ws = p.ws;
    const bf16_t* PROJ = (const bf16_t*)(ws + WS_BIG); bf16_t* CT = (bf16_t*)(ws + WS_A2); float* DEC = (float*)(ws + WS_DEC);
    const float* cosT = (const float*)(ws + WS_COS); const float* sinT = (const float*)(ws + WS_SIN);
    LAS bf16_t* Kdt = (LAS bf16_t*)(lds + wave * WAVE_LDS); LAS bf16_t* Vt = Kdt + 64 * VPITCH;
    for (int u = blockIdx.x * NWAVES + wave; u < NBATCH * NCHUNK * 8; u += G * NWAVES) {
        int h8 = u & 7; asm volatile("" : "+s"(h8));
        const int bn = u >> 3, b = bn >> 7, n = bn & 127;
        const size_t tok0 = (size_t)b * SEQ + (size_t)n * 64;
        const bf16_t* P = PROJ + tok0 * NPROJ;
        const int unit = (b * 8 + h8) * NCHUNK + n;
        int ln = lane; asm volatile("" : "+v"(ln));
        const int r = ln & 15, q = ln >> 4;
        const int vcol = (h8 < 4) ? C_GV + h8 * 128 : C_RV + (h8 - 4) * 128;
        const int kcol = (h8 < 4) ? C_GK + h8 * 64 : C_RK + (h8 - 4) * 64;
        bf16x8 kf[4][2];
#pragma unroll
        for (int mt = 0; mt < 4; ++mt)
#pragma unroll
            for (int ks = 0; ks < 2; ++ks) kf[mt][ks] = *(const bf16x8*)(P + (size_t)(16 * mt + r) * NPROJ + kcol + 32 * ks + 8 * q);
        LDS_FENCE();
        if (h8 < 4) {
            const int h = h8;
            float bc[4][2][8], bl[2][8];
            gla_gates(P, C_Z + h * 64, p.gla_b_gate + h * 64, r, q, bc, bl);
            if (r == 0) {
#pragma unroll
                for (int ks = 0; ks < 2; ++ks) {
                    f32x4 d0, d1;
#pragma unroll
                    for (int e = 0; e < 4; ++e) { d0[e] = __expf(bl[ks][e]); d1[e] = __expf(bl[ks][4 + e]); }
                    *(f32x4*)(DEC + (size_t)unit * 64 + 32 * ks + 8 * q) = d0; *(f32x4*)(DEC + (size_t)unit * 64 + 32 * ks + 8 * q + 4) = d1;
                }
            }
#pragma unroll
            for (int mt = 0; mt < 4; ++mt)
#pragma unroll
                for (int ks = 0; ks < 2; ++ks) {
                    f32x4 k0, k1; unpack8(kf[mt][ks], k0, k1);
#pragma unroll
                    for (int e = 0; e < 4; ++e) {
                        Kdt[(32 * ks + 8 * q + e) * VPITCH + 16 * mt + r] = f2bf(k0[e] * __expf(bl[ks][e] - bc[mt][ks][e]));
                        Kdt[(32 * ks + 8 * q + 4 + e) * VPITCH + 16 * mt + r] = f2bf(k1[e] * __expf(bl[ks][4 + e] - bc[mt][ks][4 + e]));
                    }
                }
        } else {
            const int hr = h8 - 4; const float l2g = ret_log2g(hr);
            if (r == 0) {
                const float d = exp2f(64.0f * l2g); const f32x4 dv = {d, d, d, d};
#pragma unroll
                for (int ks = 0; ks < 2; ++ks) { *(f32x4*)(DEC + (size_t)unit * 64 + 32 * ks + 8 * q) = dv; *(f32x4*)(DEC + (size_t)unit * 64 + 32 * ks + 8 * q + 4) = dv; }
            }
#pragma unroll
            for (int mt = 0; mt < 4; ++mt) {
                CFENCE();
                f32x4 o[4]; rope_tile(kf[mt][0], kf[mt][1], cosT, sinT, n * 64 + 16 * mt + r, q, o);
                const float sc = 0.125f * exp2f((float)(63 - (16 * mt + r)) * l2g);
#pragma unroll
                for (int e = 0; e < 4; ++e) {
                    Kdt[(8 * q + e) * VPITCH + 16 * mt + r] = f2bf(o[0][e] * sc); Kdt[(8 * q + 4 + e) * VPITCH + 16 * mt + r] = f2bf(o[1][e] * sc);
                    Kdt[(32 + 8 * q + e) * VPITCH + 16 * mt + r] = f2bf(o[2][e] * sc); Kdt[(32 + 8 * q + 4 + e) * VPITCH + 16 * mt + r] = f2bf(o[3][e] * sc);
                }
            }
        }
        bf16_t* outp = CT + (size_t)unit * 8192;
#pragma unroll 1
        for (int vh = 0; vh < 2; ++vh) {
            CFENCE();
            bf16x8 xv[8];
#pragma unroll
            for (int i = 0; i < 8; ++i) xv[i] = *(const bf16x8*)(P + (size_t)(i * 8 + (ln >> 3)) * NPROJ + vcol + vh * 64 + (ln & 7) * 8);
            LDS_FENCE();
#pragma unroll
            for (int i = 0; i < 8; ++i) {
                const int token = i * 8 + (ln >> 3), vv = (ln & 7) * 8;
#pragma unroll
                for (int e = 0; e < 8; ++e) Vt[(vv + e) * VPITCH + token] = (bf16_t)xv[i][e];
            }
            LDS_FENCE();
#pragma unroll
            for (int vt = 0; vt < 4; ++vt) {
                CFENCE();
                bf16x8 a[2];
#pragma unroll
                for (int s = 0; s < 2; ++s) a[s] = *(const LAS bf16x8*)(Vt + (16 * vt + r) * VPITCH + 32 * s + 8 * q);
#pragma unroll
                for (int dt = 0; dt < 4; ++dt) {
                    f32x4 acc = {0.f, 0.f, 0.f, 0.f};
#pragma unroll
                    for (int s = 0; s < 2; ++s) { const bf16x8 bb = *(const LAS bf16x8*)(Kdt + (16 * dt + r) * VPITCH + 32 * s + 8 * q); acc = MFMA16(a[s], bb, acc); }
#pragma unroll
                    for (int e = 0; e < 4; ++e) outp[(vh * 64 + 16 * vt + 4 * q + e) * 64 + 16 * dt + r] = f2bf(acc[e]);
                }
            }
        }
    }
}

__device__ __forceinline__ void chunk_scan(const Params& p, int G) {
    unsigned char* ws = p.ws; bf16_t* CT = (bf16_t*)(ws + WS_A2); const float* DEC = (const float*)(ws + WS_DEC);
    typedef float f32x2v __attribute__((ext_vector_type(2)));
    const int NGT = G * NTHREADS;
    for (int o = blockIdx.x * NTHREADS + threadIdx.x; o < 32 * 128 * 32; o += NGT) {
        const int d2 = o & 31, v = (o >> 5) & 127, bh = o >> 12;
        bf16_t* base = CT + (size_t)bh * NCHUNK * 8192 + v * 64 + d2 * 2; const float* dbase = DEC + (size_t)bh * NCHUNK * 64 + d2 * 2;
        float s0 = 0.f, s1 = 0.f;
#pragma unroll 1
        for (int n0 = 0; n0 < NCHUNK; n0 += 32) {
            unsigned uu[32]; f32x2v dd[32];
#pragma unroll
            for (int j = 0; j < 32; ++j) { uu[j] = *(const unsigned*)(base + (size_t)(n0 + j) * 8192); dd[j] = *(const f32x2v*)(dbase + (size_t)(n0 + j) * 64); }
#pragma unroll
            for (int j = 0; j < 32; ++j) {
                *(unsigned*)(base + (size_t)(n0 + j) * 8192) = cvtpk(s0, s1);
                s0 = dd[j][0] * s0 + __uint_as_float(uu[j] << 16); s1 = dd[j][1] * s1 + __uint_as_float(uu[j] & 0xffff0000u);
            }
        }
    }
}

template <bool GN> __device__ __forceinline__ void norm_gate_store(const f32x4 (&O)[8], const bf16x8 (&gt)[4], const float (&gn)[8], int it, int r, int q, bf16_t* y) {
    f32x4 mean = {0.f, 0.f, 0.f, 0.f};
    if (GN) {
        f32x4 s = {0.f, 0.f, 0.f, 0.f};
#pragma unroll
        for (int vt = 0; vt < 8; ++vt) s += O[vt];
#pragma unroll
        for (int e = 0; e < 4; ++e) { float t = s[e]; t += __shfl_xor(t, 1); t += __shfl_xor(t, 2); t += __shfl_xor(t, 4); t += __shfl_xor(t, 8); mean[e] = t * (1.0f / 128.0f); }
    }
    f32x4 ss = {0.f, 0.f, 0.f, 0.f};
#pragma unroll
    for (int vt = 0; vt < 8; ++vt) { const f32x4 d = O[vt] - mean; ss += d * d; }
    f32x4 rstd;
#pragma unroll
    for (int e = 0; e < 4; ++e) { float t = ss[e]; t += __shfl_xor(t, 1); t += __shfl_xor(t, 2); t += __shfl_xor(t, 4); t += __shfl_xor(t, 8); rstd[e] = __builtin_amdgcn_rsqf(t * (1.0f / 128.0f) + 1e-6f); }
#pragma unroll
    for (int e = 0; e < 4; ++e) {
        const int i = 16 * it + 4 * q + e;
        f32x4 g0, g1; unpack8(gt[e], g0, g1);
        f32x4 o0, o1;
#pragma unroll
        for (int vt = 0; vt < 4; ++vt) {
            const float ga = g0[vt], gb = g1[vt];
            o0[vt] = (O[vt][e] - mean[e]) * rstd[e] * gn[vt] * (ga * __builtin_amdgcn_rcpf(1.0f + __expf(-ga)));
            o1[vt] = (O[4 + vt][e] - mean[e]) * rstd[e] * gn[4 + vt] * (gb * __builtin_amdgcn_rcpf(1.0f + __expf(-gb)));
        }
        *(bf16x8*)(y + (size_t)i * DM + 8 * r) = pack8(o0, o1);
    }
}
__device__ __forceinline__ void out_tile(f32x4 (&O)[8], const bf16x8 (&pf)[2], const bf16x8 (&qi)[2], const LAS bf16_t* Vt, const bf16x8 (&spf)[8][2], int r, int q) {
#pragma unroll
    for (int vt = 0; vt < 8; ++vt) {
        f32x4 acc = {0.f, 0.f, 0.f, 0.f};
#pragma unroll
        for (int s = 0; s < 2; ++s) {
            const u32x2 lo = *(const LAS u32x2*)(Vt + (16 * vt + r) * VPITCH + 32 * s + 4 * q), hi = *(const LAS u32x2*)(Vt + (16 * vt + r) * VPITCH + 32 * s + 16 + 4 * q);
            const u32x4 w = {lo.x, lo.y, hi.x, hi.y};
            acc = MFMA16(pf[s], __builtin_bit_cast(bf16x8, w), acc);
        }
#pragma unroll
        for (int ks = 0; ks < 2; ++ks) acc = MFMA16(qi[ks], spf[vt][ks], acc);
        O[vt] = acc;
    }
}
template <bool GN> __device__ __forceinline__ void out_all(const bf16x8 (&pfa)[4][2], const bf16x8 (&QI)[4][2], const LAS bf16_t* Vt, const bf16_t* SP, const float* gain, const bf16_t* gate, bf16_t* y, int r, int q) {
    bf16x8 spf[8][2]; float gn[8];
    { const f32x4 ga = *(const f32x4*)(gain + 8 * r), gb = *(const f32x4*)(gain + 8 * r + 4);
#pragma unroll
      for (int vt = 0; vt < 4; ++vt) { gn[vt] = ga[vt]; gn[4 + vt] = gb[vt]; } }
#pragma unroll
    for (int vt = 0; vt < 8; ++vt)
#pragma unroll
        for (int ks = 0; ks < 2; ++ks) spf[vt][ks] = *(const bf16x8*)(SP + (8 * r + vt) * 64 + 32 * ks + 8 * q);
#pragma unroll
    for (int it = 0; it < 4; ++it) {
        CFENCE();
        bf16x8 gt[4];
#pragma unroll
        for (int e = 0; e < 4; ++e) gt[e] = *(const bf16x8*)(gate + (size_t)(16 * it + 4 * q + e) * NPROJ + 8 * r);
        CFENCE();
        f32x4 O[8];
        out_tile(O, pfa[it], QI[it], Vt, spf, r, q);
        CFENCE();
        norm_gate_store<GN>(O, gt, gn, it, r, q, y);
    }
}

__device__ __forceinline__ void chunk_output(const Params& p, LAS unsigned char* lds, int G) {
    const int tid = threadIdx.x, lane = tid & 63, wave = __builtin_amdgcn_readfirstlane(tid >> 6);
    unsigned char* ws = p.ws;
    const bf16_t* PROJ = (const bf16_t*)(ws + WS_BIG); const bf16_t* SPB = (const bf16_t*)(ws + WS_A2); bf16_t* Y = (bf16_t*)(ws + WS_A1);
    const float* cosT = (const float*)(ws + WS_COS); const float* sinT = (const float*)(ws + WS_SIN);
    LAS bf16_t* Vt = (LAS bf16_t*)(lds + wave * WAVE_LDS);
    for (int u = blockIdx.x * NWAVES + wave; u < NBATCH * NCHUNK * 8; u += G * NWAVES) {
        int h8 = u & 7; asm volatile("" : "+s"(h8));
        const int bn = u >> 3, b = bn >> 7, n = bn & 127;
        const size_t tok0 = (size_t)b * SEQ + (size_t)n * 64;
        const bf16_t* P = PROJ + tok0 * NPROJ;
        const int unit = (b * 8 + h8) * NCHUNK + n;
        const bf16_t* SP = SPB + (size_t)unit * 8192;
        int ln = lane; asm volatile("" : "+v"(ln));
        const int r = ln & 15, q = ln >> 4;
        const int vcol = (h8 < 4) ? C_GV + h8 * 128 : C_RV + (h8 - 4) * 128;
        LDS_FENCE();
        {
            bf16x8 xv[16];
#pragma unroll
            for (int i = 0; i < 16; ++i) xv[i] = *(const bf16x8*)(P + (size_t)(i * 4 + q) * NPROJ + vcol + r * 8);
            CFENCE();
#pragma unroll
            for (int i = 0; i < 16; ++i) {
                const int token = i * 4 + q;
#pragma unroll
                for (int e = 0; e < 8; ++e) Vt[(16 * e + r) * VPITCH + token] = (bf16_t)xv[i][e];
            }
        }
        LDS_FENCE();
        CFENCE();
#ifdef NO_GLA4
        if (false) {
#else
        if (h8 < 4) {
#endif
            const int h = h8;
            bf16x8 Qe[4][2], Qi[4][2], Ki[4][2], Ke[4][2], pfa[4][2];
            {
                bf16x8 qf[4][2], kf[4][2];
#pragma unroll
                for (int mt = 0; mt < 4; ++mt)
#pragma unroll
                    for (int ks = 0; ks < 2; ++ks) {
                        qf[mt][ks] = *(const bf16x8*)(P + (size_t)(16 * mt + r) * NPROJ + C_GQ + h * 64 + 32 * ks + 8 * q);
                        kf[mt][ks] = *(const bf16x8*)(P + (size_t)(16 * mt + r) * NPROJ + C_GK + h * 64 + 32 * ks + 8 * q);
                    }
                float bc[4][2][8], bl[2][8];
                gla_gates(P, C_Z + h * 64, p.gla_b_gate + h * 64, r, q, bc, bl);
#pragma unroll
                for (int mt = 0; mt < 4; ++mt)
#pragma unroll
                    for (int ks = 0; ks < 2; ++ks) {
                        CFENCE();
                        f32x4 q0, q1, k0, k1; unpack8(qf[mt][ks], q0, q1); unpack8(kf[mt][ks], k0, k1);
                        f32x4 e0, e1, i0, i1;
#pragma unroll
                        for (int e = 0; e < 4; ++e) { e0[e] = __expf(bc[mt][ks][e]); e1[e] = __expf(bc[mt][ks][4 + e]); i0[e] = __expf(-bc[mt][ks][e]); i1[e] = __expf(-bc[mt][ks][4 + e]); }
                        Qe[mt][ks] = pack8(q0 * e0 * 0.125f, q1 * e1 * 0.125f); Qi[mt][ks] = pack8(q0 * i0 * 0.125f, q1 * i1 * 0.125f);
                        Ki[mt][ks] = pack8(k0 * i0, k1 * i1); Ke[mt][ks] = pack8(k0 * e0, k1 * e1);
                    }
            }
#pragma unroll
            for (int it = 0; it < 4; ++it) {
                f32x4 Pt[4];
#pragma unroll
                for (int jt = 0; jt < 4; ++jt) {
                    f32x4 lo = {0.f, 0.f, 0.f, 0.f}, up = {0.f, 0.f, 0.f, 0.f};
                    if (jt <= it) { lo = MFMA16(Ki[jt][0], Qe[it][0], lo); lo = MFMA16(Ki[jt][1], Qe[it][1], lo); }
                    if (jt >= it) { up = MFMA16(Ke[jt][0], Qi[it][0], up); up = MFMA16(Ke[jt][1], Qi[it][1], up); }
                    if (jt < it) Pt[jt] = lo; else if (jt > it) Pt[jt] = up;
                    else {
#pragma unroll
                        for (int e = 0; e < 4; ++e) Pt[jt][e] = (4 * q + e <= r) ? lo[e] : up[e];
                    }
                }
                pfa[it][0] = pack8(Pt[0], Pt[1]); pfa[it][1] = pack8(Pt[2], Pt[3]);
                CFENCE();
            }
            out_all<false>(pfa, Qe, Vt, SP, p.gla_norm_g + h * 128, P + C_GG + h * 128, Y + tok0 * DM + h * 128, r, q);
        }
#ifdef NO_RET4
        else if (false) {
#else
        else {
#endif
            const int hr = h8 - 4; const float l2g = ret_log2g(hr);
            bf16x8 Qr[4][2], Qd[4][2], Kr[4][2], pfa[4][2];
            {
                bf16x8 qf[4][2], kf[4][2];
#pragma unroll
                for (int mt = 0; mt < 4; ++mt)
#pragma unroll
                    for (int ks = 0; ks < 2; ++ks) {
                        qf[mt][ks] = *(const bf16x8*)(P + (size_t)(16 * mt + r) * NPROJ + C_RQ + hr * 64 + 32 * ks + 8 * q);
                        kf[mt][ks] = *(const bf16x8*)(P + (size_t)(16 * mt + r) * NPROJ + C_RK + hr * 64 + 32 * ks + 8 * q);
                    }
#pragma unroll
                for (int mt = 0; mt < 4; ++mt) {
                    const int pos = n * 64 + 16 * mt + r;
                    CFENCE();
                    {
                        f32x4 o[4]; rope_tile(qf[mt][0], qf[mt][1], cosT, sinT, pos, q, o);
                        Qr[mt][0] = pack8(o[0], o[1]); Qr[mt][1] = pack8(o[2], o[3]);
                        const float qd = exp2f((float)(16 * mt + r + 1) * l2g);
                        Qd[mt][0] = pack8(o[0] * qd, o[1] * qd); Qd[mt][1] = pack8(o[2] * qd, o[3] * qd);
                    }
                    CFENCE();
                    {
                        f32x4 o[4]; rope_tile(kf[mt][0], kf[mt][1], cosT, sinT, pos, q, o);
                        Kr[mt][0] = pack8(o[0] * 0.125f, o[1] * 0.125f); Kr[mt][1] = pack8(o[2] * 0.125f, o[3] * 0.125f);
                    }
                }
            }
#pragma unroll
            for (int it = 0; it < 4; ++it) {
                f32x4 Pt[4];
#pragma unroll
                for (int jt = 0; jt < 4; ++jt) {
                    f32x4 st = {0.f, 0.f, 0.f, 0.f};
                    st = MFMA16(Kr[jt][0], Qr[it][0], st); st = MFMA16(Kr[jt][1], Qr[it][1], st);
#pragma unroll
                    for (int e = 0; e < 4; ++e) { const int dj = (16 * it + r) - (16 * jt + 4 * q + e); Pt[jt][e] = st[e] * exp2f((float)(dj < 0 ? -dj : dj) * l2g); }
                }
                pfa[it][0] = pack8(Pt[0], Pt[1]); pfa[it][1] = pack8(Pt[2], Pt[3]);
                CFENCE();
            }
            out_all<true>(pfa, Qd, Vt, SP, p.ret_norm_g + hr * 128, P + C_RG + hr * 128, Y + tok0 * DM + 512 + hr * 128, r, q);
        }
    }
}

__device__ __forceinline__ void stage_image(LAS unsigned char* lds, const bf16_t* src, int tid) {
#pragma unroll
    for (int i = 0; i < 16; ++i) { const int row = (tid >> 5) + 16 * i, c = tid & 31; const u32x4 x = *(const u32x4*)(src + (size_t)row * 256 + c * 8);
        *(LAS u32x4*)(lds + (16 * (tid >> 5) + i) * APITCH + c * 16) = x; }
}
__device__ __forceinline__ void cross_attention(const Params& p, LAS unsigned char* lds, int G) {
    const int tid = threadIdx.x, lane = tid & 63, wave = __builtin_amdgcn_readfirstlane(tid >> 6);
    unsigned char* ws = p.ws;
    const bf16_t* Q = (const bf16_t*)(ws + WS_A1); const bf16_t* Kb = (const bf16_t*)(ws + WS_KB); const bf16_t* Vtg = (const bf16_t*)(ws + WS_VT); bf16_t* OA = (bf16_t*)(ws + WS_BIG);
    for (int u = blockIdx.x; u < 512; u += G) {
        const int bh = u >> 5, b = bh >> 2, h = bh & 3, qb = u & 31;
        int ln = lane; asm volatile("" : "+v"(ln));
        const int r = ln & 15, q = ln >> 4;
        const size_t i0 = (size_t)b * SEQ + qb * 256 + wave * 32;
        __syncthreads();
        {
#pragma unroll
            for (int i = 0; i < 16; ++i) { const int row = (tid >> 5) + 16 * i, c = tid & 31; const u32x4 x = *(const u32x4*)(Kb + (size_t)(b * 256 + row) * 1024 + h * 256 + c * 8); *(LAS u32x4*)(lds + row * APITCH + c * 16) = x; }
        }
        bf16x8 Qf[2][8];
#pragma unroll
        for (int it = 0; it < 2; ++it)
#pragma unroll
            for (int ks = 0; ks < 8; ++ks) Qf[it][ks] = *(const bf16x8*)(Q + (i0 + 16 * it + r) * DM + h * 256 + 32 * ks + 8 * q);
        __syncthreads();
        bf16x8 pf[2][8];
        {
            f32x4 S[2][16];
#pragma unroll
            for (int mt = 0; mt < 16; ++mt) {
                f32x4 a0 = {0.f, 0.f, 0.f, 0.f}, a1 = {0.f, 0.f, 0.f, 0.f};
                CFENCE();
#pragma unroll
                for (int ks = 0; ks < 8; ++ks) { const bf16x8 a = *(const LAS bf16x8*)(lds + (16 * mt + r) * APITCH + (32 * ks + 8 * q) * 2); a0 = MFMA16(a, Qf[0][ks], a0); a1 = MFMA16(a, Qf[1][ks], a1); }
                S[0][mt] = a0; S[1][mt] = a1;
            }
#pragma unroll
            for (int it = 0; it < 2; ++it) {
                CFENCE();
                float mx = -3.0e38f;
#pragma unroll
                for (int mt = 0; mt < 16; ++mt) mx = fmaxf(fmaxf(fmaxf(S[it][mt][0], S[it][mt][1]), fmaxf(S[it][mt][2], S[it][mt][3])), mx);
                mx = fmaxf(mx, __shfl_xor(mx, 16)); mx = fmaxf(mx, __shfl_xor(mx, 32));
                CFENCE();
                float sum = 0.f;
#pragma unroll
                for (int mt = 0; mt < 16; ++mt) {
#pragma unroll
                    for (int e = 0; e < 4; ++e) { S[it][mt][e] = __builtin_amdgcn_exp2f(S[it][mt][e] - mx); sum += S[it][mt][e]; }
                }
                sum += __shfl_xor(sum, 16); sum += __shfl_xor(sum, 32);
                const float inv = 1.0f / sum;
                CFENCE();
#pragma unroll
                for (int s = 0; s < 8; ++s) { pf[it][s] = pack8(S[it][2 * s] * inv, S[it][2 * s + 1] * inv); CFENCE(); }
            }
        }
        __syncthreads();
        stage_image(lds, Vtg + (size_t)(b * 1024 + h * 256) * 256, tid);
        __syncthreads();
        unsigned ob[2][4][8];
#pragma unroll
        for (int np = 0; np < 8; ++np) {
            f32x4 a0[2], a1[2];
#pragma unroll
            for (int h2 = 0; h2 < 2; ++h2) {
                const int nt = 2 * np + h2;
                f32x4 c0 = {0.f, 0.f, 0.f, 0.f}, c1 = {0.f, 0.f, 0.f, 0.f};
                CFENCE();
#pragma unroll
                for (int s = 0; s < 8; ++s) {
                    const u32x2 lo = *(const LAS u32x2*)(lds + (16 * nt + r) * APITCH + (32 * s + 4 * q) * 2), hi = *(const LAS u32x2*)(lds + (16 * nt + r) * APITCH + (32 * s + 16 + 4 * q) * 2);
                    const u32x4 w = {lo.x, lo.y, hi.x, hi.y};
                    c0 = MFMA16(pf[0][s], __builtin_bit_cast(bf16x8, w), c0); c1 = MFMA16(pf[1][s], __builtin_bit_cast(bf16x8, w), c1);
                }
                a0[h2] = c0; a1[h2] = c1;
            }
#pragma unroll
            for (int e = 0; e < 4; ++e) { ob[0][e][np] = cvtpk(a0[0][e], a0[1][e]); ob[1][e][np] = cvtpk(a1[0][e], a1[1][e]); }
        }
#pragma unroll
        for (int it = 0; it < 2; ++it)
#pragma unroll
            for (int e = 0; e < 4; ++e) {
                bf16_t* o = OA + (i0 + 16 * it + 4 * q + e) * DM + h * 256 + 16 * r;
                const u32x4 w0 = {ob[it][e][0], ob[it][e][1], ob[it][e][2], ob[it][e][3]}, w1 = {ob[it][e][4], ob[it][e][5], ob[it][e][6], ob[it][e][7]};
                *(u32x4*)o = w0; *(u32x4*)(o + 8) = w1;
            }
    }
}

__device__ __forceinline__ void final_norm(const Params& p, int G) {
    const int lane = threadIdx.x & 63, wave = __builtin_amdgcn_readfirstlane(threadIdx.x >> 6);
    const bf16_t* H = (const bf16_t*)(p.ws + WS_A2); const float* SSQ = (const float*)(p.ws + WS_SSQ3);
    const f32x4 g0 = *(const f32x4*)(p.final_norm_g + lane * 8), g1 = *(const f32x4*)(p.final_norm_g + lane * 8 + 4), g2 = *(const f32x4*)(p.final_norm_g + 512 + lane * 8), g3 = *(const f32x4*)(p.final_norm_g + 512 + lane * 8 + 4);
    for (int m4 = blockIdx.x * NWAVES + wave; m4 < NTOK / 4; m4 += G * NWAVES) {
        bf16x8 h0[4], h1[4]; f32x4 sp[4];
#pragma unroll
        for (int j = 0; j < 4; ++j) {
            const size_t m = (size_t)m4 * 4 + j;
            h0[j] = *(const bf16x8*)(H + m * DM + lane * 8); h1[j] = *(const bf16x8*)(H + m * DM + 512 + lane * 8);
            sp[j] = *(const f32x4*)(SSQ + m * 16 + 4 * (lane & 3));
        }
#pragma unroll
        for (int j = 0; j < 4; ++j) {
            const size_t m = (size_t)m4 * 4 + j;
            float t = (sp[j][0] + sp[j][1]) + (sp[j][2] + sp[j][3]);
            t += __shfl_xor(t, 1); t += __shfl_xor(t, 2);
            const float rstd = 1.0f / sqrtf(t * (1.0f / 1024.0f) + 1e-6f);
            f32x4 a0, a1, b0, b1; unpack8(h0[j], a0, a1); unpack8(h1[j], b0, b1);
            float* o = p.out + m * DM + lane * 8;
            *(f32x4*)(o) = a0 * rstd * g0; *(f32x4*)(o + 4) = a1 * rstd * g1; *(f32x4*)(o + 512) = b0 * rstd * g2; *(f32x4*)(o + 516) = b1 * rstd * g3;
        }
    }
}

constexpr int NPHASE = 12;
__global__ void __launch_bounds__(NTHREADS, 2) fwd_megakernel(Params p) {
    extern __shared__ __attribute__((aligned(16))) unsigned char lds_raw[];
    LAS unsigned char* lds = (LAS unsigned char*)lds_raw;
    cg::grid_group grid = cg::this_grid();
    const int G = gridDim.x, lo = p.ph_lo, hi = p.ph_hi;
    unsigned char* ws = p.ws;
#define IN(k) (lo <= (k) && (k) < hi)
#ifndef DBG_REP
#define DBG_REP (-1)
#endif
#define REPS(k) ((DBG_REP) == (k) ? 2 : 1)
#define SEAM(k) do { if (IN(k) && IN((k) + 1)) xcd_barrier(bar); } while (0)
    LAS unsigned* misc = (LAS unsigned*)(lds + MISC_OFF);
    if (threadIdx.x < 16) misc[threadIdx.x] = 0u;
    __syncthreads();
    XcdBarrier bar; bar.bar = (unsigned*)(ws + WS_CTL); bar.x = 0; bar.st = nullptr;
    if (hi - lo > 1) { bar = xcd_barrier_post((unsigned*)(ws + WS_CTL), (volatile LAS unsigned*)misc); grid.sync(); }
#ifndef NO_P0
    if (IN(0)) { p0_prologue(p, lds, G); }
#endif
#if defined(DBG_REP) && DBG_REP == 0
    __syncthreads(); if (IN(0)) { p0_prologue(p, lds, G); }
#endif
    SEAM(0);
    if (IN(1)) {
        {
            pg8::Gemm g{(const bf16_t*)(ws + WS_A1), (const bf16_t*)(ws + WS_WIN), NTOK, NPROJ, DM}; pg8::StaticOrder S; S.init(NTOK, NPROJ, G, (int)blockIdx.x);
            pg8::EpiBf16<0> E{(bf16_t*)(ws + WS_BIG), NPROJ, nullptr, 0, 0, 1.f};
            pg8::gemm_phase<pg8::EpiBf16<0>, pg8::StaticOrder, true, true>(lds, g, S, E);
        }
        __syncthreads();
        {
            pg8::Gemm g{(const bf16_t*)(ws + WS_MEMN), (const bf16_t*)(ws + WS_WKV), NMEMROWS, 2048, DM}; pg8::StaticOrder S; S.init(NMEMROWS, 2048, G, (int)((blockIdx.x + G / 2) % G));
            pg8::EpiKV E{(bf16_t*)(ws + WS_KB), (bf16_t*)(ws + WS_VT)};
            pg8::gemm_phase<pg8::EpiKV, pg8::StaticOrder, true, true>(lds, g, S, E);
        }
        __syncthreads();
    } SEAM(1);
    #ifndef NO_P2
    if (IN(2)) { chunk_contrib(p, lds, G); }
#endif
#if defined(DBG_REP) && DBG_REP == 2
    __syncthreads(); if (IN(2)) { chunk_contrib(p, lds, G); }
#endif
    SEAM(2);
    if (IN(3)) { chunk_scan(p, G); } SEAM(3);
    #ifndef NO_P4
    if (IN(4)) { chunk_output(p, lds, G); }
#endif
#if defined(DBG_REP) && DBG_REP == 4
    __syncthreads(); if (IN(4)) { chunk_output(p, lds, G); }
#endif
    SEAM(4);
    if (IN(5)) {
        pg8::Gemm g{(const bf16_t*)(ws + WS_A1), (const bf16_t*)(ws + WS_WOUT), NTOK, DM, DM}; pg8::StaticOrder S; S.init(NTOK, DM, G, (int)blockIdx.x);
        pg8::EpiRes<false> E{p.x, (bf16_t*)(ws + WS_A2), (float*)(ws + WS_SSQ1)};
        pg8::gemm_phase<pg8::EpiRes<false>, pg8::StaticOrder, true, true>(lds, g, S, E);
        __syncthreads();
    } SEAM(5);
#ifdef DBG_XBAR
    if (IN(5) && IN(6)) { for (int i_ = 0; i_ < 10; ++i_) xcd_barrier(bar); }
#endif
    if (IN(6)) {
        pg8::Gemm g{(const bf16_t*)(ws + WS_A2), (const bf16_t*)(ws + WS_WQ), NTOK, DM, DM}; pg8::StaticOrder S; S.init(NTOK, DM, G, (int)blockIdx.x);
        pg8::EpiScale<0> E{(bf16_t*)(ws + WS_A1), DM, (const float*)(ws + WS_SSQ1), 0.0625f * 1.4426950408889634f};
        pg8::gemm_phase<pg8::EpiScale<0>, pg8::StaticOrder, true, true>(lds, g, S, E);
        __syncthreads();
    } SEAM(6);
#ifndef NO_P7
    if (IN(7)) { cross_attention(p, lds, G); __syncthreads(); }
#endif
#if defined(DBG_REP) && DBG_REP == 7
    if (IN(7)) { cross_attention(p, lds, G); __syncthreads(); }
#endif
    SEAM(7);
    if (IN(8)) {
        pg8::Gemm g{(const bf16_t*)(ws + WS_BIG), (const bf16_t*)(ws + WS_WO), NTOK, DM, DM}; pg8::StaticOrder S; S.init(NTOK, DM, G, (int)blockIdx.x);
        pg8::EpiRes<true> E{(const void*)(ws + WS_A2), (bf16_t*)(ws + WS_A1), (float*)(ws + WS_SSQ2)};
        pg8::gemm_phase<pg8::EpiRes<true>, pg8::StaticOrder, true, true>(lds, g, S, E);
        __syncthreads();
    } SEAM(8);
    if (IN(9)) {
        pg8::Gemm g{(const bf16_t*)(ws + WS_A1), (const bf16_t*)(ws + WS_W1), NTOK, DFF, DM}; pg8::StaticOrder S; S.init(NTOK, DFF, G, (int)blockIdx.x);
        pg8::EpiScale<1> E{(bf16_t*)(ws + WS_BIG), DFF, (const float*)(ws + WS_SSQ2), 1.0f};
        pg8::gemm_phase<pg8::EpiScale<1>, pg8::StaticOrder, true, true>(lds, g, S, E);
        __syncthreads();
    } SEAM(9);
    if (IN(10)) {
        pg8::Gemm g{(const bf16_t*)(ws + WS_BIG), (const bf16_t*)(ws + WS_W2), NTOK, DM, DFF}; pg8::StaticOrder S; S.init(NTOK, DM, G, (int)blockIdx.x);
        pg8::EpiRes<true> E{(const void*)(ws + WS_A1), (bf16_t*)(ws + WS_A2), (float*)(ws + WS_SSQ3)};
        pg8::gemm_phase<pg8::EpiRes<true>, pg8::StaticOrder, true, true>(lds, g, S, E);
        __syncthreads();
    } SEAM(10);
    if (IN(11)) { final_norm(p, G); }
#undef IN
#undef SEAM
}

#ifndef MK_PER_PHASE
#define MK_PER_PHASE 0
#endif
#ifdef DBG_DUMP_OFF
__global__ void dump_kernel(const bf16_t* src, size_t n, float* out) {
    for (size_t i = (size_t)blockIdx.x * blockDim.x + threadIdx.x; i < (size_t)NTOK * DM; i += (size_t)gridDim.x * blockDim.x) {
        float s = 0.f; for (size_t j = i; j < n; j += (size_t)NTOK * DM) s += bf2f(src[j]); out[i] = s; }
}
#endif
extern "C" void kernel_launch(void* const* d_in, const int* in_sizes, int n_in, void* d_out, int out_size, void* d_ws, size_t ws_size, hipStream_t stream) {
    static int grid = 0;
    if (grid == 0) {
        if (n_in != 18 || ws_size < WS_NEED) { fprintf(stderr, "kernel_launch: expected 18 inputs and >= %zu bytes of workspace (got %d, %zu)\n", (size_t)WS_NEED, n_in, ws_size); grid = -1; return; }
        int dev = 0, cus = 0, per_cu = 0;
        (void)hipGetDevice(&dev); (void)hipDeviceGetAttribute(&cus, hipDeviceAttributeMultiprocessorCount, dev);
        if (hipFuncSetAttribute((const void*)fwd_megakernel, hipFuncAttributeMaxDynamicSharedMemorySize, LDS_BYTES) != hipSuccess) { fprintf(stderr, "kernel_launch: hipFuncSetAttribute failed\n"); grid = -1; return; }
        if (hipOccupancyMaxActiveBlocksPerMultiprocessor(&per_cu, (const void*)fwd_megakernel, NTHREADS, LDS_BYTES) != hipSuccess || per_cu < 1) { fprintf(stderr, "kernel_launch: occupancy query failed (%d)\n", per_cu); (void)hipGetLastError(); grid = -1; return; }
        grid = cus * per_cu;
    }
    if (grid < 0) return;
    Params p{};
    const float** pp = (const float**)&p;
    for (int i = 0; i < 18; ++i) pp[i] = (const float*)d_in[i];
    p.out = (float*)d_out; p.ws = (unsigned char*)d_ws;
#if MK_PER_PHASE
#ifndef DBG_HI
#define DBG_HI NPHASE
#endif
    for (int k = 0; k < DBG_HI; ++k) { p.ph_lo = k; p.ph_hi = k + 1; hipLaunchKernelGGL(fwd_megakernel, dim3(grid), dim3(NTHREADS), LDS_BYTES, stream, p);
#ifdef DBG_HOSTREP
        if (k == DBG_HOSTREP) hipLaunchKernelGGL(fwd_megakernel, dim3(grid), dim3(NTHREADS), LDS_BYTES, stream, p);
#endif
    }
#ifdef DBG_DUMP_OFF
    hipLaunchKernelGGL(dump_kernel, dim3(2048), dim3(256), 0, stream, (const bf16_t*)((unsigned char*)d_ws + (size_t)(DBG_DUMP_OFF) * MiB), (size_t)(DBG_DUMP_N), (float*)d_out);
#endif
#else
    p.ph_lo = 0; p.ph_hi = NPHASE;
    if (hipMemsetAsync((char*)d_ws + WS_CTL, 0, 16384, stream) != hipSuccess) { fprintf(stderr, "kernel_launch: hipMemsetAsync failed\n"); return; }
    void* args[] = {&p};
    const hipError_t e = hipLaunchCooperativeKernel((const void*)fwd_megakernel, dim3(grid), dim3(NTHREADS), args, LDS_BYTES, stream);
    if (e != hipSuccess) fprintf(stderr, "kernel_launch: cooperative launch failed: %s (grid %d)\n", hipGetErrorString(e), grid);
#endif
}
```

```cpp
#include <hip/hip_runtime.h>
#include <hip/hip_cooperative_groups.h>
#include <cstdio>
#include <cstdint>
namespace cg = cooperative_groups;
namespace pg8 {
#define PG8_LAS __attribute__((address_space(3)))
typedef unsigned short bf16_t;
typedef short bf16x8 __attribute__((ext_vector_type(8)));
typedef float f32x4 __attribute__((ext_vector_type(4)));
typedef unsigned u32x4 __attribute__((ext_vector_type(4)));
constexpr int BM = 256, BK = 64, HALF = 128, HTB = HALF * BK * 2  , STAGE_BYTES = 8 * HTB, NXCD = 8, WGM = 8;

__host__ __device__ __forceinline__ int lds_byte(int r, int c) { const int st = (r >> 4) * 2 + (c >> 5), rr = r & 15, cc = c & 31, ob = rr * 64 + cc * 2; return st * 1024 + (ob ^ (((ob >> 9) & 1) << 5)); }
__host__ __device__ __forceinline__ void stage_rc(int b, int& R, int& C) { const int st = b / 1024, sb = b % 1024, swz = sb ^ (((sb >> 9) & 1) << 5); R = (st >> 1) * 16 + swz / 64; C = (st & 1) * 32 + (swz % 64) / 2; }
__host__ __device__ __forceinline__ int perm32(int rho) { const int n = rho >> 4, i = rho & 15; return 8 * (i >> 2) + 4 * n + (i & 3); }

struct Unit { int pm, pn; };
struct Gemm { const bf16_t* A; const bf16_t* Bt; int M, N, K; };

struct StaticOrder {
    int nM, nN, nwg, G, c;
    __host__ __device__ void init(int M, int N, int G_, int c_) { nM = M / BM; nN = N / BM; nwg = nM * nN; G = G_; c = c_; }
    __host__ __device__ bool next(int i, Unit& u) const {
        const long L = (long)i * G + c; if (L >= nwg) return false;
        int wgid = (int)L; { const int q = nwg / NXCD, r = nwg % NXCD, xcd = wgid % NXCD, off = wgid / NXCD; wgid = (xcd < r ? xcd * (q + 1) : r * (q + 1) + (xcd - r) * q) + off; }
        const int nig = WGM * nN, gid = wgid / nig, fm = gid * WGM, gsz = (nM - fm) < WGM ? (nM - fm) : WGM;
        u.pm = fm + ((wgid % nig) % gsz); u.pn = (wgid % nig) / gsz; return true;
    }
    __device__ __forceinline__ void a_ready(const Unit&) const {}
    __device__ __forceinline__ void done(const Unit&) const {}
};

__device__ __forceinline__ unsigned cvt_pk_bf16(float lo, float hi) { unsigned r; asm volatile("v_cvt_pk_bf16_f32 %0, %1, %2" : "=v"(r) : "v"(lo), "v"(hi)); return r; }
typedef float f32x2 __attribute__((ext_vector_type(2)));
__device__ __forceinline__ f32x2 gelu_pk(f32x2 v) {
    const f32x2 av = __builtin_elementwise_abs(v), d = av * 0.2316418882f + 1.0f;
    f32x2 t; t.x = __builtin_amdgcn_rcpf(d.x); t.y = __builtin_amdgcn_rcpf(d.y);
    f32x2 q = t * 0.5307027145f + (-0.7265760135f); q = q * t + 0.7107068705f; q = q * t + (-0.142248368f); q = q * t + 0.127414796f; q = q * t;
    const f32x2 s = (v * v) * (-0.72134752044f);
    f32x2 e; e.x = __builtin_amdgcn_exp2f(s.x); e.y = __builtin_amdgcn_exp2f(s.y);
    const f32x2 m = v * (q * e), r = v - m;
    f32x2 o; o.x = v.x < 0.f ? m.x : r.x; o.y = v.y < 0.f ? m.y : r.y; return o;
}

template <int ACT  > struct EpiBf16 {
    static constexpr bool PERM = true, AFTER_DRAIN = false; static_assert(ACT == 0 || ACT == 1, "EpiBf16: ACT is 0 (none) or 1 (gelu_pk)");
    bf16_t* O; int ldc; const float* bias; int split_cols; size_t split_stride; float scale0;
    __device__ __forceinline__ void operator()(const f32x4 (&acc)[2][2][4][2], const Unit& u, int wr, int wc, int fr, int fq) const {
        const int row0 = u.pm * BM + wr * 64 + fr; int colt = u.pn * BM; bf16_t* base = O;
        float sc = 1.f; if (split_cols) { const int t = colt / split_cols; base += (size_t)t * split_stride; colt -= t * split_cols; if (t == 0) sc = scale0; }
        const int col0 = colt + wc * 32 + 8 * fq, bcol0 = u.pn * BM + wc * 32 + 8 * fq;
        f32x4 bv[2][2];
#pragma unroll
        for (int bj = 0; bj < 2; ++bj)
#pragma unroll
            for (int n = 0; n < 2; ++n) bv[bj][n] = bias ? *(const f32x4*)(bias + bcol0 + bj * HALF + 4 * n) : (f32x4){0.f, 0.f, 0.f, 0.f};
#pragma unroll
        for (int ai = 0; ai < 2; ++ai)
#pragma unroll
            for (int m = 0; m < 4; ++m) { bf16_t* rowp = base + (size_t)(row0 + ai * HALF + m * 16) * ldc + col0;
#pragma unroll
                for (int bj = 0; bj < 2; ++bj) { f32x4 v0 = acc[ai][bj][m][0] + bv[bj][0], v1 = acc[ai][bj][m][1] + bv[bj][1];
                    if (ACT == 1) { f32x2 a = gelu_pk((f32x2){v0[0], v0[1]}), b = gelu_pk((f32x2){v0[2], v0[3]}), c = gelu_pk((f32x2){v1[0], v1[1]}), d = gelu_pk((f32x2){v1[2], v1[3]});
                        v0 = (f32x4){a.x, a.y, b.x, b.y}; v1 = (f32x4){c.x, c.y, d.x, d.y}; }
                    v0 = v0 * sc; v1 = v1 * sc; u32x4 w; w.x = cvt_pk_bf16(v0[0], v0[1]); w.y = cvt_pk_bf16(v0[2], v0[3]); w.z = cvt_pk_bf16(v1[0], v1[1]); w.w = cvt_pk_bf16(v1[2], v1[3]);
                    *(u32x4*)(rowp + bj * HALF) = w; } }
    }
};

struct PanelStats {
    unsigned* xbuf;
    unsigned* cnt;
    unsigned* tmo;
    int ntn; float eps;
    unsigned code;
    __device__ __forceinline__ bool run(const f32x4 (&v)[2][2][4][2], const Unit& u, int wr, int wc, int fr, int fq, PG8_LAS unsigned char* lds, int wid, int lane) const {
        typedef float f32x2v __attribute__((ext_vector_type(2)));
        PG8_LAS f32x2v* P = (PG8_LAS f32x2v*)lds;
        PG8_LAS f32x2v* S = (PG8_LAS f32x2v*)(lds + 8192);
        PG8_LAS unsigned* flag = (PG8_LAS unsigned*)(lds + 8192 + 2048);
#pragma unroll
        for (int ai = 0; ai < 2; ++ai)
#pragma unroll
            for (int m = 0; m < 4; ++m) {
                float s = 0.f;
#pragma unroll
                for (int bj = 0; bj < 2; ++bj)
#pragma unroll
                    for (int n = 0; n < 2; ++n) { const f32x4 x = v[ai][bj][m][n]; s += (x[0] + x[1]) + (x[2] + x[3]); }
                s += __shfl_xor(s, 16); s += __shfl_xor(s, 32);
                const float mw = s * (1.0f / 64.0f); float q = 0.f;
#pragma unroll
                for (int bj = 0; bj < 2; ++bj)
#pragma unroll
                    for (int n = 0; n < 2; ++n) { const f32x4 d = v[ai][bj][m][n] - mw; q += (d[0] * d[0] + d[1] * d[1]) + (d[2] * d[2] + d[3] * d[3]); }
                q += __shfl_xor(q, 16); q += __shfl_xor(q, 32);
                if (fq == 0) P[(ai * HALF + wr * 64 + m * 16 + fr) * 4 + wc] = (f32x2v){mw, q};
            }
        asm volatile("s_waitcnt lgkmcnt(0)" ::: "memory"); __builtin_amdgcn_s_barrier(); asm volatile("" ::: "memory");
#if defined(BROKEN_EXCHANGE_NO_WAIT)
#warning BROKEN CONTROL BUILD: the row-statistics exchange does not wait; results are wrong by design
        if (blockIdx.x >= 64) { const long long t0_ = clock64(); while (clock64() - t0_ < 60000) __builtin_amdgcn_s_sleep(8); }
#endif
        const int row = wid * 32 + (lane & 31);
        if (lane < 32) {
            const f32x2v a = P[row * 4 + 0], b = P[row * 4 + 1], c = P[row * 4 + 2], d = P[row * 4 + 3];
            const float mt = (a.x + b.x + c.x + d.x) * 0.25f;
            const float da = a.x - mt, db = b.x - mt, dc = c.x - mt, dd = d.x - mt;
            const float m2 = (a.y + b.y) + (c.y + d.y) + 64.0f * ((da * da + db * db) + (dc * dc + dd * dd));
            unsigned long long* slot = (unsigned long long*)xbuf + ((size_t)(u.pm * BM + row) * 4 + u.pn);
            __hip_atomic_store(slot, ((unsigned long long)__float_as_uint(m2) << 32) | __float_as_uint(mt), __ATOMIC_RELAXED, __HIP_MEMORY_SCOPE_AGENT);
        }
        asm volatile("s_waitcnt vmcnt(0)" ::: "memory");
        if (lane == 0) __hip_atomic_fetch_add(cnt + 64 * u.pm, 1u, __ATOMIC_RELAXED, __HIP_MEMORY_SCOPE_AGENT);
        if (wid == 0) {
            bool dead = false; const unsigned long long t0 = __builtin_amdgcn_s_memrealtime(); const unsigned want = 8u * (unsigned)ntn;
            for (;;) {
#if defined(BROKEN_EXCHANGE_NO_WAIT)
                break;
#endif
                if ((unsigned)__builtin_amdgcn_readfirstlane(__hip_atomic_load(cnt + 64 * u.pm, __ATOMIC_RELAXED, __HIP_MEMORY_SCOPE_AGENT)) >= want) break;
                if (__builtin_amdgcn_s_memrealtime() - t0 > 2000000ull) {
                    if (lane == 0) { unsigned expect = 0u; __hip_atomic_compare_exchange_strong(tmo + 1, &expect, code | (unsigned)(u.pm & 0xff), __ATOMIC_RELAXED, __ATOMIC_RELAXED, __HIP_MEMORY_SCOPE_AGENT);
                                     __hip_atomic_store(tmo, 1u, __ATOMIC_RELAXED, __HIP_MEMORY_SCOPE_AGENT); }
                    dead = true; break; }
                __builtin_amdgcn_s_sleep(2);
            }
            __builtin_amdgcn_fence(__ATOMIC_ACQUIRE, "agent");
            if (lane == 0) flag[0] = dead ? 1u : 0u;
        }
        asm volatile("s_waitcnt vmcnt(0) lgkmcnt(0)" ::: "memory"); __builtin_amdgcn_s_barrier(); asm volatile("" ::: "memory");
        const bool bad = flag[0] != 0u;
        if (lane < 32) {
            const unsigned long long* slot = (const unsigned long long*)xbuf + (size_t)(u.pm * BM + row) * 4; float mt[4], m2[4]; float ms = 0.f;
#pragma unroll
            for (int t = 0; t < 4; ++t) { if (t < ntn) { const unsigned long long w = __hip_atomic_load(slot + t, __ATOMIC_RELAXED, __HIP_MEMORY_SCOPE_AGENT); mt[t] = __uint_as_float((unsigned)w); m2[t] = __uint_as_float((unsigned)(w >> 32)); } else { mt[t] = 0.f; m2[t] = 0.f; } ms += mt[t]; }
            const float mean = ms / (float)ntn; float q = 0.f;
#pragma unroll
            for (int t = 0; t < 4; ++t) if (t < ntn) { const float dm = mt[t] - mean; q += m2[t] + 256.0f * dm * dm; }
            S[row] = (f32x2v){mean, 1.0f / sqrtf(q / (256.0f * (float)ntn) + eps)};
        }
        asm volatile("s_waitcnt lgkmcnt(0)" ::: "memory"); __builtin_amdgcn_s_barrier(); asm volatile("" ::: "memory");
        return bad;
    }
};
struct EpiLnRes {
    static constexpr bool PERM = false, AFTER_DRAIN = true;
    const float* base; float* out; int ldc; const float* bias; PanelStats st; unsigned poison;
    __device__ __forceinline__ void fused(f32x4 (&acc)[2][2][4][2], const Unit& u, int wr, int wc, int fr, int fq, PG8_LAS unsigned char* lds, int wid, int lane) const {
        typedef float f32x2v __attribute__((ext_vector_type(2)));
        const PG8_LAS f32x2v* S = (const PG8_LAS f32x2v*)(lds + 8192);
        const int col0 = u.pn * BM + wc * 32 + 4 * fq;
#pragma unroll
        for (int bj = 0; bj < 2; ++bj)
#pragma unroll
            for (int n = 0; n < 2; ++n) { const f32x4 bv = bias ? *(const f32x4*)(bias + col0 + bj * HALF + n * 16) : (f32x4){0.f, 0.f, 0.f, 0.f};
#pragma unroll
                for (int ai = 0; ai < 2; ++ai)
#pragma unroll
                    for (int m = 0; m < 4; ++m) acc[ai][bj][m][n] += bv; }
        f32x4 pre[4][2][2];
#pragma unroll
        for (int m = 0; m < 4; ++m) { const size_t off = (size_t)(u.pm * BM + wr * 64 + m * 16 + fr) * ldc + col0;
#pragma unroll
            for (int bj = 0; bj < 2; ++bj)
#pragma unroll
                for (int n = 0; n < 2; ++n) pre[m][bj][n] = *(const f32x4*)(base + off + bj * HALF + n * 16); }
        const bool bad = st.run(acc, u, wr, wc, fr, fq, lds, wid, lane) || poison != 0u;
        const float qnan = __builtin_nanf("");
#pragma unroll
        for (int ai = 0; ai < 2; ++ai)
#pragma unroll
            for (int m = 0; m < 4; ++m) { const int r = ai * HALF + wr * 64 + m * 16 + fr; const f32x2v sr = S[r]; const size_t off = (size_t)(u.pm * BM + r) * ldc + col0;
#pragma unroll
                for (int bj = 0; bj < 2; ++bj)
#pragma unroll
                    for (int n = 0; n < 2; ++n) { const f32x4 bs = ai == 0 ? pre[m][bj][n] : *(const f32x4*)(base + off + bj * HALF + n * 16); f32x4 o = bs + (acc[ai][bj][m][n] - sr.x) * sr.y;
                        if (bad) o = (f32x4){qnan, qnan, qnan, qnan}; *(f32x4*)(out + off + bj * HALF + n * 16) = o; }
                if (m & 1) asm volatile("" ::: "memory"); }
    }
};
struct EpiLnResLn {
    static constexpr bool PERM = false, AFTER_DRAIN = true;
    const float* base; float* out; bf16_t* xn; int ldc; const float* bias; PanelStats st1, st2; unsigned poison;
    __device__ __forceinline__ void fused(f32x4 (&acc)[2][2][4][2], const Unit& u, int wr, int wc, int fr, int fq, PG8_LAS unsigned char* lds, int wid, int lane) const {
        typedef float f32x2v __attribute__((ext_vector_type(2))); typedef unsigned u32x2v __attribute__((ext_vector_type(2)));
        const PG8_LAS f32x2v* S = (const PG8_LAS f32x2v*)(lds + 8192);
        const int col0 = u.pn * BM + wc * 32 + 4 * fq;
#pragma unroll
        for (int bj = 0; bj < 2; ++bj)
#pragma unroll
            for (int n = 0; n < 2; ++n) { const f32x4 bv = bias ? *(const f32x4*)(bias + col0 + bj * HALF + n * 16) : (f32x4){0.f, 0.f, 0.f, 0.f};
#pragma unroll
                for (int ai = 0; ai < 2; ++ai)
#pragma unroll
                    for (int m = 0; m < 4; ++m) acc[ai][bj][m][n] += bv; }
        bool bad = st1.run(acc, u, wr, wc, fr, fq, lds, wid, lane) || poison != 0u;
        const float qnan = __builtin_nanf("");
#pragma unroll
        for (int ai = 0; ai < 2; ++ai)
#pragma unroll
            for (int m = 0; m < 4; ++m) { const int r = ai * HALF + wr * 64 + m * 16 + fr; const f32x2v sr = S[r]; const size_t off = (size_t)(u.pm * BM + r) * ldc + col0;
#pragma unroll
                for (int bj = 0; bj < 2; ++bj)
#pragma unroll
                    for (int n = 0; n < 2; ++n) { const f32x4 bs = *(const f32x4*)(base + off + bj * HALF + n * 16); acc[ai][bj][m][n] = bs + (acc[ai][bj][m][n] - sr.x) * sr.y; }
                asm volatile("" : "+v"(acc[ai][0][m][0]), "+v"(acc[ai][0][m][1]), "+v"(acc[ai][1][m][0]), "+v"(acc[ai][1][m][1]));
                if (m & 1) asm volatile("" ::: "memory"); }
        const bool bad1 = bad;
        bad = st2.run(acc, u, wr, wc, fr, fq, lds, wid, lane) || bad;
#pragma unroll
        for (int ai = 0; ai < 2; ++ai)
#pragma unroll
            for (int m = 0; m < 4; ++m) { const int r = ai * HALF + wr * 64 + m * 16 + fr; const f32x2v sr = S[r]; const size_t off = (size_t)(u.pm * BM + r) * ldc + col0;
#pragma unroll
                for (int bj = 0; bj < 2; ++bj)
#pragma unroll
                    for (int n = 0; n < 2; ++n) { const f32x4 x1 = acc[ai][bj][m][n]; *(f32x4*)(out + off + bj * HALF + n * 16) = bad1 ? (f32x4){qnan, qnan, qnan, qnan} : x1;
                        const f32x4 o = (x1 - sr.x) * sr.y; u32x2v w; w.x = cvt_pk_bf16(o[0], o[1]); w.y = cvt_pk_bf16(o[2], o[3]);
                        if (bad) { w.x = 0x7fc07fc0u; w.y = 0x7fc07fc0u; } *(u32x2v*)(xn + off + bj * HALF + n * 16) = w; }
                asm volatile("" ::: "memory"); }
    }
};

template <class Epi, class Sched, bool ALIGN_EPI = false, bool SP2 = false>
__device__ __forceinline__ void gemm_phase(PG8_LAS unsigned char* lds, const Gemm g, const Sched& S, const Epi& E) {
    const int tid = threadIdx.x, wid = __builtin_amdgcn_readfirstlane(tid >> 6), lane = tid & 63, wr = wid >> 2, wc = wid & 3, fr = lane & 15, fq = lane >> 4;
    const int K = g.K, nt = K / BK;
    unsigned voffA[2], voffB[2];
#pragma unroll
    for (int i = 0; i < 2; ++i) { int R, C; stage_rc(tid * 16 + i * 8192, R, C); const int Rb = Epi::PERM ? ((R & ~31) + perm32(R & 31)) : R;
        voffA[i] = (unsigned)(R * K + C) * 2u; voffB[i] = (unsigned)(Rb * K + C) * 2u; }
    const size_t kstep = (size_t)(BK * 2);
    const size_t hstep = (size_t)HALF * K * 2;
    const size_t tstep = 2 * hstep;
    const unsigned ldsw = (unsigned)wid * 1024u;
    const int aoff = lds_byte(wr * 64 + fr, fq * 8), boff = lds_byte(wc * 32 + fr, fq * 8);
#define PG8_SA(b, h) (((b) * 2 + (h)) * HTB)
#define PG8_SB(b, h) ((4 + (b) * 2 + (h)) * HTB)
#define PG8_STAGE(bufoff, gbase, voff) do { _Pragma("unroll") for (int _i = 0; _i < 2; ++_i) \
        __builtin_amdgcn_global_load_lds((const unsigned*)((const char*)(gbase) + (voff)[_i]), (PG8_LAS unsigned*)(lds + (bufoff) + ldsw + _i * 8192), 16, 0, 0); } while (0)
#define PG8_LDA(dst, b, h) do { _Pragma("unroll") for (int m = 0; m < 4; ++m) _Pragma("unroll") for (int k = 0; k < 2; ++k) dst[m][k] = *(const PG8_LAS bf16x8*)(lds + PG8_SA(b, h) + aoff + m * 2048 + k * 1024); } while (0)
#define PG8_LDB(dst, b, h) do { _Pragma("unroll") for (int n = 0; n < 2; ++n) _Pragma("unroll") for (int k = 0; k < 2; ++k) dst[n][k] = *(const PG8_LAS bf16x8*)(lds + PG8_SB(b, h) + boff + n * 2048 + k * 1024); } while (0)
#define PG8_MMA(ai, bj, At, Bt) do { __builtin_amdgcn_s_setprio(1); _Pragma("unroll") for (int m = 0; m < 4; ++m) _Pragma("unroll") for (int n = 0; n < 2; ++n) _Pragma("unroll") for (int k = 0; k < 2; ++k) \
        acc[ai][bj][m][n] = __builtin_amdgcn_mfma_f32_16x16x32_bf16(Bt[n][k], At[m][k], acc[ai][bj][m][n], 0, 0, 0); __builtin_amdgcn_s_setprio(0); } while (0)
#define PG8_WAIT_V(n) asm volatile("s_waitcnt vmcnt(" #n ")" ::: "memory")
#define PG8_WAIT_L(n) asm volatile("s_waitcnt lgkmcnt(" #n ")" ::: "memory")
#define PG8_BAR __builtin_amdgcn_s_barrier()
#define PG8_SCHED __builtin_amdgcn_sched_barrier(0)
    Unit cur, nxt; int ui = 0;
    if (!S.next(0, cur)) return;
    f32x4 acc[2][2][4][2];
#pragma unroll
    for (int a = 0; a < 2; ++a)
#pragma unroll
        for (int b = 0; b < 2; ++b)
#pragma unroll
            for (int m = 0; m < 4; ++m)
#pragma unroll
                for (int n = 0; n < 2; ++n) acc[a][b][m][n] = (f32x4){0.f, 0.f, 0.f, 0.f};
    bf16x8 At[4][2], B0[2][2], B1[2][2];
    const char* cA = (const char*)g.A + (size_t)cur.pm * tstep; const char* cB = (const char*)g.Bt + (size_t)cur.pn * tstep;
    S.a_ready(cur);
    if constexpr (SP2) {
        PG8_STAGE(PG8_SB(0, 0), cB, voffB); PG8_STAGE(PG8_SB(0, 1), cB + hstep, voffB); PG8_STAGE(PG8_SA(0, 0), cA, voffA); PG8_STAGE(PG8_SA(0, 1), cA + hstep, voffA);
        if (wr == 1) PG8_BAR;
        PG8_WAIT_V(2); PG8_BAR;
        PG8_STAGE(PG8_SB(1, 0), cB + kstep, voffB); PG8_STAGE(PG8_SA(1, 0), cA + kstep, voffA); PG8_STAGE(PG8_SB(1, 1), cB + hstep + kstep, voffB);
        PG8_WAIT_V(6); PG8_BAR;
    } else {
        PG8_STAGE(PG8_SB(0, 0), cB, voffB); PG8_STAGE(PG8_SA(0, 0), cA, voffA); PG8_STAGE(PG8_SB(0, 1), cB + hstep, voffB); PG8_STAGE(PG8_SA(0, 1), cA + hstep, voffA);
        if (wr == 1) PG8_BAR;
        PG8_WAIT_V(4); PG8_BAR;
        PG8_STAGE(PG8_SB(1, 0), cB + kstep, voffB); PG8_STAGE(PG8_SA(1, 0), cA + kstep, voffA); PG8_STAGE(PG8_SB(1, 1), cB + hstep + kstep, voffB);
        PG8_WAIT_V(6); PG8_BAR;
    }
    for (;;) {
        const bool has_next = S.next(ui + 1, nxt);
        const char* nA = has_next ? (const char*)g.A + (size_t)nxt.pm * tstep : cA; const char* nB = has_next ? (const char*)g.Bt + (size_t)nxt.pn * tstep : cB;
        for (int t = 0; t < nt; t += 2) {
            const bool last = (t == nt - 2);
            const char* a1 = cA + (size_t)(t + 1) * kstep;
            const char* a2 = last ? nA : cA + (size_t)(t + 2) * kstep; const char* b2 = last ? nB : cB + (size_t)(t + 2) * kstep;
            const char* a3 = a2 + kstep; const char* b3 = b2 + kstep;
            if (last && has_next) S.a_ready(nxt);
            if constexpr (SP2) {
            PG8_LDB(B0, 0, 0); PG8_LDB(B1, 0, 1); PG8_SCHED; PG8_LDA(At, 0, 0); PG8_STAGE(PG8_SA(1, 1), a1 + hstep, voffA);
            PG8_WAIT_V(8); PG8_WAIT_L(0); PG8_BAR; PG8_MMA(0, 0, At, B0); PG8_MMA(0, 1, At, B1); PG8_BAR; PG8_SCHED;
            PG8_LDA(At, 0, 1); PG8_STAGE(PG8_SB(0, 0), b2, voffB); PG8_STAGE(PG8_SB(0, 1), b2 + hstep, voffB); PG8_STAGE(PG8_SA(0, 0), a2, voffA);
            PG8_WAIT_V(8); PG8_WAIT_L(0); PG8_BAR; PG8_MMA(1, 0, At, B0); PG8_MMA(1, 1, At, B1); PG8_BAR; PG8_SCHED;
            PG8_LDB(B0, 1, 0); PG8_LDB(B1, 1, 1); PG8_SCHED; PG8_LDA(At, 1, 0); PG8_STAGE(PG8_SA(0, 1), a2 + hstep, voffA);
            PG8_WAIT_V(8); PG8_WAIT_L(0); PG8_BAR; PG8_MMA(0, 0, At, B0); PG8_MMA(0, 1, At, B1); PG8_BAR; PG8_SCHED;
            PG8_LDA(At, 1, 1); PG8_STAGE(PG8_SB(1, 0), b3, voffB); PG8_STAGE(PG8_SB(1, 1), b3 + hstep, voffB); PG8_STAGE(PG8_SA(1, 0), a3, voffA);
            PG8_WAIT_V(8); PG8_WAIT_L(0); PG8_BAR; PG8_MMA(1, 0, At, B0); PG8_MMA(1, 1, At, B1); PG8_BAR; PG8_SCHED;
            } else {
            PG8_LDB(B0, 0, 0); PG8_SCHED; PG8_LDA(At, 0, 0); PG8_STAGE(PG8_SA(1, 1), a1 + hstep, voffA);
            PG8_WAIT_L(8); PG8_BAR; PG8_WAIT_L(0); PG8_MMA(0, 0, At, B0); PG8_BAR; PG8_SCHED;
            PG8_LDB(B1, 0, 1); PG8_STAGE(PG8_SB(0, 0), b2, voffB);
            PG8_BAR; PG8_WAIT_L(0); PG8_MMA(0, 1, At, B1); PG8_BAR;
            PG8_LDA(At, 0, 1); PG8_STAGE(PG8_SA(0, 0), a2, voffA);
            PG8_BAR; PG8_WAIT_L(0); PG8_MMA(1, 0, At, B0); PG8_BAR; PG8_SCHED;
            PG8_STAGE(PG8_SB(0, 1), b2 + hstep, voffB);
            PG8_WAIT_V(6); PG8_BAR; PG8_MMA(1, 1, At, B1); PG8_BAR;
            PG8_LDB(B0, 1, 0); PG8_SCHED; PG8_LDA(At, 1, 0); PG8_STAGE(PG8_SA(0, 1), a2 + hstep, voffA);
            PG8_WAIT_L(8); PG8_BAR; PG8_WAIT_L(0); PG8_MMA(0, 0, At, B0); PG8_BAR; PG8_SCHED;
            PG8_LDB(B1, 1, 1); PG8_STAGE(PG8_SB(1, 0), b3, voffB);
            PG8_BAR; PG8_WAIT_L(0); PG8_MMA(0, 1, At, B1); PG8_BAR;
            PG8_LDA(At, 1, 1); PG8_STAGE(PG8_SA(1, 0), a3, voffA);
            PG8_BAR; PG8_WAIT_L(0); PG8_MMA(1, 0, At, B0); PG8_BAR; PG8_SCHED;
            PG8_STAGE(PG8_SB(1, 1), b3 + hstep, voffB);
            PG8_WAIT_V(6); PG8_BAR; PG8_MMA(1, 1, At, B1); PG8_BAR;
            }
        }
        if constexpr (ALIGN_EPI) { if (wr == 0) PG8_BAR; }
        if constexpr (!Epi::AFTER_DRAIN) { E(acc, cur, wr, wc, fr, fq); S.done(cur); }
        if (!has_next) break;
#pragma unroll
        for (int a = 0; a < 2; ++a)
#pragma unroll
            for (int b = 0; b < 2; ++b)
#pragma unroll
                for (int m = 0; m < 4; ++m)
#pragma unroll
                    for (int n = 0; n < 2; ++n) acc[a][b][m][n] = (f32x4){0.f, 0.f, 0.f, 0.f};
        cur = nxt; cA = nA; cB = nB; ++ui;
        if constexpr (ALIGN_EPI) { if (wr == 1) PG8_BAR; }
    }
    PG8_WAIT_V(0);
    if constexpr (!ALIGN_EPI) { if (wr == 0) PG8_BAR; }
    PG8_BAR;
    if constexpr (Epi::AFTER_DRAIN) { E.fused(acc, cur, wr, wc, fr, fq, lds, wid, lane); S.done(cur); }
#undef PG8_SA
#undef PG8_SB
#undef PG8_STAGE
#undef PG8_LDA
#undef PG8_LDB
#undef PG8_MMA
#undef PG8_WAIT_V
#undef PG8_WAIT_L
#undef PG8_BAR
#undef PG8_SCHED
}
}

typedef float f32x2_t __attribute__((ext_vector_type(2))); typedef __bf16 bf16x2_t __attribute__((ext_vector_type(2)));
__device__ __forceinline__ unsigned cvtpk(float lo, float hi) { f32x2_t v = {lo, hi}; bf16x2_t b = __builtin_convertvector(v, bf16x2_t); return __builtin_bit_cast(unsigned, b); }

namespace pg8 {
template <bool BASE_BF16> struct EpiRes {
    static constexpr bool PERM = true, AFTER_DRAIN = false;
    const void* base; bf16_t* hb; float* ssq;
    __device__ __forceinline__ void operator()(const f32x4 (&acc)[2][2][4][2], const Unit& u, int wr, int wc, int fr, int fq) const {
        const int row0 = u.pm * BM + wr * 64 + fr, col0 = u.pn * BM + wc * 32 + 8 * fq;
#pragma unroll
        for (int ai = 0; ai < 2; ++ai) {
            f32x4 b0[4][2], b1[4][2];
#pragma unroll
            for (int m = 0; m < 4; ++m)
#pragma unroll
                for (int bj = 0; bj < 2; ++bj) {
                    const size_t off = (size_t)(row0 + ai * HALF + m * 16) * 1024 + col0 + bj * HALF;
                    if (BASE_BF16) {
                        const u32x4 w = *(const u32x4*)((const bf16_t*)base + off);
                        b0[m][bj][0] = __uint_as_float(w.x << 16); b0[m][bj][1] = __uint_as_float(w.x & 0xffff0000u); b0[m][bj][2] = __uint_as_float(w.y << 16); b0[m][bj][3] = __uint_as_float(w.y & 0xffff0000u);
                        b1[m][bj][0] = __uint_as_float(w.z << 16); b1[m][bj][1] = __uint_as_float(w.z & 0xffff0000u); b1[m][bj][2] = __uint_as_float(w.w << 16); b1[m][bj][3] = __uint_as_float(w.w & 0xffff0000u);
                    } else { b0[m][bj] = *(const f32x4*)((const float*)base + off); b1[m][bj] = *(const f32x4*)((const float*)base + off + 4); }
                }
#pragma unroll
            for (int m = 0; m < 4; ++m) {
                const size_t row = (size_t)(row0 + ai * HALF + m * 16); float s = 0.f;
#pragma unroll
                for (int bj = 0; bj < 2; ++bj) {
                    const size_t off = row * 1024 + col0 + bj * HALF;
                    const f32x4 v0 = acc[ai][bj][m][0] + b0[m][bj], v1 = acc[ai][bj][m][1] + b1[m][bj];
                    s += (v0[0] * v0[0] + v0[1] * v0[1]) + (v0[2] * v0[2] + v0[3] * v0[3]) + (v1[0] * v1[0] + v1[1] * v1[1]) + (v1[2] * v1[2] + v1[3] * v1[3]);
                    u32x4 w; w.x = cvtpk(v0[0], v0[1]); w.y = cvtpk(v0[2], v0[3]); w.z = cvtpk(v1[0], v1[1]); w.w = cvtpk(v1[2], v1[3]); *(u32x4*)(hb + off) = w;
                }
                s += __shfl_xor(s, 16); s += __shfl_xor(s, 32); if (fq == 0) ssq[row * 16 + u.pn * 4 + wc] = s;
            }
        }
    }
};
template <int MODE> struct EpiScale {
    static constexpr bool PERM = true, AFTER_DRAIN = false;
    bf16_t* O; int ldc; const float* ssq; float scale;
    __device__ __forceinline__ void operator()(const f32x4 (&acc)[2][2][4][2], const Unit& u, int wr, int wc, int fr, int fq) const {
        const int row0 = u.pm * BM + wr * 64 + fr, col0 = u.pn * BM + wc * 32 + 8 * fq;
        f32x4 sp[2][4];
#pragma unroll
        for (int ai = 0; ai < 2; ++ai)
#pragma unroll
            for (int m = 0; m < 4; ++m) sp[ai][m] = *(const f32x4*)(ssq + (size_t)(row0 + ai * HALF + m * 16) * 16 + 4 * fq);
#pragma unroll
        for (int ai = 0; ai < 2; ++ai)
#pragma unroll
            for (int m = 0; m < 4; ++m) {
                const size_t row = (size_t)(row0 + ai * HALF + m * 16);
                float t = (sp[ai][m][0] + sp[ai][m][1]) + (sp[ai][m][2] + sp[ai][m][3]);
                t += __shfl_xor(t, 16); t += __shfl_xor(t, 32);
                const float rs = __builtin_amdgcn_rsqf(t * (1.0f / 1024.0f) + 1e-6f) * scale;
#pragma unroll
                for (int bj = 0; bj < 2; ++bj) {
                    f32x4 v0 = acc[ai][bj][m][0] * rs, v1 = acc[ai][bj][m][1] * rs;
                    if (MODE == 1) {
#pragma unroll
                        for (int e = 0; e < 4; ++e) { const float a = fmaxf(v0[e], 0.f), b = fmaxf(v1[e], 0.f); v0[e] = a * a; v1[e] = b * b; }
                    }
                    u32x4 w; w.x = cvtpk(v0[0], v0[1]); w.y = cvtpk(v0[2], v0[3]); w.z = cvtpk(v1[0], v1[1]); w.w = cvtpk(v1[2], v1[3]);
                    *(u32x4*)(O + row * ldc + col0 + bj * HALF) = w;
                }
            }
    }
};
struct EpiKV {
    static constexpr bool PERM = true, AFTER_DRAIN = false;
    bf16_t* Kb; bf16_t* Vt;
    __device__ __forceinline__ void operator()(const f32x4 (&acc)[2][2][4][2], const Unit& u, int wr, int wc, int fr, int fq) const {
        const int row0 = u.pm * BM + wr * 64 + fr, col0 = u.pn * BM + wc * 32 + 8 * fq;
#pragma unroll
        for (int ai = 0; ai < 2; ++ai)
#pragma unroll
            for (int m = 0; m < 4; ++m) {
                const int row = row0 + ai * HALF + m * 16;
#pragma unroll
                for (int bj = 0; bj < 2; ++bj) {
                    const int col = col0 + bj * HALF; const f32x4 v0 = acc[ai][bj][m][0], v1 = acc[ai][bj][m][1];
                    u32x4 w; w.x = cvtpk(v0[0], v0[1]); w.y = cvtpk(v0[2], v0[3]); w.z = cvtpk(v1[0], v1[1]); w.w = cvtpk(v1[2], v1[3]);
                    if (col < 1024) { *(u32x4*)(Kb + (size_t)row * 1024 + col) = w; }
                    else {
                        const int b = row >> 8, mm = row & 255; bf16_t* p = Vt + ((size_t)(b * 1024 + (col - 1024))) * 256 + mm;
                        p[0 * 256] = (bf16_t)(w.x & 0xffffu); p[1 * 256] = (bf16_t)(w.x >> 16); p[2 * 256] = (bf16_t)(w.y & 0xffffu); p[3 * 256] = (bf16_t)(w.y >> 16);
                        p[4 * 256] = (bf16_t)(w.z & 0xffffu); p[5 * 256] = (bf16_t)(w.z >> 16); p[6 * 256] = (bf16_t)(w.w & 0xffffu); p[7 * 256] = (bf16_t)(w.w >> 16);
                    }
                }
            }
    }
};
}

#define LAS __attribute__((address_space(3)))
typedef pg8::bf16_t bf16_t;
typedef pg8::bf16x8 bf16x8;
typedef pg8::f32x4 f32x4;
typedef pg8::u32x4 u32x4;
typedef unsigned u32x2 __attribute__((ext_vector_type(2)));

constexpr int NTOK = 32768, DM = 1024, SEQ = 8192, NBATCH = 4, NCHUNK = 128, NPROJ = 3328, DFF = 4096, NMEMROWS = 1024;
constexpr int C_GQ = 0, C_GK = 256, C_GV = 512, C_GG = 1024, C_RQ = 1536, C_RK = 1792, C_RV = 2048, C_RG = 2560, C_Z = 3072;
constexpr int NWAVES = 8, NTHREADS = 512;
constexpr int WAVE_LDS = 18432, MISC_OFF = NWAVES * WAVE_LDS, LDS_BYTES = MISC_OFF + 64;
constexpr int VPITCH = 72;
constexpr int APITCH = 528;
constexpr size_t MiB = 1u << 20;
constexpr size_t WS_WIN = 1 * MiB, WS_WOUT = 8 * MiB, WS_WQ = 10 * MiB, WS_WKV = 12 * MiB, WS_WO = 16 * MiB, WS_W1 = 18 * MiB, WS_W2 = 26 * MiB;
constexpr size_t WS_COS = 34 * MiB, WS_SIN = 35 * MiB, WS_MEMN = 36 * MiB, WS_KB = 38 * MiB, WS_VT = 40 * MiB, WS_DEC = 42 * MiB, WS_SSQ1 = 44 * MiB, WS_SSQ2 = 46 * MiB, WS_SSQ3 = 48 * MiB, WS_CTL = 0;
constexpr size_t WS_A1 = 64 * MiB;
constexpr size_t WS_A2 = 128 * MiB;
constexpr size_t WS_BIG = 192 * MiB;
constexpr size_t WS_NEED = 448 * MiB;

struct Params {
    const float *x, *mem, *norm_mix_g, *w_in, *gla_w_gate, *gla_b_gate, *gla_norm_g, *ret_norm_g, *w_out, *norm_x_g, *norm_mem_g, *xa_w_q, *xa_w_kv, *xa_w_o, *norm_ffn_g, *ffn_w1, *ffn_w2, *final_norm_g;
    float* out; unsigned char* ws; int ph_lo, ph_hi;
};

__device__ __forceinline__ float bf2f(unsigned short b) { return __uint_as_float(((unsigned)b) << 16); }
__device__ __forceinline__ unsigned short f2bf(float f) { const unsigned u = __float_as_uint(f); return (unsigned short)((u + 0x7fffu + ((u >> 16) & 1u)) >> 16); }
__device__ __forceinline__ bf16x8 pack8(f32x4 a, f32x4 b) {
    u32x4 w; w.x = cvtpk(a[0], a[1]); w.y = cvtpk(a[2], a[3]); w.z = cvtpk(b[0], b[1]); w.w = cvtpk(b[2], b[3]);
    return __builtin_bit_cast(bf16x8, w);
}
__device__ __forceinline__ void unpack8(bf16x8 v, f32x4& a, f32x4& b) {
    const u32x4 w = __builtin_bit_cast(u32x4, v);
    a[0] = __uint_as_float(w.x << 16); a[1] = __uint_as_float(w.x & 0xffff0000u); a[2] = __uint_as_float(w.y << 16); a[3] = __uint_as_float(w.y & 0xffff0000u);
    b[0] = __uint_as_float(w.z << 16); b[1] = __uint_as_float(w.z & 0xffff0000u); b[2] = __uint_as_float(w.w << 16); b[3] = __uint_as_float(w.w & 0xffff0000u);
}
__device__ __forceinline__ float wave_sum(float v) {
#pragma unroll
    for (int o = 1; o < 64; o <<= 1) v += __shfl_xor(v, o);
    return v;
}
#define MFMA16(a, b, c) __builtin_amdgcn_mfma_f32_16x16x32_bf16((a), (b), (c), 0, 0, 0)
#define LDS_FENCE() asm volatile("s_waitcnt lgkmcnt(0)" ::: "memory")
#define CFENCE() do { asm volatile("" ::: "memory"); __builtin_amdgcn_sched_barrier(0); } while (0)
__device__ __forceinline__ float scan16(float v, int r) {
#pragma unroll
    for (int off = 1; off < 16; off <<= 1) { const float t = __shfl_up(v, off, 16); if (r >= off) v += t; }
    return v;
}

#define XB_TMO      128
#define XB_XCNT(j)  (256  + 64 * (j))
#define XB_XSUB(j)  (1280 + 64 * (j))
#define XB_XGEN(j)  (2304 + 64 * (j))
#define XB_TOP      3328
#define XB_TOPGEN   3392
#define XCD_BAR_WORDS 3456
#define XB_SPIN_CAP (1u << 18)

__device__ __forceinline__ unsigned xb_ld(unsigned* p)              { return __hip_atomic_load(p, __ATOMIC_RELAXED, __HIP_MEMORY_SCOPE_AGENT); }
__device__ __forceinline__ unsigned xb_add(unsigned* p, unsigned v) { return __hip_atomic_fetch_add(p, v, __ATOMIC_RELAXED, __HIP_MEMORY_SCOPE_AGENT); }
__device__ __forceinline__ unsigned xb_xcc_id() { return (unsigned)__builtin_amdgcn_s_getreg((3 << 11) | 20) & 0xFu; }
#define XB_SPIN(cond, bar) do { unsigned _sp = 0; while (cond) { __builtin_amdgcn_s_sleep(1); \
    if ((++_sp & 255u) == 0u) { if (xb_ld(&(bar)[XB_TMO])) break; if (_sp > XB_SPIN_CAP) { atomicAdd(&(bar)[XB_TMO], 1u); break; } } } } while (0)

struct XcdBarrier {
    unsigned* bar; unsigned x;
    volatile LAS unsigned* st;
};

__device__ __forceinline__ XcdBarrier xcd_barrier_post(unsigned* bar, volatile LAS unsigned* st) {
    XcdBarrier b; b.bar = bar; b.x = xb_xcc_id(); b.st = st;
    if (threadIdx.x == 0) (void)xb_add(&bar[XB_XCNT(b.x)], 1u);
    return b;
}
__device__ __forceinline__ void xcd_barrier_complete(unsigned* bar, unsigned x, unsigned& nloc, unsigned& nx) {
    const unsigned G = gridDim.x * gridDim.y * gridDim.z;
    unsigned sum, cnt, mine, sp = 0u;
    for (;;) {
        sum = 0u; cnt = 0u; mine = 0u;
#pragma unroll
        for (unsigned j = 0; j < 16; ++j) { const unsigned c = xb_ld(&bar[XB_XCNT(j)]); sum += c; cnt += (c > 0u) ? 1u : 0u; mine = (j == x) ? c : mine; }
        if (sum == G) break;
        __builtin_amdgcn_s_sleep(1);
        if ((++sp & 255u) == 0u) { if (xb_ld(&bar[XB_TMO])) break; if (sp > XB_SPIN_CAP) { atomicAdd(&bar[XB_TMO], 1u); break; } }
    }
    nloc = mine > 0u ? mine : 1u; nx = cnt > 0u ? cnt : 1u;
}

__device__ __forceinline__ void xcd_barrier(const XcdBarrier& b) {
    asm volatile("s_waitcnt vmcnt(0)" ::: "memory");
    __syncthreads();
    if (threadIdx.x == 0) {
        unsigned* bar = b.bar;
        __builtin_amdgcn_s_waitcnt(0);
        unsigned nloc = b.st[0], nx = b.st[1];
        if (nloc == 0u) { xcd_barrier_complete(bar, b.x, nloc, nx); b.st[0] = nloc; b.st[1] = nx; }
        const unsigned old = xb_add(&bar[XB_XSUB(b.x)], 1u);
        const unsigned gen = old / nloc;
        if (old + 1u == (gen + 1u) * nloc) {
            __builtin_amdgcn_fence(__ATOMIC_RELEASE, "agent");
            asm volatile("s_waitcnt vmcnt(0)" ::: "memory");
            const unsigned og = xb_add(&bar[XB_TOP], 1u);
            const unsigned tg = og / nx;
            if (og + 1u == (tg + 1u) * nx) xb_add(&bar[XB_TOPGEN], 1u);
            else XB_SPIN(xb_ld(&bar[XB_TOPGEN]) == tg, bar);
            __builtin_amdgcn_fence(__ATOMIC_ACQUIRE, "agent");
            xb_add(&bar[XB_XGEN(b.x)], 1u);
            asm volatile("s_waitcnt vmcnt(0)" ::: "memory");
        } else {
            XB_SPIN(xb_ld(&bar[XB_XGEN(b.x)]) == gen, bar);
            __builtin_amdgcn_fence(__ATOMIC_ACQUIRE, "agent");
            asm volatile("s_waitcnt vmcnt(0)" ::: "memory");
        }
    }
    __syncthreads();
}

__device__ __forceinline__ void transpose_item(const float* W, int ldw, int col0, int K, int Nn, const float* g, bf16_t* WT, int row_off, LAS float* scr, int item, int lane) {
    const int nblk = Nn / 32, kb = item / nblk, nb = item % nblk, k0 = 64 * kb, n0 = 32 * nb;
    f32x4 v[8]; const int c4 = (lane & 7) * 4;
#pragma unroll
    for (int i = 0; i < 8; ++i) { const int kk = (lane >> 3) + 8 * i; v[i] = *(const f32x4*)(W + (size_t)(k0 + kk) * ldw + col0 + n0 + c4); }
#pragma unroll
    for (int i = 0; i < 8; ++i) { const int kk = (lane >> 3) + 8 * i; f32x4 w = v[i]; if (g) w *= g[k0 + kk];
        scr[kk * 33 + c4 + 0] = w[0]; scr[kk * 33 + c4 + 1] = w[1]; scr[kk * 33 + c4 + 2] = w[2]; scr[kk * 33 + c4 + 3] = w[3]; }
    LDS_FENCE();
    const int c = lane & 7;
#pragma unroll
    for (int j = 0; j < 4; ++j) { const int n = (lane >> 3) + 8 * j; const LAS float* s = scr + (8 * c) * 33 + n;
        u32x4 o; o.x = cvtpk(s[0 * 33], s[1 * 33]); o.y = cvtpk(s[2 * 33], s[3 * 33]); o.z = cvtpk(s[4 * 33], s[5 * 33]); o.w = cvtpk(s[6 * 33], s[7 * 33]);
        *(u32x4*)(WT + (size_t)(row_off + n0 + n) * K + k0 + 8 * c) = o; }
    LDS_FENCE();
}
template <int NR> __device__ __forceinline__ void rms_rows_to_bf16(const float* x, const float* g, bf16_t* o, int lane) {
    const f32x4* gr = (const f32x4*)g + lane;
    f32x4 v[NR][4]; float rs[NR];
#pragma unroll
    for (int i = 0; i < NR; ++i)
#pragma unroll
        for (int j = 0; j < 4; ++j) v[i][j] = ((const f32x4*)(x + (size_t)i * DM) + lane)[64 * j];
#pragma unroll
    for (int i = 0; i < NR; ++i) {
        float s = 0.f;
#pragma unroll
        for (int j = 0; j < 4; ++j) s += (v[i][j][0] * v[i][j][0] + v[i][j][1] * v[i][j][1]) + (v[i][j][2] * v[i][j][2] + v[i][j][3] * v[i][j][3]);
        rs[i] = 1.0f / sqrtf(wave_sum(s) * (1.0f / 1024.0f) + 1e-6f);
    }
#pragma unroll
    for (int j = 0; j < 4; ++j) { const f32x4 gg = gr[64 * j];
#pragma unroll
        for (int i = 0; i < NR; ++i) { u32x2 w; w.x = cvtpk(v[i][j][0] * rs[i] * gg[0], v[i][j][1] * rs[i] * gg[1]); w.y = cvtpk(v[i][j][2] * rs[i] * gg[2], v[i][j][3] * rs[i] * gg[3]); ((u32x2*)(o + (size_t)i * DM) + lane)[64 * j] = w; } }
}
__device__ __forceinline__ void p0_prologue(const Params& p, LAS unsigned char* lds, int G) {
    const int tid = threadIdx.x, lane = tid & 63, wave = __builtin_amdgcn_readfirstlane(tid >> 6);
    unsigned char* ws = p.ws;
    LAS float* scr = (LAS float*)(lds + wave * WAVE_LDS);
    const int gw = blockIdx.x * NWAVES + wave, NGW = G * NWAVES;
    bf16_t* Win_t = (bf16_t*)(ws + WS_WIN);
    constexpr int I_INA = 16 * 32, I_INB = 16 * 64, I_KV = 16 * 64;
    constexpr int NITEMS = I_INA + I_INB + I_KV;
    for (int it = gw; it < NITEMS; it += NGW) {
        int r = it;
        if (r < I_INA) { transpose_item(p.w_in, 3088, 0, 1024, 1024, nullptr, Win_t, 0, scr, r, lane); continue; } r -= I_INA;
        if (r < I_INB) { transpose_item(p.w_in, 3088, 1040, 1024, 2048, nullptr, Win_t, 1024, scr, r, lane); continue; } r -= I_INB;
        transpose_item(p.xa_w_kv, 2048, 0, 1024, 2048, nullptr, (bf16_t*)(ws + WS_WKV), 0, scr, r, lane);
    }
    const int gt = blockIdx.x * NTHREADS + tid, NGT = G * NTHREADS;
    for (int o = gt; o < 256 * 1024; o += NGT) {
        const int n = o >> 10, k = o & 1023; const float* wr = p.w_in + (size_t)k * 3088 + 1024; float s = 0.f;
#pragma unroll
        for (int r = 0; r < 16; ++r) s += wr[r] * p.gla_w_gate[r * 256 + n];
        Win_t[(size_t)(3072 + n) * 1024 + k] = f2bf(s);
    }
    float* cosT = (float*)(ws + WS_COS); float* sinT = (float*)(ws + WS_SIN);
    for (int o = gt; o < SEQ * 32; o += NGT) {
        const int pos = o >> 5, i = o & 31; double f = 1.0;
        for (int k = 0; k < i; ++k) f *= 0.7498942093324559;
        const double t = (double)pos * f * 0.15915494309189535;
        const float fr = (float)(t - floor(t));
        cosT[o] = __builtin_amdgcn_cosf(fr); sinT[o] = __builtin_amdgcn_sinf(fr);
    }
    bf16_t* XN = (bf16_t*)(ws + WS_A1); bf16_t* MEMN = (bf16_t*)(ws + WS_MEMN);
    for (int m4 = gw; m4 < (NTOK + NMEMROWS) / 4; m4 += NGW) {
        const int m = 4 * m4;
        if (m < NTOK) rms_rows_to_bf16<4>(p.x + (size_t)m * DM, p.norm_mix_g, XN + (size_t)m * DM, lane);
        else rms_rows_to_bf16<4>(p.mem + (size_t)(m - NTOK) * DM, p.norm_mem_g, MEMN + (size_t)(m - NTOK) * DM, lane);
    }
}

__device__ __forceinline__ void late_weights(const Params& p, LAS unsigned char* lds, int widx, int nworkers) {
    const int tid = threadIdx.x, lane = tid & 63, wave = __builtin_amdgcn_readfirstlane(tid >> 6);
    unsigned char* ws = p.ws;
    LAS float* scr = (LAS float*)(lds + wave * WAVE_LDS);
    constexpr int I_OUT = 16 * 32, I_Q = 16 * 32, I_O = 16 * 32, I_1 = 16 * 128, I_2 = 64 * 32;
    constexpr int NITEMS = I_OUT + I_Q + I_O + I_1 + I_2;
    for (int it = widx * NWAVES + wave; it < NITEMS; it += nworkers * NWAVES) {
        int r = it;
        if (r < I_OUT) { transpose_item(p.w_out, 1024, 0, 1024, 1024, nullptr, (bf16_t*)(ws + WS_WOUT), 0, scr, r, lane); continue; } r -= I_OUT;
        if (r < I_Q) { transpose_item(p.xa_w_q, 1024, 0, 1024, 1024, p.norm_x_g, (bf16_t*)(ws + WS_WQ), 0, scr, r, lane); continue; } r -= I_Q;
        if (r < I_O) { transpose_item(p.xa_w_o, 1024, 0, 1024, 1024, nullptr, (bf16_t*)(ws + WS_WO), 0, scr, r, lane); continue; } r -= I_O;
        if (r < I_1) { transpose_item(p.ffn_w1, 4096, 0, 1024, 4096, p.norm_ffn_g, (bf16_t*)(ws + WS_W1), 0, scr, r, lane); continue; } r -= I_1;
        transpose_item(p.ffn_w2, 1024, 0, 4096, 1024, nullptr, (bf16_t*)(ws + WS_W2), 0, scr, r, lane);
    }
}

__device__ __forceinline__ void gla_gates(const bf16_t* P, int zcol, const float* bg, int r, int q, float (&bc)[4][2][8], float (&bl)[2][8]) {
    bf16x8 zf[4][2];
#pragma unroll
    for (int mt = 0; mt < 4; ++mt)
#pragma unroll
        for (int ks = 0; ks < 2; ++ks) zf[mt][ks] = *(const bf16x8*)(P + (size_t)(16 * mt + r) * NPROJ + zcol + 32 * ks + 8 * q);
    CFENCE();
#pragma unroll
    for (int ks = 0; ks < 2; ++ks) {
        const f32x4 b0 = *(const f32x4*)(bg + 32 * ks + 8 * q), b1 = *(const f32x4*)(bg + 32 * ks + 8 * q + 4);
#pragma unroll
        for (int mt = 0; mt < 4; ++mt) {
            f32x4 z0, z1; unpack8(zf[mt][ks], z0, z1); z0 += b0; z1 += b1;
#pragma unroll
            for (int e = 0; e < 4; ++e) {
                bc[mt][ks][e] = (fminf(z0[e], 0.f) - __logf(1.0f + __expf(-fabsf(z0[e])))) * (1.0f / 16.0f);
                bc[mt][ks][4 + e] = (fminf(z1[e], 0.f) - __logf(1.0f + __expf(-fabsf(z1[e])))) * (1.0f / 16.0f);
            }
        }
#pragma unroll
        for (int e = 0; e < 8; ++e) {
            float carry = 0.f;
#pragma unroll
            for (int mt = 0; mt < 4; ++mt) { const float v = scan16(bc[mt][ks][e], r); const float tot = __shfl(v, 15, 16); bc[mt][ks][e] = v + carry; carry += tot; }
            bl[ks][e] = carry;
        }
    }
}
__device__ __forceinline__ float ret_log2g(int hr) { return hr == 0 ? -0.04580368961312479f : hr == 1 ? -0.008973692110584325f : hr == 2 ? -0.0017761724589428754f : -0.0003522634716290214f; }
__device__ __forceinline__ void rope_tile(bf16x8 f0, bf16x8 f1, const float* cosT, const float* sinT, int pos, int q, f32x4 (&o)[4]) {
    f32x4 a0, a1, b0, b1; unpack8(f0, a0, a1); unpack8(f1, b0, b1);
    const f32x4 c0 = *(const f32x4*)(cosT + pos * 32 + 8 * q), c1 = *(const f32x4*)(cosT + pos * 32 + 8 * q + 4), s0 = *(const f32x4*)(sinT + pos * 32 + 8 * q), s1 = *(const f32x4*)(sinT + pos * 32 + 8 * q + 4);
    o[0] = a0 * c0 - b0 * s0; o[1] = a1 * c1 - b1 * s1; o[2] = a0 * s0 + b0 * c0; o[3] = a1 * s1 + b1 * c1;
}

__device__ __forceinline__ void chunk_contrib(const Params& p, LAS unsigned char* lds, int G) {
    const int tid = threadIdx.x, lane = tid & 63, wave = __builtin_amdgcn_readfirstlane(tid >> 6);
    unsigned char* ws = p.ws;
    const bf16_t* PROJ = (const bf16_t*)(ws + WS_BIG); bf16_t* CT = (bf16_t*)(ws + WS_A2); float* DEC = (float*)(ws + WS_DEC);
    const float* cosT = (const float*)(ws + WS_COS); const float* sinT = (const float*)(ws + WS_SIN);
    LAS bf16_t* Kdt = (LAS bf16_t*)(lds + wave * WAVE_LDS); LAS bf16_t* Vt = Kdt + 64 * VPITCH;
    for (int u = blockIdx.x * NWAVES + wave; u < NBATCH * NCHUNK * 8; u += G * NWAVES) {
        int h8 = u & 7; asm volatile("" : "+s"(h8));
        const int bn = u >> 3, b = bn >> 7, n = bn & 127;
        const size_t tok0 = (size_t)b * SEQ + (size_t)n * 64;
        const bf16_t* P = PROJ + tok0 * NPROJ;
        const int unit = (b * 8 + h8) * NCHUNK + n;
        int ln = lane; asm volatile("" : "+v"(ln));
        const int r = ln & 15, q = ln >> 4;
        const int vcol = (h8 < 4) ? C_GV + h8 * 128 : C_RV + (h8 - 4) * 128;
        const int kcol = (h8 < 4) ? C_GK + h8 * 64 : C_RK + (h8 - 4) * 64;
        bf16x8 kf[4][2];
#pragma unroll
        for (int mt = 0; mt < 4; ++mt)
#pragma unroll
            for (int ks = 0; ks < 2; ++ks) kf[mt][ks] = *(const bf16x8*)(P + (size_t)(16 * mt + r) * NPROJ + kcol + 32 * ks + 8 * q);
        LDS_FENCE();
        if (h8 < 4) {
            const int h = h8;
            float bc[4][2][8], bl[2][8];
            gla_gates(P, C_Z + h * 64, p.gla_b_gate + h * 64, r, q, bc, bl);
            if (r == 0) {
#pragma unroll
                for (int ks = 0; ks < 2; ++ks) {
                    f32x4 d0, d1;
#pragma unroll
                    for (int e = 0; e < 4; ++e) { d0[e] = __expf(bl[ks][e]); d1[e] = __expf(bl[ks][4 + e]); }
                    *(f32x4*)(DEC + (size_t)unit * 64 + 32 * ks + 8 * q) = d0; *(f32x4*)(DEC + (size_t)unit * 64 + 32 * ks + 8 * q + 4) = d1;
                }
            }
#pragma unroll
            for (int mt = 0; mt < 4; ++mt)
#pragma unroll
                for (int ks = 0; ks < 2; ++ks) {
                    f32x4 k0, k1; unpack8(kf[mt][ks], k0, k1);
#pragma unroll
                    for (int e = 0; e < 4; ++e) {
                        Kdt[(32 * ks + 8 * q + e) * VPITCH + 16 * mt + r] = f2bf(k0[e] * __expf(bl[ks][e] - bc[mt][ks][e]));
                        Kdt[(32 * ks + 8 * q + 4 + e) * VPITCH + 16 * mt + r] = f2bf(k1[e] * __expf(bl[ks][4 + e] - bc[mt][ks][4 + e]));
                    }
                }
        } else {
            const int hr = h8 - 4; const float l2g = ret_log2g(hr);
            if (r == 0) {
                const float d = exp2f(64.0f * l2g); const f32x4 dv = {d, d, d, d};
#pragma unroll
                for (int ks = 0; ks < 2; ++ks) { *(f32x4*)(DEC + (size_t)unit * 64 + 32 * ks + 8 * q) = dv; *(f32x4*)(DEC + (size_t)unit * 64 + 32 * ks + 8 * q + 4) = dv; }
            }
#pragma unroll
            for (int mt = 0; mt < 4; ++mt) {
                CFENCE();
                f32x4 o[4]; rope_tile(kf[mt][0], kf[mt][1], cosT, sinT, n * 64 + 16 * mt + r, q, o);
                const float sc = 0.125f * exp2f((float)(63 - (16 * mt + r)) * l2g);
#pragma unroll
                for (int e = 0; e < 4; ++e) {
                    Kdt[(8 * q + e) * VPITCH + 16 * mt + r] = f2bf(o[0][e] * sc); Kdt[(8 * q + 4 + e) * VPITCH + 16 * mt + r] = f2bf(o[1][e] * sc);
                    Kdt[(32 + 8 * q + e) * VPITCH + 16 * mt + r] = f2bf(o[2][e] * sc); Kdt[(32 + 8 * q + 4 + e) * VPITCH + 16 * mt + r] = f2bf(o[3][e] * sc);
                }
            }
        }
        bf16_t* outp = CT + (size_t)unit * 8192;
#pragma unroll 1
        for (int vh = 0; vh < 2; ++vh) {
            CFENCE();
            bf16x8 xv[8];
#pragma unroll
            for (int i = 0; i < 8; ++i) xv[i] = *(const bf16x8*)(P + (size_t)(i * 8 + (ln >> 3)) * NPROJ + vcol + vh * 64 + (ln & 7) * 8);
            LDS_FENCE();
#pragma unroll
            for (int i = 0; i < 8; ++i) {
                const int token = i * 8 + (ln >> 3), vv = (ln & 7) * 8;
#pragma unroll
                for (int e = 0; e < 8; ++e) Vt[(vv + e) * VPITCH + token] = (bf16_t)xv[i][e];
            }
            LDS_FENCE();
#pragma unroll
            for (int vt = 0; vt < 4; ++vt) {
                CFENCE();
                bf16x8 a[2];
#pragma unroll
                for (int s = 0; s < 2; ++s) a[s] = *(const LAS bf16x8*)(Vt + (16 * vt + r) * VPITCH + 32 * s + 8 * q);
#pragma unroll
                for (int dt = 0; dt < 4; ++dt) {
                    f32x4 acc = {0.f, 0.f, 0.f, 0.f};
#pragma unroll
                    for (int s = 0; s < 2; ++s) { const bf16x8 bb = *(const LAS bf16x8*)(Kdt + (16 * dt + r) * VPITCH + 32 * s + 8 * q); acc = MFMA16(a[s], bb, acc); }
#pragma unroll
                    for (int e = 0; e < 4; ++e) outp[(vh * 64 + 16 * vt + 4 * q + e) * 64 + 16 * dt + r] = f2bf(acc[e]);
                }
            }
        }
    }
}

__device__ __forceinline__ void chunk_scan(const Params& p, int G) {
    unsigned char* ws = p.ws; bf16_t* CT = (bf16_t*)(ws + WS_A2); const float* DEC = (const float*)(ws + WS_DEC);
    typedef float f32x2v __attribute__((ext_vector_type(2)));
    const int NGT = G * NTHREADS;
    for (int o = blockIdx.x * NTHREADS + threadIdx.x; o < 32 * 128 * 32; o += NGT) {
        const int d2 = o & 31, v = (o >> 5) & 127, bh = o >> 12;
        bf16_t* base = CT + (size_t)bh * NCHUNK * 8192 + v * 64 + d2 * 2; const float* dbase = DEC + (size_t)bh * NCHUNK * 64 + d2 * 2;
        float s0 = 0.f, s1 = 0.f;
#pragma unroll 1
        for (int n0 = 0; n0 < NCHUNK; n0 += 32) {
            unsigned uu[32]; f32x2v dd[32];
#pragma unroll
            for (int j = 0; j < 32; ++j) { uu[j] = *(const unsigned*)(base + (size_t)(n0 + j) * 8192); dd[j] = *(const f32x2v*)(dbase + (size_t)(n0 + j) * 64); }
#pragma unroll
            for (int j = 0; j < 32; ++j) {
                *(unsigned*)(base + (size_t)(n0 + j) * 8192) = cvtpk(s0, s1);
                s0 = dd[j][0] * s0 + __uint_as_float(uu[j] << 16); s1 = dd[j][1] * s1 + __uint_as_float(uu[j] & 0xffff0000u);
            }
        }
    }
}

template <bool GN> __device__ __forceinline__ void norm_gate_store(const f32x4 (&O)[8], const bf16x8 (&gt)[4], const float (&gn)[8], int it, int r, int q, bf16_t* y) {
    f32x4 mean = {0.f, 0.f, 0.f, 0.f};
    if (GN) {
        f32x4 s = {0.f, 0.f, 0.f, 0.f};
#pragma unroll
        for (int vt = 0; vt < 8; ++vt) s += O[vt];
#pragma unroll
        for (int e = 0; e < 4; ++e) { float t = s[e]; t += __shfl_xor(t, 1); t += __shfl_xor(t, 2); t += __shfl_xor(t, 4); t += __shfl_xor(t, 8); mean[e] = t * (1.0f / 128.0f); }
    }
    f32x4 ss = {0.f, 0.f, 0.f, 0.f};
#pragma unroll
    for (int vt = 0; vt < 8; ++vt) { const f32x4 d = O[vt] - mean; ss += d * d; }
    f32x4 rstd;
#pragma unroll
    for (int e = 0; e < 4; ++e) { float t = ss[e]; t += __shfl_xor(t, 1); t += __shfl_xor(t, 2); t += __shfl_xor(t, 4); t += __shfl_xor(t, 8); rstd[e] = __builtin_amdgcn_rsqf(t * (1.0f / 128.0f) + 1e-6f); }
#pragma unroll
    for (int e = 0; e < 4; ++e) {
        const int i = 16 * it + 4 * q + e;
        f32x4 g0, g1; unpack8(gt[e], g0, g1);
        f32x4 o0, o1;
#pragma unroll
        for (int vt = 0; vt < 4; ++vt) {
            const float ga = g0[vt], gb = g1[vt];
            o0[vt] = (O[vt][e] - mean[e]) * rstd[e] * gn[vt] * (ga * __builtin_amdgcn_rcpf(1.0f + __expf(-ga)));
            o1[vt] = (O[4 + vt][e] - mean[e]) * rstd[e] * gn[4 + vt] * (gb * __builtin_amdgcn_rcpf(1.0f + __expf(-gb)));
        }
        *(bf16x8*)(y + (size_t)i * DM + 8 * r) = pack8(o0, o1);
    }
}
__device__ __forceinline__ void out_tile(f32x4 (&O)[8], const bf16x8 (&pf)[2], const bf16x8 (&qi)[2], const LAS bf16_t* Vt, const bf16x8 (&spf)[8][2], int r, int q) {
#pragma unroll
    for (int vt = 0; vt < 8; ++vt) {
        f32x4 acc = {0.f, 0.f, 0.f, 0.f};
#pragma unroll
        for (int s = 0; s < 2; ++s) {
            const u32x2 lo = *(const LAS u32x2*)(Vt + (16 * vt + r) * VPITCH + 32 * s + 4 * q), hi = *(const LAS u32x2*)(Vt + (16 * vt + r) * VPITCH + 32 * s + 16 + 4 * q);
            const u32x4 w = {lo.x, lo.y, hi.x, hi.y};
            acc = MFMA16(pf[s], __builtin_bit_cast(bf16x8, w), acc);
        }
#pragma unroll
        for (int ks = 0; ks < 2; ++ks) acc = MFMA16(qi[ks], spf[vt][ks], acc);
        O[vt] = acc;
    }
}
template <bool GN> __device__ __forceinline__ void out_all(const bf16x8 (&pfa)[4][2], const bf16x8 (&QI)[4][2], const LAS bf16_t* Vt, const bf16_t* SP, const float* gain, const bf16_t* gate, bf16_t* y, int r, int q) {
    bf16x8 spf[8][2]; float gn[8];
    { const f32x4 ga = *(const f32x4*)(gain + 8 * r), gb = *(const f32x4*)(gain + 8 * r + 4);
#pragma unroll
      for (int vt = 0; vt < 4; ++vt) { gn[vt] = ga[vt]; gn[4 + vt] = gb[vt]; } }
#pragma unroll
    for (int vt = 0; vt < 8; ++vt)
#pragma unroll
        for (int ks = 0; ks < 2; ++ks) spf[vt][ks] = *(const bf16x8*)(SP + (8 * r + vt) * 64 + 32 * ks + 8 * q);
#pragma unroll
    for (int it = 0; it < 4; ++it) {
        CFENCE();
        bf16x8 gt[4];
#pragma unroll
        for (int e = 0; e < 4; ++e) gt[e] = *(const bf16x8*)(gate + (size_t)(16 * it + 4 * q + e) * NPROJ + 8 * r);
        CFENCE();
        f32x4 O[8];
        out_tile(O, pfa[it], QI[it], Vt, spf, r, q);
        CFENCE();
        norm_gate_store<GN>(O, gt, gn, it, r, q, y);
    }
}

__device__ __forceinline__ void chunk_output(const Params& p, LAS unsigned char* lds, int G) {
    const int tid = threadIdx.x, lane = tid & 63, wave = __builtin_amdgcn_readfirstlane(tid >> 6);
    unsigned char* ws = p.ws;
    const bf16_t* PROJ = (const bf16_t*)(ws + WS_BIG); const bf16_t* SPB = (const bf16_t*)(ws + WS_A2); bf16_t* Y = (bf16_t*)(ws + WS_A1);
    const float* cosT = (const float*)(ws + WS_COS); const float* sinT = (const float*)(ws + WS_SIN);
    LAS bf16_t* Vt = (LAS bf16_t*)(lds + wave * WAVE_LDS);
    for (int u = blockIdx.x * NWAVES + wave; u < NBATCH * NCHUNK * 8; u += G * NWAVES) {
        int h8 = u & 7; asm volatile("" : "+s"(h8));
        const int bn = u >> 3, b = bn >> 7, n = bn & 127;
        const size_t tok0 = (size_t)b * SEQ + (size_t)n * 64;
        const bf16_t* P = PROJ + tok0 * NPROJ;
        const int unit = (b * 8 + h8) * NCHUNK + n;
        const bf16_t* SP = SPB + (size_t)unit * 8192;
        int ln = lane; asm volatile("" : "+v"(ln));
        const int r = ln & 15, q = ln >> 4;
        const int vcol = (h8 < 4) ? C_GV + h8 * 128 : C_RV + (h8 - 4) * 128;
        LDS_FENCE();
        {
            bf16x8 xv[16];
#pragma unroll
            for (int i = 0; i < 16; ++i) xv[i] = *(const bf16x8*)(P + (size_t)(i * 4 + q) * NPROJ + vcol + r * 8);
            CFENCE();
#pragma unroll
            for (int i = 0; i < 16; ++i) {
                const int token = i * 4 + q;
#pragma unroll
                for (int e = 0; e < 8; ++e) Vt[(16 * e + r) * VPITCH + token] = (bf16_t)xv[i][e];
            }
        }
        LDS_FENCE();
        CFENCE();
#ifdef NO_GLA4
        if (false) {
#else
        if (h8 < 4) {
#endif
            const int h = h8;
            bf16x8 Qe[4][2], Qi[4][2], Ki[4][2], Ke[4][2], pfa[4][2];
            {
                bf16x8 qf[4][2], kf[4][2];
#pragma unroll
                for (int mt = 0; mt < 4; ++mt)
#pragma unroll
                    for (int ks = 0; ks < 2; ++ks) {
                        qf[mt][ks] = *(const bf16x8*)(P + (size_t)(16 * mt + r) * NPROJ + C_GQ + h * 64 + 32 * ks + 8 * q);
                        kf[mt][ks] = *(const bf16x8*)(P + (size_t)(16 * mt + r) * NPROJ + C_GK + h * 64 + 32 * ks + 8 * q);
                    }
                float bc[4][2][8], bl[2][8];
                gla_gates(P, C_Z + h * 64, p.gla_b_gate + h * 64, r, q, bc, bl);
#pragma unroll
                for (int mt = 0; mt < 4; ++mt)
#pragma unroll
                    for (int ks = 0; ks < 2; ++ks) {
                        CFENCE();
                        f32x4 q0, q1, k0, k1; unpack8(qf[mt][ks], q0, q1); unpack8(kf[mt][ks], k0, k1);
                        f32x4 e0, e1, i0, i1;
#pragma unroll
                        for (int e = 0; e < 4; ++e) { e0[e] = __expf(bc[mt][ks][e]); e1[e] = __expf(bc[mt][ks][4 + e]); i0[e] = __expf(-bc[mt][ks][e]); i1[e] = __expf(-bc[mt][ks][4 + e]); }
                        Qe[mt][ks] = pack8(q0 * e0 * 0.125f, q1 * e1 * 0.125f); Qi[mt][ks] = pack8(q0 * i0 * 0.125f, q1 * i1 * 0.125f);
                        Ki[mt][ks] = pack8(k0 * i0, k1 * i1); Ke[mt][ks] = pack8(k0 * e0, k1 * e1);
                    }
            }
#pragma unroll
            for (int it = 0; it < 4; ++it) {
                f32x4 Pt[4];
#pragma unroll
                for (int jt = 0; jt < 4; ++jt) {
                    f32x4 lo = {0.f, 0.f, 0.f, 0.f}, up = {0.f, 0.f, 0.f, 0.f};
                    if (jt <= it) { lo = MFMA16(Ki[jt][0], Qe[it][0], lo); lo = MFMA16(Ki[jt][1], Qe[it][1], lo); }
                    if (jt >= it) { up = MFMA16(Ke[jt][0], Qi[it][0], up); up = MFMA16(Ke[jt][1], Qi[it][1], up); }
                    if (jt < it) Pt[jt] = lo; else if (jt > it) Pt[jt] = up;
                    else {
#pragma unroll
                        for (int e = 0; e < 4; ++e) Pt[jt][e] = (4 * q + e <= r) ? lo[e] : up[e];
                    }
                }
                pfa[it][0] = pack8(Pt[0], Pt[1]); pfa[it][1] = pack8(Pt[2], Pt[3]);
                CFENCE();
            }
            out_all<false>(pfa, Qe, Vt, SP, p.gla_norm_g + h * 128, P + C_GG + h * 128, Y + tok0 * DM + h * 128, r, q);
        }
#ifdef NO_RET4
        else if (false) {
#else
        else {
#endif
            const int hr = h8 - 4; const float l2g = ret_log2g(hr);
            bf16x8 Qr[4][2], Qd[4][2], Kr[4][2], pfa[4][2];
            {
                bf16x8 qf[4][2], kf[4][2];
#pragma unroll
                for (int mt = 0; mt < 4; ++mt)
#pragma unroll
                    for (int ks = 0; ks < 2; ++ks) {
                        qf[mt][ks] = *(const bf16x8*)(P + (size_t)(16 * mt + r) * NPROJ + C_RQ + hr * 64 + 32 * ks + 8 * q);
                        kf[mt][ks] = *(const bf16x8*)(P + (size_t)(16 * mt + r) * NPROJ + C_RK + hr * 64 + 32 * ks + 8 * q);
                    }
#pragma unroll
                for (int mt = 0; mt < 4; ++mt) {
                    const int pos = n * 64 + 16 * mt + r;
                    CFENCE();
                    {
                        f32x4 o[4]; rope_tile(qf[mt][0], qf[mt][1], cosT, sinT, pos, q, o);
                        Qr[mt][0] = pack8(o[0], o[1]); Qr[mt][1] = pack8(o[2], o[3]);
                        const float qd = exp2f((float)(16 * mt + r + 1) * l2g);
                        Qd[mt][0] = pack8(o[0] * qd, o[1] * qd); Qd[mt][1] = pack8(o[2] * qd, o[3] * qd);
                    }
                    CFENCE();
                    {
                        f32x4 o[4]; rope_tile(kf[mt][0], kf[mt][1], cosT, sinT, pos, q, o);
                        Kr[mt][0] = pack8(o[0] * 0.125f, o[1] * 0.125f); Kr[mt][1] = pack8(o[2] * 0.125f, o[3] * 0.125f);
                    }
                }
            }
#pragma unroll
            for (int it = 0; it < 4; ++it) {
                f32x4 Pt[4];
#pragma unroll
                for (int jt = 0; jt < 4; ++jt) {
                    f32x4 st = {0.f, 0.f, 0.f, 0.f};
                    st = MFMA16(Kr[jt][0], Qr[it][0], st); st = MFMA16(Kr[jt][1], Qr[it][1], st);
#pragma unroll
                    for (int e = 0; e < 4; ++e) { const int dj = (16 * it + r) - (16 * jt + 4 * q + e); Pt[jt][e] = st[e] * exp2f((float)(dj < 0 ? -dj : dj) * l2g); }
                }
                pfa[it][0] = pack8(Pt[0], Pt[1]); pfa[it][1] = pack8(Pt[2], Pt[3]);
                CFENCE();
            }
            out_all<true>(pfa, Qd, Vt, SP, p.ret_norm_g + hr * 128, P + C_RG + hr * 128, Y + tok0 * DM + 512 + hr * 128, r, q);
        }
    }
}

__device__ __forceinline__ void stage_image(LAS unsigned char* lds, const bf16_t* src, int tid) {
#pragma unroll
    for (int i = 0; i < 16; ++i) { const int row = (tid >> 5) + 16 * i, c = tid & 31; const u32x4 x = *(const u32x4*)(src + (size_t)row * 256 + c * 8);
        *(LAS u32x4*)(lds + (16 * (tid >> 5) + i) * APITCH + c * 16) = x; }
}
__device__ __forceinline__ void cross_attention(const Params& p, LAS unsigned char* lds, int G) {
    const int tid = threadIdx.x, lane = tid & 63, wave = __builtin_amdgcn_readfirstlane(tid >> 6);
    unsigned char* ws = p.ws;
    const bf16_t* Q = (const bf16_t*)(ws + WS_A1); const bf16_t* Kb = (const bf16_t*)(ws + WS_KB); const bf16_t* Vtg = (const bf16_t*)(ws + WS_VT); bf16_t* OA = (bf16_t*)(ws + WS_BIG);
    for (int u = blockIdx.x; u < 512; u += G) {
        const int bh = u >> 5, b = bh >> 2, h = bh & 3, qb = u & 31;
        int ln = lane; asm volatile("" : "+v"(ln));
        const int r = ln & 15, q = ln >> 4;
        const size_t i0 = (size_t)b * SEQ + qb * 256 + wave * 32;
        __syncthreads();
        {
#pragma unroll
            for (int i = 0; i < 16; ++i) { const int row = (tid >> 5) + 16 * i, c = tid & 31; const u32x4 x = *(const u32x4*)(Kb + (size_t)(b * 256 + row) * 1024 + h * 256 + c * 8); *(LAS u32x4*)(lds + row * APITCH + c * 16) = x; }
        }
        bf16x8 Qf[2][8];
#pragma unroll
        for (int it = 0; it < 2; ++it)
#pragma unroll
            for (int ks = 0; ks < 8; ++ks) Qf[it][ks] = *(const bf16x8*)(Q + (i0 + 16 * it + r) * DM + h * 256 + 32 * ks + 8 * q);
        __syncthreads();
        bf16x8 pf[2][8];
        {
            f32x4 S[2][16];
#pragma unroll
            for (int mt = 0; mt < 16; ++mt) {
                f32x4 a0 = {0.f, 0.f, 0.f, 0.f}, a1 = {0.f, 0.f, 0.f, 0.f};
                CFENCE();
#pragma unroll
                for (int ks = 0; ks < 8; ++ks) { const bf16x8 a = *(const LAS bf16x8*)(lds + (16 * mt + r) * APITCH + (32 * ks + 8 * q) * 2); a0 = MFMA16(a, Qf[0][ks], a0); a1 = MFMA16(a, Qf[1][ks], a1); }
                S[0][mt] = a0; S[1][mt] = a1;
            }
#pragma unroll
            for (int it = 0; it < 2; ++it) {
                CFENCE();
                float mx = -3.0e38f;
#pragma unroll
                for (int mt = 0; mt < 16; ++mt) mx = fmaxf(fmaxf(fmaxf(S[it][mt][0], S[it][mt][1]), fmaxf(S[it][mt][2], S[it][mt][3])), mx);
                mx = fmaxf(mx, __shfl_xor(mx, 16)); mx = fmaxf(mx, __shfl_xor(mx, 32));
                CFENCE();
                float sum = 0.f;
#pragma unroll
                for (int mt = 0; mt < 16; ++mt) {
#pragma unroll
                    for (int e = 0; e < 4; ++e) { S[it][mt][e] = __builtin_amdgcn_exp2f(S[it][mt][e] - mx); sum += S[it][mt][e]; }
                }
                sum += __shfl_xor(sum, 16); sum += __shfl_xor(sum, 32);
                const float inv = 1.0f / sum;
                CFENCE();
#pragma unroll
                for (int s = 0; s < 8; ++s) { pf[it][s] = pack8(S[it][2 * s] * inv, S[it][2 * s + 1] * inv); CFENCE(); }
            }
        }
        __syncthreads();
        stage_image(lds, Vtg + (size_t)(b * 1024 + h * 256) * 256, tid);
        __syncthreads();
        unsigned ob[2][4][8];
#pragma unroll
        for (int np = 0; np < 8; ++np) {
            f32x4 a0[2], a1[2];
#pragma unroll
            for (int h2 = 0; h2 < 2; ++h2) {
                const int nt = 2 * np + h2;
                f32x4 c0 = {0.f, 0.f, 0.f, 0.f}, c1 = {0.f, 0.f, 0.f, 0.f};
                CFENCE();
#pragma unroll
                for (int s = 0; s < 8; ++s) {
                    const u32x2 lo = *(const LAS u32x2*)(lds + (16 * nt + r) * APITCH + (32 * s + 4 * q) * 2), hi = *(const LAS u32x2*)(lds + (16 * nt + r) * APITCH + (32 * s + 16 + 4 * q) * 2);
                    const u32x4 w = {lo.x, lo.y, hi.x, hi.y};
                    c0 = MFMA16(pf[0][s], __builtin_bit_cast(bf16x8, w), c0); c1 = MFMA16(pf[1][s], __builtin_bit_cast(bf16x8, w), c1);
                }
                a0[h2] = c0; a1[h2] = c1;
            }
#pragma unroll
            for (int e = 0; e < 4; ++e) { ob[0][e][np] = cvtpk(a0[0][e], a0[1][e]); ob[1][e][np] = cvtpk(a1[0][e], a1[1][e]); }
        }
#pragma unroll
        for (int it = 0; it < 2; ++it)
#pragma unroll
            for (int e = 0; e < 4; ++e) {
                bf16_t* o = OA + (i0 + 16 * it + 4 * q + e) * DM + h * 256 + 16 * r;
                const u32x4 w0 = {ob[it][e][0], ob[it][e][1], ob[it][e][2], ob[it][e][3]}, w1 = {ob[it][e][4], ob[it][e][5], ob[it][e][6], ob[it][e][7]};
                *(u32x4*)o = w0; *(u32x4*)(o + 8) = w1;
            }
    }
}

__device__ __forceinline__ void final_norm(const Params& p, int G) {
    const int lane = threadIdx.x & 63, wave = __builtin_amdgcn_readfirstlane(threadIdx.x >> 6);
    const bf16_t* H = (const bf16_t*)(p.ws + WS_A2); const float* SSQ = (const float*)(p.ws + WS_SSQ3);
    const f32x4 g0 = *(const f32x4*)(p.final_norm_g + lane * 8), g1 = *(const f32x4*)(p.final_norm_g + lane * 8 + 4), g2 = *(const f32x4*)(p.final_norm_g + 512 + lane * 8), g3 = *(const f32x4*)(p.final_norm_g + 512 + lane * 8 + 4);
    for (int m4 = blockIdx.x * NWAVES + wave; m4 < NTOK / 4; m4 += G * NWAVES) {
        bf16x8 h0[4], h1[4]; f32x4 sp[4];
#pragma unroll
        for (int j = 0; j < 4; ++j) {
            const size_t m = (size_t)m4 * 4 + j;
            h0[j] = *(const bf16x8*)(H + m * DM + lane * 8); h1[j] = *(const bf16x8*)(H + m * DM + 512 + lane * 8);
            sp[j] = *(const f32x4*)(SSQ + m * 16 + 4 * (lane & 3));
        }
#pragma unroll
        for (int j = 0; j < 4; ++j) {
            const size_t m = (size_t)m4 * 4 + j;
            float t = (sp[j][0] + sp[j][1]) + (sp[j][2] + sp[j][3]);
            t += __shfl_xor(t, 1); t += __shfl_xor(t, 2);
            const float rstd = 1.0f / sqrtf(t * (1.0f / 1024.0f) + 1e-6f);
            f32x4 a0, a1, b0, b1; unpack8(h0[j], a0, a1); unpack8(h1[j], b0, b1);
            float* o = p.out + m * DM + lane * 8;
            *(f32x4*)(o) = a0 * rstd * g0; *(f32x4*)(o + 4) = a1 * rstd * g1; *(f32x4*)(o + 512) = b0 * rstd * g2; *(f32x4*)(o + 516) = b1 * rstd * g3;
        }
    }
}

constexpr int NPHASE = 12;
__global__ void __launch_bounds__(NTHREADS, 2) fwd_megakernel(Params p) {
    extern __shared__ __attribute__((aligned(16))) unsigned char lds_raw[];
    LAS unsigned char* lds = (LAS unsigned char*)lds_raw;
    cg::grid_group grid = cg::this_grid();
    const int G = gridDim.x, lo = p.ph_lo, hi = p.ph_hi;
    unsigned char* ws = p.ws;
#define IN(k) (lo <= (k) && (k) < hi)
#ifndef DBG_REP
#define DBG_REP (-1)
#endif
#define REPS(k) ((DBG_REP) == (k) ? 2 : 1)
#define SEAM(k) do { if (IN(k) && IN((k) + 1)) xcd_barrier(bar); } while (0)
    LAS unsigned* misc = (LAS unsigned*)(lds + MISC_OFF);
    if (threadIdx.x < 16) misc[threadIdx.x] = 0u;
    __syncthreads();
    XcdBarrier bar; bar.bar = (unsigned*)(ws + WS_CTL); bar.x = 0; bar.st = nullptr;
    if (hi - lo > 1) { bar = xcd_barrier_post((unsigned*)(ws + WS_CTL), (volatile LAS unsigned*)misc); grid.sync(); }
#ifndef NO_P0
    if (IN(0)) { p0_prologue(p, lds, G); }
#endif
#if defined(DBG_REP) && DBG_REP == 0
    __syncthreads(); if (IN(0)) { p0_prologue(p, lds, G); }
#endif
    SEAM(0);
    if (IN(1)) {
        {
            pg8::Gemm g{(const bf16_t*)(ws + WS_A1), (const bf16_t*)(ws + WS_WIN), NTOK, NPROJ, DM}; pg8::StaticOrder S; S.init(NTOK, NPROJ, G, (int)blockIdx.x);
            pg8::EpiBf16<0> E{(bf16_t*)(ws + WS_BIG), NPROJ, nullptr, 0, 0, 1.f};
            pg8::gemm_phase<pg8::EpiBf16<0>, pg8::StaticOrder, true, true>(lds, g, S, E);
        }
        __syncthreads();
        {
            pg8::Gemm g{(const bf16_t*)(ws + WS_MEMN), (const bf16_t*)(ws + WS_WKV), NMEMROWS, 2048, DM}; pg8::StaticOrder S; S.init(NMEMROWS, 2048, G, (int)((blockIdx.x + G / 2) % G));
            pg8::EpiKV E{(bf16_t*)(ws + WS_KB), (bf16_t*)(ws + WS_VT)};
            pg8::gemm_phase<pg8::EpiKV, pg8::StaticOrder, true, true>(lds, g, S, E);
        }
        __syncthreads();
        {
            const bool std_grid = (G == 256);
            if (!std_grid) late_weights(p, lds, (int)blockIdx.x, G);
            else if (blockIdx.x >= 160) late_weights(p, lds, (int)blockIdx.x - 160, 96);
        }
        __syncthreads();
    } SEAM(1);
    #ifndef NO_P2
    if (IN(2)) { chunk_contrib(p, lds, G); }
#endif
#if defined(DBG_REP) && DBG_REP == 2
    __syncthreads(); if (IN(2)) { chunk_contrib(p, lds, G); }
#endif
    SEAM(2);
    if (IN(3)) { chunk_scan(p, G); } SEAM(3);
    #ifndef NO_P4
    if (IN(4)) { chunk_output(p, lds, G); }
#endif
#if defined(DBG_REP) && DBG_REP == 4
    __syncthreads(); if (IN(4)) { chunk_output(p, lds, G); }
#endif
    SEAM(4);
    if (IN(5)) {
        pg8::Gemm g{(const bf16_t*)(ws + WS_A1), (const bf16_t*)(ws + WS_WOUT), NTOK, DM, DM}; pg8::StaticOrder S; S.init(NTOK, DM, G, (int)blockIdx.x);
        pg8::EpiRes<false> E{p.x, (bf16_t*)(ws + WS_A2), (float*)(ws + WS_SSQ1)};
        pg8::gemm_phase<pg8::EpiRes<false>, pg8::StaticOrder, true, true>(lds, g, S, E);
        __syncthreads();
    } SEAM(5);
#ifdef DBG_XBAR
    if (IN(5) && IN(6)) { for (int i_ = 0; i_ < 10; ++i_) xcd_barrier(bar); }
#endif
    if (IN(6)) {
        pg8::Gemm g{(const bf16_t*)(ws + WS_A2), (const bf16_t*)(ws + WS_WQ), NTOK, DM, DM}; pg8::StaticOrder S; S.init(NTOK, DM, G, (int)blockIdx.x);
        pg8::EpiScale<0> E{(bf16_t*)(ws + WS_A1), DM, (const float*)(ws + WS_SSQ1), 0.0625f * 1.4426950408889634f};
        pg8::gemm_phase<pg8::EpiScale<0>, pg8::StaticOrder, true, true>(lds, g, S, E);
        __syncthreads();
    } SEAM(6);
#ifndef NO_P7
    if (IN(7)) { cross_attention(p, lds, G); __syncthreads(); }
#endif
#if defined(DBG_REP) && DBG_REP == 7
    if (IN(7)) { cross_attention(p, lds, G); __syncthreads(); }
#endif
    SEAM(7);
    if (IN(8)) {
        pg8::Gemm g{(const bf16_t*)(ws + WS_BIG), (const bf16_t*)(ws + WS_WO), NTOK, DM, DM}; pg8::StaticOrder S; S.init(NTOK, DM, G, (int)blockIdx.x);
        pg8::EpiRes<true> E{(const void*)(ws + WS_A2), (bf16_t*)(ws + WS_A1), (float*)(ws + WS_SSQ2)};
        pg8::gemm_phase<pg8::EpiRes<true>, pg8::StaticOrder, true, true>(lds, g, S, E);
        __syncthreads();
    } SEAM(8);
    if (IN(9)) {
        pg8::Gemm g{(const bf16_t*)(ws + WS_A1), (const bf16_t*)(ws + WS_W1), NTOK, DFF, DM}; pg8::StaticOrder S; S.init(NTOK, DFF, G, (int)blockIdx.x);
        pg8::EpiScale<1> E{(bf16_t*)(ws + WS_BIG), DFF, (const float*)(ws + WS_SSQ2), 1.0f};
        pg8::gemm_phase<pg8::EpiScale<1>, pg8::StaticOrder, true, true>(lds, g, S, E);
        __syncthreads();
    } SEAM(9);
    if (IN(10)) {
        pg8::Gemm g{(const bf16_t*)(ws + WS_BIG), (const bf16_t*)(ws + WS_W2), NTOK, DM, DFF}; pg8::StaticOrder S; S.init(NTOK, DM, G, (int)blockIdx.x);
        pg8::EpiRes<true> E{(const void*)(ws + WS_A1), (bf16_t*)(ws + WS_A2), (float*)(ws + WS_SSQ3)};
        pg8::gemm_phase<pg8::EpiRes<true>, pg8::StaticOrder, true, true>(lds, g, S, E);
        __syncthreads();
    } SEAM(10);
    if (IN(11)) { final_norm(p, G); }
#undef IN
#undef SEAM
}

#ifndef MK_PER_PHASE
#define MK_PER_PHASE 0
#endif
#ifdef DBG_DUMP_OFF
__global__ void dump_kernel(const bf16_t* src, size_t n, float* out) {
    for (size_t i = (size_t)blockIdx.x * blockDim.x + threadIdx.x; i < (size_t)NTOK * DM; i += (size_t)gridDim.x * blockDim.x) {
        float s = 0.f; for (size_t j = i; j < n; j += (size_t)NTOK * DM) s += bf2f(src[j]); out[i] = s; }
}
#endif
extern "C" void kernel_launch(void* const* d_in, const int* in_sizes, int n_in, void* d_out, int out_size, void* d_ws, size_t ws_size, hipStream_t stream) {
    static int grid = 0;
    if (grid == 0) {
        if (n_in != 18 || ws_size < WS_NEED) { fprintf(stderr, "kernel_launch: expected 18 inputs and >= %zu bytes of workspace (got %d, %zu)\n", (size_t)WS_NEED, n_in, ws_size); grid = -1; return; }
        int dev = 0, cus = 0, per_cu = 0;
        (void)hipGetDevice(&dev); (void)hipDeviceGetAttribute(&cus, hipDeviceAttributeMultiprocessorCount, dev);
        if (hipFuncSetAttribute((const void*)fwd_megakernel, hipFuncAttributeMaxDynamicSharedMemorySize, LDS_BYTES) != hipSuccess) { fprintf(stderr, "kernel_launch: hipFuncSetAttribute failed\n"); grid = -1; return; }
        if (hipOccupancyMaxActiveBlocksPerMultiprocessor(&per_cu, (const void*)fwd_megakernel, NTHREADS, LDS_BYTES) != hipSuccess || per_cu < 1) { fprintf(stderr, "kernel_launch: occupancy query failed (%d)\n", per_cu); (void)hipGetLastError(); grid = -1; return; }
        grid = cus * per_cu;
    }
    if (grid < 0) return;
    Params p{};
    const float** pp = (const float**)&p;
    for (int i = 0; i < 18; ++i) pp[i] = (const float*)d_in[i];
    p.out = (float*)d_out; p.ws = (unsigned char*)d_ws;
#if MK_PER_PHASE
#ifndef DBG_HI
#define DBG_HI NPHASE
#endif
    for (int k = 0; k < DBG_HI; ++k) { p.ph_lo = k; p.ph_hi = k + 1; hipLaunchKernelGGL(fwd_megakernel, dim3(grid), dim3(NTHREADS), LDS_BYTES, stream, p);
#ifdef DBG_HOSTREP
        if (k == DBG_HOSTREP) hipLaunchKernelGGL(fwd_megakernel, dim3(grid), dim3(NTHREADS), LDS_BYTES, stream, p);
#endif
    }
#ifdef DBG_DUMP_OFF
    hipLaunchKernelGGL(dump_kernel, dim3(2048), dim3(256), 0, stream, (const bf16_t*)((unsigned char*)d_ws + (size_t)(DBG_DUMP_OFF) * MiB), (size_t)(DBG_DUMP_N), (float*)d_out);
#endif
#else
    p.ph_lo = 0; p.ph_hi = NPHASE;
    if (hipMemsetAsync((char*)d_ws + WS_CTL, 0, 16384, stream) != hipSuccess) { fprintf(stderr, "kernel_launch: hipMemsetAsync failed\n"); return; }
    void* args[] = {&p};
    const hipError_t e = hipLaunchCooperativeKernel((const void*)fwd_megakernel, dim3(grid), dim3(NTHREADS), args, LDS_BYTES, stream);
    if (e != hipSuccess) fprintf(stderr, "kernel_launch: cooperative launch failed: %s (grid %d)\n", hipGetErrorString(e), grid);
#endif
}
```

```cpp
#include <hip/hip_runtime.h>
#include <hip/hip_cooperative_groups.h>
#include <cstdio>
#include <cstdint>
namespace cg = cooperative_groups;
namespace pg8 {
#define PG8_LAS __attribute__((address_space(3)))
typedef unsigned short bf16_t;
typedef short bf16x8 __attribute__((ext_vector_type(8)));
typedef float f32x4 __attribute__((ext_vector_type(4)));
typedef unsigned u32x4 __attribute__((ext_vector_type(4)));
constexpr int BM = 256, BK = 64, HALF = 128, HTB = HALF * BK * 2  , STAGE_BYTES = 8 * HTB, NXCD = 8, WGM = 8;

__host__ __device__ __forceinline__ int lds_byte(int r, int c) { const int st = (r >> 4) * 2 + (c >> 5), rr = r & 15, cc = c & 31, ob = rr * 64 + cc * 2; return st * 1024 + (ob ^ (((ob >> 9) & 1) << 5)); }
__host__ __device__ __forceinline__ void stage_rc(int b, int& R, int& C) { const int st = b / 1024, sb = b % 1024, swz = sb ^ (((sb >> 9) & 1) << 5); R = (st >> 1) * 16 + swz / 64; C = (st & 1) * 32 + (swz % 64) / 2; }
__host__ __device__ __forceinline__ int perm32(int rho) { const int n = rho >> 4, i = rho & 15; return 8 * (i >> 2) + 4 * n + (i & 3); }

struct Unit { int pm, pn; };
struct Gemm { const bf16_t* A; const bf16_t* Bt; int M, N, K; };

struct StaticOrder {
    int nM, nN, nwg, G, c;
    __host__ __device__ void init(int M, int N, int G_, int c_) { nM = M / BM; nN = N / BM; nwg = nM * nN; G = G_; c = c_; }
    __host__ __device__ bool next(int i, Unit& u) const {
        const long L = (long)i * G + c; if (L >= nwg) return false;
        int wgid = (int)L; { const int q = nwg / NXCD, r = nwg % NXCD, xcd = wgid % NXCD, off = wgid / NXCD; wgid = (xcd < r ? xcd * (q + 1) : r * (q + 1) + (xcd - r) * q) + off; }
        const int nig = WGM * nN, gid = wgid / nig, fm = gid * WGM, gsz = (nM - fm) < WGM ? (nM - fm) : WGM;
        u.pm = fm + ((wgid % nig) % gsz); u.pn = (wgid % nig) / gsz; return true;
    }
    __device__ __forceinline__ void a_ready(const Unit&) const {}
    __device__ __forceinline__ void done(const Unit&) const {}
};

__device__ __forceinline__ unsigned cvt_pk_bf16(float lo, float hi) { unsigned r; asm volatile("v_cvt_pk_bf16_f32 %0, %1, %2" : "=v"(r) : "v"(lo), "v"(hi)); return r; }
typedef float f32x2 __attribute__((ext_vector_type(2)));
__device__ __forceinline__ f32x2 gelu_pk(f32x2 v) {
    const f32x2 av = __builtin_elementwise_abs(v), d = av * 0.2316418882f + 1.0f;
    f32x2 t; t.x = __builtin_amdgcn_rcpf(d.x); t.y = __builtin_amdgcn_rcpf(d.y);
    f32x2 q = t * 0.5307027145f + (-0.7265760135f); q = q * t + 0.7107068705f; q = q * t + (-0.142248368f); q = q * t + 0.127414796f; q = q * t;
    const f32x2 s = (v * v) * (-0.72134752044f);
    f32x2 e; e.x = __builtin_amdgcn_exp2f(s.x); e.y = __builtin_amdgcn_exp2f(s.y);
    const f32x2 m = v * (q * e), r = v - m;
    f32x2 o; o.x = v.x < 0.f ? m.x : r.x; o.y = v.y < 0.f ? m.y : r.y; return o;
}

template <int ACT  > struct EpiBf16 {
    static constexpr bool PERM = true, AFTER_DRAIN = false; static_assert(ACT == 0 || ACT == 1, "EpiBf16: ACT is 0 (none) or 1 (gelu_pk)");
    bf16_t* O; int ldc; const float* bias; int split_cols; size_t split_stride; float scale0;
    __device__ __forceinline__ void operator()(const f32x4 (&acc)[2][2][4][2], const Unit& u, int wr, int wc, int fr, int fq) const {
        const int row0 = u.pm * BM + wr * 64 + fr; int colt = u.pn * BM; bf16_t* base = O;
        float sc = 1.f; if (split_cols) { const int t = colt / split_cols; base += (size_t)t * split_stride; colt -= t * split_cols; if (t == 0) sc = scale0; }
        const int col0 = colt + wc * 32 + 8 * fq, bcol0 = u.pn * BM + wc * 32 + 8 * fq;
        f32x4 bv[2][2];
#pragma unroll
        for (int bj = 0; bj < 2; ++bj)
#pragma unroll
            for (int n = 0; n < 2; ++n) bv[bj][n] = bias ? *(const f32x4*)(bias + bcol0 + bj * HALF + 4 * n) : (f32x4){0.f, 0.f, 0.f, 0.f};
#pragma unroll
        for (int ai = 0; ai < 2; ++ai)
#pragma unroll
            for (int m = 0; m < 4; ++m) { bf16_t* rowp = base + (size_t)(row0 + ai * HALF + m * 16) * ldc + col0;
#pragma unroll
                for (int bj = 0; bj < 2; ++bj) { f32x4 v0 = acc[ai][bj][m][0] + bv[bj][0], v1 = acc[ai][bj][m][1] + bv[bj][1];
                    if (ACT == 1) { f32x2 a = gelu_pk((f32x2){v0[0], v0[1]}), b = gelu_pk((f32x2){v0[2], v0[3]}), c = gelu_pk((f32x2){v1[0], v1[1]}), d = gelu_pk((f32x2){v1[2], v1[3]});
                        v0 = (f32x4){a.x, a.y, b.x, b.y}; v1 = (f32x4){c.x, c.y, d.x, d.y}; }
                    v0 = v0 * sc; v1 = v1 * sc; u32x4 w; w.x = cvt_pk_bf16(v0[0], v0[1]); w.y = cvt_pk_bf16(v0[2], v0[3]); w.z = cvt_pk_bf16(v1[0], v1[1]); w.w = cvt_pk_bf16(v1[2], v1[3]);
                    *(u32x4*)(rowp + bj * HALF) = w; } }
    }
};

struct PanelStats {
    unsigned* xbuf;
    unsigned* cnt;
    unsigned* tmo;
    int ntn; float eps;
    unsigned code;
    __device__ __forceinline__ bool run(const f32x4 (&v)[2][2][4][2], const Unit& u, int wr, int wc, int fr, int fq, PG8_LAS unsigned char* lds, int wid, int lane) const {
        typedef float f32x2v __attribute__((ext_vector_type(2)));
        PG8_LAS f32x2v* P = (PG8_LAS f32x2v*)lds;
        PG8_LAS f32x2v* S = (PG8_LAS f32x2v*)(lds + 8192);
        PG8_LAS unsigned* flag = (PG8_LAS unsigned*)(lds + 8192 + 2048);
#pragma unroll
        for (int ai = 0; ai < 2; ++ai)
#pragma unroll
            for (int m = 0; m < 4; ++m) {
                float s = 0.f;
#pragma unroll
                for (int bj = 0; bj < 2; ++bj)
#pragma unroll
                    for (int n = 0; n < 2; ++n) { const f32x4 x = v[ai][bj][m][n]; s += (x[0] + x[1]) + (x[2] + x[3]); }
                s += __shfl_xor(s, 16); s += __shfl_xor(s, 32);
                const float mw = s * (1.0f / 64.0f); float q = 0.f;
#pragma unroll
                for (int bj = 0; bj < 2; ++bj)
#pragma unroll
                    for (int n = 0; n < 2; ++n) { const f32x4 d = v[ai][bj][m][n] - mw; q += (d[0] * d[0] + d[1] * d[1]) + (d[2] * d[2] + d[3] * d[3]); }
                q += __shfl_xor(q, 16); q += __shfl_xor(q, 32);
                if (fq == 0) P[(ai * HALF + wr * 64 + m * 16 + fr) * 4 + wc] = (f32x2v){mw, q};
            }
        asm volatile("s_waitcnt lgkmcnt(0)" ::: "memory"); __builtin_amdgcn_s_barrier(); asm volatile("" ::: "memory");
#if defined(BROKEN_EXCHANGE_NO_WAIT)
#warning BROKEN CONTROL BUILD: the row-statistics exchange does not wait; results are wrong by design
        if (blockIdx.x >= 64) { const long long t0_ = clock64(); while (clock64() - t0_ < 60000) __builtin_amdgcn_s_sleep(8); }
#endif
        const int row = wid * 32 + (lane & 31);
        if (lane < 32) {
            const f32x2v a = P[row * 4 + 0], b = P[row * 4 + 1], c = P[row * 4 + 2], d = P[row * 4 + 3];
            const float mt = (a.x + b.x + c.x + d.x) * 0.25f;
            const float da = a.x - mt, db = b.x - mt, dc = c.x - mt, dd = d.x - mt;
            const float m2 = (a.y + b.y) + (c.y + d.y) + 64.0f * ((da * da + db * db) + (dc * dc + dd * dd));
            unsigned long long* slot = (unsigned long long*)xbuf + ((size_t)(u.pm * BM + row) * 4 + u.pn);
            __hip_atomic_store(slot, ((unsigned long long)__float_as_uint(m2) << 32) | __float_as_uint(mt), __ATOMIC_RELAXED, __HIP_MEMORY_SCOPE_AGENT);
        }
        asm volatile("s_waitcnt vmcnt(0)" ::: "memory");
        if (lane == 0) __hip_atomic_fetch_add(cnt + 64 * u.pm, 1u, __ATOMIC_RELAXED, __HIP_MEMORY_SCOPE_AGENT);
        if (wid == 0) {
            bool dead = false; const unsigned long long t0 = __builtin_amdgcn_s_memrealtime(); const unsigned want = 8u * (unsigned)ntn;
            for (;;) {
#if defined(BROKEN_EXCHANGE_NO_WAIT)
                break;
#endif
                if ((unsigned)__builtin_amdgcn_readfirstlane(__hip_atomic_load(cnt + 64 * u.pm, __ATOMIC_RELAXED, __HIP_MEMORY_SCOPE_AGENT)) >= want) break;
                if (__builtin_amdgcn_s_memrealtime() - t0 > 2000000ull) {
                    if (lane == 0) { unsigned expect = 0u; __hip_atomic_compare_exchange_strong(tmo + 1, &expect, code | (unsigned)(u.pm & 0xff), __ATOMIC_RELAXED, __ATOMIC_RELAXED, __HIP_MEMORY_SCOPE_AGENT);
                                     __hip_atomic_store(tmo, 1u, __ATOMIC_RELAXED, __HIP_MEMORY_SCOPE_AGENT); }
                    dead = true; break; }
                __builtin_amdgcn_s_sleep(2);
            }
            __builtin_amdgcn_fence(__ATOMIC_ACQUIRE, "agent");
            if (lane == 0) flag[0] = dead ? 1u : 0u;
        }
        asm volatile("s_waitcnt vmcnt(0) lgkmcnt(0)" ::: "memory"); __builtin_amdgcn_s_barrier(); asm volatile("" ::: "memory");
        const bool bad = flag[0] != 0u;
        if (lane < 32) {
            const unsigned long long* slot = (const unsigned long long*)xbuf + (size_t)(u.pm * BM + row) * 4; float mt[4], m2[4]; float ms = 0.f;
#pragma unroll
            for (int t = 0; t < 4; ++t) { if (t < ntn) { const unsigned long long w = __hip_atomic_load(slot + t, __ATOMIC_RELAXED, __HIP_MEMORY_SCOPE_AGENT); mt[t] = __uint_as_float((unsigned)w); m2[t] = __uint_as_float((unsigned)(w >> 32)); } else { mt[t] = 0.f; m2[t] = 0.f; } ms += mt[t]; }
            const float mean = ms / (float)ntn; float q = 0.f;
#pragma unroll
            for (int t = 0; t < 4; ++t) if (t < ntn) { const float dm = mt[t] - mean; q += m2[t] + 256.0f * dm * dm; }
            S[row] = (f32x2v){mean, 1.0f / sqrtf(q / (256.0f * (float)ntn) + eps)};
        }
        asm volatile("s_waitcnt lgkmcnt(0)" ::: "memory"); __builtin_amdgcn_s_barrier(); asm volatile("" ::: "memory");
        return bad;
    }
};
struct EpiLnRes {
    static constexpr bool PERM = false, AFTER_DRAIN = true;
    const float* base; float* out; int ldc; const float* bias; PanelStats st; unsigned poison;
    __device__ __forceinline__ void fused(f32x4 (&acc)[2][2][4][2], const Unit& u, int wr, int wc, int fr, int fq, PG8_LAS unsigned char* lds, int wid, int lane) const {
        typedef float f32x2v __attribute__((ext_vector_type(2)));
        const PG8_LAS f32x2v* S = (const PG8_LAS f32x2v*)(lds + 8192);
        const int col0 = u.pn * BM + wc * 32 + 4 * fq;
#pragma unroll
        for (int bj = 0; bj < 2; ++bj)
#pragma unroll
            for (int n = 0; n < 2; ++n) { const f32x4 bv = bias ? *(const f32x4*)(bias + col0 + bj * HALF + n * 16) : (f32x4){0.f, 0.f, 0.f, 0.f};
#pragma unroll
                for (int ai = 0; ai < 2; ++ai)
#pragma unroll
                    for (int m = 0; m < 4; ++m) acc[ai][bj][m][n] += bv; }
        f32x4 pre[4][2][2];
#pragma unroll
        for (int m = 0; m < 4; ++m) { const size_t off = (size_t)(u.pm * BM + wr * 64 + m * 16 + fr) * ldc + col0;
#pragma unroll
            for (int bj = 0; bj < 2; ++bj)
#pragma unroll
                for (int n = 0; n < 2; ++n) pre[m][bj][n] = *(const f32x4*)(base + off + bj * HALF + n * 16); }
        const bool bad = st.run(acc, u, wr, wc, fr, fq, lds, wid, lane) || poison != 0u;
        const float qnan = __builtin_nanf("");
#pragma unroll
        for (int ai = 0; ai < 2; ++ai)
#pragma unroll
            for (int m = 0; m < 4; ++m) { const int r = ai * HALF + wr * 64 + m * 16 + fr; const f32x2v sr = S[r]; const size_t off = (size_t)(u.pm * BM + r) * ldc + col0;
#pragma unroll
                for (int bj = 0; bj < 2; ++bj)
#pragma unroll
                    for (int n = 0; n < 2; ++n) { const f32x4 bs = ai == 0 ? pre[m][bj][n] : *(const f32x4*)(base + off + bj * HALF + n * 16); f32x4 o = bs + (acc[ai][bj][m][n] - sr.x) * sr.y;
                        if (bad) o = (f32x4){qnan, qnan, qnan, qnan}; *(f32x4*)(out + off + bj * HALF + n * 16) = o; }
                if (m & 1) asm volatile("" ::: "memory"); }
    }
};
struct EpiLnResLn {
    static constexpr bool PERM = false, AFTER_DRAIN = true;
    const float* base; float* out; bf16_t* xn; int ldc; const float* bias; PanelStats st1, st2; unsigned poison;
    __device__ __forceinline__ void fused(f32x4 (&acc)[2][2][4][2], const Unit& u, int wr, int wc, int fr, int fq, PG8_LAS unsigned char* lds, int wid, int lane) const {
        typedef float f32x2v __attribute__((ext_vector_type(2))); typedef unsigned u32x2v __attribute__((ext_vector_type(2)));
        const PG8_LAS f32x2v* S = (const PG8_LAS f32x2v*)(lds + 8192);
        const int col0 = u.pn * BM + wc * 32 + 4 * fq;
#pragma unroll
        for (int bj = 0; bj < 2; ++bj)
#pragma unroll
            for (int n = 0; n < 2; ++n) { const f32x4 bv = bias ? *(const f32x4*)(bias + col0 + bj * HALF + n * 16) : (f32x4){0.f, 0.f, 0.f, 0.f};
#pragma unroll
                for (int ai = 0; ai < 2; ++ai)
#pragma unroll
                    for (int m = 0; m < 4; ++m) acc[ai][bj][m][n] += bv; }
        bool bad = st1.run(acc, u, wr, wc, fr, fq, lds, wid, lane) || poison != 0u;
        const float qnan = __builtin_nanf("");
#pragma unroll
        for (int ai = 0; ai < 2; ++ai)
#pragma unroll
            for (int m = 0; m < 4; ++m) { const int r = ai * HALF + wr * 64 + m * 16 + fr; const f32x2v sr = S[r]; const size_t off = (size_t)(u.pm * BM + r) * ldc + col0;
#pragma unroll
                for (int bj = 0; bj < 2; ++bj)
#pragma unroll
                    for (int n = 0; n < 2; ++n) { const f32x4 bs = *(const f32x4*)(base + off + bj * HALF + n * 16); acc[ai][bj][m][n] = bs + (acc[ai][bj][m][n] - sr.x) * sr.y; }
                asm volatile("" : "+v"(acc[ai][0][m][0]), "+v"(acc[ai][0][m][1]), "+v"(acc[ai][1][m][0]), "+v"(acc[ai][1][m][1]));
                if (m & 1) asm volatile("" ::: "memory"); }
        const bool bad1 = bad;
        bad = st2.run(acc, u, wr, wc, fr, fq, lds, wid, lane) || bad;
#pragma unroll
        for (int ai = 0; ai < 2; ++ai)
#pragma unroll
            for (int m = 0; m < 4; ++m) { const int r = ai * HALF + wr * 64 + m * 16 + fr; const f32x2v sr = S[r]; const size_t off = (size_t)(u.pm * BM + r) * ldc + col0;
#pragma unroll
                for (int bj = 0; bj < 2; ++bj)
#pragma unroll
                    for (int n = 0; n < 2; ++n) { const f32x4 x1 = acc[ai][bj][m][n]; *(f32x4*)(out + off + bj * HALF + n * 16) = bad1 ? (f32x4){qnan, qnan, qnan, qnan} : x1;
                        const f32x4 o = (x1 - sr.x) * sr.y; u32x2v w; w.x = cvt_pk_bf16(o[0], o[1]); w.y = cvt_pk_bf16(o[2], o[3]);
                        if (bad) { w.x = 0x7fc07fc0u; w.y = 0x7fc07fc0u; } *(u32x2v*)(xn + off + bj * HALF + n * 16) = w; }
                asm volatile("" ::: "memory"); }
    }
};

template <class Epi, class Sched, bool ALIGN_EPI = false, bool SP2 = false>
__device__ __forceinline__ void gemm_phase(PG8_LAS unsigned char* lds, const Gemm g, const Sched& S, const Epi& E) {
    const int tid = threadIdx.x, wid = __builtin_amdgcn_readfirstlane(tid >> 6), lane = tid & 63, wr = wid >> 2, wc = wid & 3, fr = lane & 15, fq = lane >> 4;
    const int K = g.K, nt = K / BK;
    unsigned voffA[2], voffB[2];
#pragma unroll
    for (int i = 0; i < 2; ++i) { int R, C; stage_rc(tid * 16 + i * 8192, R, C); const int Rb = Epi::PERM ? ((R & ~31) + perm32(R & 31)) : R;
        voffA[i] = (unsigned)(R * K + C) * 2u; voffB[i] = (unsigned)(Rb * K + C) * 2u; }
    const size_t kstep = (size_t)(BK * 2);
    const size_t hstep = (size_t)HALF * K * 2;
    const size_t tstep = 2 * hstep;
    const unsigned ldsw = (unsigned)wid * 1024u;
    const int aoff = lds_byte(wr * 64 + fr, fq * 8), boff = lds_byte(wc * 32 + fr, fq * 8);
#define PG8_SA(b, h) (((b) * 2 + (h)) * HTB)
#define PG8_SB(b, h) ((4 + (b) * 2 + (h)) * HTB)
#define PG8_STAGE(bufoff, gbase, voff) do { _Pragma("unroll") for (int _i = 0; _i < 2; ++_i) \
        __builtin_amdgcn_global_load_lds((const unsigned*)((const char*)(gbase) + (voff)[_i]), (PG8_LAS unsigned*)(lds + (bufoff) + ldsw + _i * 8192), 16, 0, 0); } while (0)
#define PG8_LDA(dst, b, h) do { _Pragma("unroll") for (int m = 0; m < 4; ++m) _Pragma("unroll") for (int k = 0; k < 2; ++k) dst[m][k] = *(const PG8_LAS bf16x8*)(lds + PG8_SA(b, h) + aoff + m * 2048 + k * 1024); } while (0)
#define PG8_LDB(dst, b, h) do { _Pragma("unroll") for (int n = 0; n < 2; ++n) _Pragma("unroll") for (int k = 0; k < 2; ++k) dst[n][k] = *(const PG8_LAS bf16x8*)(lds + PG8_SB(b, h) + boff + n * 2048 + k * 1024); } while (0)
#define PG8_MMA(ai, bj, At, Bt) do { __builtin_amdgcn_s_setprio(1); _Pragma("unroll") for (int m = 0; m < 4; ++m) _Pragma("unroll") for (int n = 0; n < 2; ++n) _Pragma("unroll") for (int k = 0; k < 2; ++k) \
        acc[ai][bj][m][n] = __builtin_amdgcn_mfma_f32_16x16x32_bf16(Bt[n][k], At[m][k], acc[ai][bj][m][n], 0, 0, 0); __builtin_amdgcn_s_setprio(0); } while (0)
#define PG8_WAIT_V(n) asm volatile("s_waitcnt vmcnt(" #n ")" ::: "memory")
#define PG8_WAIT_L(n) asm volatile("s_waitcnt lgkmcnt(" #n ")" ::: "memory")
#define PG8_BAR __builtin_amdgcn_s_barrier()
#define PG8_SCHED __builtin_amdgcn_sched_barrier(0)
    Unit cur, nxt; int ui = 0;
    if (!S.next(0, cur)) return;
    f32x4 acc[2][2][4][2];
#pragma unroll
    for (int a = 0; a < 2; ++a)
#pragma unroll
        for (int b = 0; b < 2; ++b)
#pragma unroll
            for (int m = 0; m < 4; ++m)
#pragma unroll
                for (int n = 0; n < 2; ++n) acc[a][b][m][n] = (f32x4){0.f, 0.f, 0.f, 0.f};
    bf16x8 At[4][2], B0[2][2], B1[2][2];
    const char* cA = (const char*)g.A + (size_t)cur.pm * tstep; const char* cB = (const char*)g.Bt + (size_t)cur.pn * tstep;
    S.a_ready(cur);
    if constexpr (SP2) {
        PG8_STAGE(PG8_SB(0, 0), cB, voffB); PG8_STAGE(PG8_SB(0, 1), cB + hstep, voffB); PG8_STAGE(PG8_SA(0, 0), cA, voffA); PG8_STAGE(PG8_SA(0, 1), cA + hstep, voffA);
        if (wr == 1) PG8_BAR;
        PG8_WAIT_V(2); PG8_BAR;
        PG8_STAGE(PG8_SB(1, 0), cB + kstep, voffB); PG8_STAGE(PG8_SA(1, 0), cA + kstep, voffA); PG8_STAGE(PG8_SB(1, 1), cB + hstep + kstep, voffB);
        PG8_WAIT_V(6); PG8_BAR;
    } else {
        PG8_STAGE(PG8_SB(0, 0), cB, voffB); PG8_STAGE(PG8_SA(0, 0), cA, voffA); PG8_STAGE(PG8_SB(0, 1), cB + hstep, voffB); PG8_STAGE(PG8_SA(0, 1), cA + hstep, voffA);
        if (wr == 1) PG8_BAR;
        PG8_WAIT_V(4); PG8_BAR;
        PG8_STAGE(PG8_SB(1, 0), cB + kstep, voffB); PG8_STAGE(PG8_SA(1, 0), cA + kstep, voffA); PG8_STAGE(PG8_SB(1, 1), cB + hstep + kstep, voffB);
        PG8_WAIT_V(6); PG8_BAR;
    }
    for (;;) {
        const bool has_next = S.next(ui + 1, nxt);
        const char* nA = has_next ? (const char*)g.A + (size_t)nxt.pm * tstep : cA; const char* nB = has_next ? (const char*)g.Bt + (size_t)nxt.pn * tstep : cB;
        for (int t = 0; t < nt; t += 2) {
            const bool last = (t == nt - 2);
            const char* a1 = cA + (size_t)(t + 1) * kstep;
            const char* a2 = last ? nA : cA + (size_t)(t + 2) * kstep; const char* b2 = last ? nB : cB + (size_t)(t + 2) * kstep;
            const char* a3 = a2 + kstep; const char* b3 = b2 + kstep;
            if (last && has_next) S.a_ready(nxt);
            if constexpr (SP2) {
            PG8_LDB(B0, 0, 0); PG8_LDB(B1, 0, 1); PG8_SCHED; PG8_LDA(At, 0, 0); PG8_STAGE(PG8_SA(1, 1), a1 + hstep, voffA);
            PG8_WAIT_V(8); PG8_WAIT_L(0); PG8_BAR; PG8_MMA(0, 0, At, B0); PG8_MMA(0, 1, At, B1); PG8_BAR; PG8_SCHED;
            PG8_LDA(At, 0, 1); PG8_STAGE(PG8_SB(0, 0), b2, voffB); PG8_STAGE(PG8_SB(0, 1), b2 + hstep, voffB); PG8_STAGE(PG8_SA(0, 0), a2, voffA);
            PG8_WAIT_V(8); PG8_WAIT_L(0); PG8_BAR; PG8_MMA(1, 0, At, B0); PG8_MMA(1, 1, At, B1); PG8_BAR; PG8_SCHED;
            PG8_LDB(B0, 1, 0); PG8_LDB(B1, 1, 1); PG8_SCHED; PG8_LDA(At, 1, 0); PG8_STAGE(PG8_SA(0, 1), a2 + hstep, voffA);
            PG8_WAIT_V(8); PG8_WAIT_L(0); PG8_BAR; PG8_MMA(0, 0, At, B0); PG8_MMA(0, 1, At, B1); PG8_BAR; PG8_SCHED;
            PG8_LDA(At, 1, 1); PG8_STAGE(PG8_SB(1, 0), b3, voffB); PG8_STAGE(PG8_SB(1, 1), b3 + hstep, voffB); PG8_STAGE(PG8_SA(1, 0), a3, voffA);
            PG8_WAIT_V(8); PG8_WAIT_L(0); PG8_BAR; PG8_MMA(1, 0, At, B0); PG8_MMA(1, 1, At, B1); PG8_BAR; PG8_SCHED;
            } else {
            PG8_LDB(B0, 0, 0); PG8_SCHED; PG8_LDA(At, 0, 0); PG8_STAGE(PG8_SA(1, 1), a1 + hstep, voffA);
            PG8_WAIT_L(8); PG8_BAR; PG8_WAIT_L(0); PG8_MMA(0, 0, At, B0); PG8_BAR; PG8_SCHED;
            PG8_LDB(B1, 0, 1); PG8_STAGE(PG8_SB(0, 0), b2, voffB);
            PG8_BAR; PG8_WAIT_L(0); PG8_MMA(0, 1, At, B1); PG8_BAR;
            PG8_LDA(At, 0, 1); PG8_STAGE(PG8_SA(0, 0), a2, voffA);
            PG8_BAR; PG8_WAIT_L(0); PG8_MMA(1, 0, At, B0); PG8_BAR; PG8_SCHED;
            PG8_STAGE(PG8_SB(0, 1), b2 + hstep, voffB);
            PG8_WAIT_V(6); PG8_BAR; PG8_MMA(1, 1, At, B1); PG8_BAR;
            PG8_LDB(B0, 1, 0); PG8_SCHED; PG8_LDA(At, 1, 0); PG8_STAGE(PG8_SA(0, 1), a2 + hstep, voffA);
            PG8_WAIT_L(8); PG8_BAR; PG8_WAIT_L(0); PG8_MMA(0, 0, At, B0); PG8_BAR; PG8_SCHED;
            PG8_LDB(B1, 1, 1); PG8_STAGE(PG8_SB(1, 0), b3, voffB);
            PG8_BAR; PG8_WAIT_L(0); PG8_MMA(0, 1, At, B1); PG8_BAR;
            PG8_LDA(At, 1, 1); PG8_STAGE(PG8_SA(1, 0), a3, voffA);
            PG8_BAR; PG8_WAIT_L(0); PG8_MMA(1, 0, At, B0); PG8_BAR; PG8_SCHED;
            PG8_STAGE(PG8_SB(1, 1), b3 + hstep, voffB);
            PG8_WAIT_V(6); PG8_BAR; PG8_MMA(1, 1, At, B1); PG8_BAR;
            }
        }
        if constexpr (ALIGN_EPI) { if (wr == 0) PG8_BAR; }
        if constexpr (!Epi::AFTER_DRAIN) { E(acc, cur, wr, wc, fr, fq); S.done(cur); }
        if (!has_next) break;
#pragma unroll
        for (int a = 0; a < 2; ++a)
#pragma unroll
            for (int b = 0; b < 2; ++b)
#pragma unroll
                for (int m = 0; m < 4; ++m)
#pragma unroll
                    for (int n = 0; n < 2; ++n) acc[a][b][m][n] = (f32x4){0.f, 0.f, 0.f, 0.f};
        cur = nxt; cA = nA; cB = nB; ++ui;
        if constexpr (ALIGN_EPI) { if (wr == 1) PG8_BAR; }
    }
    PG8_WAIT_V(0);
    if constexpr (!ALIGN_EPI) { if (wr == 0) PG8_BAR; }
    PG8_BAR;
    if constexpr (Epi::AFTER_DRAIN) { E.fused(acc, cur, wr, wc, fr, fq, lds, wid, lane); S.done(cur); }
#undef PG8_SA
#undef PG8_SB
#undef PG8_STAGE
#undef PG8_LDA
#undef PG8_LDB
#undef PG8_MMA
#undef PG8_WAIT_V
#undef PG8_WAIT_L
#undef PG8_BAR
#undef PG8_SCHED
}
}

typedef float f32x2_t __attribute__((ext_vector_type(2))); typedef __bf16 bf16x2_t __attribute__((ext_vector_type(2)));
__device__ __forceinline__ unsigned cvtpk(float lo, float hi) { f32x2_t v = {lo, hi}; bf16x2_t b = __builtin_convertvector(v, bf16x2_t); return __builtin_bit_cast(unsigned, b); }

namespace pg8 {
template <bool BASE_BF16> struct EpiRes {
    static constexpr bool PERM = true, AFTER_DRAIN = false;
    const void* base; bf16_t* hb; float* ssq;
    __device__ __forceinline__ void operator()(const f32x4 (&acc)[2][2][4][2], const Unit& u, int wr, int wc, int fr, int fq) const {
        const int row0 = u.pm * BM + wr * 64 + fr, col0 = u.pn * BM + wc * 32 + 8 * fq;
#pragma unroll
        for (int ai = 0; ai < 2; ++ai) {
            f32x4 b0[4][2], b1[4][2];
#pragma unroll
            for (int m = 0; m < 4; ++m)
#pragma unroll
                for (int bj = 0; bj < 2; ++bj) {
                    const size_t off = (size_t)(row0 + ai * HALF + m * 16) * 1024 + col0 + bj * HALF;
                    if (BASE_BF16) {
                        const u32x4 w = *(const u32x4*)((const bf16_t*)base + off);
                        b0[m][bj][0] = __uint_as_float(w.x << 16); b0[m][bj][1] = __uint_as_float(w.x & 0xffff0000u); b0[m][bj][2] = __uint_as_float(w.y << 16); b0[m][bj][3] = __uint_as_float(w.y & 0xffff0000u);
                        b1[m][bj][0] = __uint_as_float(w.z << 16); b1[m][bj][1] = __uint_as_float(w.z & 0xffff0000u); b1[m][bj][2] = __uint_as_float(w.w << 16); b1[m][bj][3] = __uint_as_float(w.w & 0xffff0000u);
                    } else { b0[m][bj] = *(const f32x4*)((const float*)base + off); b1[m][bj] = *(const f32x4*)((const float*)base + off + 4); }
                }
#pragma unroll
            for (int m = 0; m < 4; ++m) {
                const size_t row = (size_t)(row0 + ai * HALF + m * 16); float s = 0.f;
#pragma unroll
                for (int bj = 0; bj < 2; ++bj) {
                    const size_t off = row * 1024 + col0 + bj * HALF;
                    const f32x4 v0 = acc[ai][bj][m][0] + b0[m][bj], v1 = acc[ai][bj][m][1] + b1[m][bj];
                    s += (v0[0] * v0[0] + v0[1] * v0[1]) + (v0[2] * v0[2] + v0[3] * v0[3]) + (v1[0] * v1[0] + v1[1] * v1[1]) + (v1[2] * v1[2] + v1[3] * v1[3]);
                    u32x4 w; w.x = cvtpk(v0[0], v0[1]); w.y = cvtpk(v0[2], v0[3]); w.z = cvtpk(v1[0], v1[1]); w.w = cvtpk(v1[2], v1[3]); *(u32x4*)(hb + off) = w;
                }
                s += __shfl_xor(s, 16); s += __shfl_xor(s, 32); if (fq == 0) ssq[row * 16 + u.pn * 4 + wc] = s;
            }
        }
    }
};
template <int MODE> struct EpiScale {
    static constexpr bool PERM = true, AFTER_DRAIN = false;
    bf16_t* O; int ldc; const float* ssq; float scale;
    __device__ __forceinline__ void operator()(const f32x4 (&acc)[2][2][4][2], const Unit& u, int wr, int wc, int fr, int fq) const {
        const int row0 = u.pm * BM + wr * 64 + fr, col0 = u.pn * BM + wc * 32 + 8 * fq;
        f32x4 sp[2][4];
#pragma unroll
        for (int ai = 0; ai < 2; ++ai)
#pragma unroll
            for (int m = 0; m < 4; ++m) sp[ai][m] = *(const f32x4*)(ssq + (size_t)(row0 + ai * HALF + m * 16) * 16 + 4 * fq);
#pragma unroll
        for (int ai = 0; ai < 2; ++ai)
#pragma unroll
            for (int m = 0; m < 4; ++m) {
                const size_t row = (size_t)(row0 + ai * HALF + m * 16);
                float t = (sp[ai][m][0] + sp[ai][m][1]) + (sp[ai][m][2] + sp[ai][m][3]);
                t += __shfl_xor(t, 16); t += __shfl_xor(t, 32);
                const float rs = __builtin_amdgcn_rsqf(t * (1.0f / 1024.0f) + 1e-6f) * scale;
#pragma unroll
                for (int bj = 0; bj < 2; ++bj) {
                    f32x4 v0 = acc[ai][bj][m][0] * rs, v1 = acc[ai][bj][m][1] * rs;
                    if (MODE == 1) {
#pragma unroll
                        for (int e = 0; e < 4; ++e) { const float a = fmaxf(v0[e], 0.f), b = fmaxf(v1[e], 0.f); v0[e] = a * a; v1[e] = b * b; }
                    }
                    u32x4 w; w.x = cvtpk(v0[0], v0[1]); w.y = cvtpk(v0[2], v0[3]); w.z = cvtpk(v1[0], v1[1]); w.w = cvtpk(v1[2], v1[3]);
                    *(u32x4*)(O + row * ldc + col0 + bj * HALF) = w;
                }
            }
    }
};
struct EpiKV {
    static constexpr bool PERM = true, AFTER_DRAIN = false;
    bf16_t* Kb; bf16_t* Vt;
    __device__ __forceinline__ void operator()(const f32x4 (&acc)[2][2][4][2], const Unit& u, int wr, int wc, int fr, int fq) const {
        const int row0 = u.pm * BM + wr * 64 + fr, col0 = u.pn * BM + wc * 32 + 8 * fq;
#pragma unroll
        for (int ai = 0; ai < 2; ++ai)
#pragma unroll
            for (int m = 0; m < 4; ++m) {
                const int row = row0 + ai * HALF + m * 16;
#pragma unroll
                for (int bj = 0; bj < 2; ++bj) {
                    const int col = col0 + bj * HALF; const f32x4 v0 = acc[ai][bj][m][0], v1 = acc[ai][bj][m][1];
                    u32x4 w; w.x = cvtpk(v0[0], v0[1]); w.y = cvtpk(v0[2], v0[3]); w.z = cvtpk(v1[0], v1[1]); w.w = cvtpk(v1[2], v1[3]);
                    if (col < 1024) { *(u32x4*)(Kb + (size_t)row * 1024 + col) = w; }
                    else {
                        const int b = row >> 8, mm = row & 255; bf16_t* p = Vt + ((size_t)(b * 1024 + (col - 1024))) * 256 + mm;
                        p[0 * 256] = (bf16_t)(w.x & 0xffffu); p[1 * 256] = (bf16_t)(w.x >> 16); p[2 * 256] = (bf16_t)(w.y & 0xffffu); p[3 * 256] = (bf16_t)(w.y >> 16);
                        p[4 * 256] = (bf16_t)(w.z & 0xffffu); p[5 * 256] = (bf16_t)(w.z >> 16); p[6 * 256] = (bf16_t)(w.w & 0xffffu); p[7 * 256] = (bf16_t)(w.w >> 16);
                    }
                }
            }
    }
};
}

#define LAS __attribute__((address_space(3)))
typedef pg8::bf16_t bf16_t;
typedef pg8::bf16x8 bf16x8;
typedef pg8::f32x4 f32x4;
typedef pg8::u32x4 u32x4;
typedef unsigned u32x2 __attribute__((ext_vector_type(2)));

constexpr int NTOK = 32768, DM = 1024, SEQ = 8192, NBATCH = 4, NCHUNK = 128, NPROJ = 3328, DFF = 4096, NMEMROWS = 1024;
constexpr int C_GQ = 0, C_GK = 256, C_GV = 512, C_GG = 1024, C_RQ = 1536, C_RK = 1792, C_RV = 2048, C_RG = 2560, C_Z = 3072;
constexpr int NWAVES = 8, NTHREADS = 512;
constexpr int WAVE_LDS = 18432, MISC_OFF = NWAVES * WAVE_LDS, LDS_BYTES = MISC_OFF + 64;
constexpr int VPITCH = 72;
constexpr int APITCH = 528;
constexpr size_t MiB = 1u << 20;
constexpr size_t WS_WIN = 1 * MiB, WS_WOUT = 8 * MiB, WS_WQ = 10 * MiB, WS_WKV = 12 * MiB, WS_WO = 16 * MiB, WS_W1 = 18 * MiB, WS_W2 = 26 * MiB;
constexpr size_t WS_COS = 34 * MiB, WS_SIN = 35 * MiB, WS_MEMN = 36 * MiB, WS_KB = 38 * MiB, WS_VT = 40 * MiB, WS_DEC = 42 * MiB, WS_SSQ1 = 44 * MiB, WS_SSQ2 = 46 * MiB, WS_SSQ3 = 48 * MiB, WS_CTL = 0;
constexpr size_t WS_A1 = 64 * MiB;
constexpr size_t WS_A2 = 128 * MiB;
constexpr size_t WS_BIG = 192 * MiB;
constexpr size_t WS_NEED = 448 * MiB;

struct Params {
    const float *x, *mem, *norm_mix_g, *w_in, *gla_w_gate, *gla_b_gate, *gla_norm_g, *ret_norm_g, *w_out, *norm_x_g, *norm_mem_g, *xa_w_q, *xa_w_kv, *xa_w_o, *norm_ffn_g, *ffn_w1, *ffn_w2, *final_norm_g;
    float* out; unsigned char* ws; int ph_lo, ph_hi;
};

__device__ __forceinline__ float bf2f(unsigned short b) { return __uint_as_float(((unsigned)b) << 16); }
__device__ __forceinline__ unsigned short f2bf(float f) { const unsigned u = __float_as_uint(f); return (unsigned short)((u + 0x7fffu + ((u >> 16) & 1u)) >> 16); }
__device__ __forceinline__ bf16x8 pack8(f32x4 a, f32x4 b) {
    u32x4 w; w.x = cvtpk(a[0], a[1]); w.y = cvtpk(a[2], a[3]); w.z = cvtpk(b[0], b[1]); w.w = cvtpk(b[2], b[3]);
    return __builtin_bit_cast(bf16x8, w);
}
__device__ __forceinline__ void unpack8(bf16x8 v, f32x4& a, f32x4& b) {
    const u32x4 w = __builtin_bit_cast(u32x4, v);
    a[0] = __uint_as_float(w.x << 16); a[1] = __uint_as_float(w.x & 0xffff0000u); a[2] = __uint_as_float(w.y << 16); a[3] = __uint_as_float(w.y & 0xffff0000u);
    b[0] = __uint_as_float(w.z << 16); b[1] = __uint_as_float(w.z & 0xffff0000u); b[2] = __uint_as_float(w.w << 16); b[3] = __uint_as_float(w.w & 0xffff0000u);
}
__device__ __forceinline__ float wave_sum(float v) {
#pragma unroll
    for (int o = 1; o < 64; o <<= 1) v += __shfl_xor(v, o);
    return v;
}
#define MFMA16(a, b, c) __builtin_amdgcn_mfma_f32_16x16x32_bf16((a), (b), (c), 0, 0, 0)
#define LDS_FENCE() asm volatile("s_waitcnt lgkmcnt(0)" ::: "memory")
#define CFENCE() do { asm volatile("" ::: "memory"); __builtin_amdgcn_sched_barrier(0); } while (0)
__device__ __forceinline__ float scan16(float v, int r) {
#pragma unroll
    for (int off = 1; off < 16; off <<= 1) { const float t = __shfl_up(v, off, 16); if (r >= off) v += t; }
    return v;
}

#define XB_TMO      128
#define XB_XCNT(j)  (256  + 64 * (j))
#define XB_XSUB(j)  (1280 + 64 * (j))
#define XB_XGEN(j)  (2304 + 64 * (j))
#define XB_TOP      3328
#define XB_TOPGEN   3392
#define XCD_BAR_WORDS 3456
#define XB_SPIN_CAP (1u << 18)

__device__ __forceinline__ unsigned xb_ld(unsigned* p)              { return __hip_atomic_load(p, __ATOMIC_RELAXED, __HIP_MEMORY_SCOPE_AGENT); }
__device__ __forceinline__ unsigned xb_add(unsigned* p, unsigned v) { return __hip_atomic_fetch_add(p, v, __ATOMIC_RELAXED, __HIP_MEMORY_SCOPE_AGENT); }
__device__ __forceinline__ unsigned xb_xcc_id() { return (unsigned)__builtin_amdgcn_s_getreg((3 << 11) | 20) & 0xFu; }
#define XB_SPIN(cond, bar) do { unsigned _sp = 0; while (cond) { __builtin_amdgcn_s_sleep(1); \
    if ((++_sp & 255u) == 0u) { if (xb_ld(&(bar)[XB_TMO])) break; if (_sp > XB_SPIN_CAP) { atomicAdd(&(bar)[XB_TMO], 1u); break; } } } } while (0)

struct XcdBarrier {
    unsigned* bar; unsigned x;
    volatile LAS unsigned* st;
};

__device__ __forceinline__ XcdBarrier xcd_barrier_post(unsigned* bar, volatile LAS unsigned* st) {
    XcdBarrier b; b.bar = bar; b.x = xb_xcc_id(); b.st = st;
    if (threadIdx.x == 0) (void)xb_add(&bar[XB_XCNT(b.x)], 1u);
    return b;
}
__device__ __forceinline__ void xcd_barrier_complete(unsigned* bar, unsigned x, unsigned& nloc, unsigned& nx) {
    const unsigned G = gridDim.x * gridDim.y * gridDim.z;
    unsigned sum, cnt, mine, sp = 0u;
    for (;;) {
        sum = 0u; cnt = 0u; mine = 0u;
#pragma unroll
        for (unsigned j = 0; j < 16; ++j) { const unsigned c = xb_ld(&bar[XB_XCNT(j)]); sum += c; cnt += (c > 0u) ? 1u : 0u; mine = (j == x) ? c : mine; }
        if (sum == G) break;
        __builtin_amdgcn_s_sleep(1);
        if ((++sp & 255u) == 0u) { if (xb_ld(&bar[XB_TMO])) break; if (sp > XB_SPIN_CAP) { atomicAdd(&bar[XB_TMO], 1u); break; } }
    }
    nloc = mine > 0u ? mine : 1u; nx = cnt > 0u ? cnt : 1u;
}

__device__ __forceinline__ void xcd_barrier(const XcdBarrier& b) {
    asm volatile("s_waitcnt vmcnt(0)" ::: "memory");
    __syncthreads();
    if (threadIdx.x == 0) {
        unsigned* bar = b.bar;
        __builtin_amdgcn_s_waitcnt(0);
        unsigned nloc = b.st[0], nx = b.st[1];
        if (nloc == 0u) { xcd_barrier_complete(bar, b.x, nloc, nx); b.st[0] = nloc; b.st[1] = nx; }
        const unsigned old = xb_add(&bar[XB_XSUB(b.x)], 1u);
        const unsigned gen = old / nloc;
        if (old + 1u == (gen + 1u) * nloc) {
            __builtin_amdgcn_fence(__ATOMIC_RELEASE, "agent");
            asm volatile("s_waitcnt vmcnt(0)" ::: "memory");
            const unsigned og = xb_add(&bar[XB_TOP], 1u);
            const unsigned tg = og / nx;
            if (og + 1u == (tg + 1u) * nx) xb_add(&bar[XB_TOPGEN], 1u);
            else XB_SPIN(xb_ld(&bar[XB_TOPGEN]) == tg, bar);
            __builtin_amdgcn_fence(__ATOMIC_ACQUIRE, "agent");
            xb_add(&bar[XB_XGEN(b.x)], 1u);
            asm volatile("s_waitcnt vmcnt(0)" ::: "memory");
        } else {
            XB_SPIN(xb_ld(&bar[XB_XGEN(b.x)]) == gen, bar);
            __builtin_amdgcn_fence(__ATOMIC_ACQUIRE, "agent");
            asm volatile("s_waitcnt vmcnt(0)" ::: "memory");
        }
    }
    __syncthreads();
}

__device__ __forceinline__ void transpose_item(const float* W, int ldw, int col0, int K, int Nn, const float* g, bf16_t* WT, int row_off, LAS float* scr, int item, int lane) {
    const int nblk = Nn / 32, kb = item / nblk, nb = item % nblk, k0 = 64 * kb, n0 = 32 * nb;
    f32x4 v[8]; const int c4 = (lane & 7) * 4;
#pragma unroll
    for (int i = 0; i < 8; ++i) { const int kk = (lane >> 3) + 8 * i; v[i] = *(const f32x4*)(W + (size_t)(k0 + kk) * ldw + col0 + n0 + c4); }
#pragma unroll
    for (int i = 0; i < 8; ++i) { const int kk = (lane >> 3) + 8 * i; f32x4 w = v[i]; if (g) w *= g[k0 + kk];
        scr[kk * 33 + c4 + 0] = w[0]; scr[kk * 33 + c4 + 1] = w[1]; scr[kk * 33 + c4 + 2] = w[2]; scr[kk * 33 + c4 + 3] = w[3]; }
    LDS_FENCE();
    const int c = lane & 7;
#pragma unroll
    for (int j = 0; j < 4; ++j) { const int n = (lane >> 3) + 8 * j; const LAS float* s = scr + (8 * c) * 33 + n;
        u32x4 o; o.x = cvtpk(s[0 * 33], s[1 * 33]); o.y = cvtpk(s[2 * 33], s[3 * 33]); o.z = cvtpk(s[4 * 33], s[5 * 33]); o.w = cvtpk(s[6 * 33], s[7 * 33]);
        *(u32x4*)(WT + (size_t)(row_off + n0 + n) * K + k0 + 8 * c) = o; }
    LDS_FENCE();
}
template <int NR> __device__ __forceinline__ void rms_rows_to_bf16(const float* x, const float* g, bf16_t* o, int lane) {
    const f32x4* gr = (const f32x4*)g + lane;
    f32x4 v[NR][4]; float rs[NR];
#pragma unroll
    for (int i = 0; i < NR; ++i)
#pragma unroll
        for (int j = 0; j < 4; ++j) v[i][j] = ((const f32x4*)(x + (size_t)i * DM) + lane)[64 * j];
#pragma unroll
    for (int i = 0; i < NR; ++i) {
        float s = 0.f;
#pragma unroll
        for (int j = 0; j < 4; ++j) s += (v[i][j][0] * v[i][j][0] + v[i][j][1] * v[i][j][1]) + (v[i][j][2] * v[i][j][2] + v[i][j][3] * v[i][j][3]);
        rs[i] = 1.0f / sqrtf(wave_sum(s) * (1.0f / 1024.0f) + 1e-6f);
    }
#pragma unroll
    for (int j = 0; j < 4; ++j) { const f32x4 gg = gr[64 * j];
#pragma unroll
        for (int i = 0; i < NR; ++i) { u32x2 w; w.x = cvtpk(v[i][j][0] * rs[i] * gg[0], v[i][j][1] * rs[i] * gg[1]); w.y = cvtpk(v[i][j][2] * rs[i] * gg[2], v[i][j][3] * rs[i] * gg[3]); ((u32x2*)(o + (size_t)i * DM) + lane)[64 * j] = w; } }
}
__device__ __forceinline__ void p0_prologue(const Params& p, LAS unsigned char* lds, int G) {
    const int tid = threadIdx.x, lane = tid & 63, wave = __builtin_amdgcn_readfirstlane(tid >> 6);
    unsigned char* ws = p.ws;
    LAS float* scr = (LAS float*)(lds + wave * WAVE_LDS);
    const int gw = blockIdx.x * NWAVES + wave, NGW = G * NWAVES;
    bf16_t* Win_t = (bf16_t*)(ws + WS_WIN);
    constexpr int I_INA = 16 * 32, I_INB = 16 * 64, I_KV = 16 * 64;
    constexpr int NITEMS = I_INA + I_INB + I_KV;
    for (int it = gw; it < NITEMS; it += NGW) {
        int r = it;
        if (r < I_INA) { transpose_item(p.w_in, 3088, 0, 1024, 1024, nullptr, Win_t, 0, scr, r, lane); continue; } r -= I_INA;
        if (r < I_INB) { transpose_item(p.w_in, 3088, 1040, 1024, 2048, nullptr, Win_t, 1024, scr, r, lane); continue; } r -= I_INB;
        transpose_item(p.xa_w_kv, 2048, 0, 1024, 2048, nullptr, (bf16_t*)(ws + WS_WKV), 0, scr, r, lane);
    }
    const int gt = blockIdx.x * NTHREADS + tid, NGT = G * NTHREADS;
    for (int o = gt; o < 256 * 1024; o += NGT) {
        const int n = o >> 10, k = o & 1023; const float* wr = p.w_in + (size_t)k * 3088 + 1024; float s = 0.f;
#pragma unroll
        for (int r = 0; r < 16; ++r) s += wr[r] * p.gla_w_gate[r * 256 + n];
        Win_t[(size_t)(3072 + n) * 1024 + k] = f2bf(s);
    }
    float* cosT = (float*)(ws + WS_COS); float* sinT = (float*)(ws + WS_SIN);
    for (int o = gt; o < SEQ * 32; o += NGT) {
        const int pos = o >> 5, i = o & 31; double f = 1.0;
        for (int k = 0; k < i; ++k) f *= 0.7498942093324559;
        const double t = (double)pos * f * 0.15915494309189535;
        const float fr = (float)(t - floor(t));
        cosT[o] = __builtin_amdgcn_cosf(fr); sinT[o] = __builtin_amdgcn_sinf(fr);
    }
    bf16_t* XN = (bf16_t*)(ws + WS_A1); bf16_t* MEMN = (bf16_t*)(ws + WS_MEMN);
    for (int m4 = gw; m4 < (NTOK + NMEMROWS) / 4; m4 += NGW) {
        const int m = 4 * m4;
        if (m < NTOK) rms_rows_to_bf16<4>(p.x + (size_t)m * DM, p.norm_mix_g, XN + (size_t)m * DM, lane);
        else rms_rows_to_bf16<4>(p.mem + (size_t)(m - NTOK) * DM, p.norm_mem_g, MEMN + (size_t)(m - NTOK) * DM, lane);
    }
}

__device__ __forceinline__ void late_weights(const Params& p, LAS unsigned char* lds, int widx, int nworkers) {
    const int tid = threadIdx.x, lane = tid & 63, wave = __builtin_amdgcn_readfirstlane(tid >> 6);
    unsigned char* ws = p.ws;
    LAS float* scr = (LAS float*)(lds + wave * WAVE_LDS);
    constexpr int I_OUT = 16 * 32, I_Q = 16 * 32, I_O = 16 * 32, I_1 = 16 * 128, I_2 = 64 * 32;
    constexpr int NITEMS = I_OUT + I_Q + I_O + I_1 + I_2;
    for (int it = widx * NWAVES + wave; it < NITEMS; it += nworkers * NWAVES) {
        int r = it;
        if (r < I_OUT) { transpose_item(p.w_out, 1024, 0, 1024, 1024, nullptr, (bf16_t*)(ws + WS_WOUT), 0, scr, r, lane); continue; } r -= I_OUT;
        if (r < I_Q) { transpose_item(p.xa_w_q, 1024, 0, 1024, 1024, p.norm_x_g, (bf16_t*)(ws + WS_WQ), 0, scr, r, lane); continue; } r -= I_Q;
        if (r < I_O) { transpose_item(p.xa_w_o, 1024, 0, 1024, 1024, nullptr, (bf16_t*)(ws + WS_WO), 0, scr, r, lane); continue; } r -= I_O;
        if (r < I_1) { transpose_item(p.ffn_w1, 4096, 0, 1024, 4096, p.norm_ffn_g, (bf16_t*)(ws + WS_W1), 0, scr, r, lane); continue; } r -= I_1;
        transpose_item(p.ffn_w2, 1024, 0, 4096, 1024, nullptr, (bf16_t*)(ws + WS_W2), 0, scr, r, lane);
    }
}

__device__ __forceinline__ void gla_gates(const bf16_t* P, int zcol, const float* bg, int r, int q, float (&bc)[4][2][8], float (&bl)[2][8]) {
    bf16x8 zf[4][2];
#pragma unroll
    for (int mt = 0; mt < 4; ++mt)
#pragma unroll
        for (int ks = 0; ks < 2; ++ks) zf[mt][ks] = *(const bf16x8*)(P + (size_t)(16 * mt + r) * NPROJ + zcol + 32 * ks + 8 * q);
    CFENCE();
#pragma unroll
    for (int ks = 0; ks < 2; ++ks) {
        const f32x4 b0 = *(const f32x4*)(bg + 32 * ks + 8 * q), b1 = *(const f32x4*)(bg + 32 * ks + 8 * q + 4);
#pragma unroll
        for (int mt = 0; mt < 4; ++mt) {
            f32x4 z0, z1; unpack8(zf[mt][ks], z0, z1); z0 += b0; z1 += b1;
#pragma unroll
            for (int e = 0; e < 4; ++e) {
                bc[mt][ks][e] = (fminf(z0[e], 0.f) - __logf(1.0f + __expf(-fabsf(z0[e])))) * (1.0f / 16.0f);
                bc[mt][ks][4 + e] = (fminf(z1[e], 0.f) - __logf(1.0f + __expf(-fabsf(z1[e])))) * (1.0f / 16.0f);
            }
        }
#pragma unroll
        for (int e = 0; e < 8; ++e) {
            float carry = 0.f;
#pragma unroll
            for (int mt = 0; mt < 4; ++mt) { const float v = scan16(bc[mt][ks][e], r); const float tot = __shfl(v, 15, 16); bc[mt][ks][e] = v + carry; carry += tot; }
            bl[ks][e] = carry;
        }
    }
}
__device__ __forceinline__ float ret_log2g(int hr) { return hr == 0 ? -0.04580368961312479f : hr == 1 ? -0.008973692110584325f : hr == 2 ? -0.0017761724589428754f : -0.0003522634716290214f; }
__device__ __forceinline__ void rope_tile(bf16x8 f0, bf16x8 f1, const float* cosT, const float* sinT, int pos, int q, f32x4 (&o)[4]) {
    f32x4 a0, a1, b0, b1; unpack8(f0, a0, a1); unpack8(f1, b0, b1);
    const f32x4 c0 = *(const f32x4*)(cosT + pos * 32 + 8 * q), c1 = *(const f32x4*)(cosT + pos * 32 + 8 * q + 4), s0 = *(const f32x4*)(sinT + pos * 32 + 8 * q), s1 = *(const f32x4*)(sinT + pos * 32 + 8 * q + 4);
    o[0] = a0 * c0 - b0 * s0; o[1] = a1 * c1 - b1 * s1; o[2] = a0 * s0 + b0 * c0; o[3] = a1 * s1 + b1 * c1;
}

__device__ __forceinline__ void chunk_contrib(const Params& p, LAS unsigned char* lds, int G) {
    const int tid = threadIdx.x, lane = tid & 63, wave = __builtin_amdgcn_readfirstlane(tid >> 6);
    unsigned char* ws = p.ws;
    const bf16_t* PROJ = (const bf16_t*)(ws + WS_BIG); bf16_t* CT = (bf16_t*)(ws + WS_A2); float* DEC = (float*)(ws + WS_DEC);
    const float* cosT = (const float*)(ws + WS_COS); const float* sinT = (const float*)(ws + WS_SIN);
    LAS bf16_t* Kdt = (LAS bf16_t*)(lds + wave * WAVE_LDS); LAS bf16_t* Vt = Kdt + 64 * VPITCH;
    for (int u = blockIdx.x * NWAVES + wave; u < NBATCH * NCHUNK * 8; u += G * NWAVES) {
        int h8 = (u & 7) ^ ((((u - (int)(blockIdx.x * NWAVES + wave)) / (G * NWAVES)) & 1) << 2); asm volatile("" : "+s"(h8));
        const int bn = u >> 3, b = bn >> 7, n = bn & 127;
        const size_t tok0 = (size_t)b * SEQ + (size_t)n * 64;
        const bf16_t* P = PROJ + tok0 * NPROJ;
        const int unit = (b * 8 + h8) * NCHUNK + n;
        int ln = lane; asm volatile("" : "+v"(ln));
        const int r = ln & 15, q = ln >> 4;
        const int vcol = (h8 < 4) ? C_GV + h8 * 128 : C_RV + (h8 - 4) * 128;
        const int kcol = (h8 < 4) ? C_GK + h8 * 64 : C_RK + (h8 - 4) * 64;
        bf16x8 kf[4][2];
#pragma unroll
        for (int mt = 0; mt < 4; ++mt)
#pragma unroll
            for (int ks = 0; ks < 2; ++ks) kf[mt][ks] = *(const bf16x8*)(P + (size_t)(16 * mt + r) * NPROJ + kcol + 32 * ks + 8 * q);
        LDS_FENCE();
        if (h8 < 4) {
            const int h = h8;
            float bc[4][2][8], bl[2][8];
            gla_gates(P, C_Z + h * 64, p.gla_b_gate + h * 64, r, q, bc, bl);
            if (r == 0) {
#pragma unroll
                for (int ks = 0; ks < 2; ++ks) {
                    f32x4 d0, d1;
#pragma unroll
                    for (int e = 0; e < 4; ++e) { d0[e] = __expf(bl[ks][e]); d1[e] = __expf(bl[ks][4 + e]); }
                    *(f32x4*)(DEC + (size_t)unit * 64 + 32 * ks + 8 * q) = d0; *(f32x4*)(DEC + (size_t)unit * 64 + 32 * ks + 8 * q + 4) = d1;
                }
            }
#pragma unroll
            for (int mt = 0; mt < 4; ++mt)
#pragma unroll
                for (int ks = 0; ks < 2; ++ks) {
                    f32x4 k0, k1; unpack8(kf[mt][ks], k0, k1);
#pragma unroll
                    for (int e = 0; e < 4; ++e) {
                        Kdt[(32 * ks + 8 * q + e) * VPITCH + 16 * mt + r] = f2bf(k0[e] * __expf(bl[ks][e] - bc[mt][ks][e]));
                        Kdt[(32 * ks + 8 * q + 4 + e) * VPITCH + 16 * mt + r] = f2bf(k1[e] * __expf(bl[ks][4 + e] - bc[mt][ks][4 + e]));
                    }
                }
        } else {
            const int hr = h8 - 4; const float l2g = ret_log2g(hr);
            if (r == 0) {
                const float d = exp2f(64.0f * l2g); const f32x4 dv = {d, d, d, d};
#pragma unroll
                for (int ks = 0; ks < 2; ++ks) { *(f32x4*)(DEC + (size_t)unit * 64 + 32 * ks + 8 * q) = dv; *(f32x4*)(DEC + (size_t)unit * 64 + 32 * ks + 8 * q + 4) = dv; }
            }
#pragma unroll
            for (int mt = 0; mt < 4; ++mt) {
                CFENCE();
                f32x4 o[4]; rope_tile(kf[mt][0], kf[mt][1], cosT, sinT, n * 64 + 16 * mt + r, q, o);
                const float sc = 0.125f * exp2f((float)(63 - (16 * mt + r)) * l2g);
#pragma unroll
                for (int e = 0; e < 4; ++e) {
                    Kdt[(8 * q + e) * VPITCH + 16 * mt + r] = f2bf(o[0][e] * sc); Kdt[(8 * q + 4 + e) * VPITCH + 16 * mt + r] = f2bf(o[1][e] * sc);
                    Kdt[(32 + 8 * q + e) * VPITCH + 16 * mt + r] = f2bf(o[2][e] * sc); Kdt[(32 + 8 * q + 4 + e) * VPITCH + 16 * mt + r] = f2bf(o[3][e] * sc);
                }
            }
        }
        bf16_t* outp = CT + (size_t)unit * 8192;
#pragma unroll 1
        for (int vh = 0; vh < 2; ++vh) {
            CFENCE();
            bf16x8 xv[8];
#pragma unroll
            for (int i = 0; i < 8; ++i) xv[i] = *(const bf16x8*)(P + (size_t)(i * 8 + (ln >> 3)) * NPROJ + vcol + vh * 64 + (ln & 7) * 8);
            LDS_FENCE();
#pragma unroll
            for (int i = 0; i < 8; ++i) {
                const int token = i * 8 + (ln >> 3), vv = (ln & 7) * 8;
#pragma unroll
                for (int e = 0; e < 8; ++e) Vt[(vv + e) * VPITCH + token] = (bf16_t)xv[i][e];
            }
            LDS_FENCE();
#pragma unroll
            for (int vt = 0; vt < 4; ++vt) {
                CFENCE();
                bf16x8 a[2];
#pragma unroll
                for (int s = 0; s < 2; ++s) a[s] = *(const LAS bf16x8*)(Vt + (16 * vt + r) * VPITCH + 32 * s + 8 * q);
#pragma unroll
                for (int dt = 0; dt < 4; ++dt) {
                    f32x4 acc = {0.f, 0.f, 0.f, 0.f};
#pragma unroll
                    for (int s = 0; s < 2; ++s) { const bf16x8 bb = *(const LAS bf16x8*)(Kdt + (16 * dt + r) * VPITCH + 32 * s + 8 * q); acc = MFMA16(a[s], bb, acc); }
#pragma unroll
                    for (int e = 0; e < 4; ++e) outp[(vh * 64 + 16 * vt + 4 * q + e) * 64 + 16 * dt + r] = f2bf(acc[e]);
                }
            }
        }
    }
}

__device__ __forceinline__ void chunk_scan(const Params& p, int G) {
    unsigned char* ws = p.ws; bf16_t* CT = (bf16_t*)(ws + WS_A2); const float* DEC = (const float*)(ws + WS_DEC);
    typedef float f32x2v __attribute__((ext_vector_type(2)));
    const int NGT = G * NTHREADS;
    for (int o = blockIdx.x * NTHREADS + threadIdx.x; o < 32 * 128 * 32; o += NGT) {
        const int d2 = o & 31, v = (o >> 5) & 127, bh = o >> 12;
        bf16_t* base = CT + (size_t)bh * NCHUNK * 8192 + v * 64 + d2 * 2; const float* dbase = DEC + (size_t)bh * NCHUNK * 64 + d2 * 2;
        float s0 = 0.f, s1 = 0.f;
#pragma unroll 1
        for (int n0 = 0; n0 < NCHUNK; n0 += 32) {
            unsigned uu[32]; f32x2v dd[32];
#pragma unroll
            for (int j = 0; j < 32; ++j) { uu[j] = *(const unsigned*)(base + (size_t)(n0 + j) * 8192); dd[j] = *(const f32x2v*)(dbase + (size_t)(n0 + j) * 64); }
#pragma unroll
            for (int j = 0; j < 32; ++j) {
                *(unsigned*)(base + (size_t)(n0 + j) * 8192) = cvtpk(s0, s1);
                s0 = dd[j][0] * s0 + __uint_as_float(uu[j] << 16); s1 = dd[j][1] * s1 + __uint_as_float(uu[j] & 0xffff0000u);
            }
        }
    }
}

template <bool GN> __device__ __forceinline__ void norm_gate_store(const f32x4 (&O)[8], const bf16x8 (&gt)[4], const float (&gn)[8], int it, int r, int q, bf16_t* y) {
    f32x4 mean = {0.f, 0.f, 0.f, 0.f};
    if (GN) {
        f32x4 s = {0.f, 0.f, 0.f, 0.f};
#pragma unroll
        for (int vt = 0; vt < 8; ++vt) s += O[vt];
#pragma unroll
        for (int e = 0; e < 4; ++e) { float t = s[e]; t += __shfl_xor(t, 1); t += __shfl_xor(t, 2); t += __shfl_xor(t, 4); t += __shfl_xor(t, 8); mean[e] = t * (1.0f / 128.0f); }
    }
    f32x4 ss = {0.f, 0.f, 0.f, 0.f};
#pragma unroll
    for (int vt = 0; vt < 8; ++vt) { const f32x4 d = O[vt] - mean; ss += d * d; }
    f32x4 rstd;
#pragma unroll
    for (int e = 0; e < 4; ++e) { float t = ss[e]; t += __shfl_xor(t, 1); t += __shfl_xor(t, 2); t += __shfl_xor(t, 4); t += __shfl_xor(t, 8); rstd[e] = __builtin_amdgcn_rsqf(t * (1.0f / 128.0f) + 1e-6f); }
#pragma unroll
    for (int e = 0; e < 4; ++e) {
        const int i = 16 * it + 4 * q + e;
        f32x4 g0, g1; unpack8(gt[e], g0, g1);
        f32x4 o0, o1;
#pragma unroll
        for (int vt = 0; vt < 4; ++vt) {
            const float ga = g0[vt], gb = g1[vt];
            o0[vt] = (O[vt][e] - mean[e]) * rstd[e] * gn[vt] * (ga * __builtin_amdgcn_rcpf(1.0f + __expf(-ga)));
            o1[vt] = (O[4 + vt][e] - mean[e]) * rstd[e] * gn[4 + vt] * (gb * __builtin_amdgcn_rcpf(1.0f + __expf(-gb)));
        }
        *(bf16x8*)(y + (size_t)i * DM + 8 * r) = pack8(o0, o1);
    }
}
__device__ __forceinline__ void out_tile(f32x4 (&O)[8], const bf16x8 (&pf)[2], const bf16x8 (&qi)[2], const LAS bf16_t* Vt, const bf16x8 (&spf)[8][2], int r, int q) {
#pragma unroll
    for (int vt = 0; vt < 8; ++vt) {
        f32x4 acc = {0.f, 0.f, 0.f, 0.f};
#pragma unroll
        for (int s = 0; s < 2; ++s) {
            const u32x2 lo = *(const LAS u32x2*)(Vt + (16 * vt + r) * VPITCH + 32 * s + 4 * q), hi = *(const LAS u32x2*)(Vt + (16 * vt + r) * VPITCH + 32 * s + 16 + 4 * q);
            const u32x4 w = {lo.x, lo.y, hi.x, hi.y};
            acc = MFMA16(pf[s], __builtin_bit_cast(bf16x8, w), acc);
        }
#pragma unroll
        for (int ks = 0; ks < 2; ++ks) acc = MFMA16(qi[ks], spf[vt][ks], acc);
        O[vt] = acc;
    }
}
template <bool GN> __device__ __forceinline__ void out_all(const bf16x8 (&pfa)[4][2], const bf16x8 (&QI)[4][2], const LAS bf16_t* Vt, const bf16_t* SP, const float* gain, const bf16_t* gate, bf16_t* y, int r, int q) {
    bf16x8 spf[8][2]; float gn[8];
    { const f32x4 ga = *(const f32x4*)(gain + 8 * r), gb = *(const f32x4*)(gain + 8 * r + 4);
#pragma unroll
      for (int vt = 0; vt < 4; ++vt) { gn[vt] = ga[vt]; gn[4 + vt] = gb[vt]; } }
#pragma unroll
    for (int vt = 0; vt < 8; ++vt)
#pragma unroll
        for (int ks = 0; ks < 2; ++ks) spf[vt][ks] = *(const bf16x8*)(SP + (8 * r + vt) * 64 + 32 * ks + 8 * q);
#pragma unroll
    for (int it = 0; it < 4; ++it) {
        CFENCE();
        bf16x8 gt[4];
#pragma unroll
        for (int e = 0; e < 4; ++e) gt[e] = *(const bf16x8*)(gate + (size_t)(16 * it + 4 * q + e) * NPROJ + 8 * r);
        CFENCE();
        f32x4 O[8];
        out_tile(O, pfa[it], QI[it], Vt, spf, r, q);
        CFENCE();
        norm_gate_store<GN>(O, gt, gn, it, r, q, y);
    }
}

__device__ __forceinline__ void chunk_output(const Params& p, LAS unsigned char* lds, int G) {
    const int tid = threadIdx.x, lane = tid & 63, wave = __builtin_amdgcn_readfirstlane(tid >> 6);
    unsigned char* ws = p.ws;
    const bf16_t* PROJ = (const bf16_t*)(ws + WS_BIG); const bf16_t* SPB = (const bf16_t*)(ws + WS_A2); bf16_t* Y = (bf16_t*)(ws + WS_A1);
    const float* cosT = (const float*)(ws + WS_COS); const float* sinT = (const float*)(ws + WS_SIN);
    LAS bf16_t* Vt = (LAS bf16_t*)(lds + wave * WAVE_LDS);
    for (int u = blockIdx.x * NWAVES + wave; u < NBATCH * NCHUNK * 8; u += G * NWAVES) {
        int h8 = (u & 7) ^ ((((u - (int)(blockIdx.x * NWAVES + wave)) / (G * NWAVES)) & 1) << 2); asm volatile("" : "+s"(h8));
        const int bn = u >> 3, b = bn >> 7, n = bn & 127;
        const size_t tok0 = (size_t)b * SEQ + (size_t)n * 64;
        const bf16_t* P = PROJ + tok0 * NPROJ;
        const int unit = (b * 8 + h8) * NCHUNK + n;
        const bf16_t* SP = SPB + (size_t)unit * 8192;
        int ln = lane; asm volatile("" : "+v"(ln));
        const int r = ln & 15, q = ln >> 4;
        const int vcol = (h8 < 4) ? C_GV + h8 * 128 : C_RV + (h8 - 4) * 128;
        LDS_FENCE();
        {
            bf16x8 xv[16];
#pragma unroll
            for (int i = 0; i < 16; ++i) xv[i] = *(const bf16x8*)(P + (size_t)(i * 4 + q) * NPROJ + vcol + r * 8);
            CFENCE();
#pragma unroll
            for (int i = 0; i < 16; ++i) {
                const int token = i * 4 + q;
#pragma unroll
                for (int e = 0; e < 8; ++e) Vt[(16 * e + r) * VPITCH + token] = (bf16_t)xv[i][e];
            }
        }
        LDS_FENCE();
        CFENCE();
#ifdef NO_GLA4
        if (false) {
#else
        if (h8 < 4) {
#endif
            const int h = h8;
            bf16x8 Qe[4][2], Qi[4][2], Ki[4][2], Ke[4][2], pfa[4][2];
            {
                bf16x8 qf[4][2], kf[4][2];
#pragma unroll
                for (int mt = 0; mt < 4; ++mt)
#pragma unroll
                    for (int ks = 0; ks < 2; ++ks) {
                        qf[mt][ks] = *(const bf16x8*)(P + (size_t)(16 * mt + r) * NPROJ + C_GQ + h * 64 + 32 * ks + 8 * q);
                        kf[mt][ks] = *(const bf16x8*)(P + (size_t)(16 * mt + r) * NPROJ + C_GK + h * 64 + 32 * ks + 8 * q);
                    }
                float bc[4][2][8], bl[2][8];
                gla_gates(P, C_Z + h * 64, p.gla_b_gate + h * 64, r, q, bc, bl);
#pragma unroll
                for (int mt = 0; mt < 4; ++mt)
#pragma unroll
                    for (int ks = 0; ks < 2; ++ks) {
                        CFENCE();
                        f32x4 q0, q1, k0, k1; unpack8(qf[mt][ks], q0, q1); unpack8(kf[mt][ks], k0, k1);
                        f32x4 e0, e1, i0, i1;
#pragma unroll
                        for (int e = 0; e < 4; ++e) { e0[e] = __expf(bc[mt][ks][e]); e1[e] = __expf(bc[mt][ks][4 + e]); i0[e] = __expf(-bc[mt][ks][e]); i1[e] = __expf(-bc[mt][ks][4 + e]); }
                        Qe[mt][ks] = pack8(q0 * e0 * 0.125f, q1 * e1 * 0.125f); Qi[mt][ks] = pack8(q0 * i0 * 0.125f, q1 * i1 * 0.125f);
                        Ki[mt][ks] = pack8(k0 * i0, k1 * i1); Ke[mt][ks] = pack8(k0 * e0, k1 * e1);
                    }
            }
#pragma unroll
            for (int it = 0; it < 4; ++it) {
                f32x4 Pt[4];
#pragma unroll
                for (int jt = 0; jt < 4; ++jt) {
                    f32x4 lo = {0.f, 0.f, 0.f, 0.f}, up = {0.f, 0.f, 0.f, 0.f};
                    if (jt <= it) { lo = MFMA16(Ki[jt][0], Qe[it][0], lo); lo = MFMA16(Ki[jt][1], Qe[it][1], lo); }
                    if (jt >= it) { up = MFMA16(Ke[jt][0], Qi[it][0], up); up = MFMA16(Ke[jt][1], Qi[it][1], up); }
                    if (jt < it) Pt[jt] = lo; else if (jt > it) Pt[jt] = up;
                    else {
#pragma unroll
                        for (int e = 0; e < 4; ++e) Pt[jt][e] = (4 * q + e <= r) ? lo[e] : up[e];
                    }
                }
                pfa[it][0] = pack8(Pt[0], Pt[1]); pfa[it][1] = pack8(Pt[2], Pt[3]);
                CFENCE();
            }
            out_all<false>(pfa, Qe, Vt, SP, p.gla_norm_g + h * 128, P + C_GG + h * 128, Y + tok0 * DM + h * 128, r, q);
        }
#ifdef NO_RET4
        else if (false) {
#else
        else {
#endif
            const int hr = h8 - 4; const float l2g = ret_log2g(hr);
            bf16x8 Qr[4][2], Qd[4][2], Kr[4][2], pfa[4][2];
            {
                bf16x8 qf[4][2], kf[4][2];
#pragma unroll
                for (int mt = 0; mt < 4; ++mt)
#pragma unroll
                    for (int ks = 0; ks < 2; ++ks) {
                        qf[mt][ks] = *(const bf16x8*)(P + (size_t)(16 * mt + r) * NPROJ + C_RQ + hr * 64 + 32 * ks + 8 * q);
                        kf[mt][ks] = *(const bf16x8*)(P + (size_t)(16 * mt + r) * NPROJ + C_RK + hr * 64 + 32 * ks + 8 * q);
                    }
#pragma unroll
                for (int mt = 0; mt < 4; ++mt) {
                    const int pos = n * 64 + 16 * mt + r;
                    CFENCE();
                    {
                        f32x4 o[4]; rope_tile(qf[mt][0], qf[mt][1], cosT, sinT, pos, q, o);
                        Qr[mt][0] = pack8(o[0], o[1]); Qr[mt][1] = pack8(o[2], o[3]);
                        const float qd = exp2f((float)(16 * mt + r + 1) * l2g);
                        Qd[mt][0] = pack8(o[0] * qd, o[1] * qd); Qd[mt][1] = pack8(o[2] * qd, o[3] * qd);
                    }
                    CFENCE();
                    {
                        f32x4 o[4]; rope_tile(kf[mt][0], kf[mt][1], cosT, sinT, pos, q, o);
                        Kr[mt][0] = pack8(o[0] * 0.125f, o[1] * 0.125f); Kr[mt][1] = pack8(o[2] * 0.125f, o[3] * 0.125f);
                    }
                }
            }
#pragma unroll
            for (int it = 0; it < 4; ++it) {
                f32x4 Pt[4];
#pragma unroll
                for (int jt = 0; jt < 4; ++jt) {
                    f32x4 st = {0.f, 0.f, 0.f, 0.f};
                    st = MFMA16(Kr[jt][0], Qr[it][0], st); st = MFMA16(Kr[jt][1], Qr[it][1], st);
#pragma unroll
                    for (int e = 0; e < 4; ++e) { const int dj = (16 * it + r) - (16 * jt + 4 * q + e); Pt[jt][e] = st[e] * exp2f((float)(dj < 0 ? -dj : dj) * l2g); }
                }
                pfa[it][0] = pack8(Pt[0], Pt[1]); pfa[it][1] = pack8(Pt[2], Pt[3]);
                CFENCE();
            }
            out_all<true>(pfa, Qd, Vt, SP, p.ret_norm_g + hr * 128, P + C_RG + hr * 128, Y + tok0 * DM + 512 + hr * 128, r, q);
        }
    }
}

__device__ __forceinline__ void stage_image(LAS unsigned char* lds, const bf16_t* src, int tid) {
#pragma unroll
    for (int i = 0; i < 16; ++i) { const int row = (tid >> 5) + 16 * i, c = tid & 31; const u32x4 x = *(const u32x4*)(src + (size_t)row * 256 + c * 8);
        *(LAS u32x4*)(lds + (16 * (tid >> 5) + i) * APITCH + c * 16) = x; }
}
__device__ __forceinline__ void cross_attention(const Params& p, LAS unsigned char* lds, int G) {
    const int tid = threadIdx.x, lane = tid & 63, wave = __builtin_amdgcn_readfirstlane(tid >> 6);
    unsigned char* ws = p.ws;
    const bf16_t* Q = (const bf16_t*)(ws + WS_A1); const bf16_t* Kb = (const bf16_t*)(ws + WS_KB); const bf16_t* Vtg = (const bf16_t*)(ws + WS_VT); bf16_t* OA = (bf16_t*)(ws + WS_BIG);
    for (int u = blockIdx.x; u < 512; u += G) {
        const int bh = u >> 5, b = bh >> 2, h = bh & 3, qb = u & 31;
        int ln = lane; asm volatile("" : "+v"(ln));
        const int r = ln & 15, q = ln >> 4;
        const size_t i0 = (size_t)b * SEQ + qb * 256 + wave * 32;
        __syncthreads();
        {
#pragma unroll
            for (int i = 0; i < 16; ++i) { const int row = (tid >> 5) + 16 * i, c = tid & 31; const u32x4 x = *(const u32x4*)(Kb + (size_t)(b * 256 + row) * 1024 + h * 256 + c * 8); *(LAS u32x4*)(lds + row * APITCH + c * 16) = x; }
        }
        bf16x8 Qf[2][8];
#pragma unroll
        for (int it = 0; it < 2; ++it)
#pragma unroll
            for (int ks = 0; ks < 8; ++ks) Qf[it][ks] = *(const bf16x8*)(Q + (i0 + 16 * it + r) * DM + h * 256 + 32 * ks + 8 * q);
        __syncthreads();
        bf16x8 pf[2][8];
        {
            f32x4 S[2][16];
#pragma unroll
            for (int mt = 0; mt < 16; ++mt) {
                f32x4 a0 = {0.f, 0.f, 0.f, 0.f}, a1 = {0.f, 0.f, 0.f, 0.f};
                CFENCE();
#pragma unroll
                for (int ks = 0; ks < 8; ++ks) { const bf16x8 a = *(const LAS bf16x8*)(lds + (16 * mt + r) * APITCH + (32 * ks + 8 * q) * 2); a0 = MFMA16(a, Qf[0][ks], a0); a1 = MFMA16(a, Qf[1][ks], a1); }
                S[0][mt] = a0; S[1][mt] = a1;
            }
#pragma unroll
            for (int it = 0; it < 2; ++it) {
                CFENCE();
                float mx = -3.0e38f;
#pragma unroll
                for (int mt = 0; mt < 16; ++mt) mx = fmaxf(fmaxf(fmaxf(S[it][mt][0], S[it][mt][1]), fmaxf(S[it][mt][2], S[it][mt][3])), mx);
                mx = fmaxf(mx, __shfl_xor(mx, 16)); mx = fmaxf(mx, __shfl_xor(mx, 32));
                CFENCE();
                float sum = 0.f;
#pragma unroll
                for (int mt = 0; mt < 16; ++mt) {
#pragma unroll
                    for (int e = 0; e < 4; ++e) { S[it][mt][e] = __builtin_amdgcn_exp2f(S[it][mt][e] - mx); sum += S[it][mt][e]; }
                }
                sum += __shfl_xor(sum, 16); sum += __shfl_xor(sum, 32);
                const float inv = 1.0f / sum;
                CFENCE();
#pragma unroll
                for (int s = 0; s < 8; ++s) { pf[it][s] = pack8(S[it][2 * s] * inv, S[it][2 * s + 1] * inv); CFENCE(); }
            }
        }
        __syncthreads();
        stage_image(lds, Vtg + (size_t)(b * 1024 + h * 256) * 256, tid);
        __syncthreads();
        unsigned ob[2][4][8];
#pragma unroll
        for (int np = 0; np < 8; ++np) {
            f32x4 a0[2], a1[2];
#pragma unroll
            for (int h2 = 0; h2 < 2; ++h2) {
                const int nt = 2 * np + h2;
                f32x4 c0 = {0.f, 0.f, 0.f, 0.f}, c1 = {0.f, 0.f, 0.f, 0.f};
                CFENCE();
#pragma unroll
                for (int s = 0; s < 8; ++s) {
                    const u32x2 lo = *(const LAS u32x2*)(lds + (16 * nt + r) * APITCH + (32 * s + 4 * q) * 2), hi = *(const LAS u32x2*)(lds + (16 * nt + r) * APITCH + (32 * s + 16 + 4 * q) * 2);
                    const u32x4 w = {lo.x, lo.y, hi.x, hi.y};
                    c0 = MFMA16(pf[0][s], __builtin_bit_cast(bf16x8, w), c0); c1 = MFMA16(pf[1][s], __builtin_bit_cast(bf16x8, w), c1);
                }
                a0[h2] = c0; a1[h2] = c1;
            }
#pragma unroll
            for (int e = 0; e < 4; ++e) { ob[0][e][np] = cvtpk(a0[0][e], a0[1][e]); ob[1][e][np] = cvtpk(a1[0][e], a1[1][e]); }
        }
#pragma unroll
        for (int it = 0; it < 2; ++it)
#pragma unroll
            for (int e = 0; e < 4; ++e) {
                bf16_t* o = OA + (i0 + 16 * it + 4 * q + e) * DM + h * 256 + 16 * r;
                const u32x4 w0 = {ob[it][e][0], ob[it][e][1], ob[it][e][2], ob[it][e][3]}, w1 = {ob[it][e][4], ob[it][e][5], ob[it][e][6], ob[it][e][7]};
                *(u32x4*)o = w0; *(u32x4*)(o + 8) = w1;
            }
    }
}

__device__ __forceinline__ void final_norm(const Params& p, int G) {
    const int lane = threadIdx.x & 63, wave = __builtin_amdgcn_readfirstlane(threadIdx.x >> 6);
    const bf16_t* H = (const bf16_t*)(p.ws + WS_A2); const float* SSQ = (const float*)(p.ws + WS_SSQ3);
    const f32x4 g0 = *(const f32x4*)(p.final_norm_g + lane * 8), g1 = *(const f32x4*)(p.final_norm_g + lane * 8 + 4), g2 = *(const f32x4*)(p.final_norm_g + 512 + lane * 8), g3 = *(const f32x4*)(p.final_norm_g + 512 + lane * 8 + 4);
    for (int m4 = blockIdx.x * NWAVES + wave; m4 < NTOK / 4; m4 += G * NWAVES) {
        bf16x8 h0[4], h1[4]; f32x4 sp[4];
#pragma unroll
        for (int j = 0; j < 4; ++j) {
            const size_t m = (size_t)m4 * 4 + j;
            h0[j] = *(const bf16x8*)(H + m * DM + lane * 8); h1[j] = *(const bf16x8*)(H + m * DM + 512 + lane * 8);
            sp[j] = *(const f32x4*)(SSQ + m * 16 + 4 * (lane & 3));
        }
#pragma unroll
        for (int j = 0; j < 4; ++j) {
            const size_t m = (size_t)m4 * 4 + j;
            float t = (sp[j][0] + sp[j][1]) + (sp[j][2] + sp[j][3]);
            t += __shfl_xor(t, 1); t += __shfl_xor(t, 2);
            const float rstd = 1.0f / sqrtf(t * (1.0f / 1024.0f) + 1e-6f);
            f32x4 a0, a1, b0, b1; unpack8(h0[j], a0, a1); unpack8(h1[j], b0, b1);
            float* o = p.out + m * DM + lane * 8;
            *(f32x4*)(o) = a0 * rstd * g0; *(f32x4*)(o + 4) = a1 * rstd * g1; *(f32x4*)(o + 512) = b0 * rstd * g2; *(f32x4*)(o + 516) = b1 * rstd * g3;
        }
    }
}

constexpr int NPHASE = 12;
__global__ void __launch_bounds__(NTHREADS, 2) fwd_megakernel(Params p) {
    extern __shared__ __attribute__((aligned(16))) unsigned char lds_raw[];
    LAS unsigned char* lds = (LAS unsigned char*)lds_raw;
    cg::grid_group grid = cg::this_grid();
    const int G = gridDim.x, lo = p.ph_lo, hi = p.ph_hi;
    unsigned char* ws = p.ws;
#define IN(k) (lo <= (k) && (k) < hi)
#ifndef DBG_REP
#define DBG_REP (-1)
#endif
#define REPS(k) ((DBG_REP) == (k) ? 2 : 1)
#define SEAM(k) do { if (IN(k) && IN((k) + 1)) xcd_barrier(bar); } while (0)
    LAS unsigned* misc = (LAS unsigned*)(lds + MISC_OFF);
    if (threadIdx.x < 16) misc[threadIdx.x] = 0u;
    __syncthreads();
    XcdBarrier bar; bar.bar = (unsigned*)(ws + WS_CTL); bar.x = 0; bar.st = nullptr;
    if (hi - lo > 1) { bar = xcd_barrier_post((unsigned*)(ws + WS_CTL), (volatile LAS unsigned*)misc); grid.sync(); }
#ifndef NO_P0
    if (IN(0)) { p0_prologue(p, lds, G); }
#endif
#if defined(DBG_REP) && DBG_REP == 0
    __syncthreads(); if (IN(0)) { p0_prologue(p, lds, G); }
#endif
    SEAM(0);
    if (IN(1)) {
        {
            pg8::Gemm g{(const bf16_t*)(ws + WS_A1), (const bf16_t*)(ws + WS_WIN), NTOK, NPROJ, DM}; pg8::StaticOrder S; S.init(NTOK, NPROJ, G, (int)blockIdx.x);
            pg8::EpiBf16<0> E{(bf16_t*)(ws + WS_BIG), NPROJ, nullptr, 0, 0, 1.f};
            pg8::gemm_phase<pg8::EpiBf16<0>, pg8::StaticOrder, true, true>(lds, g, S, E);
        }
        __syncthreads();
        {
            pg8::Gemm g{(const bf16_t*)(ws + WS_MEMN), (const bf16_t*)(ws + WS_WKV), NMEMROWS, 2048, DM}; pg8::StaticOrder S; S.init(NMEMROWS, 2048, G, (int)((blockIdx.x + G / 2) % G));
            pg8::EpiKV E{(bf16_t*)(ws + WS_KB), (bf16_t*)(ws + WS_VT)};
            pg8::gemm_phase<pg8::EpiKV, pg8::StaticOrder, true, true>(lds, g, S, E);
        }
        __syncthreads();
        {
            const bool std_grid = (G == 256);
            if (!std_grid) late_weights(p, lds, (int)blockIdx.x, G);
            else if (blockIdx.x >= 160) late_weights(p, lds, (int)blockIdx.x - 160, 96);
        }
        __syncthreads();
    } SEAM(1);
    #ifndef NO_P2
    if (IN(2)) { chunk_contrib(p, lds, G); }
#endif
#if defined(DBG_REP) && DBG_REP == 2
    __syncthreads(); if (IN(2)) { chunk_contrib(p, lds, G); }
#endif
    SEAM(2);
    if (IN(3)) { chunk_scan(p, G); } SEAM(3);
    #ifndef NO_P4
    if (IN(4)) { chunk_output(p, lds, G); }
#endif
#if defined(DBG_REP) && DBG_REP == 4
    __syncthreads(); if (IN(4)) { chunk_output(p, lds, G); }
#endif
    SEAM(4);
    if (IN(5)) {
        pg8::Gemm g{(const bf16_t*)(ws + WS_A1), (const bf16_t*)(ws + WS_WOUT), NTOK, DM, DM}; pg8::StaticOrder S; S.init(NTOK, DM, G, (int)blockIdx.x);
        pg8::EpiRes<false> E{p.x, (bf16_t*)(ws + WS_A2), (float*)(ws + WS_SSQ1)};
        pg8::gemm_phase<pg8::EpiRes<false>, pg8::StaticOrder, true, true>(lds, g, S, E);
        __syncthreads();
    } SEAM(5);
#ifdef DBG_XBAR
    if (IN(5) && IN(6)) { for (int i_ = 0; i_ < 10; ++i_) xcd_barrier(bar); }
#endif
    if (IN(6)) {
        pg8::Gemm g{(const bf16_t*)(ws + WS_A2), (const bf16_t*)(ws + WS_WQ), NTOK, DM, DM}; pg8::StaticOrder S; S.init(NTOK, DM, G, (int)blockIdx.x);
        pg8::EpiScale<0> E{(bf16_t*)(ws + WS_A1), DM, (const float*)(ws + WS_SSQ1), 0.0625f * 1.4426950408889634f};
        pg8::gemm_phase<pg8::EpiScale<0>, pg8::StaticOrder, true, true>(lds, g, S, E);
        __syncthreads();
    } SEAM(6);
#ifndef NO_P7
    if (IN(7)) { cross_attention(p, lds, G); __syncthreads(); }
#endif
#if defined(DBG_REP) && DBG_REP == 7
    if (IN(7)) { cross_attention(p, lds, G); __syncthreads(); }
#endif
    SEAM(7);
    if (IN(8)) {
        pg8::Gemm g{(const bf16_t*)(ws + WS_BIG), (const bf16_t*)(ws + WS_WO), NTOK, DM, DM}; pg8::StaticOrder S; S.init(NTOK, DM, G, (int)blockIdx.x);
        pg8::EpiRes<true> E{(const void*)(ws + WS_A2), (bf16_t*)(ws + WS_A1), (float*)(ws + WS_SSQ2)};
        pg8::gemm_phase<pg8::EpiRes<true>, pg8::StaticOrder, true, true>(lds, g, S, E);
        __syncthreads();
    } SEAM(8);
    if (IN(9)) {
        pg8::Gemm g{(const bf16_t*)(ws + WS_A1), (const bf16_t*)(ws + WS_W1), NTOK, DFF, DM}; pg8::StaticOrder S; S.init(NTOK, DFF, G, (int)blockIdx.x);
        pg8::EpiScale<1> E{(bf16_t*)(ws + WS_BIG), DFF, (const float*)(ws + WS_SSQ2), 1.0f};
        pg8::gemm_phase<pg8::EpiScale<1>, pg8::StaticOrder, true, true>(lds, g, S, E);
        __syncthreads();
    } SEAM(9);
    if (IN(10)) {
        pg8::Gemm g{(const bf16_t*)(ws + WS_BIG), (const bf16_t*)(ws + WS_W2), NTOK, DM, DFF}; pg8::StaticOrder S; S.init(NTOK, DM, G, (int)blockIdx.x);
        pg8::EpiRes<true> E{(const void*)(ws + WS_A1), (bf16_t*)(ws + WS_A2), (float*)(ws + WS_SSQ3)};
        pg8::gemm_phase<pg8::EpiRes<true>, pg8::StaticOrder, true, true>(lds, g, S, E);
        __syncthreads();
    } SEAM(10);
    if (IN(11)) { final_norm(p, G); }
#undef IN
#undef SEAM
}

#ifndef MK_PER_PHASE
#define MK_PER_PHASE 0
#endif
#ifdef DBG_DUMP_OFF
__global__ void dump_kernel(const bf16_t* src, size_t n, float* out) {
    for (size_t i = (size_t)blockIdx.x * blockDim.x + threadIdx.x; i < (size_t)NTOK * DM; i += (size_t)gridDim.x * blockDim.x) {
        float s = 0.f; for (size_t j = i; j < n; j += (size_t)NTOK * DM) s += bf2f(src[j]); out[i] = s; }
}
#endif
extern "C" void kernel_launch(void* const* d_in, const int* in_sizes, int n_in, void* d_out, int out_size, void* d_ws, size_t ws_size, hipStream_t stream) {
    static int grid = 0;
    if (grid == 0) {
        if (n_in != 18 || ws_size < WS_NEED) { fprintf(stderr, "kernel_launch: expected 18 inputs and >= %zu bytes of workspace (got %d, %zu)\n", (size_t)WS_NEED, n_in, ws_size); grid = -1; return; }
        int dev = 0, cus = 0, per_cu = 0;
        (void)hipGetDevice(&dev); (void)hipDeviceGetAttribute(&cus, hipDeviceAttributeMultiprocessorCount, dev);
        if (hipFuncSetAttribute((const void*)fwd_megakernel, hipFuncAttributeMaxDynamicSharedMemorySize, LDS_BYTES) != hipSuccess) { fprintf(stderr, "kernel_launch: hipFuncSetAttribute failed\n"); grid = -1; return; }
        if (hipOccupancyMaxActiveBlocksPerMultiprocessor(&per_cu, (const void*)fwd_megakernel, NTHREADS, LDS_BYTES) != hipSuccess || per_cu < 1) { fprintf(stderr, "kernel_launch: occupancy query failed (%d)\n", per_cu); (void)hipGetLastError(); grid = -1; return; }
        grid = cus * per_cu;
    }
    if (grid < 0) return;
    Params p{};
    const float** pp = (const float**)&p;
    for (int i = 0; i < 18; ++i) pp[i] = (const float*)d_in[i];
    p.out = (float*)d_out; p.ws = (unsigned char*)d_ws;
#if MK_PER_PHASE
#ifndef DBG_HI
#define DBG_HI NPHASE
#endif
    for (int k = 0; k < DBG_HI; ++k) { p.ph_lo = k; p.ph_hi = k + 1; hipLaunchKernelGGL(fwd_megakernel, dim3(grid), dim3(NTHREADS), LDS_BYTES, stream, p);
#ifdef DBG_HOSTREP
        if (k == DBG_HOSTREP) hipLaunchKernelGGL(fwd_megakernel, dim3(grid), dim3(NTHREADS), LDS_BYTES, stream, p);
#endif
    }
#ifdef DBG_DUMP_OFF
    hipLaunchKernelGGL(dump_kernel, dim3(2048), dim3(256), 0, stream, (const bf16_t*)((unsigned char*)d_ws + (size_t)(DBG_DUMP_OFF) * MiB), (size_t)(DBG_DUMP_N), (float*)d_out);
#endif
#else
    p.ph_lo = 0; p.ph_hi = NPHASE;
    if (hipMemsetAsync((char*)d_ws + WS_CTL, 0, 16384, stream) != hipSuccess) { fprintf(stderr, "kernel_launch: hipMemsetAsync failed\n"); return; }
    void* args[] = {&p};
    const hipError_t e = hipLaunchCooperativeKernel((const void*)fwd_megakernel, dim3(grid), dim3(NTHREADS), args, LDS_BYTES, stream);
    if (e != hipSuccess) fprintf(stderr, "kernel_launch: cooperative launch failed: %s (grid %d)\n", hipGetErrorString(e), grid);
#endif
}
```
